# Optimizing an MI355X kernel written in HIP

```python
import math
import jax
import jax.numpy as jnp
from jax import lax
import numpy as np

D_MODEL = 1024
BATCH = 16
SEQ = 2048
DEPTH = 2

CTX_LEN = 256
GRID_W = 64
HEAD_DIM = 64
A_HEADS = D_MODEL // (2 * HEAD_DIM)
A_KV_HEADS = A_HEADS // 4
A_GROUP = A_HEADS // A_KV_HEADS
A_Q_BLOCK = 128
B_HEADS = D_MODEL // (4 * HEAD_DIM)
WIN_R = 8
WIN_C = 16
C_WIDTH = D_MODEL // 4
CONV_W = 3
A_WIDTH = A_HEADS * HEAD_DIM
A_KV_WIDTH = A_KV_HEADS * HEAD_DIM
B_WIDTH = B_HEADS * HEAD_DIM
MIX_WIDTH = A_WIDTH + B_WIDTH + C_WIDTH
IN_SIZES = (A_WIDTH, B_WIDTH, C_WIDTH, C_WIDTH, C_WIDTH, A_KV_WIDTH, A_KV_WIDTH, B_WIDTH, B_WIDTH)
KV_START = A_WIDTH + B_WIDTH + 3 * C_WIDTH
KV_SIZES = (A_KV_WIDTH, A_KV_WIDTH, B_WIDTH, B_WIDTH)
IN_WIDTH = KV_START + 2 * A_KV_WIDTH + 2 * B_WIDTH
D_FF = 256 * ((8 * D_MODEL // 3 + 255) // 256)
N_EXPERTS = 8
TOP_K = 2
MOE_BLOCK = 512
ROPE_THETA = 10000.0
NORM_EPS = 1e-6
NEG_INF = -1e30

kernel_name = 'hybrid_parallel_group_dit_block'


def rms_norm(x, gain=None):
    xf = x.astype(jnp.float32)
    y = (xf * lax.rsqrt(jnp.mean(xf * xf, axis=-1, keepdims=True) + NORM_EPS)).astype(x.dtype)
    return y if gain is None else y * gain


def modulate(x, shift, scale):
    return rms_norm(x) * (1 + scale) + shift


def split_cols(p, sizes):
    return jnp.split(p, np.cumsum(sizes)[:-1].tolist(), axis=-1)


def axial_rope_tables(n_tokens):
    t = jnp.arange(n_tokens)
    row = (t // GRID_W).astype(jnp.float32)
    col = (t % GRID_W).astype(jnp.float32)
    half = HEAD_DIM // 2
    inv_freq = ROPE_THETA ** (-jnp.arange(0, half, 2, dtype=jnp.float32) / half)
    ang_r = row[:, None] * inv_freq
    ang_c = col[:, None] * inv_freq
    return (jnp.cos(ang_r), jnp.sin(ang_r), jnp.cos(ang_c), jnp.sin(ang_c))


def axial_rope(x, tabs):
    cos_r, sin_r, cos_c, sin_c = tabs
    extra = x.ndim - 3

    def rot(u, cos, sin):
        cos = cos.reshape(cos.shape[0], *([1] * extra), cos.shape[1]).astype(u.dtype)
        sin = sin.reshape(sin.shape[0], *([1] * extra), sin.shape[1]).astype(u.dtype)
        u1, u2 = jnp.split(u, 2, axis=-1)
        return jnp.concatenate([u1 * cos - u2 * sin, u2 * cos + u1 * sin], axis=-1)

    xr, xc = jnp.split(x, 2, axis=-1)
    return jnp.concatenate([rot(xr, cos_r, sin_r), rot(xc, cos_c, sin_c)], axis=-1)


def gqa_attend(q, k, v):
    s = jnp.einsum('bqkgd,bskd->bkgqs', q, k, preferred_element_type=jnp.float32) * (HEAD_DIM ** -0.5)
    p = jax.nn.softmax(s, axis=-1).astype(v.dtype)
    return jnp.einsum('bkgqs,bskd->bqkgd', p, v)


def global_gqa(q, k, v, k_ctx, v_ctx):
    b, s = q.shape[:2]
    nb = s // A_Q_BLOCK
    k_all = jnp.concatenate([k, k_ctx], axis=1)
    v_all = jnp.concatenate([v, v_ctx], axis=1)
    qb = q.reshape(b, nb, A_Q_BLOCK, A_KV_HEADS, A_GROUP, HEAD_DIM).transpose(1, 0, 2, 3, 4, 5)
    o = lax.map(lambda q_blk: gqa_attend(q_blk, k_all, v_all), qb)
    return o.transpose(1, 0, 2, 3, 4, 5).reshape(b, s, A_WIDTH)


def neighbourhood_attn(q, k, v, k_ctx, v_ctx, rpb):
    b, s, n_heads, hd = q.shape
    rows = s // GRID_W
    wr = min(WIN_R, rows)
    r = np.arange(rows)
    rs = np.clip(r - wr // 2, 0, rows - wr)
    cc = np.arange(GRID_W)
    cs = np.clip(cc - WIN_C // 2, 0, GRID_W - WIN_C)
    dr_idx = rs[:, None] + np.arange(wr)[None, :] - r[:, None] + WIN_R - 1
    dc_idx = np.clip(cc[None, :] - cc[:, None] + WIN_C - 1, 0, 2 * WIN_C - 2)
    in_win = (cc[None, :] >= cs[:, None]) & (cc[None, :] < cs[:, None] + WIN_C)
    bias = rpb[:, dr_idx[:, :, None, None], dc_idx[None, None, :, :]].astype(jnp.float32)
    bias = jnp.where(in_win[None, None, None], bias, NEG_INF)
    bias = bias.transpose(1, 0, 3, 2, 4).reshape(rows, n_heads, GRID_W, wr * GRID_W)
    k_grid = k.reshape(b, rows, GRID_W, n_heads, hd)
    v_grid = v.reshape(b, rows, GRID_W, n_heads, hd)
    q_rows = q.reshape(b, rows, GRID_W, n_heads, hd).transpose(1, 0, 2, 3, 4)
    scale = hd ** -0.5

    def row_block(args):
        q_r, r0, bias_r = args
        k_band = lax.dynamic_slice_in_dim(k_grid, r0, wr, axis=1).reshape(b, wr * GRID_W, n_heads, hd)
        v_band = lax.dynamic_slice_in_dim(v_grid, r0, wr, axis=1).reshape(b, wr * GRID_W, n_heads, hd)
        s_lat = jnp.einsum('bqhd,bkhd->bhqk', q_r, k_band, preferred_element_type=jnp.float32) * scale + bias_r[None]
        s_ctx = jnp.einsum('bqhd,bkhd->bhqk', q_r, k_ctx, preferred_element_type=jnp.float32) * scale
        p = jax.nn.softmax(jnp.concatenate([s_lat, s_ctx], axis=-1), axis=-1).astype(v.dtype)
        v_all = jnp.concatenate([v_band, v_ctx], axis=1)
        return jnp.einsum('bhqk,bkhd->bqhd', p, v_all)

    o = lax.map(row_block, (q_rows, jnp.asarray(rs, jnp.int32), bias))
    return o.transpose(1, 0, 2, 3, 4).reshape(b, s, n_heads * hd)


def short_conv_mixer(u_post, u_pre, u_val, conv_w, conv_b):
    z = u_pre * u_val
    y = lax.conv_general_dilated(z, conv_w[:, None, :], window_strides=(1,),
                                 padding=((CONV_W // 2, CONV_W // 2),),
                                 dimension_numbers=('NWC', 'WIO', 'NWC'),
                                 feature_group_count=C_WIDTH) + conv_b
    return u_post * y


def merge_groups(oa, ob, oc, g_out, w_out):
    ga, gb, gc = split_cols(g_out, (A_WIDTH, B_WIDTH, C_WIDTH))
    cat = jnp.concatenate([rms_norm(oa, ga), rms_norm(ob, gb), rms_norm(oc, gc)], axis=-1)
    return cat @ w_out


def swiglu(h, w1, w3, w2):
    return (jax.nn.silu(h @ w1) * (h @ w3)) @ w2


def moe_swiglu(h, w_router, b_router, w1, w3, w2):
    shp = h.shape
    xf = h.reshape(-1, shp[-1])
    n = xf.shape[0]
    logits = (xf @ w_router).astype(jnp.float32) + b_router.astype(jnp.float32)
    top_v, top_e = lax.top_k(logits, TOP_K)
    gates = jax.nn.softmax(top_v, axis=-1)
    e_flat = top_e.reshape(-1)
    g_flat = gates.reshape(-1)
    tok = jnp.repeat(jnp.arange(n, dtype=jnp.int32), TOP_K)
    n_assign = n * TOP_K
    counts = jnp.zeros((N_EXPERTS,), jnp.int32).at[e_flat].add(1)
    padded = (counts + MOE_BLOCK - 1) // MOE_BLOCK * MOE_BLOCK
    pad_end = jnp.cumsum(padded)
    pad_start = pad_end - padded
    start = jnp.cumsum(counts) - counts
    order = jnp.argsort(e_flat)
    e_sorted = e_flat[order]
    dest = pad_start[e_sorted] + jnp.arange(n_assign, dtype=jnp.int32) - start[e_sorted]
    n_blocks = -(-n_assign // MOE_BLOCK) + N_EXPERTS
    cap = n_blocks * MOE_BLOCK
    buf_tok = jnp.zeros((cap,), jnp.int32).at[dest].set(tok[order])
    buf_gate = jnp.zeros((cap,), jnp.float32).at[dest].set(g_flat[order])
    blk_e = jnp.minimum(jnp.searchsorted(pad_end, jnp.arange(n_blocks, dtype=jnp.int32) * MOE_BLOCK, side='right'),
                        N_EXPERTS - 1).astype(jnp.int32)
    xb = xf[buf_tok].reshape(n_blocks, MOE_BLOCK, shp[-1])

    def expert_block(args):
        x_blk, e = args
        return swiglu(x_blk, w1[e], w3[e], w2[e])

    yb = lax.map(expert_block, (xb, blk_e)).reshape(cap, shp[-1])
    y = jax.ops.segment_sum(yb * buf_gate[:, None].astype(yb.dtype), buf_tok, num_segments=n)
    return y.reshape(shp)


def setup_inputs(seed: int = 0) -> dict:
    key = jax.random.key(seed)
    ks = iter(jax.random.split(key, 32))
    n_dense = (DEPTH + 1) // 2
    n_moe = DEPTH // 2

    def nrm(shape, scale):
        return jax.random.normal(next(ks), shape, jnp.float32) * scale

    return {
        'x': nrm((BATCH, SEQ, D_MODEL), 1.0),
        'c': nrm((BATCH, D_MODEL), 1.0),
        'ctx': nrm((BATCH, CTX_LEN, D_MODEL), 1.0),
        'c_ctx': nrm((D_MODEL,), 1.0),
        'w_mod': nrm((DEPTH, D_MODEL, 6 * D_MODEL), 0.5 * D_MODEL ** -0.5),
        'b_mod': nrm((DEPTH, 6 * D_MODEL), 0.02),
        'w_in': nrm((DEPTH, D_MODEL, IN_WIDTH), D_MODEL ** -0.5),
        'gq_a': 1.0 + nrm((DEPTH, HEAD_DIM), 0.02),
        'gk_a': 1.0 + nrm((DEPTH, HEAD_DIM), 0.02),
        'gq_b': 1.0 + nrm((DEPTH, HEAD_DIM), 0.02),
        'gk_b': 1.0 + nrm((DEPTH, HEAD_DIM), 0.02),
        'rpb': nrm((DEPTH, B_HEADS, 2 * WIN_R - 1, 2 * WIN_C - 1), 0.1),
        'conv_w': nrm((DEPTH, CONV_W, C_WIDTH), CONV_W ** -0.5),
        'conv_b': nrm((DEPTH, C_WIDTH), 0.02),
        'g_out': 1.0 + nrm((DEPTH, MIX_WIDTH), 0.02),
        'w_out': nrm((DEPTH, MIX_WIDTH, D_MODEL), MIX_WIDTH ** -0.5),
        'ffn_w1': nrm((n_dense, D_MODEL, D_FF), D_MODEL ** -0.5),
        'ffn_w3': nrm((n_dense, D_MODEL, D_FF), D_MODEL ** -0.5),
        'ffn_w2': nrm((n_dense, D_FF, D_MODEL), D_FF ** -0.5),
        'moe_router': nrm((n_moe, D_MODEL, N_EXPERTS), D_MODEL ** -0.5),
        'moe_router_b': nrm((n_moe, N_EXPERTS), 0.01),
        'moe_w1': nrm((n_moe, N_EXPERTS, D_MODEL, D_FF), D_MODEL ** -0.5),
        'moe_w3': nrm((n_moe, N_EXPERTS, D_MODEL, D_FF), D_MODEL ** -0.5),
        'moe_w2': nrm((n_moe, N_EXPERTS, D_FF, D_MODEL), D_FF ** -0.5),
    }


def reference(x, c, ctx, c_ctx, w_mod, b_mod, w_in, gq_a, gk_a, gq_b, gk_b, rpb, conv_w, conv_b,
              g_out, w_out, ffn_w1, ffn_w3, ffn_w2, moe_router, moe_router_b, moe_w1, moe_w3, moe_w2):
    b, s, _ = x.shape
    n_ctx = ctx.shape[1]
    tabs = axial_rope_tables(s)
    silu_c = jax.nn.silu(c)
    silu_cc = jax.nn.silu(c_ctx)
    for l in range(DEPTH):
        last = l == DEPTH - 1
        mx = (silu_c @ w_mod[l] + b_mod[l])[:, None, :]
        mc = silu_cc @ w_mod[l] + b_mod[l]
        sh_a, sc_a, g_a, sh_f, sc_f, g_f = jnp.split(mx, 6, axis=-1)
        csh_a, csc_a, cg_a, csh_f, csc_f, cg_f = jnp.split(mc, 6, axis=-1)

        hx = modulate(x, sh_a, sc_a)
        hc = modulate(ctx, csh_a, csc_a)
        aq, bq, cpost, cpre, cval, ak, av, bk, bv = split_cols(hx @ w_in[l], IN_SIZES)
        if last:
            akc, avc, bkc, bvc = split_cols(hc @ w_in[l][:, KV_START:], KV_SIZES)
        else:
            aqc, bqc, cpostc, cprec, cvalc, akc, avc, bkc, bvc = split_cols(hc @ w_in[l], IN_SIZES)

        qa = axial_rope(rms_norm(aq.reshape(b, s, A_KV_HEADS, A_GROUP, HEAD_DIM), gq_a[l]), tabs)
        ka = axial_rope(rms_norm(ak.reshape(b, s, A_KV_HEADS, HEAD_DIM), gk_a[l]), tabs)
        va = av.reshape(b, s, A_KV_HEADS, HEAD_DIM)
        kac = rms_norm(akc.reshape(b, n_ctx, A_KV_HEADS, HEAD_DIM), gk_a[l])
        vac = avc.reshape(b, n_ctx, A_KV_HEADS, HEAD_DIM)
        oa = global_gqa(qa, ka, va, kac, vac)

        qb_ = rms_norm(bq.reshape(b, s, B_HEADS, HEAD_DIM), gq_b[l])
        kb_ = rms_norm(bk.reshape(b, s, B_HEADS, HEAD_DIM), gk_b[l])
        vb_ = bv.reshape(b, s, B_HEADS, HEAD_DIM)
        kbc = rms_norm(bkc.reshape(b, n_ctx, B_HEADS, HEAD_DIM), gk_b[l])
        vbc = bvc.reshape(b, n_ctx, B_HEADS, HEAD_DIM)
        ob = neighbourhood_attn(qb_, kb_, vb_, kbc, vbc, rpb[l])

        oc = short_conv_mixer(cpost, cpre, cval, conv_w[l], conv_b[l])

        x = x + g_a * merge_groups(oa, ob, oc, g_out[l], w_out[l])

        if not last:
            qac = rms_norm(aqc.reshape(b, n_ctx, A_KV_HEADS, A_GROUP, HEAD_DIM), gq_a[l])
            oac = gqa_attend(qac, kac, vac).reshape(b, n_ctx, A_WIDTH)
            qbc = rms_norm(bqc.reshape(b, n_ctx, B_HEADS, 1, HEAD_DIM), gq_b[l])
            obc = gqa_attend(qbc, kbc, vbc).reshape(b, n_ctx, B_WIDTH)
            occ = short_conv_mixer(cpostc, cprec, cvalc, conv_w[l], conv_b[l])
            ctx = ctx + cg_a * merge_groups(oac, obc, occ, g_out[l], w_out[l])

        hx = modulate(x, sh_f, sc_f)
        if l % 2 == 0:
            i = l // 2
            x = x + g_f * swiglu(hx, ffn_w1[i], ffn_w3[i], ffn_w2[i])
            if not last:
                hc2 = modulate(ctx, csh_f, csc_f)
                ctx = ctx + cg_f * swiglu(hc2, ffn_w1[i], ffn_w3[i], ffn_w2[i])
        else:
            i = l // 2
            x = x + g_f * moe_swiglu(hx, moe_router[i], moe_router_b[i], moe_w1[i], moe_w3[i], moe_w2[i])
            if not last:
                hc2 = modulate(ctx, csh_f, csc_f)
                ctx = ctx + cg_f * moe_swiglu(hc2, moe_router[i], moe_router_b[i], moe_w1[i], moe_w3[i], moe_w2[i])
    return x
```

```cpp
#define MK_N_LAUNCHES 1
#include <hip/hip_runtime.h>
#include <cstdio>
#include <cstdint>
#include <cstddef>
#include <cmath>
namespace pg8 {
#define PG8_LAS __attribute__((address_space(3)))
typedef unsigned short bf16_t;
typedef short bf16x8 __attribute__((ext_vector_type(8)));
typedef float f32x4 __attribute__((ext_vector_type(4)));
typedef unsigned u32x4 __attribute__((ext_vector_type(4)));
constexpr int BM = 256, BK = 64, HALF = 128, HTB = HALF * BK * 2  , STAGE_BYTES = 8 * HTB, NXCD = 8, WGM = 8;

__host__ __device__ __forceinline__ int lds_byte(int r, int c) { const int st = (r >> 4) * 2 + (c >> 5), rr = r & 15, cc = c & 31, ob = rr * 64 + cc * 2; return st * 1024 + (ob ^ (((ob >> 9) & 1) << 5)); }
__host__ __device__ __forceinline__ void stage_rc(int b, int& R, int& C) { const int st = b / 1024, sb = b % 1024, swz = sb ^ (((sb >> 9) & 1) << 5); R = (st >> 1) * 16 + swz / 64; C = (st & 1) * 32 + (swz % 64) / 2; }
__host__ __device__ __forceinline__ int perm32(int rho) { const int n = rho >> 4, i = rho & 15; return 8 * (i >> 2) + 4 * n + (i & 3); }

struct Unit { int pm, pn, e; };
struct Gemm { const bf16_t* A; const bf16_t* Bt; int M, N, K; };

struct StaticOrder {
    int nM, nN, nwg, G, c;
    __host__ __device__ void init(int M, int N, int G_, int c_) { nM = M / BM; nN = N / BM; nwg = nM * nN; G = G_; c = c_; }
    __host__ __device__ bool next(int i, Unit& u) const {
        const long L = (long)i * G + c; if (L >= nwg) return false;
        int wgid = (int)L; { const int q = nwg / NXCD, r = nwg % NXCD, xcd = wgid % NXCD, off = wgid / NXCD; wgid = (xcd < r ? xcd * (q + 1) : r * (q + 1) + (xcd - r) * q) + off; }
        const int nig = WGM * nN, gid = wgid / nig, fm = gid * WGM, gsz = (nM - fm) < WGM ? (nM - fm) : WGM;
        u.pm = fm + ((wgid % nig) % gsz); u.pn = (wgid % nig) / gsz; return true;
    }
    __device__ __forceinline__ void a_ready(const Unit&) const {}
    __device__ __forceinline__ void done(const Unit&) const {}
};

__device__ __forceinline__ unsigned cvt_pk_bf16(float lo, float hi) { unsigned r; asm volatile("v_cvt_pk_bf16_f32 %0, %1, %2" : "=v"(r) : "v"(lo), "v"(hi)); return r; }
typedef float f32x2 __attribute__((ext_vector_type(2)));
__device__ __forceinline__ f32x2 gelu_pk(f32x2 v) {
    const f32x2 av = __builtin_elementwise_abs(v), d = av * 0.2316418882f + 1.0f;
    f32x2 t; t.x = __builtin_amdgcn_rcpf(d.x); t.y = __builtin_amdgcn_rcpf(d.y);
    f32x2 q = t * 0.5307027145f + (-0.7265760135f); q = q * t + 0.7107068705f; q = q * t + (-0.142248368f); q = q * t + 0.127414796f; q = q * t;
    const f32x2 s = (v * v) * (-0.72134752044f);
    f32x2 e; e.x = __builtin_amdgcn_exp2f(s.x); e.y = __builtin_amdgcn_exp2f(s.y);
    const f32x2 m = v * (q * e), r = v - m;
    f32x2 o; o.x = v.x < 0.f ? m.x : r.x; o.y = v.y < 0.f ? m.y : r.y; return o;
}

template <int ACT  > struct EpiBf16 {
    static constexpr bool PERM = true, AFTER_DRAIN = false; static_assert(ACT == 0 || ACT == 1, "EpiBf16: ACT is 0 (none) or 1 (gelu_pk)");
    bf16_t* O; int ldc; const float* bias; int split_cols; size_t split_stride; float scale0;
    __device__ __forceinline__ void operator()(const f32x4 (&acc)[2][2][4][2], const Unit& u, int wr, int wc, int fr, int fq) const {
        const int row0 = u.pm * BM + wr * 64 + fr; int colt = u.pn * BM; bf16_t* base = O;
        float sc = 1.f; if (split_cols) { const int t = colt / split_cols; base += (size_t)t * split_stride; colt -= t * split_cols; if (t == 0) sc = scale0; }
        const int col0 = colt + wc * 32 + 8 * fq, bcol0 = u.pn * BM + wc * 32 + 8 * fq;
        f32x4 bv[2][2];
#pragma unroll
        for (int bj = 0; bj < 2; ++bj)
#pragma unroll
            for (int n = 0; n < 2; ++n) bv[bj][n] = bias ? *(const f32x4*)(bias + bcol0 + bj * HALF + 4 * n) : (f32x4){0.f, 0.f, 0.f, 0.f};
#pragma unroll
        for (int ai = 0; ai < 2; ++ai)
#pragma unroll
            for (int m = 0; m < 4; ++m) { bf16_t* rowp = base + (size_t)(row0 + ai * HALF + m * 16) * ldc + col0;
#pragma unroll
                for (int bj = 0; bj < 2; ++bj) { f32x4 v0 = acc[ai][bj][m][0] + bv[bj][0], v1 = acc[ai][bj][m][1] + bv[bj][1];
                    if (ACT == 1) { f32x2 a = gelu_pk((f32x2){v0[0], v0[1]}), b = gelu_pk((f32x2){v0[2], v0[3]}), c = gelu_pk((f32x2){v1[0], v1[1]}), d = gelu_pk((f32x2){v1[2], v1[3]});
                        v0 = (f32x4){a.x, a.y, b.x, b.y}; v1 = (f32x4){c.x, c.y, d.x, d.y}; }
                    v0 = v0 * sc; v1 = v1 * sc; u32x4 w; w.x = cvt_pk_bf16(v0[0], v0[1]); w.y = cvt_pk_bf16(v0[2], v0[3]); w.z = cvt_pk_bf16(v1[0], v1[1]); w.w = cvt_pk_bf16(v1[2], v1[3]);
                    *(u32x4*)(rowp + bj * HALF) = w; } }
    }
};

struct TabOrder {
    const volatile PG8_LAS unsigned* tab;
    __device__ __forceinline__ bool next(int i, Unit& u) const {
        if (i >= 32) return false;
        const volatile PG8_LAS unsigned* r = tab + 8 * i;
        if (__builtin_amdgcn_readfirstlane(r[6]) == 0u) return false;
        u.pm = (int)__builtin_amdgcn_readfirstlane(r[4]); u.pn = (int)__builtin_amdgcn_readfirstlane(r[5]); u.e = i; return true;
    }
    __device__ __forceinline__ const char* abase(const Unit& u, size_t) const { const volatile PG8_LAS unsigned* r = tab + 8 * u.e; const unsigned lo = __builtin_amdgcn_readfirstlane(r[0]), hi = __builtin_amdgcn_readfirstlane(r[1]); return (const char*)(((unsigned long long)hi << 32) | lo); }
    __device__ __forceinline__ const char* bbase(const Unit& u, size_t) const { const volatile PG8_LAS unsigned* r = tab + 8 * u.e; const unsigned lo = __builtin_amdgcn_readfirstlane(r[2]), hi = __builtin_amdgcn_readfirstlane(r[3]); return (const char*)(((unsigned long long)hi << 32) | lo); }
    __device__ __forceinline__ void a_ready(const Unit&) const {}
    __device__ __forceinline__ void done(const Unit&) const {}
};
__device__ __forceinline__ TabOrder build_units(PG8_LAS unsigned char* tabmem, int K, const void* A, const void* B, int G, int c,
                                                int np0, int nn0, int cn0, int mode0, int poff0, int np1, int nn1, int cn1, int mode1, const int* pend, size_t estride) {
    __syncthreads();
    if (threadIdx.x < 32) {
        int i_ = (int)threadIdx.x; asm volatile("" : "+v"(i_)); const int i = i_;
        const int n0 = np0 * nn0, nwg = n0 + np1 * nn1; const long L = (long)i * G + c; const bool ok = L < nwg;
        int w = ok ? (int)L : 0; { const int q = nwg / NXCD, r = nwg % NXCD, xcd = w % NXCD, off = w / NXCD; w = (xcd < r ? xcd * (q + 1) : r * (q + 1) + (xcd - r) * q) + off; }
        const bool s0 = w < n0; const int ww = s0 ? w : w - n0; const int np = s0 ? np0 : np1, nn = s0 ? nn0 : nn1, cn = s0 ? cn0 : cn1, mode = s0 ? mode0 : mode1;
        const int nig = WGM * nn, gid = ww / nig, fm = gid * WGM, gsz = (np - fm) < WGM ? (np - fm) : WGM;
        const int pv = fm + ((ww % nig) % gsz), pn = cn + (ww % nig) / gsz;
        const int pm0 = pv + poff0, pm1 = pv + (pv >> 3), pm2 = 9 * pv + 8; const int pm = mode == 0 ? pm0 : (mode == 1 ? pm1 : pm2);
        int e = 0;
        if (pend) {
#pragma unroll
            for (int k = 0; k < 8; ++k) e += (pend[k] <= pm) ? 1 : 0;
        }
        const size_t tstep = (size_t)256 * K * 2;
        const unsigned long long a = (unsigned long long)((const char*)A + (size_t)pm * tstep), b = (unsigned long long)((const char*)B + (size_t)e * estride + (size_t)pn * tstep);
        PG8_LAS unsigned* r = (PG8_LAS unsigned*)tabmem + 8 * i;
        r[0] = (unsigned)a; r[1] = (unsigned)(a >> 32); r[2] = (unsigned)b; r[3] = (unsigned)(b >> 32); r[4] = (unsigned)pm; r[5] = (unsigned)pn; r[6] = ok ? 1u : 0u; r[7] = 0u; }
    __syncthreads();
    TabOrder T; T.tab = (const volatile PG8_LAS unsigned*)tabmem; return T;
}

struct EpiRawBf16 {
    static constexpr bool PERM = true, AFTER_DRAIN = false;
    bf16_t* O; int ldc;
    __device__ __forceinline__ void operator()(const f32x4 (&acc)[2][2][4][2], const Unit& u, int wr, int wc, int fr, int fq) const {
        const int row0 = u.pm * BM + wr * 64 + fr, col0 = u.pn * BM + wc * 32 + 8 * fq;
#pragma unroll
        for (int ai = 0; ai < 2; ++ai)
#pragma unroll
            for (int m = 0; m < 4; ++m) { bf16_t* rowp = O + (size_t)(row0 + ai * HALF + m * 16) * ldc + col0;
#pragma unroll
                for (int bj = 0; bj < 2; ++bj) { const f32x4 v0 = acc[ai][bj][m][0], v1 = acc[ai][bj][m][1];
                    u32x4 w; w.x = cvt_pk_bf16(v0[0], v0[1]); w.y = cvt_pk_bf16(v0[2], v0[3]); w.z = cvt_pk_bf16(v1[0], v1[1]); w.w = cvt_pk_bf16(v1[2], v1[3]);
                    *(u32x4*)(rowp + bj * HALF) = w; } }
    }
};
struct EpiGateRes {
    static constexpr bool PERM = false, AFTER_DRAIN = false;
    const float* xin_lat; const float* xin_ctx; float* xout_lat; float* xout_ctx; const float* mod; int goff;
    __device__ __forceinline__ void operator()(const f32x4 (&acc)[2][2][4][2], const Unit& u, int wr, int wc, int fr, int fq) const {
        const int b = u.pm / 9, j = u.pm % 9;
        const float* bi; float* bo; const float* g;
        if (j < 8) { const size_t r0 = (size_t)(b * 2048 + j * 256) * 1024; bi = xin_lat + r0; bo = xout_lat + r0; g = mod + b * 6144 + goff; }
        else { const size_t r0 = (size_t)(b * 256) * 1024; bi = xin_ctx + r0; bo = xout_ctx + r0; g = mod + 16 * 6144 + goff; }
        const int col0 = u.pn * BM + wc * 32 + 4 * fq;
        f32x4 gv[2][2];
#pragma unroll
        for (int bj = 0; bj < 2; ++bj)
#pragma unroll
            for (int n = 0; n < 2; ++n) gv[bj][n] = *(const f32x4*)(g + col0 + bj * HALF + n * 16);
#pragma unroll
        for (int ai = 0; ai < 2; ++ai)
#pragma unroll
            for (int m = 0; m < 4; ++m) { const size_t off = (size_t)(ai * HALF + wr * 64 + m * 16 + fr) * 1024 + col0;
#pragma unroll
                for (int bj = 0; bj < 2; ++bj)
#pragma unroll
                    for (int n = 0; n < 2; ++n) { const f32x4 xi = *(const f32x4*)(bi + off + bj * HALF + n * 16);
                        *(f32x4*)(bo + off + bj * HALF + n * 16) = xi + gv[bj][n] * acc[ai][bj][m][n]; }
                if (m & 1) asm volatile("" ::: "memory"); }
    }
};
struct EpiSwiglu {
    static constexpr bool PERM = true, AFTER_DRAIN = false;
    bf16_t* H; int ldh; int p0;
    __device__ __forceinline__ void operator()(const f32x4 (&acc)[2][2][4][2], const Unit& u, int wr, int wc, int fr, int fq) const {
        const int row0 = (u.pm - p0) * BM + wr * 64 + fr, col0 = u.pn * HALF + wc * 32 + 8 * fq;
#pragma unroll
        for (int ai = 0; ai < 2; ++ai)
#pragma unroll
            for (int m = 0; m < 4; ++m) { bf16_t* rowp = H + (size_t)(row0 + ai * HALF + m * 16) * ldh + col0;
                float h[8];
#pragma unroll
                for (int n = 0; n < 2; ++n)
#pragma unroll
                    for (int k = 0; k < 4; ++k) { const float a = acc[ai][0][m][n][k], b3 = acc[ai][1][m][n][k];
                        const float sg = __builtin_amdgcn_rcpf(1.0f + __builtin_amdgcn_exp2f(-1.4426950408889634f * a)); h[n * 4 + k] = a * sg * b3; }
                u32x4 w; w.x = cvt_pk_bf16(h[0], h[1]); w.y = cvt_pk_bf16(h[2], h[3]); w.z = cvt_pk_bf16(h[4], h[5]); w.w = cvt_pk_bf16(h[6], h[7]);
                *(u32x4*)rowp = w; }
    }
};
struct EpiMoeOut {
    static constexpr bool PERM = true, AFTER_DRAIN = false;
    bf16_t* Y; const float* sgate;
    __device__ __forceinline__ void operator()(const f32x4 (&acc)[2][2][4][2], const Unit& u, int wr, int wc, int fr, int fq) const {
        const int row0 = u.pm * BM + wr * 64 + fr, col0 = u.pn * BM + wc * 32 + 8 * fq;
#pragma unroll
        for (int ai = 0; ai < 2; ++ai)
#pragma unroll
            for (int m = 0; m < 4; ++m) { const int row = row0 + ai * HALF + m * 16; const float gt = sgate[row]; bf16_t* rowp = Y + (size_t)row * 1024 + col0;
#pragma unroll
                for (int bj = 0; bj < 2; ++bj) { const f32x4 v0 = acc[ai][bj][m][0] * gt, v1 = acc[ai][bj][m][1] * gt;
                    u32x4 w; w.x = cvt_pk_bf16(v0[0], v0[1]); w.y = cvt_pk_bf16(v0[2], v0[3]); w.z = cvt_pk_bf16(v1[0], v1[1]); w.w = cvt_pk_bf16(v1[2], v1[3]);
                    *(u32x4*)(rowp + bj * HALF) = w; } }
    }
};
template <class Epi, class Sched, bool ALIGN_EPI = false, bool SP2 = false>
__device__ __forceinline__ void gemm_phase(PG8_LAS unsigned char* lds, const Gemm g, const Sched& S, const Epi& E) {
    int tid_ = threadIdx.x; asm volatile("" : "+v"(tid_));
    const int tid = tid_, wid = __builtin_amdgcn_readfirstlane(tid >> 6), lane = tid & 63, wr = wid >> 2, wc = wid & 3, fr = lane & 15, fq = lane >> 4;
    const int K = g.K, nt = K / BK;
    unsigned voffA[2], voffB[2];
#pragma unroll
    for (int i = 0; i < 2; ++i) { int R, C; stage_rc(tid * 16 + i * 8192, R, C); const int Rb = Epi::PERM ? ((R & ~31) + perm32(R & 31)) : R;
        voffA[i] = (unsigned)(R * K + C) * 2u; voffB[i] = (unsigned)(Rb * K + C) * 2u; }
    const size_t kstep = (size_t)(BK * 2);
    const size_t hstep = (size_t)HALF * K * 2;
    const size_t tstep = 2 * hstep;
    const unsigned ldsw = (unsigned)wid * 1024u;
    const int aoff = lds_byte(wr * 64 + fr, fq * 8), boff = lds_byte(wc * 32 + fr, fq * 8);
#define PG8_SA(b, h) (((b) * 2 + (h)) * HTB)
#define PG8_SB(b, h) ((4 + (b) * 2 + (h)) * HTB)
#define PG8_STAGE(bufoff, gbase, voff) do { _Pragma("unroll") for (int _i = 0; _i < 2; ++_i) \
        __builtin_amdgcn_global_load_lds((const unsigned*)((const char*)(gbase) + (voff)[_i]), (PG8_LAS unsigned*)(lds + (bufoff) + ldsw + _i * 8192), 16, 0, 0); } while (0)
#define PG8_LDA(dst, b, h) do { _Pragma("unroll") for (int m = 0; m < 4; ++m) _Pragma("unroll") for (int k = 0; k < 2; ++k) dst[m][k] = *(const PG8_LAS bf16x8*)(lds + PG8_SA(b, h) + aoff + m * 2048 + k * 1024); } while (0)
#define PG8_LDB(dst, b, h) do { _Pragma("unroll") for (int n = 0; n < 2; ++n) _Pragma("unroll") for (int k = 0; k < 2; ++k) dst[n][k] = *(const PG8_LAS bf16x8*)(lds + PG8_SB(b, h) + boff + n * 2048 + k * 1024); } while (0)
#define PG8_MMA(ai, bj, At, Bt) do { __builtin_amdgcn_s_setprio(1); _Pragma("unroll") for (int m = 0; m < 4; ++m) _Pragma("unroll") for (int n = 0; n < 2; ++n) _Pragma("unroll") for (int k = 0; k < 2; ++k) \
        acc[ai][bj][m][n] = __builtin_amdgcn_mfma_f32_16x16x32_bf16(Bt[n][k], At[m][k], acc[ai][bj][m][n], 0, 0, 0); __builtin_amdgcn_s_setprio(0); } while (0)
#define PG8_WAIT_V(n) asm volatile("s_waitcnt vmcnt(" #n ")" ::: "memory")
#define PG8_WAIT_L(n) asm volatile("s_waitcnt lgkmcnt(" #n ")" ::: "memory")
#define PG8_BAR __builtin_amdgcn_s_barrier()
#define PG8_SCHED __builtin_amdgcn_sched_barrier(0)
    Unit cur, nxt; int ui = 0;
    if (!S.next(0, cur)) return;
    f32x4 acc[2][2][4][2];
#pragma unroll
    for (int a = 0; a < 2; ++a)
#pragma unroll
        for (int b = 0; b < 2; ++b)
#pragma unroll
            for (int m = 0; m < 4; ++m)
#pragma unroll
                for (int n = 0; n < 2; ++n) acc[a][b][m][n] = (f32x4){0.f, 0.f, 0.f, 0.f};
    bf16x8 At[4][2], B0[2][2], B1[2][2];
    const char* cA = S.abase(cur, tstep); const char* cB = S.bbase(cur, tstep);
    S.a_ready(cur);
    if constexpr (SP2) {
        PG8_STAGE(PG8_SB(0, 0), cB, voffB); PG8_STAGE(PG8_SB(0, 1), cB + hstep, voffB); PG8_STAGE(PG8_SA(0, 0), cA, voffA); PG8_STAGE(PG8_SA(0, 1), cA + hstep, voffA);
        if (wr == 1) PG8_BAR;
        PG8_WAIT_V(2); PG8_BAR;
        PG8_STAGE(PG8_SB(1, 0), cB + kstep, voffB); PG8_STAGE(PG8_SA(1, 0), cA + kstep, voffA); PG8_STAGE(PG8_SB(1, 1), cB + hstep + kstep, voffB);
        PG8_WAIT_V(6); PG8_BAR;
    } else {
        PG8_STAGE(PG8_SB(0, 0), cB, voffB); PG8_STAGE(PG8_SA(0, 0), cA, voffA); PG8_STAGE(PG8_SB(0, 1), cB + hstep, voffB); PG8_STAGE(PG8_SA(0, 1), cA + hstep, voffA);
        if (wr == 1) PG8_BAR;
        PG8_WAIT_V(4); PG8_BAR;
        PG8_STAGE(PG8_SB(1, 0), cB + kstep, voffB); PG8_STAGE(PG8_SA(1, 0), cA + kstep, voffA); PG8_STAGE(PG8_SB(1, 1), cB + hstep + kstep, voffB);
        PG8_WAIT_V(6); PG8_BAR;
    }
    for (;;) {
        const bool has_next = S.next(ui + 1, nxt);
        const char* nA = has_next ? S.abase(nxt, tstep) : cA; const char* nB = has_next ? S.bbase(nxt, tstep) : cB;
        for (int t = 0; t < nt; t += 2) {
            const bool last = (t == nt - 2);
            const char* a1 = cA + (size_t)(t + 1) * kstep;
            const char* a2 = last ? nA : cA + (size_t)(t + 2) * kstep; const char* b2 = last ? nB : cB + (size_t)(t + 2) * kstep;
            const char* a3 = a2 + kstep; const char* b3 = b2 + kstep;
            if (last && has_next) S.a_ready(nxt);
            if constexpr (SP2) {
            PG8_LDB(B0, 0, 0); PG8_LDB(B1, 0, 1); PG8_SCHED; PG8_LDA(At, 0, 0); PG8_STAGE(PG8_SA(1, 1), a1 + hstep, voffA);
            PG8_WAIT_V(8); PG8_WAIT_L(0); PG8_BAR; PG8_MMA(0, 0, At, B0); PG8_MMA(0, 1, At, B1); PG8_BAR; PG8_SCHED;
            PG8_LDA(At, 0, 1); PG8_STAGE(PG8_SB(0, 0), b2, voffB); PG8_STAGE(PG8_SB(0, 1), b2 + hstep, voffB); PG8_STAGE(PG8_SA(0, 0), a2, voffA);
            PG8_WAIT_V(8); PG8_WAIT_L(0); PG8_BAR; PG8_MMA(1, 0, At, B0); PG8_MMA(1, 1, At, B1); PG8_BAR; PG8_SCHED;
            PG8_LDB(B0, 1, 0); PG8_LDB(B1, 1, 1); PG8_SCHED; PG8_LDA(At, 1, 0); PG8_STAGE(PG8_SA(0, 1), a2 + hstep, voffA);
            PG8_WAIT_V(8); PG8_WAIT_L(0); PG8_BAR; PG8_MMA(0, 0, At, B0); PG8_MMA(0, 1, At, B1); PG8_BAR; PG8_SCHED;
            PG8_LDA(At, 1, 1); PG8_STAGE(PG8_SB(1, 0), b3, voffB); PG8_STAGE(PG8_SB(1, 1), b3 + hstep, voffB); PG8_STAGE(PG8_SA(1, 0), a3, voffA);
            PG8_WAIT_V(8); PG8_WAIT_L(0); PG8_BAR; PG8_MMA(1, 0, At, B0); PG8_MMA(1, 1, At, B1); PG8_BAR; PG8_SCHED;
            } else {
            PG8_LDB(B0, 0, 0); PG8_SCHED; PG8_LDA(At, 0, 0); PG8_STAGE(PG8_SA(1, 1), a1 + hstep, voffA);
            PG8_WAIT_L(8); PG8_BAR; PG8_WAIT_L(0); PG8_MMA(0, 0, At, B0); PG8_BAR; PG8_SCHED;
            PG8_LDB(B1, 0, 1); PG8_STAGE(PG8_SB(0, 0), b2, voffB);
            PG8_BAR; PG8_WAIT_L(0); PG8_MMA(0, 1, At, B1); PG8_BAR;
            PG8_LDA(At, 0, 1); PG8_STAGE(PG8_SA(0, 0), a2, voffA);
            PG8_BAR; PG8_WAIT_L(0); PG8_MMA(1, 0, At, B0); PG8_BAR; PG8_SCHED;
            PG8_STAGE(PG8_SB(0, 1), b2 + hstep, voffB);
            PG8_WAIT_V(6); PG8_BAR; PG8_MMA(1, 1, At, B1); PG8_BAR;
            PG8_LDB(B0, 1, 0); PG8_SCHED; PG8_LDA(At, 1, 0); PG8_STAGE(PG8_SA(0, 1), a2 + hstep, voffA);
            PG8_WAIT_L(8); PG8_BAR; PG8_WAIT_L(0); PG8_MMA(0, 0, At, B0); PG8_BAR; PG8_SCHED;
            PG8_LDB(B1, 1, 1); PG8_STAGE(PG8_SB(1, 0), b3, voffB);
            PG8_BAR; PG8_WAIT_L(0); PG8_MMA(0, 1, At, B1); PG8_BAR;
            PG8_LDA(At, 1, 1); PG8_STAGE(PG8_SA(1, 0), a3, voffA);
            PG8_BAR; PG8_WAIT_L(0); PG8_MMA(1, 0, At, B0); PG8_BAR; PG8_SCHED;
            PG8_STAGE(PG8_SB(1, 1), b3 + hstep, voffB);
            PG8_WAIT_V(6); PG8_BAR; PG8_MMA(1, 1, At, B1); PG8_BAR;
            }
        }
        if constexpr (ALIGN_EPI) { if (wr == 0) PG8_BAR; }
        if constexpr (!Epi::AFTER_DRAIN) { E(acc, cur, wr, wc, fr, fq); S.done(cur); }
        if (!has_next) break;
#pragma unroll
        for (int a = 0; a < 2; ++a)
#pragma unroll
            for (int b = 0; b < 2; ++b)
#pragma unroll
                for (int m = 0; m < 4; ++m)
#pragma unroll
                    for (int n = 0; n < 2; ++n) acc[a][b][m][n] = (f32x4){0.f, 0.f, 0.f, 0.f};
        cur = nxt; cA = nA; cB = nB; ++ui;
        if constexpr (ALIGN_EPI) { if (wr == 1) PG8_BAR; }
    }
    PG8_WAIT_V(0);
    if constexpr (!ALIGN_EPI) { if (wr == 0) PG8_BAR; }
    PG8_BAR;
    if constexpr (Epi::AFTER_DRAIN) { E.fused(acc, cur, wr, wc, fr, fq, lds, wid, lane); S.done(cur); }
#undef PG8_SA
#undef PG8_SB
#undef PG8_STAGE
#undef PG8_LDA
#undef PG8_LDB
#undef PG8_MMA
#undef PG8_WAIT_V
#undef PG8_WAIT_L
#undef PG8_BAR
#undef PG8_SCHED
}
}

constexpr int NWAVES = 8;
#ifndef MK_N_LAUNCHES
#define MK_N_LAUNCHES 1
#endif
constexpr int NPH = 23;
constexpr int BATCH = 16, SEQ = 2048, DM = 1024, CTXL = 256, TPB = SEQ + CTXL, MROWS = BATCH * TPB, NPAN = MROWS / 256;
constexpr int INW = 2304, DFF = 2816, NEXP = 8, NTOK = BATCH * SEQ;
constexpr int QA_OFF = 0, QB_OFF = 512, CPOST_OFF = 768, CPRE_OFF = 1024, CVAL_OFF = 1280, KA_OFF = 1536, VA_OFF = 1664, KB_OFF = 1792, VB_OFF = 2048;
constexpr float NORM_EPS = 1e-6f, LOG2E = 1.4426950408889634f, C2 = 0.125f * 1.4426950408889634f;
constexpr int MOE_HCAP = 136;
constexpr int SLOT_CAP = 2 * NTOK + NEXP * 256;

constexpr size_t MiB = 1u << 20;
constexpr size_t WS_CTL = 0, CTL_ZERO_BYTES = 1 * MiB;
constexpr size_t WS_MOD = 1 * MiB;
constexpr size_t WS_MISC = 2 * MiB;
constexpr size_t WS_WIN = 6 * MiB;
constexpr size_t WS_WOUT = 15 * MiB;
constexpr size_t WS_F13 = 19 * MiB;
constexpr size_t WS_F2 = 30 * MiB;
constexpr size_t WS_M13 = 36 * MiB;
constexpr size_t WS_M2 = 124 * MiB;
constexpr size_t WS_XC = 168 * MiB;
constexpr size_t WS_XN = 184 * MiB;
constexpr size_t WS_P = 256 * MiB;
constexpr size_t WS_XT = 316 * MiB;
constexpr size_t WS_END = 504 * MiB;
static_assert(WS_P + (size_t)MROWS * DFF * 2 <= WS_END && WS_XT + (size_t)MOE_HCAP * 256 * DFF * 2 <= WS_END && WS_XN + (size_t)SLOT_CAP * DM * 2 <= WS_XT, "ws map");
constexpr size_t MS_TOKE = 0, MS_TOKG = 256 * 1024, MS_TOKS = 512 * 1024, MS_SLOTG = 768 * 1024, MS_META = 1088 * 1024, MS_ROPE = 1152 * 1024;
constexpr int CW_TMO = 0, CW_CODE = 1, CW_BAR = 4096, CW_CNT = 16384;

constexpr int RING_BYTES = 131072, LDSCTL_OFF = RING_BYTES, MISC_OFF = LDSCTL_OFF + 320, LDS_BYTES = 147456;

#define GAS __attribute__((address_space(1)))
#define LAS __attribute__((address_space(3)))
typedef unsigned short bf16;
typedef unsigned v4u __attribute__((ext_vector_type(4)));
typedef unsigned v2u __attribute__((ext_vector_type(2)));
typedef float f32x4 __attribute__((ext_vector_type(4)));
#define LDS_WAIT() asm volatile("s_waitcnt lgkmcnt(0)" ::: "memory")
#define VM_WAIT() asm volatile("s_waitcnt vmcnt(0)" ::: "memory")
__device__ __forceinline__ unsigned f2bf(float f) { unsigned u = __builtin_bit_cast(unsigned, f); return (u + 0x7fffu + ((u >> 16) & 1u)) >> 16; }
__device__ __forceinline__ unsigned pk2(float lo, float hi) { return f2bf(lo) | (f2bf(hi) << 16); }
__device__ __forceinline__ float bflo(unsigned w) { return __uint_as_float(w << 16); }
__device__ __forceinline__ float bfhi(unsigned w) { return __uint_as_float(w & 0xffff0000u); }
__device__ __forceinline__ float bf1(bf16 h) { return __uint_as_float((unsigned)h << 16); }
__device__ __forceinline__ float wave_sum(float v) {
#pragma unroll
    for (int o = 1; o < 64; o <<= 1) v += __shfl_xor(v, o);
    return v;
}
__device__ __forceinline__ float half_sum(float v) {
#pragma unroll
    for (int o = 1; o < 32; o <<= 1) v += __shfl_xor(v, o);
    return v;
}
#define XB_TMO      128
#define XB_XCNT(j)  (256  + 64 * (j))
#define XB_XSUB(j)  (1280 + 64 * (j))
#define XB_XGEN(j)  (2304 + 64 * (j))
#define XB_TOP      3328
#define XB_TOPGEN   3392
#define XCD_BAR_WORDS 3456
#define XB_SPIN_CAP (1u << 18)

__device__ __forceinline__ unsigned xb_ld(unsigned* p)              { return __hip_atomic_load(p, __ATOMIC_RELAXED, __HIP_MEMORY_SCOPE_AGENT); }
__device__ __forceinline__ unsigned xb_add(unsigned* p, unsigned v) { return __hip_atomic_fetch_add(p, v, __ATOMIC_RELAXED, __HIP_MEMORY_SCOPE_AGENT); }
__device__ __forceinline__ unsigned xb_xcc_id() { return (unsigned)__builtin_amdgcn_s_getreg((3 << 11) | 20) & 0xFu; }
#define XB_SPIN(cond, bar) do { unsigned _sp = 0; while (cond) { __builtin_amdgcn_s_sleep(1); \
    if ((++_sp & 255u) == 0u) { if (xb_ld(&(bar)[XB_TMO])) break; if (_sp > XB_SPIN_CAP) { atomicAdd(&(bar)[XB_TMO], 1u); break; } } } } while (0)

struct XcdBarrier {
    unsigned* bar; unsigned x;
    volatile LAS unsigned* st;
};

__device__ __forceinline__ XcdBarrier xcd_barrier_post(unsigned* bar, volatile LAS unsigned* st) {
    XcdBarrier b; b.bar = bar; b.x = xb_xcc_id(); b.st = st;
    if (threadIdx.x == 0) (void)xb_add(&bar[XB_XCNT(b.x)], 1u);
    return b;
}
__device__ __forceinline__ void xcd_barrier_complete(unsigned* bar, unsigned x, unsigned& nloc, unsigned& nx) {
    const unsigned G = gridDim.x * gridDim.y * gridDim.z;
    unsigned sum, cnt, mine, sp = 0u;
    for (;;) {
        sum = 0u; cnt = 0u; mine = 0u;
#pragma unroll
        for (unsigned j = 0; j < 16; ++j) { const unsigned c = xb_ld(&bar[XB_XCNT(j)]); sum += c; cnt += (c > 0u) ? 1u : 0u; mine = (j == x) ? c : mine; }
        if (sum == G) break;
        __builtin_amdgcn_s_sleep(1);
        if ((++sp & 255u) == 0u) { if (xb_ld(&bar[XB_TMO])) break; if (sp > XB_SPIN_CAP) { atomicAdd(&bar[XB_TMO], 1u); break; } }
    }
    nloc = mine > 0u ? mine : 1u; nx = cnt > 0u ? cnt : 1u;
}

__device__ __forceinline__ void xcd_barrier(const XcdBarrier& b) {
    asm volatile("s_waitcnt vmcnt(0)" ::: "memory");
    __syncthreads();
    if (threadIdx.x == 0) {
        unsigned* bar = b.bar;
        __builtin_amdgcn_s_waitcnt(0);
        unsigned nloc = b.st[0], nx = b.st[1];
        if (nloc == 0u) { xcd_barrier_complete(bar, b.x, nloc, nx); b.st[0] = nloc; b.st[1] = nx; }
        const unsigned old = xb_add(&bar[XB_XSUB(b.x)], 1u);
        const unsigned gen = old / nloc;
        if (old + 1u == (gen + 1u) * nloc) {
            __builtin_amdgcn_fence(__ATOMIC_RELEASE, "agent");
            asm volatile("s_waitcnt vmcnt(0)" ::: "memory");
            const unsigned og = xb_add(&bar[XB_TOP], 1u);
            const unsigned tg = og / nx;
            if (og + 1u == (tg + 1u) * nx) xb_add(&bar[XB_TOPGEN], 1u);
            else XB_SPIN(xb_ld(&bar[XB_TOPGEN]) == tg, bar);
            __builtin_amdgcn_fence(__ATOMIC_ACQUIRE, "agent");
            xb_add(&bar[XB_XGEN(b.x)], 1u);
            asm volatile("s_waitcnt vmcnt(0)" ::: "memory");
        } else {
            XB_SPIN(xb_ld(&bar[XB_XGEN(b.x)]) == gen, bar);
            __builtin_amdgcn_fence(__ATOMIC_ACQUIRE, "agent");
            asm volatile("s_waitcnt vmcnt(0)" ::: "memory");
        }
    }
    __syncthreads();
}

struct Frame {
    LAS unsigned char* lds;
    volatile LAS unsigned* MISC;
    unsigned* ctl;
    int tid, lane, wave, vcu, G;
    float* out; unsigned char* ws;
};
__device__ __forceinline__ const float* inp(const Frame& F, int i) {
    const volatile LAS unsigned* t = (const volatile LAS unsigned*)(F.lds + LDSCTL_OFF + 64) + 2 * i;
    const unsigned lo = __builtin_amdgcn_readfirstlane(t[0]), hi = __builtin_amdgcn_readfirstlane(t[1]);
    return (const float*)(((unsigned long long)hi << 32) | lo);
}
enum { I_X = 0, I_C, I_CTX, I_CCTX, I_WMOD, I_BMOD, I_WIN, I_GQA, I_GKA, I_GQB, I_GKB, I_RPB, I_CONVW, I_CONVB, I_GOUT, I_WOUT, I_F1, I_F3, I_F2, I_ROUTER, I_ROUTERB, I_M1, I_M3, I_M2 };

__device__ __forceinline__ void p0_transpose_item(const float* W, int K, int N, bf16* WT, int row_off, int il, int half, LAS float* scr, int item, int lane) {
    const int nblk = N / 32, kb = item / nblk, nb = item % nblk, k0 = 64 * kb, n0 = 32 * nb;
#pragma unroll 8
    for (int i = 0; i < 32; ++i) { const int kk = 2 * i + (lane >> 5); scr[kk * 33 + (lane & 31)] = W[(size_t)(k0 + kk) * N + n0 + (lane & 31)]; }
    LDS_WAIT(); asm volatile("" ::: "memory");
    const int c = lane & 7;
    const int orow0 = il ? ((n0 >> 7) * 256 + half * 128 + (n0 & 127)) : (row_off + n0);
#pragma unroll
    for (int j = 0; j < 4; ++j) { const int n = (lane >> 3) + 8 * j; const LAS float* s = scr + (8 * c) * 33 + n;
        v4u o; o.x = pk2(s[0 * 33], s[1 * 33]); o.y = pk2(s[2 * 33], s[3 * 33]); o.z = pk2(s[4 * 33], s[5 * 33]); o.w = pk2(s[6 * 33], s[7 * 33]);
        *(GAS v4u*)(WT + (size_t)(orow0 + n) * K + k0 + 8 * c) = o; }
    LDS_WAIT(); asm volatile("" ::: "memory");
}
__device__ __forceinline__ float silu_f(float v) { return v / (1.0f + __expf(-v)); }

__device__ __forceinline__ void p0_prologue(Frame& F) {
    const int gw = F.vcu * NWAVES + F.wave, NGW = F.G * NWAVES;
    if (blockIdx.x == 0) {
        float* tab = (float*)(F.ws + WS_MISC + MS_ROPE);
        for (int idx = F.tid; idx < 1024; idx += NWAVES * 64) { const int pos = idx >> 4, i = idx & 15;
            const float inv = powf(10000.0f, -(float)(2 * i) / 32.0f); const float ang = (float)pos * inv;
            tab[2 * idx] = cosf(ang); tab[2 * idx + 1] = sinf(ang); }
    }
    {
        LAS float* sv = (LAS float*)F.lds;
        LAS float* red = (LAS float*)(F.lds + 17 * 1024 * 4);
        bool staged = false;
        for (int task = blockIdx.x; task < 192; task += F.G) {
            if (!staged) {
                for (int idx = F.tid; idx < 17 * 1024; idx += NWAVES * 64) { const int r = idx >> 10, k = idx & 1023; const float v = r < 16 ? inp(F, I_C)[r * 1024 + k] : inp(F, I_CCTX)[k]; sv[idx] = silu_f(v); }
                staged = true; __syncthreads();
            }
            const int l = task / 96, cb = task % 96, col = cb * 64 + F.lane;
            const float* W = inp(F, I_WMOD) + (size_t)l * 1024 * 6144 + col;
            float acc[17];
#pragma unroll
            for (int r = 0; r < 17; ++r) acc[r] = 0.f;
            const int kbeg = F.wave * 128;
#pragma unroll 4
            for (int k = kbeg; k < kbeg + 128; ++k) { const float wv = W[(size_t)k * 6144];
#pragma unroll
                for (int r = 0; r < 17; ++r) acc[r] += sv[r * 1024 + k] * wv; }
#pragma unroll
            for (int r = 0; r < 17; ++r) red[(F.wave * 17 + r) * 64 + F.lane] = acc[r];
            __syncthreads();
            for (int idx = F.tid; idx < 17 * 64; idx += NWAVES * 64) { const int r = idx >> 6, ln = idx & 63; float s = 0.f;
#pragma unroll
                for (int w = 0; w < 8; ++w) s += red[(w * 17 + r) * 64 + ln];
                const int n = cb * 64 + ln;
                ((float*)(F.ws + WS_MOD))[((size_t)l * 17 + r) * 6144 + n] = s + inp(F, I_BMOD)[l * 6144 + n]; }
            __syncthreads();
        }
        __syncthreads();
    }
    {
        LAS float* scr = (LAS float*)(F.lds + F.wave * 16384);
        constexpr int IT_IN = 16 * 72, IT_OUT = 16 * 32, IT_F = 1408;
        constexpr int NITEMS = 2 * IT_IN + 2 * IT_OUT + 3 * IT_F + 24 * IT_F;
        for (int it = gw; it < NITEMS; it += NGW) {
            int r = it;
            if (r < 2 * IT_IN) { const int l = r / IT_IN; p0_transpose_item(inp(F, I_WIN) + (size_t)l * 1024 * INW, 1024, INW, (bf16*)(F.ws + WS_WIN) + (size_t)l * INW * 1024, 0, 0, 0, scr, r % IT_IN, F.lane); continue; } r -= 2 * IT_IN;
            if (r < 2 * IT_OUT) { const int l = r / IT_OUT; p0_transpose_item(inp(F, I_WOUT) + (size_t)l * 1024 * 1024, 1024, 1024, (bf16*)(F.ws + WS_WOUT) + (size_t)l * 1024 * 1024, 0, 0, 0, scr, r % IT_OUT, F.lane); continue; } r -= 2 * IT_OUT;
            if (r < IT_F) { p0_transpose_item(inp(F, I_F1), 1024, DFF, (bf16*)(F.ws + WS_F13), 0, 1, 0, scr, r, F.lane); continue; } r -= IT_F;
            if (r < IT_F) { p0_transpose_item(inp(F, I_F3), 1024, DFF, (bf16*)(F.ws + WS_F13), 0, 1, 1, scr, r, F.lane); continue; } r -= IT_F;
            if (r < IT_F) { p0_transpose_item(inp(F, I_F2), DFF, 1024, (bf16*)(F.ws + WS_F2), 0, 0, 0, scr, r, F.lane); continue; } r -= IT_F;
            { const int e = r / (3 * IT_F), q = r % (3 * IT_F), which = q / IT_F, item = q % IT_F;
              if (which == 0) p0_transpose_item(inp(F, I_M1) + (size_t)e * 1024 * DFF, 1024, DFF, (bf16*)(F.ws + WS_M13) + (size_t)e * 5632 * 1024, 0, 1, 0, scr, item, F.lane);
              else if (which == 1) p0_transpose_item(inp(F, I_M3) + (size_t)e * 1024 * DFF, 1024, DFF, (bf16*)(F.ws + WS_M13) + (size_t)e * 5632 * 1024, 0, 1, 1, scr, item, F.lane);
              else p0_transpose_item(inp(F, I_M2) + (size_t)e * DFF * 1024, DFF, 1024, (bf16*)(F.ws + WS_M2) + (size_t)e * 1024 * DFF, 0, 0, 0, scr, item, F.lane); }
        }
    }
}

__device__ __forceinline__ const float* xrow_ptr(const float* lat, const float* ctx, int s) { const int b = s / TPB, j = s % TPB; return j < SEQ ? lat + (size_t)(b * SEQ + j) * DM : ctx + (size_t)(b * CTXL + j - SEQ) * DM; }

__device__ __forceinline__ void norm_mod_rows(Frame& F, const float* lat, const float* ctx, const float* mod, int shoff, int scoff, bf16* XN, bool with_ctx) {
    const int gw = F.vcu * NWAVES + F.wave, NGW = F.G * NWAVES;
    for (int s = gw; s < MROWS; s += NGW) {
        const int b = s / TPB, j = s % TPB; if (!with_ctx && j >= SEQ) continue;
        const GAS f32x4* xr = (const GAS f32x4*)xrow_ptr(lat, ctx, s) + F.lane;
        const float* mrow = mod + (size_t)(j < SEQ ? b : 16) * 6144;
        f32x4 v[4]; float ss = 0.f;
#pragma unroll
        for (int q = 0; q < 4; ++q) { v[q] = xr[64 * q]; ss += (v[q].x * v[q].x + v[q].y * v[q].y) + (v[q].z * v[q].z + v[q].w * v[q].w); }
        const float rstd = 1.0f / sqrtf(wave_sum(ss) * (1.0f / DM) + NORM_EPS);
        GAS v2u* o8 = (GAS v2u*)(XN + (size_t)s * DM) + F.lane;
#pragma unroll
        for (int q = 0; q < 4; ++q) { const f32x4 sh = *(const f32x4*)(mrow + shoff + 4 * F.lane + 256 * q), sc = *(const f32x4*)(mrow + scoff + 4 * F.lane + 256 * q);
            const f32x4 y = v[q] * rstd * (sc + 1.0f) + sh; v2u w; w.x = pk2(y.x, y.y); w.y = pk2(y.z, y.w); o8[64 * q] = w; }
    }
}

__device__ __forceinline__ void headnorm_rows(Frame& F, int l, bool ctx_q) {
    const int gw = F.vcu * NWAVES + F.wave, NGW = F.G * NWAVES; bf16* P = (bf16*)(F.ws + WS_P);
    const float* tab = (const float*)(F.ws + WS_MISC + MS_ROPE);
    const int d = F.lane;
    const float gqa = inp(F, I_GQA)[l * 64 + d], gka = inp(F, I_GKA)[l * 64 + d], gqb = inp(F, I_GQB)[l * 64 + d], gkb = inp(F, I_GKB)[l * 64 + d];
    for (int s = gw; s < MROWS; s += NGW) {
        const int j = s % TPB; const bool lat = j < SEQ; bf16* p = P + (size_t)s * INW;
        float cs = 1.f, sn = 0.f;
        if (lat) { const int pos = (d < 32) ? (j >> 6) : (j & 63); const int i = d & 15; cs = tab[2 * (pos * 16 + i)]; sn = tab[2 * (pos * 16 + i) + 1]; }
        const float sgn = (d & 16) ? 1.f : -1.f;
#pragma unroll 1
        for (int h = 0; h < 18; ++h) {
            int off; float g; bool rope, isq;
            if (h < 8) { off = QA_OFF + 64 * h; g = gqa; rope = true; isq = true; }
            else if (h < 12) { off = QB_OFF + 64 * (h - 8); g = gqb; rope = false; isq = true; }
            else if (h < 14) { off = KA_OFF + 64 * (h - 12); g = gka; rope = true; isq = false; }
            else { off = KB_OFF + 64 * (h - 14); g = gkb; rope = false; isq = false; }
            if (isq && !lat && !ctx_q) continue;
            const float v = bf1(p[off + d]);
            const float ss = wave_sum(v * v);
            float y = v * (1.0f / sqrtf(ss * (1.0f / 64.0f) + NORM_EPS)) * g;
            const float pr = __shfl_xor(y, 16);
            if (rope && lat) y = y * cs + sgn * pr * sn;
            if (isq) y *= C2;
            p[off + d] = (bf16)f2bf(y);
        }
    }
}

struct NaiveState { float q[64], o[64], m, l; };
__device__ __forceinline__ void na_load_q(NaiveState& S, const bf16* qp) {
#pragma unroll
    for (int c = 0; c < 8; ++c) { const v4u w = *(const v4u*)(qp + 8 * c);
        S.q[8 * c + 0] = bflo(w.x); S.q[8 * c + 1] = bfhi(w.x); S.q[8 * c + 2] = bflo(w.y); S.q[8 * c + 3] = bfhi(w.y);
        S.q[8 * c + 4] = bflo(w.z); S.q[8 * c + 5] = bfhi(w.z); S.q[8 * c + 6] = bflo(w.w); S.q[8 * c + 7] = bfhi(w.w); }
#pragma unroll
    for (int i = 0; i < 64; ++i) S.o[i] = 0.f;
    S.m = -1e30f; S.l = 0.f;
}
__device__ __forceinline__ float na_dot(const NaiveState& S, const bf16* kp) {
    float s = 0.f;
#pragma unroll
    for (int c = 0; c < 8; ++c) { const v4u w = *(const v4u*)(kp + 8 * c);
        s += S.q[8 * c + 0] * bflo(w.x) + S.q[8 * c + 1] * bfhi(w.x) + S.q[8 * c + 2] * bflo(w.y) + S.q[8 * c + 3] * bfhi(w.y)
           + S.q[8 * c + 4] * bflo(w.z) + S.q[8 * c + 5] * bfhi(w.z) + S.q[8 * c + 6] * bflo(w.w) + S.q[8 * c + 7] * bfhi(w.w); }
    return s;
}
__device__ __forceinline__ void na_acc(NaiveState& S, float p, const bf16* vp) {
#pragma unroll
    for (int c = 0; c < 8; ++c) { const v4u w = *(const v4u*)(vp + 8 * c);
        S.o[8 * c + 0] += p * bflo(w.x); S.o[8 * c + 1] += p * bfhi(w.x); S.o[8 * c + 2] += p * bflo(w.y); S.o[8 * c + 3] += p * bfhi(w.y);
        S.o[8 * c + 4] += p * bflo(w.z); S.o[8 * c + 5] += p * bfhi(w.z); S.o[8 * c + 6] += p * bflo(w.w); S.o[8 * c + 7] += p * bfhi(w.w); }
}
__device__ __forceinline__ void na_step2(NaiveState& S, float s0, float s1, const bf16* v0, const bf16* v1) {
    const float mn = fmaxf(S.m, fmaxf(s0, s1));
    const float sc = __builtin_amdgcn_exp2f(S.m - mn), p0 = __builtin_amdgcn_exp2f(s0 - mn), p1 = __builtin_amdgcn_exp2f(s1 - mn);
    S.l = S.l * sc + p0 + p1; S.m = mn;
#pragma unroll
    for (int i = 0; i < 64; ++i) S.o[i] *= sc;
    na_acc(S, p0, v0); na_acc(S, p1, v1);
}
__device__ __forceinline__ void na_store(const NaiveState& S, bf16* op) {
    const float inv = 1.0f / S.l;
#pragma unroll
    for (int c = 0; c < 8; ++c) { v4u w; w.x = pk2(S.o[8 * c + 0] * inv, S.o[8 * c + 1] * inv); w.y = pk2(S.o[8 * c + 2] * inv, S.o[8 * c + 3] * inv);
        w.z = pk2(S.o[8 * c + 4] * inv, S.o[8 * c + 5] * inv); w.w = pk2(S.o[8 * c + 6] * inv, S.o[8 * c + 7] * inv); *(v4u*)(op + 8 * c) = w; }
}
__device__ __forceinline__ void attn_naive_phase(Frame& F, int l, bool with_ctx) {
    const int gw = F.vcu * NWAVES + F.wave, NGW = F.G * NWAVES; bf16* P = (bf16*)(F.ws + WS_P);
    const float* rpb = inp(F, I_RPB) + (size_t)l * 4 * 15 * 31;
    const int ntask = with_ctx ? 6912 : 6144;
    for (int task = gw; task < ntask; task += NGW) {
        NaiveState S;
        if (task < 4096 || (task >= 6144 && task < 6656)) {
            int b, qh, j0, k0, k1;
            if (task < 4096) { b = task >> 8; qh = (task >> 5) & 7; j0 = (task & 31) * 64; k0 = 0; k1 = TPB; }
            else { const int t = task - 6144; b = t >> 5; qh = (t >> 2) & 7; j0 = SEQ + (t & 3) * 64; k0 = SEQ; k1 = TPB; }
            bf16* qp = P + (size_t)(b * TPB + j0 + F.lane) * INW + QA_OFF + qh * 64;
            na_load_q(S, qp);
            const bf16* Kb = P + (size_t)(b * TPB) * INW + KA_OFF + (qh >> 2) * 64; const bf16* Vb = P + (size_t)(b * TPB) * INW + VA_OFF + (qh >> 2) * 64;
            for (int k = k0; k < k1; k += 2) { const float s0 = na_dot(S, Kb + (size_t)k * INW), s1 = na_dot(S, Kb + (size_t)(k + 1) * INW); na_step2(S, s0, s1, Vb + (size_t)k * INW, Vb + (size_t)(k + 1) * INW); }
            na_store(S, qp);
        } else {
            int b, h, j; bool lat;
            if (task < 6144) { const int t = task - 4096; b = t >> 7; h = (t >> 5) & 3; j = (t & 31) * 64 + F.lane; lat = true; }
            else { const int t = task - 6656; b = t >> 4; h = (t >> 2) & 3; j = SEQ + (t & 3) * 64 + F.lane; lat = false; }
            bf16* qp = P + (size_t)(b * TPB + j) * INW + QB_OFF + h * 64;
            na_load_q(S, qp);
            const bf16* Kb = P + (size_t)(b * TPB) * INW + KB_OFF + h * 64; const bf16* Vb = P + (size_t)(b * TPB) * INW + VB_OFF + h * 64;
            if (lat) {
                const int r = j >> 6, c = j & 63; int rs = r - 4; rs = rs < 0 ? 0 : (rs > 24 ? 24 : rs); int cs = c - 8; cs = cs < 0 ? 0 : (cs > 48 ? 48 : cs);
                for (int i = 0; i < 8; ++i) { const int kr = rs + i; const float* brow = rpb + (h * 15 + (kr - r + 7)) * 31 + (15 - c);
                    for (int jc = 0; jc < 16; jc += 2) { const int kc = cs + jc; const int k = kr * 64 + kc;
                        const float s0 = na_dot(S, Kb + (size_t)k * INW) + brow[kc] * LOG2E, s1 = na_dot(S, Kb + (size_t)(k + 1) * INW) + brow[kc + 1] * LOG2E;
                        na_step2(S, s0, s1, Vb + (size_t)k * INW, Vb + (size_t)(k + 1) * INW); } }
            }
            for (int k = SEQ; k < TPB; k += 2) { const float s0 = na_dot(S, Kb + (size_t)k * INW), s1 = na_dot(S, Kb + (size_t)(k + 1) * INW); na_step2(S, s0, s1, Vb + (size_t)k * INW, Vb + (size_t)(k + 1) * INW); }
            na_store(S, qp);
        }
    }
}

__device__ __forceinline__ void unpack8(const v4u w, float (&v)[8]) { v[0] = bflo(w.x); v[1] = bfhi(w.x); v[2] = bflo(w.y); v[3] = bfhi(w.y); v[4] = bflo(w.z); v[5] = bfhi(w.z); v[6] = bflo(w.w); v[7] = bfhi(w.w); }
__device__ __forceinline__ void merge_rows(Frame& F, int l, bool with_ctx) {
    const int gw = F.vcu * NWAVES + F.wave, NGW = F.G * NWAVES; const bf16* P = (const bf16*)(F.ws + WS_P); bf16* CAT = (bf16*)(F.ws + WS_XN);
    const float* gout = inp(F, I_GOUT) + l * 1024; const float* cw = inp(F, I_CONVW) + l * 3 * 256; const float* cb = inp(F, I_CONVB) + l * 256;
    const int lane = F.lane;
    for (int s = gw; s < MROWS; s += NGW) {
        const int j = s % TPB; const bool lat = j < SEQ; if (!with_ctx && !lat) continue;
        const bf16* p = P + (size_t)s * INW;
        float va[8], vb[8];
        unpack8(*(const v4u*)(p + 8 * lane), va);
        if (lane < 32) unpack8(*(const v4u*)(p + 512 + 8 * lane), vb);
        else {
            const int ch0 = 8 * (lane - 32); const int jlo = lat ? 0 : SEQ, jhi = lat ? SEQ : TPB;
            float post[8], y[8];
            unpack8(*(const v4u*)(p + CPOST_OFF + ch0), post);
#pragma unroll
            for (int k = 0; k < 8; ++k) y[k] = cb[ch0 + k];
#pragma unroll
            for (int tap = 0; tap < 3; ++tap) { const int jj = j + tap - 1;
                if (jj >= jlo && jj < jhi) { const bf16* pp = p + (ptrdiff_t)(tap - 1) * INW; float a[8], c[8]; unpack8(*(const v4u*)(pp + CPRE_OFF + ch0), a); unpack8(*(const v4u*)(pp + CVAL_OFF + ch0), c);
#pragma unroll
                    for (int k = 0; k < 8; ++k) y[k] += cw[tap * 256 + ch0 + k] * (a[k] * c[k]); } }
#pragma unroll
            for (int k = 0; k < 8; ++k) vb[k] = post[k] * y[k];
        }
        float sa = 0.f, sb = 0.f;
#pragma unroll
        for (int k = 0; k < 8; ++k) { sa += va[k] * va[k]; sb += vb[k] * vb[k]; }
        const float ra = 1.0f / sqrtf(wave_sum(sa) * (1.0f / 512.0f) + NORM_EPS), rb = 1.0f / sqrtf(half_sum(sb) * (1.0f / 256.0f) + NORM_EPS);
        v4u oa, ob; float g[8];
#pragma unroll
        for (int k = 0; k < 8; ++k) g[k] = gout[8 * lane + k];
        oa.x = pk2(va[0] * ra * g[0], va[1] * ra * g[1]); oa.y = pk2(va[2] * ra * g[2], va[3] * ra * g[3]); oa.z = pk2(va[4] * ra * g[4], va[5] * ra * g[5]); oa.w = pk2(va[6] * ra * g[6], va[7] * ra * g[7]);
#pragma unroll
        for (int k = 0; k < 8; ++k) g[k] = gout[512 + 8 * lane + k];
        ob.x = pk2(vb[0] * rb * g[0], vb[1] * rb * g[1]); ob.y = pk2(vb[2] * rb * g[2], vb[3] * rb * g[3]); ob.z = pk2(vb[4] * rb * g[4], vb[5] * rb * g[5]); ob.w = pk2(vb[6] * rb * g[6], vb[7] * rb * g[7]);
        *(v4u*)(CAT + (size_t)s * DM + 8 * lane) = oa; *(v4u*)(CAT + (size_t)s * DM + 512 + 8 * lane) = ob;
    }
}

__device__ __forceinline__ void moe_route(Frame& F, const float* mod) {
    const float* X = F.out; bf16* XT = (bf16*)(F.ws + WS_XT);
    int* tok_e = (int*)(F.ws + WS_MISC + MS_TOKE); float* tok_g = (float*)(F.ws + WS_MISC + MS_TOKG);
    const float* wr = inp(F, I_ROUTER); const float* br = inp(F, I_ROUTERB);
    LAS int* le = (LAS int*)F.lds;
    for (int ch = blockIdx.x; ch < NTOK / 128; ch += F.G) {
        for (int i = 0; i < 16; ++i) {
            const int tl = F.wave * 16 + i, tok = ch * 128 + tl, b = tok / SEQ;
            const GAS f32x4* xr = (const GAS f32x4*)(X + (size_t)tok * DM) + F.lane; const float* mrow = mod + (size_t)b * 6144;
            f32x4 v[4]; float ss = 0.f;
#pragma unroll
            for (int q = 0; q < 4; ++q) { v[q] = xr[64 * q]; ss += (v[q].x * v[q].x + v[q].y * v[q].y) + (v[q].z * v[q].z + v[q].w * v[q].w); }
            const float rstd = 1.0f / sqrtf(wave_sum(ss) * (1.0f / DM) + NORM_EPS);
            float lg[8];
#pragma unroll
            for (int e = 0; e < 8; ++e) lg[e] = 0.f;
            GAS v2u* o8 = (GAS v2u*)(XT + (size_t)tok * DM) + F.lane;
#pragma unroll
            for (int q = 0; q < 4; ++q) { const int col = 4 * F.lane + 256 * q; const f32x4 sh = *(const f32x4*)(mrow + 3072 + col), sc = *(const f32x4*)(mrow + 4096 + col);
                const f32x4 y = v[q] * rstd * (sc + 1.0f) + sh; v2u w; w.x = pk2(y.x, y.y); w.y = pk2(y.z, y.w); o8[64 * q] = w;
#pragma unroll
                for (int k = 0; k < 4; ++k) { const f32x4 w0 = *(const f32x4*)(wr + (size_t)(col + k) * 8), w1 = *(const f32x4*)(wr + (size_t)(col + k) * 8 + 4); const float yk = y[k];
                    lg[0] += yk * w0.x; lg[1] += yk * w0.y; lg[2] += yk * w0.z; lg[3] += yk * w0.w; lg[4] += yk * w1.x; lg[5] += yk * w1.y; lg[6] += yk * w1.z; lg[7] += yk * w1.w; } }
#pragma unroll
            for (int e = 0; e < 8; ++e) lg[e] = wave_sum(lg[e]) + br[e];
            int e0 = 0; float v0 = lg[0];
#pragma unroll
            for (int e = 1; e < 8; ++e) if (lg[e] > v0) { v0 = lg[e]; e0 = e; }
            int e1 = -1; float v1 = -3.0e38f;
#pragma unroll
            for (int e = 0; e < 8; ++e) if (e != e0 && lg[e] > v1) { v1 = lg[e]; e1 = e; }
            const float p1 = __expf(v1 - v0), g0 = 1.0f / (1.0f + p1), g1 = p1 / (1.0f + p1);
            if (F.lane == 0) { tok_e[2 * tok] = e0; tok_e[2 * tok + 1] = e1; tok_g[2 * tok] = g0; tok_g[2 * tok + 1] = g1; le[2 * tl] = e0; le[2 * tl + 1] = e1; }
        }
        __syncthreads();
        if (F.tid < 8) { int n = 0; for (int a = 0; a < 256; ++a) n += (le[a] == F.tid) ? 1 : 0; F.ctl[CW_CNT + ch * 8 + F.tid] = (unsigned)n; }
        __syncthreads();
    }
}
__device__ __forceinline__ void moe_sort_scatter(Frame& F) {
    const bf16* XT = (const bf16*)(F.ws + WS_XT); bf16* XS = (bf16*)(F.ws + WS_XN);
    const int* tok_e = (const int*)(F.ws + WS_MISC + MS_TOKE); const float* tok_g = (const float*)(F.ws + WS_MISC + MS_TOKG);
    int* tok_s = (int*)(F.ws + WS_MISC + MS_TOKS); float* slot_g = (float*)(F.ws + WS_MISC + MS_SLOTG); int* meta = (int*)(F.ws + WS_MISC + MS_META);
    LAS int* ltot = (LAS int*)F.lds; LAS int* lpre = ltot + 8; LAS int* lslot = ltot + 16; LAS int* lex = ltot + 16 + 256;
    for (int ch = blockIdx.x; ch < NTOK / 128; ch += F.G) {
        if (F.tid < 8) { int tot = 0, pre = 0; for (int c2 = 0; c2 < NTOK / 128; ++c2) { const int n = (int)F.ctl[CW_CNT + c2 * 8 + F.tid]; tot += n; pre += (c2 < ch) ? n : 0; } ltot[F.tid] = tot; lpre[F.tid] = pre; }
        if (F.tid < 256) lex[F.tid] = tok_e[2 * (ch * 128) + F.tid];
        __syncthreads();
        int pstart[9]; pstart[0] = 0;
#pragma unroll
        for (int e = 0; e < 8; ++e) pstart[e + 1] = pstart[e] + ((ltot[e] + 255) & ~255);
        if (F.tid < 8) { int base = 0;
#pragma unroll
            for (int e = 0; e < 8; ++e) if (e == F.tid) base = pstart[e] + lpre[e];
            for (int a = 0; a < 256; ++a) { if (lex[a] == F.tid) { lslot[a] = base; ++base; } } }
        __syncthreads();
        if (F.tid < 256) { const int slot = lslot[F.tid]; tok_s[2 * (ch * 128) + F.tid] = slot; slot_g[slot] = tok_g[2 * (ch * 128) + F.tid]; }
        for (int a = F.wave; a < 256; a += NWAVES) { const int tok = ch * 128 + (a >> 1), slot = lslot[a];
            const GAS v4u* src = (const GAS v4u*)(XT + (size_t)tok * DM) + F.lane; GAS v4u* dst = (GAS v4u*)(XS + (size_t)slot * DM) + F.lane;
            dst[0] = src[0]; dst[64] = src[64]; }
        if (ch < 8) {
            int p0 = 0, p1 = 0;
#pragma unroll
            for (int e = 0; e < 8; ++e) if (e == ch) { p0 = pstart[e] + ltot[e]; p1 = pstart[e + 1]; }
            for (int r = p0 + F.wave; r < p1; r += NWAVES) { GAS v4u* dst = (GAS v4u*)(XS + (size_t)r * DM) + F.lane; dst[0] = (v4u){0u, 0u, 0u, 0u}; dst[64] = (v4u){0u, 0u, 0u, 0u}; if (F.lane == 0) slot_g[r] = 0.f; }
        }
        if (ch == 0 && F.tid == 0) {
#pragma unroll
            for (int e = 0; e < 8; ++e) meta[e] = pstart[e + 1] >> 8;
        }
        __syncthreads();
    }
}
__device__ __forceinline__ void moe_combine(Frame& F, const float* mod) {
    const int gw = F.vcu * NWAVES + F.wave, NGW = F.G * NWAVES; const bf16* Y = (const bf16*)(F.ws + WS_XN); const int* tok_s = (const int*)(F.ws + WS_MISC + MS_TOKS);
    for (int tok = gw; tok < NTOK; tok += NGW) {
        const int b = tok / SEQ, s0 = tok_s[2 * tok], s1 = tok_s[2 * tok + 1];
        GAS f32x4* xr = (GAS f32x4*)(F.out + (size_t)tok * DM) + F.lane; const float* g = mod + (size_t)b * 6144 + 5120;
        const GAS v2u* y0 = (const GAS v2u*)(Y + (size_t)s0 * DM) + F.lane; const GAS v2u* y1 = (const GAS v2u*)(Y + (size_t)s1 * DM) + F.lane;
#pragma unroll
        for (int q = 0; q < 4; ++q) { const f32x4 x = xr[64 * q]; const f32x4 gv = *(const f32x4*)(g + 4 * F.lane + 256 * q); const v2u a = y0[64 * q], c = y1[64 * q];
            f32x4 y; y.x = bflo(a.x) + bflo(c.x); y.y = bfhi(a.x) + bfhi(c.x); y.z = bflo(a.y) + bflo(c.y); y.w = bfhi(a.y) + bfhi(c.y);
            xr[64 * q] = x + gv * y; }
    }
}

struct Args { const float* in[24]; float* out; unsigned char* ws; int ph_lo, ph_hi, li, pad; };
__global__ void __launch_bounds__(NWAVES * 64, 2) mk_fwd(Args args) {
    extern __shared__ __attribute__((aligned(16))) unsigned char lds[];
    Frame F;
    F.lds = (LAS unsigned char*)lds; F.MISC = (volatile LAS unsigned*)(F.lds + MISC_OFF);
    F.tid = threadIdx.x; F.lane = F.tid & 63; F.wave = __builtin_amdgcn_readfirstlane(F.tid >> 6);
    F.G = gridDim.x; { const int bx = blockIdx.x; F.vcu = (F.G % 8 == 0) ? (bx % 8) * (F.G / 8) + bx / 8 : bx; }
    F.out = args.out; F.ws = args.ws; F.ctl = (unsigned*)(args.ws + WS_CTL);
    for (int u = F.tid; u < (LDS_BYTES - LDSCTL_OFF) / 4; u += NWAVES * 64) ((LAS unsigned*)(F.lds + LDSCTL_OFF))[u] = 0u;
    __syncthreads();
    if (F.tid < 24) { const unsigned long long p = (unsigned long long)args.in[F.tid]; LAS unsigned* t = (LAS unsigned*)(F.lds + LDSCTL_OFF + 64) + 2 * F.tid; t[0] = (unsigned)p; t[1] = (unsigned)(p >> 32); }
    __syncthreads();
    XcdBarrier bar; bar.bar = F.ctl + CW_BAR; bar.x = 0; bar.st = nullptr;
    if (MK_N_LAUNCHES == 1) bar = xcd_barrier_post(F.ctl + CW_BAR, F.MISC + 8);
    const int lo = args.ph_lo, hi = args.ph_hi;
#ifndef PHMASK
#define PHMASK 0xFFFFFFFFu
#endif
#define PHON(k) (((PHMASK) >> (k)) & 1u)
#define IN(k) (PHON(k) && lo <= (k) && (k) < hi)
#define INL(x) ((((PHMASK) >> (1 + (x))) & 1u) && lo <= pb + (x) && pb + (x) < hi)
#define INR(k) (lo <= (k) && (k) < hi)
#define SEAM(k) do { if (INR(k) && INR((k) + 1)) xcd_barrier(bar); } while (0)
    float* XC = (float*)(F.ws + WS_XC); bf16* XN = (bf16*)(F.ws + WS_XN); bf16* P = (bf16*)(F.ws + WS_P);
    const float* MOD = (const float*)(F.ws + WS_MOD);
#define TABMEM (F.lds + LDSCTL_OFF + 448)
#define PF() asm volatile("" : "+v"(F.tid), "+v"(F.lane))

    if (IN(0)) { PF(); p0_prologue(F); } SEAM(0);

#pragma unroll 1
    for (int l = 0; l < 2; ++l) {
        const int pb = 1 + 9 * l; const bool last = (l == 1);
        const float* mod = MOD + (size_t)l * 17 * 6144;
        const float* xlat = last ? F.out : inp(F, I_X); const float* xctx = last ? XC : inp(F, I_CTX);
        if (INL(0)) { PF(); norm_mod_rows(F, xlat, xctx, mod, 0, 1024, XN, true); } SEAM(pb + 0);
        if (INL(1)) { PF();
            pg8::Gemm g{XN, (const bf16*)(F.ws + WS_WIN) + (size_t)l * INW * 1024, MROWS, INW, 1024};
            const pg8::TabOrder T = last ? pg8::build_units(TABMEM, 1024, XN, g.Bt, F.G, (int)blockIdx.x, 128, 9, 0, 1, 0, 16, 3, 6, 2, nullptr, 0)
                                         : pg8::build_units(TABMEM, 1024, XN, g.Bt, F.G, (int)blockIdx.x, NPAN, 9, 0, 0, 0, 0, 1, 0, 0, nullptr, 0);
            pg8::EpiRawBf16 E{P, INW};
            pg8::gemm_phase<pg8::EpiRawBf16, pg8::TabOrder, true, true>(F.lds, g, T, E);
        } SEAM(pb + 1);
        if (INL(2)) { PF(); headnorm_rows(F, l, !last); } SEAM(pb + 2);
        if (INL(3)) { PF(); attn_naive_phase(F, l, !last); } SEAM(pb + 3);
        if (INL(4)) { PF(); merge_rows(F, l, !last); } SEAM(pb + 4);
        if (INL(5)) { PF();
            pg8::Gemm g{XN, (const bf16*)(F.ws + WS_WOUT) + (size_t)l * 1024 * 1024, MROWS, 1024, 1024};
            const pg8::TabOrder T = pg8::build_units(TABMEM, 1024, XN, g.Bt, F.G, (int)blockIdx.x, last ? 128 : NPAN, 4, 0, last ? 1 : 0, 0, 0, 1, 0, 0, nullptr, 0);
            pg8::EpiGateRes E{xlat, xctx, F.out, XC, mod, 2048};
            pg8::gemm_phase<pg8::EpiGateRes, pg8::TabOrder, true, true>(F.lds, g, T, E);
        } SEAM(pb + 5);
        if (!last) {
            if (IN(7)) { PF(); norm_mod_rows(F, F.out, XC, mod, 3072, 4096, XN, true); } SEAM(7);
            if (IN(8)) { PF();
                pg8::Gemm g{XN, (const bf16*)(F.ws + WS_F13), MROWS, 5632, 1024};
                const pg8::TabOrder T = pg8::build_units(TABMEM, 1024, XN, g.Bt, F.G, (int)blockIdx.x, NPAN, 22, 0, 0, 0, 0, 1, 0, 0, nullptr, 0);
                pg8::EpiSwiglu E{P, DFF, 0};
                pg8::gemm_phase<pg8::EpiSwiglu, pg8::TabOrder, true, true>(F.lds, g, T, E);
            } SEAM(8);
            if (IN(9)) { PF();
                pg8::Gemm g{P, (const bf16*)(F.ws + WS_F2), MROWS, 1024, DFF};
                const pg8::TabOrder T = pg8::build_units(TABMEM, DFF, P, g.Bt, F.G, (int)blockIdx.x, NPAN, 4, 0, 0, 0, 0, 1, 0, 0, nullptr, 0);
                pg8::EpiGateRes E{F.out, XC, F.out, XC, mod, 5120};
                pg8::gemm_phase<pg8::EpiGateRes, pg8::TabOrder, true, true>(F.lds, g, T, E);
            } SEAM(9);
        }
    }
    {
        const float* mod = MOD + (size_t)17 * 6144;
        if (IN(16)) { PF(); moe_route(F, mod); } SEAM(16);
        if (IN(17)) { PF(); moe_sort_scatter(F); } SEAM(17);
        const int* meta = (const int*)(F.ws + WS_MISC + MS_META);
        bf16* XS = XN; bf16* HM = (bf16*)(F.ws + WS_XT);
#pragma unroll 1
        for (int c = 0; c < 2; ++c) {
            if (IN(18 + 2 * c) || IN(19 + 2 * c)) {
                const int TP = __builtin_amdgcn_readfirstlane(meta[7]), h0 = (TP + 1) >> 1; const int p0 = c == 0 ? 0 : h0, p1 = c == 0 ? h0 : TP;
                if (IN(18 + 2 * c)) { PF();
                    pg8::Gemm g{XS, (const bf16*)(F.ws + WS_M13), 0, 5632, 1024};
                    const pg8::TabOrder T = pg8::build_units(TABMEM, 1024, XS, g.Bt, F.G, (int)blockIdx.x, p1 - p0, 22, 0, 0, p0, 0, 1, 0, 0, meta, (size_t)5632 * 1024 * 2);
                    pg8::EpiSwiglu E{HM, DFF, p0};
                    pg8::gemm_phase<pg8::EpiSwiglu, pg8::TabOrder, true, true>(F.lds, g, T, E);
                }
                SEAM(18 + 2 * c);
                if (IN(19 + 2 * c)) { PF();
                    pg8::Gemm g{HM, (const bf16*)(F.ws + WS_M2), 0, 1024, DFF};
                    const pg8::TabOrder T = pg8::build_units(TABMEM, DFF, (const char*)HM - (size_t)p0 * 256 * DFF * 2, g.Bt, F.G, (int)blockIdx.x, p1 - p0, 4, 0, 0, p0, 0, 1, 0, 0, meta, (size_t)1024 * DFF * 2);
                    pg8::EpiMoeOut E{XS, (const float*)(F.ws + WS_MISC + MS_SLOTG)};
                    pg8::gemm_phase<pg8::EpiMoeOut, pg8::TabOrder, true, true>(F.lds, g, T, E);
                }
            }
            SEAM(19 + 2 * c);
        }
        if (IN(22)) { PF(); moe_combine(F, mod); }
    }
#undef IN
#undef SEAM
}

extern "C" void kernel_launch(void* const* d_in, const int* in_sizes, int n_in, void* d_out, int out_size, void* d_ws, size_t ws_size, hipStream_t stream) {
    static int grid = 0;
    if (grid == 0) {
        if (n_in != 24 || in_sizes[0] != BATCH * SEQ * DM || out_size != BATCH * SEQ * DM || ws_size < WS_END) { fprintf(stderr, "kernel_launch: unexpected shapes / workspace (n_in %d, ws %zu, need %zu); nothing launched\n", n_in, ws_size, (size_t)WS_END); grid = -1; return; }
        int dev = 0, cus = 0, per_cu = 0;
        if (hipGetDevice(&dev) != hipSuccess || hipDeviceGetAttribute(&cus, hipDeviceAttributeMultiprocessorCount, dev) != hipSuccess) { grid = -1; return; }
        if (hipFuncSetAttribute((const void*)mk_fwd, hipFuncAttributeMaxDynamicSharedMemorySize, LDS_BYTES) != hipSuccess) { fprintf(stderr, "kernel_launch: hipFuncSetAttribute failed\n"); grid = -1; return; }
        if (hipOccupancyMaxActiveBlocksPerMultiprocessor(&per_cu, (const void*)mk_fwd, NWAVES * 64, LDS_BYTES) != hipSuccess || per_cu < 1) fprintf(stderr, "kernel_launch: occupancy query reports %d\n", per_cu);
        (void)hipGetLastError();
        grid = cus;
    }
    if (grid < 0) return;
    if (hipMemsetAsync((char*)d_ws + WS_CTL, 0, CTL_ZERO_BYTES, stream) != hipSuccess) return;
    Args a{};
    for (int i = 0; i < 24; ++i) a.in[i] = (const float*)d_in[i];
    a.out = (float*)d_out; a.ws = (unsigned char*)d_ws; a.pad = 0;
    const int nl = MK_N_LAUNCHES == 1 ? 1 : NPH;
    for (int li = 0; li < nl; ++li) {
        a.ph_lo = nl == 1 ? 0 : li; a.ph_hi = nl == 1 ? NPH : li + 1; a.li = 0;
        hipLaunchKernelGGL(mk_fwd, dim3(grid), dim3(NWAVES * 64), LDS_BYTES, stream, a);
        const hipError_t le = hipPeekAtLastError();
        if (le != hipSuccess) { fprintf(stderr, "kernel_launch: launch %d failed: %s\n", li, hipGetErrorName(le)); break; }
    }
}
```

```cpp
#define MK_N_LAUNCHES 1
#include <hip/hip_runtime.h>
#include <cstdio>
#include <cstdint>
#include <cstddef>
#include <cmath>
namespace pg8 {
#define PG8_LAS __attribute__((address_space(3)))
typedef unsigned short bf16_t;
typedef short bf16x8 __attribute__((ext_vector_type(8)));
typedef float f32x4 __attribute__((ext_vector_type(4)));
typedef unsigned u32x4 __attribute__((ext_vector_type(4)));
constexpr int BM = 256, BK = 64, HALF = 128, HTB = HALF * BK * 2  , STAGE_BYTES = 8 * HTB, NXCD = 8, WGM = 8;

__host__ __device__ __forceinline__ int lds_byte(int r, int c) { const int st = (r >> 4) * 2 + (c >> 5), rr = r & 15, cc = c & 31, ob = rr * 64 + cc * 2; return st * 1024 + (ob ^ (((ob >> 9) & 1) << 5)); }
__host__ __device__ __forceinline__ void stage_rc(int b, int& R, int& C) { const int st = b / 1024, sb = b % 1024, swz = sb ^ (((sb >> 9) & 1) << 5); R = (st >> 1) * 16 + swz / 64; C = (st & 1) * 32 + (swz % 64) / 2; }
__host__ __device__ __forceinline__ int perm32(int rho) { const int n = rho >> 4, i = rho & 15; return 8 * (i >> 2) + 4 * n + (i & 3); }

struct Unit { int pm, pn, e; };
struct Gemm { const bf16_t* A; const bf16_t* Bt; int M, N, K; };

struct StaticOrder {
    int nM, nN, nwg, G, c;
    __host__ __device__ void init(int M, int N, int G_, int c_) { nM = M / BM; nN = N / BM; nwg = nM * nN; G = G_; c = c_; }
    __host__ __device__ bool next(int i, Unit& u) const {
        const long L = (long)i * G + c; if (L >= nwg) return false;
        int wgid = (int)L; { const int q = nwg / NXCD, r = nwg % NXCD, xcd = wgid % NXCD, off = wgid / NXCD; wgid = (xcd < r ? xcd * (q + 1) : r * (q + 1) + (xcd - r) * q) + off; }
        const int nig = WGM * nN, gid = wgid / nig, fm = gid * WGM, gsz = (nM - fm) < WGM ? (nM - fm) : WGM;
        u.pm = fm + ((wgid % nig) % gsz); u.pn = (wgid % nig) / gsz; return true;
    }
    __device__ __forceinline__ void a_ready(const Unit&) const {}
    __device__ __forceinline__ void done(const Unit&) const {}
};

__device__ __forceinline__ unsigned cvt_pk_bf16(float lo, float hi) { unsigned r; asm volatile("v_cvt_pk_bf16_f32 %0, %1, %2" : "=v"(r) : "v"(lo), "v"(hi)); return r; }
typedef float f32x2 __attribute__((ext_vector_type(2)));
__device__ __forceinline__ f32x2 gelu_pk(f32x2 v) {
    const f32x2 av = __builtin_elementwise_abs(v), d = av * 0.2316418882f + 1.0f;
    f32x2 t; t.x = __builtin_amdgcn_rcpf(d.x); t.y = __builtin_amdgcn_rcpf(d.y);
    f32x2 q = t * 0.5307027145f + (-0.7265760135f); q = q * t + 0.7107068705f; q = q * t + (-0.142248368f); q = q * t + 0.127414796f; q = q * t;
    const f32x2 s = (v * v) * (-0.72134752044f);
    f32x2 e; e.x = __builtin_amdgcn_exp2f(s.x); e.y = __builtin_amdgcn_exp2f(s.y);
    const f32x2 m = v * (q * e), r = v - m;
    f32x2 o; o.x = v.x < 0.f ? m.x : r.x; o.y = v.y < 0.f ? m.y : r.y; return o;
}

template <int ACT  > struct EpiBf16 {
    static constexpr bool PERM = true, AFTER_DRAIN = false; static_assert(ACT == 0 || ACT == 1, "EpiBf16: ACT is 0 (none) or 1 (gelu_pk)");
    bf16_t* O; int ldc; const float* bias; int split_cols; size_t split_stride; float scale0;
    __device__ __forceinline__ void operator()(const f32x4 (&acc)[2][2][4][2], const Unit& u, int wr, int wc, int fr, int fq) const {
        const int row0 = u.pm * BM + wr * 64 + fr; int colt = u.pn * BM; bf16_t* base = O;
        float sc = 1.f; if (split_cols) { const int t = colt / split_cols; base += (size_t)t * split_stride; colt -= t * split_cols; if (t == 0) sc = scale0; }
        const int col0 = colt + wc * 32 + 8 * fq, bcol0 = u.pn * BM + wc * 32 + 8 * fq;
        f32x4 bv[2][2];
#pragma unroll
        for (int bj = 0; bj < 2; ++bj)
#pragma unroll
            for (int n = 0; n < 2; ++n) bv[bj][n] = bias ? *(const f32x4*)(bias + bcol0 + bj * HALF + 4 * n) : (f32x4){0.f, 0.f, 0.f, 0.f};
#pragma unroll
        for (int ai = 0; ai < 2; ++ai)
#pragma unroll
            for (int m = 0; m < 4; ++m) { bf16_t* rowp = base + (size_t)(row0 + ai * HALF + m * 16) * ldc + col0;
#pragma unroll
                for (int bj = 0; bj < 2; ++bj) { f32x4 v0 = acc[ai][bj][m][0] + bv[bj][0], v1 = acc[ai][bj][m][1] + bv[bj][1];
                    if (ACT == 1) { f32x2 a = gelu_pk((f32x2){v0[0], v0[1]}), b = gelu_pk((f32x2){v0[2], v0[3]}), c = gelu_pk((f32x2){v1[0], v1[1]}), d = gelu_pk((f32x2){v1[2], v1[3]});
                        v0 = (f32x4){a.x, a.y, b.x, b.y}; v1 = (f32x4){c.x, c.y, d.x, d.y}; }
                    v0 = v0 * sc; v1 = v1 * sc; u32x4 w; w.x = cvt_pk_bf16(v0[0], v0[1]); w.y = cvt_pk_bf16(v0[2], v0[3]); w.z = cvt_pk_bf16(v1[0], v1[1]); w.w = cvt_pk_bf16(v1[2], v1[3]);
                    *(u32x4*)(rowp + bj * HALF) = w; } }
    }
};

struct TabOrder {
    const volatile PG8_LAS unsigned* tab;
    __device__ __forceinline__ bool next(int i, Unit& u) const {
        if (i >= 32) return false;
        const volatile PG8_LAS unsigned* r = tab + 8 * i;
        if (__builtin_amdgcn_readfirstlane(r[6]) == 0u) return false;
        u.pm = (int)__builtin_amdgcn_readfirstlane(r[4]); u.pn = (int)__builtin_amdgcn_readfirstlane(r[5]); u.e = i; return true;
    }
    __device__ __forceinline__ const char* abase(const Unit& u, size_t) const { const volatile PG8_LAS unsigned* r = tab + 8 * u.e; const unsigned lo = __builtin_amdgcn_readfirstlane(r[0]), hi = __builtin_amdgcn_readfirstlane(r[1]); return (const char*)(((unsigned long long)hi << 32) | lo); }
    __device__ __forceinline__ const char* bbase(const Unit& u, size_t) const { const volatile PG8_LAS unsigned* r = tab + 8 * u.e; const unsigned lo = __builtin_amdgcn_readfirstlane(r[2]), hi = __builtin_amdgcn_readfirstlane(r[3]); return (const char*)(((unsigned long long)hi << 32) | lo); }
    __device__ __forceinline__ void a_ready(const Unit&) const {}
    __device__ __forceinline__ void done(const Unit&) const {}
};
__device__ __forceinline__ TabOrder build_units(PG8_LAS unsigned char* tabmem, int K, const void* A, const void* B, int G, int c,
                                                int np0, int nn0, int cn0, int mode0, int poff0, int np1, int nn1, int cn1, int mode1, const int* pend, size_t estride, const int tid) {
    __syncthreads();
    if (tid < 32) {
        int i_ = tid; asm volatile("" : "+v"(i_)); const int i = i_;
        const int n0 = np0 * nn0, nwg = n0 + np1 * nn1; const long L = (long)i * G + c; const bool ok = L < nwg;
        int w = ok ? (int)L : 0; { const int q = nwg / NXCD, r = nwg % NXCD, xcd = w % NXCD, off = w / NXCD; w = (xcd < r ? xcd * (q + 1) : r * (q + 1) + (xcd - r) * q) + off; }
        const bool s0 = w < n0; const int ww = s0 ? w : w - n0; const int np = s0 ? np0 : np1, nn = s0 ? nn0 : nn1, cn = s0 ? cn0 : cn1, mode = s0 ? mode0 : mode1;
        const int nig = WGM * nn, gid = ww / nig, fm = gid * WGM, gsz = (np - fm) < WGM ? (np - fm) : WGM;
        const int pv = fm + ((ww % nig) % gsz), pn = cn + (ww % nig) / gsz;
        const int pm0 = pv + poff0, pm1 = pv + (pv >> 3), pm2 = 9 * pv + 8; const int pm = mode == 0 ? pm0 : (mode == 1 ? pm1 : pm2);
        int e = 0;
        if (pend) {
#pragma unroll
            for (int k = 0; k < 8; ++k) e += (pend[k] <= pm) ? 1 : 0;
        }
        const size_t tstep = (size_t)256 * K * 2;
        const unsigned long long a = (unsigned long long)((const char*)A + (size_t)pm * tstep), b = (unsigned long long)((const char*)B + (size_t)e * estride + (size_t)pn * tstep);
        PG8_LAS unsigned* r = (PG8_LAS unsigned*)tabmem + 8 * i;
        r[0] = (unsigned)a; r[1] = (unsigned)(a >> 32); r[2] = (unsigned)b; r[3] = (unsigned)(b >> 32); r[4] = (unsigned)pm; r[5] = (unsigned)pn; r[6] = ok ? 1u : 0u; r[7] = 0u; }
    __syncthreads();
    TabOrder T; T.tab = (const volatile PG8_LAS unsigned*)tabmem; return T;
}

struct EpiRawBf16 {
    static constexpr bool PERM = true, AFTER_DRAIN = false;
    bf16_t* O; int ldc;
    __device__ __forceinline__ void operator()(const f32x4 (&acc)[2][2][4][2], const Unit& u, int wr, int wc, int fr, int fq) const {
        const int row0 = u.pm * BM + wr * 64 + fr, col0 = u.pn * BM + wc * 32 + 8 * fq;
#pragma unroll
        for (int ai = 0; ai < 2; ++ai)
#pragma unroll
            for (int m = 0; m < 4; ++m) { bf16_t* rowp = O + (size_t)(row0 + ai * HALF + m * 16) * ldc + col0;
#pragma unroll
                for (int bj = 0; bj < 2; ++bj) { const f32x4 v0 = acc[ai][bj][m][0], v1 = acc[ai][bj][m][1];
                    u32x4 w; w.x = cvt_pk_bf16(v0[0], v0[1]); w.y = cvt_pk_bf16(v0[2], v0[3]); w.z = cvt_pk_bf16(v1[0], v1[1]); w.w = cvt_pk_bf16(v1[2], v1[3]);
                    *(u32x4*)(rowp + bj * HALF) = w; } }
    }
};
struct EpiGateRes {
    static constexpr bool PERM = false, AFTER_DRAIN = false;
    const float* xin_lat; const float* xin_ctx; float* xout_lat; float* xout_ctx; const float* mod; int goff;
    __device__ __forceinline__ void operator()(const f32x4 (&acc)[2][2][4][2], const Unit& u, int wr, int wc, int fr, int fq) const {
        const int b = u.pm / 9, j = u.pm % 9;
        const float* bi; float* bo; const float* g;
        if (j < 8) { const size_t r0 = (size_t)(b * 2048 + j * 256) * 1024; bi = xin_lat + r0; bo = xout_lat + r0; g = mod + b * 6144 + goff; }
        else { const size_t r0 = (size_t)(b * 256) * 1024; bi = xin_ctx + r0; bo = xout_ctx + r0; g = mod + 16 * 6144 + goff; }
        const int col0 = u.pn * BM + wc * 32 + 4 * fq;
        f32x4 gv[2][2];
#pragma unroll
        for (int bj = 0; bj < 2; ++bj)
#pragma unroll
            for (int n = 0; n < 2; ++n) gv[bj][n] = *(const f32x4*)(g + col0 + bj * HALF + n * 16);
#pragma unroll
        for (int ai = 0; ai < 2; ++ai)
#pragma unroll
            for (int m = 0; m < 4; ++m) { const size_t off = (size_t)(ai * HALF + wr * 64 + m * 16 + fr) * 1024 + col0;
#pragma unroll
                for (int bj = 0; bj < 2; ++bj)
#pragma unroll
                    for (int n = 0; n < 2; ++n) { const f32x4 xi = *(const f32x4*)(bi + off + bj * HALF + n * 16);
                        *(f32x4*)(bo + off + bj * HALF + n * 16) = xi + gv[bj][n] * acc[ai][bj][m][n]; }
                if (m & 1) asm volatile("" ::: "memory"); }
    }
};
struct EpiSwiglu {
    static constexpr bool PERM = true, AFTER_DRAIN = false;
    bf16_t* H; int ldh; int p0;
    __device__ __forceinline__ void operator()(const f32x4 (&acc)[2][2][4][2], const Unit& u, int wr, int wc, int fr, int fq) const {
        const int row0 = (u.pm - p0) * BM + wr * 64 + fr, col0 = u.pn * HALF + wc * 32 + 8 * fq;
#pragma unroll
        for (int ai = 0; ai < 2; ++ai)
#pragma unroll
            for (int m = 0; m < 4; ++m) { bf16_t* rowp = H + (size_t)(row0 + ai * HALF + m * 16) * ldh + col0;
                float h[8];
#pragma unroll
                for (int n = 0; n < 2; ++n)
#pragma unroll
                    for (int k = 0; k < 4; ++k) { const float a = acc[ai][0][m][n][k], b3 = acc[ai][1][m][n][k];
                        const float sg = __builtin_amdgcn_rcpf(1.0f + __builtin_amdgcn_exp2f(-1.4426950408889634f * a)); h[n * 4 + k] = a * sg * b3; }
                u32x4 w; w.x = cvt_pk_bf16(h[0], h[1]); w.y = cvt_pk_bf16(h[2], h[3]); w.z = cvt_pk_bf16(h[4], h[5]); w.w = cvt_pk_bf16(h[6], h[7]);
                *(u32x4*)rowp = w; }
    }
};
struct EpiMoeOut {
    static constexpr bool PERM = true, AFTER_DRAIN = false;
    bf16_t* Y; const float* sgate;
    __device__ __forceinline__ void operator()(const f32x4 (&acc)[2][2][4][2], const Unit& u, int wr, int wc, int fr, int fq) const {
        const int row0 = u.pm * BM + wr * 64 + fr, col0 = u.pn * BM + wc * 32 + 8 * fq;
#pragma unroll
        for (int ai = 0; ai < 2; ++ai)
#pragma unroll
            for (int m = 0; m < 4; ++m) { const int row = row0 + ai * HALF + m * 16; const float gt = sgate[row]; bf16_t* rowp = Y + (size_t)row * 1024 + col0;
#pragma unroll
                for (int bj = 0; bj < 2; ++bj) { const f32x4 v0 = acc[ai][bj][m][0] * gt, v1 = acc[ai][bj][m][1] * gt;
                    u32x4 w; w.x = cvt_pk_bf16(v0[0], v0[1]); w.y = cvt_pk_bf16(v0[2], v0[3]); w.z = cvt_pk_bf16(v1[0], v1[1]); w.w = cvt_pk_bf16(v1[2], v1[3]);
                    *(u32x4*)(rowp + bj * HALF) = w; } }
    }
};
template <class Epi, class Sched, bool ALIGN_EPI = false, bool SP2 = false>
__device__ __forceinline__ void gemm_phase(PG8_LAS unsigned char* lds, const Gemm g, const Sched& S, const Epi& E, const int wave_sgpr) {
    int ln_ = (int)__builtin_amdgcn_mbcnt_hi(~0u, __builtin_amdgcn_mbcnt_lo(~0u, 0u)); asm volatile("" : "+v"(ln_)); const int tid_ = wave_sgpr * 64 + ln_;
    const int tid = tid_, wid = __builtin_amdgcn_readfirstlane(tid >> 6), lane = tid & 63, wr = wid >> 2, wc = wid & 3, fr = lane & 15, fq = lane >> 4;
    const int K = g.K, nt = K / BK;
    unsigned voffA[2], voffB[2];
#pragma unroll
    for (int i = 0; i < 2; ++i) { int R, C; stage_rc(tid * 16 + i * 8192, R, C); const int Rb = Epi::PERM ? ((R & ~31) + perm32(R & 31)) : R;
        voffA[i] = (unsigned)(R * K + C) * 2u; voffB[i] = (unsigned)(Rb * K + C) * 2u; }
    const size_t kstep = (size_t)(BK * 2);
    const size_t hstep = (size_t)HALF * K * 2;
    const size_t tstep = 2 * hstep;
    const unsigned ldsw = (unsigned)wid * 1024u;
    const int aoff = lds_byte(wr * 64 + fr, fq * 8), boff = lds_byte(wc * 32 + fr, fq * 8);
#define PG8_SA(b, h) (((b) * 2 + (h)) * HTB)
#define PG8_SB(b, h) ((4 + (b) * 2 + (h)) * HTB)
#define PG8_STAGE(bufoff, gbase, voff) do { _Pragma("unroll") for (int _i = 0; _i < 2; ++_i) \
        __builtin_amdgcn_global_load_lds((const unsigned*)((const char*)(gbase) + (voff)[_i]), (PG8_LAS unsigned*)(lds + (bufoff) + ldsw + _i * 8192), 16, 0, 0); } while (0)
#define PG8_LDA(dst, b, h) do { _Pragma("unroll") for (int m = 0; m < 4; ++m) _Pragma("unroll") for (int k = 0; k < 2; ++k) dst[m][k] = *(const PG8_LAS bf16x8*)(lds + PG8_SA(b, h) + aoff + m * 2048 + k * 1024); } while (0)
#define PG8_LDB(dst, b, h) do { _Pragma("unroll") for (int n = 0; n < 2; ++n) _Pragma("unroll") for (int k = 0; k < 2; ++k) dst[n][k] = *(const PG8_LAS bf16x8*)(lds + PG8_SB(b, h) + boff + n * 2048 + k * 1024); } while (0)
#define PG8_MMA(ai, bj, At, Bt) do { __builtin_amdgcn_s_setprio(1); _Pragma("unroll") for (int m = 0; m < 4; ++m) _Pragma("unroll") for (int n = 0; n < 2; ++n) _Pragma("unroll") for (int k = 0; k < 2; ++k) \
        acc[ai][bj][m][n] = __builtin_amdgcn_mfma_f32_16x16x32_bf16(Bt[n][k], At[m][k], acc[ai][bj][m][n], 0, 0, 0); __builtin_amdgcn_s_setprio(0); } while (0)
#define PG8_WAIT_V(n) asm volatile("s_waitcnt vmcnt(" #n ")" ::: "memory")
#define PG8_WAIT_L(n) asm volatile("s_waitcnt lgkmcnt(" #n ")" ::: "memory")
#define PG8_BAR __builtin_amdgcn_s_barrier()
#define PG8_SCHED __builtin_amdgcn_sched_barrier(0)
    Unit cur, nxt; int ui = 0;
    if (!S.next(0, cur)) return;
    f32x4 acc[2][2][4][2];
#pragma unroll
    for (int a = 0; a < 2; ++a)
#pragma unroll
        for (int b = 0; b < 2; ++b)
#pragma unroll
            for (int m = 0; m < 4; ++m)
#pragma unroll
                for (int n = 0; n < 2; ++n) acc[a][b][m][n] = (f32x4){0.f, 0.f, 0.f, 0.f};
    bf16x8 At[4][2], B0[2][2], B1[2][2];
    const char* cA = S.abase(cur, tstep); const char* cB = S.bbase(cur, tstep);
    S.a_ready(cur);
    if constexpr (SP2) {
        PG8_STAGE(PG8_SB(0, 0), cB, voffB); PG8_STAGE(PG8_SB(0, 1), cB + hstep, voffB); PG8_STAGE(PG8_SA(0, 0), cA, voffA); PG8_STAGE(PG8_SA(0, 1), cA + hstep, voffA);
        if (wr == 1) PG8_BAR;
        PG8_WAIT_V(2); PG8_BAR;
        PG8_STAGE(PG8_SB(1, 0), cB + kstep, voffB); PG8_STAGE(PG8_SA(1, 0), cA + kstep, voffA); PG8_STAGE(PG8_SB(1, 1), cB + hstep + kstep, voffB);
        PG8_WAIT_V(6); PG8_BAR;
    } else {
        PG8_STAGE(PG8_SB(0, 0), cB, voffB); PG8_STAGE(PG8_SA(0, 0), cA, voffA); PG8_STAGE(PG8_SB(0, 1), cB + hstep, voffB); PG8_STAGE(PG8_SA(0, 1), cA + hstep, voffA);
        if (wr == 1) PG8_BAR;
        PG8_WAIT_V(4); PG8_BAR;
        PG8_STAGE(PG8_SB(1, 0), cB + kstep, voffB); PG8_STAGE(PG8_SA(1, 0), cA + kstep, voffA); PG8_STAGE(PG8_SB(1, 1), cB + hstep + kstep, voffB);
        PG8_WAIT_V(6); PG8_BAR;
    }
    for (;;) {
        const bool has_next = S.next(ui + 1, nxt);
        const char* nA = has_next ? S.abase(nxt, tstep) : cA; const char* nB = has_next ? S.bbase(nxt, tstep) : cB;
        for (int t = 0; t < nt; t += 2) {
            const bool last = (t == nt - 2);
            const char* a1 = cA + (size_t)(t + 1) * kstep;
            const char* a2 = last ? nA : cA + (size_t)(t + 2) * kstep; const char* b2 = last ? nB : cB + (size_t)(t + 2) * kstep;
            const char* a3 = a2 + kstep; const char* b3 = b2 + kstep;
            if (last && has_next) S.a_ready(nxt);
            if constexpr (SP2) {
            PG8_LDB(B0, 0, 0); PG8_LDB(B1, 0, 1); PG8_SCHED; PG8_LDA(At, 0, 0); PG8_STAGE(PG8_SA(1, 1), a1 + hstep, voffA);
            PG8_WAIT_V(8); PG8_WAIT_L(0); PG8_BAR; PG8_MMA(0, 0, At, B0); PG8_MMA(0, 1, At, B1); PG8_BAR; PG8_SCHED;
            PG8_LDA(At, 0, 1); PG8_STAGE(PG8_SB(0, 0), b2, voffB); PG8_STAGE(PG8_SB(0, 1), b2 + hstep, voffB); PG8_STAGE(PG8_SA(0, 0), a2, voffA);
            PG8_WAIT_V(8); PG8_WAIT_L(0); PG8_BAR; PG8_MMA(1, 0, At, B0); PG8_MMA(1, 1, At, B1); PG8_BAR; PG8_SCHED;
            PG8_LDB(B0, 1, 0); PG8_LDB(B1, 1, 1); PG8_SCHED; PG8_LDA(At, 1, 0); PG8_STAGE(PG8_SA(0, 1), a2 + hstep, voffA);
            PG8_WAIT_V(8); PG8_WAIT_L(0); PG8_BAR; PG8_MMA(0, 0, At, B0); PG8_MMA(0, 1, At, B1); PG8_BAR; PG8_SCHED;
            PG8_LDA(At, 1, 1); PG8_STAGE(PG8_SB(1, 0), b3, voffB); PG8_STAGE(PG8_SB(1, 1), b3 + hstep, voffB); PG8_STAGE(PG8_SA(1, 0), a3, voffA);
            PG8_WAIT_V(8); PG8_WAIT_L(0); PG8_BAR; PG8_MMA(1, 0, At, B0); PG8_MMA(1, 1, At, B1); PG8_BAR; PG8_SCHED;
            } else {
            PG8_LDB(B0, 0, 0); PG8_SCHED; PG8_LDA(At, 0, 0); PG8_STAGE(PG8_SA(1, 1), a1 + hstep, voffA);
            PG8_WAIT_L(8); PG8_BAR; PG8_WAIT_L(0); PG8_MMA(0, 0, At, B0); PG8_BAR; PG8_SCHED;
            PG8_LDB(B1, 0, 1); PG8_STAGE(PG8_SB(0, 0), b2, voffB);
            PG8_BAR; PG8_WAIT_L(0); PG8_MMA(0, 1, At, B1); PG8_BAR;
            PG8_LDA(At, 0, 1); PG8_STAGE(PG8_SA(0, 0), a2, voffA);
            PG8_BAR; PG8_WAIT_L(0); PG8_MMA(1, 0, At, B0); PG8_BAR; PG8_SCHED;
            PG8_STAGE(PG8_SB(0, 1), b2 + hstep, voffB);
            PG8_WAIT_V(6); PG8_BAR; PG8_MMA(1, 1, At, B1); PG8_BAR;
            PG8_LDB(B0, 1, 0); PG8_SCHED; PG8_LDA(At, 1, 0); PG8_STAGE(PG8_SA(0, 1), a2 + hstep, voffA);
            PG8_WAIT_L(8); PG8_BAR; PG8_WAIT_L(0); PG8_MMA(0, 0, At, B0); PG8_BAR; PG8_SCHED;
            PG8_LDB(B1, 1, 1); PG8_STAGE(PG8_SB(1, 0), b3, voffB);
            PG8_BAR; PG8_WAIT_L(0); PG8_MMA(0, 1, At, B1); PG8_BAR;
            PG8_LDA(At, 1, 1); PG8_STAGE(PG8_SA(1, 0), a3, voffA);
            PG8_BAR; PG8_WAIT_L(0); PG8_MMA(1, 0, At, B0); PG8_BAR; PG8_SCHED;
            PG8_STAGE(PG8_SB(1, 1), b3 + hstep, voffB);
            PG8_WAIT_V(6); PG8_BAR; PG8_MMA(1, 1, At, B1); PG8_BAR;
            }
        }
        if constexpr (ALIGN_EPI) { if (wr == 0) PG8_BAR; }
        if constexpr (!Epi::AFTER_DRAIN) { E(acc, cur, wr, wc, fr, fq); S.done(cur); }
        if (!has_next) break;
#pragma unroll
        for (int a = 0; a < 2; ++a)
#pragma unroll
            for (int b = 0; b < 2; ++b)
#pragma unroll
                for (int m = 0; m < 4; ++m)
#pragma unroll
                    for (int n = 0; n < 2; ++n) acc[a][b][m][n] = (f32x4){0.f, 0.f, 0.f, 0.f};
        cur = nxt; cA = nA; cB = nB; ++ui;
        if constexpr (ALIGN_EPI) { if (wr == 1) PG8_BAR; }
    }
    PG8_WAIT_V(0);
    if constexpr (!ALIGN_EPI) { if (wr == 0) PG8_BAR; }
    PG8_BAR;
    if constexpr (Epi::AFTER_DRAIN) { E.fused(acc, cur, wr, wc, fr, fq, lds, wid, lane); S.done(cur); }
#undef PG8_SA
#undef PG8_SB
#undef PG8_STAGE
#undef PG8_LDA
#undef PG8_LDB
#undef PG8_MMA
#undef PG8_WAIT_V
#undef PG8_WAIT_L
#undef PG8_BAR
#undef PG8_SCHED
}
}

constexpr int NWAVES = 8;
#ifndef MK_N_LAUNCHES
#define MK_N_LAUNCHES 1
#endif
constexpr int NPH = 23;
constexpr int BATCH = 16, SEQ = 2048, DM = 1024, CTXL = 256, TPB = SEQ + CTXL, MROWS = BATCH * TPB, NPAN = MROWS / 256;
constexpr int INW = 2304, DFF = 2816, NEXP = 8, NTOK = BATCH * SEQ;
constexpr int QA_OFF = 0, QB_OFF = 512, CPOST_OFF = 768, CPRE_OFF = 1024, CVAL_OFF = 1280, KA_OFF = 1536, VA_OFF = 1664, KB_OFF = 1792, VB_OFF = 2048;
constexpr float NORM_EPS = 1e-6f, LOG2E = 1.4426950408889634f, C2 = 0.125f * 1.4426950408889634f;
constexpr int MOE_HCAP = 136;
constexpr int SLOT_CAP = 2 * NTOK + NEXP * 256;

constexpr size_t MiB = 1u << 20;
constexpr size_t WS_CTL = 0, CTL_ZERO_BYTES = 1 * MiB;
constexpr size_t WS_MOD = 1 * MiB;
constexpr size_t WS_MISC = 2 * MiB;
constexpr size_t WS_WIN = 6 * MiB;
constexpr size_t WS_WOUT = 15 * MiB;
constexpr size_t WS_F13 = 19 * MiB;
constexpr size_t WS_F2 = 30 * MiB;
constexpr size_t WS_M13 = 36 * MiB;
constexpr size_t WS_M2 = 124 * MiB;
constexpr size_t WS_XC = 168 * MiB;
constexpr size_t WS_XN = 184 * MiB;
constexpr size_t WS_P = 256 * MiB;
constexpr size_t WS_XT = 316 * MiB;
constexpr size_t WS_END = 504 * MiB;
static_assert(WS_P + (size_t)MROWS * DFF * 2 <= WS_END && WS_XT + (size_t)MOE_HCAP * 256 * DFF * 2 <= WS_END && WS_XN + (size_t)SLOT_CAP * DM * 2 <= WS_XT, "ws map");
constexpr size_t MS_TOKE = 0, MS_TOKG = 256 * 1024, MS_TOKS = 512 * 1024, MS_SLOTG = 768 * 1024, MS_META = 1088 * 1024, MS_ROPE = 1152 * 1024;
constexpr int CW_TMO = 0, CW_CODE = 1, CW_BAR = 4096, CW_CNT = 16384;

constexpr int RING_BYTES = 131072, LDSCTL_OFF = RING_BYTES, MISC_OFF = LDSCTL_OFF + 320, LDS_BYTES = 147456;

#define GAS __attribute__((address_space(1)))
#define LAS __attribute__((address_space(3)))
typedef unsigned short bf16;
typedef unsigned v4u __attribute__((ext_vector_type(4)));
typedef unsigned v2u __attribute__((ext_vector_type(2)));
typedef float f32x4 __attribute__((ext_vector_type(4)));
#define LDS_WAIT() asm volatile("s_waitcnt lgkmcnt(0)" ::: "memory")
#define VM_WAIT() asm volatile("s_waitcnt vmcnt(0)" ::: "memory")
__device__ __forceinline__ unsigned f2bf(float f) { unsigned u = __builtin_bit_cast(unsigned, f); return (u + 0x7fffu + ((u >> 16) & 1u)) >> 16; }
__device__ __forceinline__ unsigned pk2(float lo, float hi) { return f2bf(lo) | (f2bf(hi) << 16); }
__device__ __forceinline__ float bflo(unsigned w) { return __uint_as_float(w << 16); }
__device__ __forceinline__ float bfhi(unsigned w) { return __uint_as_float(w & 0xffff0000u); }
__device__ __forceinline__ float bf1(bf16 h) { return __uint_as_float((unsigned)h << 16); }
__device__ __forceinline__ float wave_sum(float v) {
#pragma unroll
    for (int o = 1; o < 64; o <<= 1) v += __shfl_xor(v, o);
    return v;
}
__device__ __forceinline__ float half_sum(float v) {
#pragma unroll
    for (int o = 1; o < 32; o <<= 1) v += __shfl_xor(v, o);
    return v;
}
#include <hip/hip_bf16.h>
#include <cmath>
namespace attn_body {
using bf16=__hip_bfloat16;
using bf16x8=__attribute__((ext_vector_type(8)))short;
using s16x4=__attribute__((ext_vector_type(4)))short;
using f32x16=__attribute__((ext_vector_type(16)))float;
using u32x4=__attribute__((ext_vector_type(4)))unsigned;
constexpr int D=64,DM=2304;
constexpr int NW=8,QBLK=32,QB=QBLK*NW,KVBLK=64;
constexpr int LDS_BT=86016, BT_STRIDE=128, BT_PAD=48;
__device__ __forceinline__ int crow(int r,int hi){return (r&3)+8*(r>>2)+4*hi;}
#define SBAR() __builtin_amdgcn_sched_barrier(0)
__device__ __forceinline__ void bias_apply(f32x16&p0,f32x16&p1,const __attribute__((address_space(3))) char*tb,unsigned m0,unsigned m1,float mh){
  const unsigned NEGB=0xf149f2cau;
  #pragma unroll
  for(int g=0;g<4;++g){
    #pragma unroll
    for(int k=0;k<4;++k){ const int r=4*g+k; const int o=((r&3)+8*(r>>2))*4; const float b0=*(const __attribute__((address_space(3))) float*)(tb+o),b1=*(const __attribute__((address_space(3))) float*)(tb+o+128);
      const unsigned s0=(unsigned)__builtin_amdgcn_sbfe((int)m0,r,1), s1=(unsigned)__builtin_amdgcn_sbfe((int)m1,r,1);
      const unsigned x0=__float_as_uint(p0[r]+(b0-mh)), x1=__float_as_uint(p1[r]+(b1-mh));
      float y0=__uint_as_float((x0&s0)|(NEGB&~s0)), y1=__uint_as_float((x1&s1)|(NEGB&~s1)); asm volatile("":"+v"(y0),"+v"(y1)); p0[r]=y0; p1[r]=y1; }
    __builtin_amdgcn_sched_barrier(0); }
}
constexpr int NSLOT=3, SLOTB=8192;
constexpr int LDS_K=0, LDS_V=NSLOT*SLOTB, LDS_WS=2*NSLOT*SLOTB, LDS_OST=LDS_WS+NW*64*4, LDS_BYTES=LDS_OST+NW*4096;
constexpr float C2=0.125f*1.4426950408889634f;
__device__ __forceinline__ void glds16(const void*gsrc,unsigned lds_dst){unsigned keep;
  asm volatile("s_mov_b32 %0, m0\n\ts_mov_b32 m0, %2\n\ts_nop 0\n\tglobal_load_lds_dwordx4 %1, off\n\ts_mov_b32 m0, %0":"=&s"(keep):"v"(gsrc),"s"(lds_dst):"memory");}
__device__ __forceinline__ float max3f(float a,float b,float c){float r;asm("v_max3_f32 %0, %1, %2, %3":"=v"(r):"v"(a),"v"(b),"v"(c));return r;}
__device__ __forceinline__ float max2f(float a,float b){float r;asm("v_max_f32_e32 %0, %1, %2":"=v"(r):"v"(a),"v"(b));return r;}
__device__ __forceinline__ float fadd_s(float a,float b){float r;asm("v_add_f32_e32 %0, %1, %2":"=v"(r):"v"(a),"v"(b));return r;}
__device__ __forceinline__ float fsub_s(float a,float b){float r;asm("v_sub_f32_e32 %0, %1, %2":"=v"(r):"v"(a),"v"(b));return r;}
typedef float f32x2_t __attribute__((ext_vector_type(2))); typedef __bf16 bf16x2_t __attribute__((ext_vector_type(2)));
__device__ __forceinline__ unsigned cvtpk_s(float lo,float hi){f32x2_t v={lo,hi};bf16x2_t b=__builtin_convertvector(v,bf16x2_t);return __builtin_bit_cast(unsigned,b);}
#define WAIT_BAR(N) asm volatile("s_waitcnt vmcnt(" #N ") lgkmcnt(0)\n\ts_barrier":::"memory")

template<bool ZERO> __device__ __forceinline__ f32x16 cinit(const f32x16&negm){ if constexpr(ZERO) return f32x16{}; else return negm; }
__device__ __forceinline__ void qkt(f32x16&p0,f32x16&p1,const char*Kslot,const bf16x8*qr,const f32x16 negm,int r32,int hi){
  const char*kb=Kslot+hi*1024+r32*16;
  #pragma unroll
  for(int d0=0;d0<4;++d0){
    const bf16x8 b0=*reinterpret_cast<const bf16x8*>(kb+d0*2048);
    const bf16x8 b1=*reinterpret_cast<const bf16x8*>(kb+d0*2048+512);
    if(d0==0){p0=__builtin_amdgcn_mfma_f32_32x32x16_bf16(b0,qr[0],negm,0,0,0);p1=__builtin_amdgcn_mfma_f32_32x32x16_bf16(b1,qr[0],negm,0,0,0);}
    else{p0=__builtin_amdgcn_mfma_f32_32x32x16_bf16(b0,qr[d0],p0,0,0,0);p1=__builtin_amdgcn_mfma_f32_32x32x16_bf16(b1,qr[d0],p1,0,0,0);}}
}
typedef __attribute__((address_space(3))) const char* lds_cptr;
typedef short v4i16_t __attribute__((ext_vector_type(4)));
__device__ __forceinline__ void kload8(bf16x8*kf,lds_cptr kp){
  kf[0]=*(const __attribute__((address_space(3))) bf16x8*)(kp);      kf[1]=*(const __attribute__((address_space(3))) bf16x8*)(kp+512);
  kf[2]=*(const __attribute__((address_space(3))) bf16x8*)(kp+2048); kf[3]=*(const __attribute__((address_space(3))) bf16x8*)(kp+2560);
  kf[4]=*(const __attribute__((address_space(3))) bf16x8*)(kp+4096); kf[5]=*(const __attribute__((address_space(3))) bf16x8*)(kp+4608);
  kf[6]=*(const __attribute__((address_space(3))) bf16x8*)(kp+6144); kf[7]=*(const __attribute__((address_space(3))) bf16x8*)(kp+6656);
}
__device__ __forceinline__ void kload2(bf16x8*kf,lds_cptr kp,int j){ kf[2*j]=*(const __attribute__((address_space(3))) bf16x8*)(kp+j*2048); kf[2*j+1]=*(const __attribute__((address_space(3))) bf16x8*)(kp+j*2048+512); }
__device__ __forceinline__ s16x4 vtr(lds_cptr p){ return __builtin_bit_cast(s16x4,__builtin_amdgcn_ds_read_tr16_b64_v4i16((__attribute__((address_space(3))) v4i16_t*)p)); }
__device__ __forceinline__ float rowmax(const f32x16&p0,const f32x16&p1){
  float a=max3f(p0[0],p0[1],p1[0]),b=max3f(p0[2],p0[3],p1[1]);a=max3f(a,p1[2],p1[3]);
  #pragma unroll
  for(int r=4;r<16;r+=4){a=max3f(a,p0[r],p0[r+1]);b=max3f(b,p0[r+2],p0[r+3]);a=max3f(a,p1[r],p1[r+1]);b=max3f(b,p1[r+2],p1[r+3]);}
  const float m=max2f(a,b);
  auto rr=__builtin_amdgcn_permlane32_swap(__float_as_uint(m),__float_as_uint(m),false,false);
  return max2f(__uint_as_float(rr[0]),__uint_as_float(rr[1]));
}
__device__ __forceinline__ void pv(f32x16*o,int vb,bf16x8 pa0,bf16x8 pa1,bf16x8 pa2,bf16x8 pa3){
  #pragma unroll
  for(int d0=0;d0<2;++d0){s16x4 lo[4],hi[4];
    #pragma unroll
    for(int ks=0;ks<4;++ks){
      asm volatile("ds_read_b64_tr_b16 %0,%1 offset:%c2":"=&v"(lo[ks]):"v"(vb),"i"(d0*4096+ks*1024):"memory");
      asm volatile("ds_read_b64_tr_b16 %0,%1 offset:%c2":"=&v"(hi[ks]):"v"(vb),"i"(d0*4096+ks*1024+512):"memory");}
    asm volatile("s_waitcnt lgkmcnt(0)":::"memory");SBAR();
    #define PK(k) (bf16x8){lo[k][0],lo[k][1],lo[k][2],lo[k][3],hi[k][0],hi[k][1],hi[k][2],hi[k][3]}
    o[d0]=__builtin_amdgcn_mfma_f32_32x32x16_bf16(pa0,PK(0),o[d0],0,0,0);
    o[d0]=__builtin_amdgcn_mfma_f32_32x32x16_bf16(pa1,PK(1),o[d0],0,0,0);
    o[d0]=__builtin_amdgcn_mfma_f32_32x32x16_bf16(pa2,PK(2),o[d0],0,0,0);
    o[d0]=__builtin_amdgcn_mfma_f32_32x32x16_bf16(pa3,PK(3),o[d0],0,0,0);
    #undef PK
  }
}

#ifndef ATTN_STORE16
#define ATTN_STORE16(p,v) (*(u32x4*)(p)=(v))
#endif
template<int THRL,bool BMODE> __device__ __forceinline__ void attn_unit(const bf16*Qu,const bf16*__restrict__ Kh,const bf16*__restrict__ Vh,bf16*Ou,const int NT,const int nfirst,const int first0,const int second0,const int qg,const float*rpbh,char*shm,const int wave_sgpr){
  int ln_=(int)__builtin_amdgcn_mbcnt_hi(~0u,__builtin_amdgcn_mbcnt_lo(~0u,0u)); asm volatile("":"+v"(ln_));
  const int wid=wave_sgpr,lane=ln_,tid=wid*64+lane,r32=lane&31,hi=lane>>5;
  const bf16*Qw=Qu+(long)(wid*QBLK)*DM;
  const unsigned lds0=(unsigned)(uintptr_t)shm;
  float*wsf=(float*)(shm+LDS_WS)+wid*64;
  const bf16*ksrc=Kh+(long)lane*DM+wid*8;
  const bf16*vsrc=Vh+(long)(16*(wid&3)+(lane>>2))*DM+(wid>>2)*32+(lane&3)*8;
  const unsigned kdst=lds0+LDS_K+wid*1024, vdst=lds0+LDS_V+wid*1024;
  #define TILE(t) (((t)<nfirst)?(first0+(t)):(second0+(t)-nfirst))
  #define DMA_K(t,slot) glds16(ksrc+(long)TILE(t)*KVBLK*DM,(unsigned)__builtin_amdgcn_readfirstlane(kdst+(slot)))
  #define DMA_V(t,slot) glds16(vsrc+(long)TILE(t)*KVBLK*DM,(unsigned)__builtin_amdgcn_readfirstlane(vdst+(slot)))
  const int vb0=(int)(lds0+LDS_V)+((lane>>4)&1)*32+(lane&3)*8+(4*hi+((lane&15)>>2))*64;
  const char*Kbase=shm+LDS_K; bf16x8 kf[8];
  const lds_cptr shm3=(lds_cptr)shm; const lds_cptr kp0=shm3+LDS_K+hi*1024+r32*16; const lds_cptr vp0=shm3+LDS_V+((lane>>4)&1)*32+(lane&3)*8+(4*hi+((lane&15)>>2))*64;
  unsigned bm0=0u,bm1=0u; int blane=0,bqr=0,brs=0;
  if constexpr(BMODE){ const int qc=(wid&1)*32+r32; int cs=qc-8; cs=cs<0?0:(cs>48?48:cs);
    _Pragma("unroll") for(int r=0;r<16;++r){ const int kc=(r&3)+8*(r>>2)+4*hi; bm0|=(kc>=cs&&kc<cs+16)?(1u<<r):0u; bm1|=(kc+32>=cs&&kc+32<cs+16)?(1u<<r):0u; }
    blane=(BT_PAD+15-qc+4*hi)*4; bqr=qg+(wid>>1); brs=bqr-4; brs=brs<0?0:(brs>24?24:brs);
    __attribute__((address_space(3))) float*bt=(__attribute__((address_space(3))) float*)(shm3+LDS_BT); for(int idx=tid;idx<15*BT_STRIDE;idx+=NW*64){ const int dr=idx/BT_STRIDE,j=idx%BT_STRIDE; bt[idx]=(j>=BT_PAD&&j<=BT_PAD+30)?rpbh[dr*31+j-BT_PAD]*1.4426950408889634f:0.f; } }
  DMA_K(0,0);DMA_V(0,0);DMA_K(1,SLOTB);
  bf16x8 qr[4];
  #pragma unroll
  for(int d0=0;d0<4;++d0)qr[d0]=*reinterpret_cast<const bf16x8*>(&Qw[(long)r32*DM+d0*16+hi*8]);
  float mhat=0.f,l_reg=0.f;f32x16 o[2];o[0]=f32x16{};o[1]=f32x16{};f32x16 negm=f32x16{}; if constexpr(!BMODE){asm volatile("":"+v"(negm));}
  #define CMASK(P0,P1,t) do{ if constexpr(BMODE){ if((t)>=nfirst){ const int kr_=second0+(t)-nfirst; const bool rv_=(kr_>=brs)&&(kr_<brs+8); int dr_=kr_-bqr+7; dr_=dr_<0?0:(dr_>14?14:dr_); \
      bias_apply(P0,P1,shm3+LDS_BT+dr_*(BT_STRIDE*4)+blane,rv_?bm0:0u,rv_?bm1:0u,mhat); } else { _Pragma("unroll") for(int r_=0;r_<16;++r_){P0[r_]-=mhat;P1[r_]-=mhat;} } } }while(0)
  bool resc=false;
  #define START(P0,P1) do{ const float rm=rowmax(P0,P1); resc=false; \
    { const float dl=rm; mhat=fadd_s(mhat,dl); \
      _Pragma("unroll") for(int r=0;r<16;++r){P0[r]=fsub_s(P0[r],dl);P1[r]=fsub_s(P1[r],dl);} \
      if constexpr(!BMODE){ _Pragma("unroll") for(int r=0;r<16;++r)negm[r]=-mhat; asm volatile("":"+v"(negm)); } } \
    _Pragma("unroll") for(int r=0;r<16;++r)P0[r]=__builtin_amdgcn_exp2f(P0[r]); }while(0)
  #define RESC() do{ if(resc){ asm volatile("s_waitcnt lgkmcnt(0)":::"memory"); \
      _Pragma("unroll") for(int d_=0;d_<2;++d_) _Pragma("unroll") for(int r=0;r<16;++r)o[d_][r]*=wsf[crow(r,hi)]; } }while(0)
  f32x16 pA0,pA1,pB0,pB1;
  int sl_prev=0,sl_cur=0,sl_next=SLOTB;
  #define ROT() do{sl_prev=sl_cur;sl_cur=sl_next;sl_next=(sl_next==(NSLOT-1)*SLOTB)?0:sl_next+SLOTB;}while(0)
  DMA_K(2,2*SLOTB);
  WAIT_BAR(3);
  qkt(pA0,pA1,Kbase,qr,cinit<BMODE>(negm),r32,hi);asm volatile("s_nop 15\n\ts_nop 7":"+v"(pA0),"+v"(pA1));CMASK(pA0,pA1,0);
  START(pA0,pA1);
  _Pragma("unroll") for(int r=0;r<16;++r)pA1[r]=__builtin_amdgcn_exp2f(pA1[r]);
  WAIT_BAR(0);
  DMA_K(3,0);DMA_V(1,SLOTB);
  ROT();
  kload8(kf,kp0+sl_cur);
  WAIT_BAR(2);
  s16x4 vlo[8],vhi[8]; u32x4 pw0,pw1,pw2,pw3;
  #define PKW(P,B) cvtpk_s(P[B],P[B+1])
  #define PAF(k) __builtin_bit_cast(bf16x8,pw##k)
  #define VFR(i) (bf16x8){vlo[i][0],vlo[i][1],vlo[i][2],vlo[i][3],vhi[i][0],vhi[i][1],vhi[i][2],vhi[i][3]}
  #define PIN(x) asm volatile("":"+v"(x))
  #define MX3(a,b,c) __builtin_fmaxf(__builtin_fmaxf((a),(b)),(c))
  #define GAPA(MF,A0,A1,A2,A3,W0,W1,PW) do{ MF; sacc+=A0; sacc+=A1; sacc+=A2; sacc+=A3; PIN(sacc); W0; W1; PIN(PW); SBAR(); }while(0)
  #define EX(v) __builtin_amdgcn_exp2f(v)
  #define GAPB(MF,X,B) do{ MF; X[B]=EX(X[B]); X[B+1]=EX(X[B+1]); X[B+2]=EX(X[B+2]); X[B+3]=EX(X[B+3]); PIN(X); SBAR(); }while(0)
  #define VRD(i) do{ vlo[i]=vtr(vp_+(((i)>>2)*4096+((i)&3)*1024)); vhi[i]=vtr(vp_+(((i)>>2)*4096+((i)&3)*1024+512)); }while(0)
  #define KRD(G,j) do{ if(G){ kload2(kf,kp0+sl_next,j); SBAR(); } }while(0)
  #define STEP(C0,C1,P0,P1,t,GK,GV,GL) do{ SBAR(); \
    const lds_cptr vp_=vp0+sl_prev; \
    VRD(0); SBAR(); float sacc=(P0[0]+P0[1]); \
    GAPA(C0=__builtin_amdgcn_mfma_f32_32x32x16_bf16(kf[0],qr[0],cinit<BMODE>(negm),0,0,0), P0[2],P0[3],P0[4],P0[5],     pw0[0]=PKW(P0,0), pw0[1]=PKW(P0,2), pw0); \
    VRD(4); SBAR(); GAPA(C1=__builtin_amdgcn_mfma_f32_32x32x16_bf16(kf[1],qr[0],cinit<BMODE>(negm),0,0,0), P0[6],P0[7],P0[8],P0[9],     pw0[2]=PKW(P0,4), pw0[3]=PKW(P0,6), pw0); \
    VRD(1); SBAR(); GAPA(C0=__builtin_amdgcn_mfma_f32_32x32x16_bf16(kf[2],qr[1],C0,0,0,0),   P0[10],P0[11],P0[12],P0[13], pw1[0]=PKW(P0,8), pw1[1]=PKW(P0,10), pw1); \
    VRD(5); SBAR(); GAPA(C1=__builtin_amdgcn_mfma_f32_32x32x16_bf16(kf[3],qr[1],C1,0,0,0),   P0[14],P0[15],P1[0],P1[1],   pw1[2]=PKW(P0,12),pw1[3]=PKW(P0,14), pw1); \
    VRD(2); SBAR(); GAPA(C0=__builtin_amdgcn_mfma_f32_32x32x16_bf16(kf[4],qr[2],C0,0,0,0),   P1[2],P1[3],P1[4],P1[5],     pw2[0]=PKW(P1,0), pw2[1]=PKW(P1,2), pw2); \
    VRD(6); SBAR(); GAPA(C1=__builtin_amdgcn_mfma_f32_32x32x16_bf16(kf[5],qr[2],C1,0,0,0),   P1[6],P1[7],P1[8],P1[9],     pw2[2]=PKW(P1,4), pw2[3]=PKW(P1,6), pw2); \
    VRD(3); SBAR(); GAPA(C0=__builtin_amdgcn_mfma_f32_32x32x16_bf16(kf[6],qr[3],C0,0,0,0),   P1[10],P1[11],P1[12],P1[13], pw3[0]=PKW(P1,8), pw3[1]=PKW(P1,10), pw3); \
    VRD(7); SBAR(); GAPA(C1=__builtin_amdgcn_mfma_f32_32x32x16_bf16(kf[7],qr[3],C1,0,0,0),   P1[14],P1[15],0.f,0.f,       pw3[2]=PKW(P1,12),pw3[3]=PKW(P1,14), pw3); \
    l_reg+=sacc; \
    if(GK){DMA_K((t)+3,sl_cur);} if(GV){DMA_V((t)+1,sl_next);} \
    CMASK(C0,C1,t); \
    { float a=MX3(C0[0],C0[1],C1[0]),b=MX3(C0[2],C0[3],C1[1]); a=MX3(a,C1[2],C1[3]); \
      _Pragma("unroll") for(int r=4;r<16;r+=4){a=MX3(a,C0[r],C0[r+1]);b=MX3(b,C0[r+2],C0[r+3]);a=MX3(a,C1[r],C1[r+1]);b=MX3(b,C1[r+2],C1[r+3]);} \
      float rm=__builtin_fmaxf(a,b); { auto rr=__builtin_amdgcn_permlane32_swap(__float_as_uint(rm),__float_as_uint(rm),false,false); rm=__builtin_fmaxf(__uint_as_float(rr[0]),__uint_as_float(rr[1])); } \
      resc=false; \
      if(__builtin_expect(__any(rm>(float)THRL),0)){ const float dl=__builtin_fmaxf(rm,0.f); mhat+=dl; \
        _Pragma("unroll") for(int r=0;r<16;++r){C0[r]-=dl;C1[r]-=dl;} \
        if constexpr(!BMODE){ _Pragma("unroll") for(int r=0;r<16;++r)negm[r]=-mhat; asm volatile("":"+v"(negm)); } \
        const float f=__builtin_amdgcn_exp2f(-dl); l_reg*=f; if(hi==0)wsf[r32]=f; resc=true; } } \
    SBAR(); \
    GAPB(o[0]=__builtin_amdgcn_mfma_f32_32x32x16_bf16(PAF(0),VFR(0),o[0],0,0,0), C0,0); \
    GAPB(o[1]=__builtin_amdgcn_mfma_f32_32x32x16_bf16(PAF(0),VFR(4),o[1],0,0,0), C0,4); \
    KRD(GL,0); GAPB(o[0]=__builtin_amdgcn_mfma_f32_32x32x16_bf16(PAF(1),VFR(1),o[0],0,0,0), C0,8); \
    KRD(GL,1); GAPB(o[1]=__builtin_amdgcn_mfma_f32_32x32x16_bf16(PAF(1),VFR(5),o[1],0,0,0), C0,12); \
    KRD(GL,2); GAPB(o[0]=__builtin_amdgcn_mfma_f32_32x32x16_bf16(PAF(2),VFR(2),o[0],0,0,0), C1,0); \
    KRD(GL,3); GAPB(o[1]=__builtin_amdgcn_mfma_f32_32x32x16_bf16(PAF(2),VFR(6),o[1],0,0,0), C1,4); \
    GAPB(o[0]=__builtin_amdgcn_mfma_f32_32x32x16_bf16(PAF(3),VFR(3),o[0],0,0,0), C1,8); \
    GAPB(o[1]=__builtin_amdgcn_mfma_f32_32x32x16_bf16(PAF(3),VFR(7),o[1],0,0,0), C1,12); \
    }while(0)
  int t=1;
  for(;t+5<NT;t+=2){
    STEP(pB0,pB1,pA0,pA1,t,true,true,true);     WAIT_BAR(2); RESC(); ROT();
    STEP(pA0,pA1,pB0,pB1,t+1,true,true,true);   WAIT_BAR(2); RESC(); ROT();
  }
  #define ENDW(tt) do{ if((tt)+3<NT){WAIT_BAR(2);} else if((tt)+2<NT){WAIT_BAR(1);} else {WAIT_BAR(0);} }while(0)
  for(;t+1<NT;t+=2){
    STEP(pB0,pB1,pA0,pA1,t,(t+3<NT),(t+1<NT),(t+1<NT));       ENDW(t);   RESC(); ROT();
    STEP(pA0,pA1,pB0,pB1,t+1,(t+4<NT),(t+2<NT),(t+2<NT));     ENDW(t+1); RESC(); ROT();
  }
  STEP(pB0,pB1,pA0,pA1,NT-1,false,false,false); RESC();
  { float sacc=pB0[0]+pB0[1]; _Pragma("unroll") for(int r=2;r<16;++r)sacc+=pB0[r]; _Pragma("unroll") for(int r=0;r<16;++r)sacc+=pB1[r]; l_reg+=sacc;
    pw0=(u32x4){PKW(pB0,0),PKW(pB0,2),PKW(pB0,4),PKW(pB0,6)};pw1=(u32x4){PKW(pB0,8),PKW(pB0,10),PKW(pB0,12),PKW(pB0,14)};pw2=(u32x4){PKW(pB1,0),PKW(pB1,2),PKW(pB1,4),PKW(pB1,6)};pw3=(u32x4){PKW(pB1,8),PKW(pB1,10),PKW(pB1,12),PKW(pB1,14)};
    SBAR(); pv(o,vb0+sl_cur,PAF(0),PAF(1),PAF(2),PAF(3)); }
  #undef PKW
  #undef PAF
  #undef VFR
  #undef PIN
  #undef MX3
  #undef GAPA
  #undef GAPB
  #undef EX
  #undef VRD
  #undef KRD
  #undef STEP
  #undef ENDW
  {auto rr=__builtin_amdgcn_permlane32_swap(__float_as_uint(l_reg),__float_as_uint(l_reg),false,false);l_reg=__uint_as_float(rr[0])+__uint_as_float(rr[1]);}
  if(hi==0)wsf[32+r32]=l_reg;asm volatile("s_waitcnt lgkmcnt(0)":::"memory");
  float rli[16];
  #pragma unroll
  for(int r=0;r<16;++r)rli[r]=__builtin_amdgcn_rcpf(wsf[32+crow(r,hi)]);
  bf16*Ow=Ou+(long)(wid*QBLK)*DM;
  { bf16*stg=(bf16*)(shm+LDS_OST)+wid*2048;
    #pragma unroll
    for(int r=0;r<16;++r){const int orow=crow(r,hi);
      #pragma unroll
      for(int d0=0;d0<2;++d0)stg[orow*64+d0*32+r32]=__float2bfloat16(o[d0][r]*rli[r]);}
    asm volatile("s_waitcnt lgkmcnt(0)":::"memory");
    #pragma unroll
    for(int i=0;i<4;++i){const int row=i*8+(lane>>3),ch=lane&7; const u32x4 v=*(const u32x4*)(stg+row*64+ch*8); ATTN_STORE16(Ow+(long)row*DM+ch*8,v);} }
  asm volatile("s_waitcnt lgkmcnt(0)\n\ts_barrier":::"memory");
  #undef TILE
  #undef DMA_K
  #undef DMA_V
  #undef CMASK
  #undef START
  #undef RESC
  #undef ROT
}
constexpr int ATTN_LDS_BYTES=LDS_BT+15*BT_STRIDE*4;
#undef SBAR
#undef WAIT_BAR
}
#define XB_TMO      128
#define XB_XCNT(j)  (256  + 64 * (j))
#define XB_XSUB(j)  (1280 + 64 * (j))
#define XB_XGEN(j)  (2304 + 64 * (j))
#define XB_TOP      3328
#define XB_TOPGEN   3392
#define XCD_BAR_WORDS 3456
#define XB_SPIN_CAP (1u << 18)

__device__ __forceinline__ unsigned xb_ld(unsigned* p)              { return __hip_atomic_load(p, __ATOMIC_RELAXED, __HIP_MEMORY_SCOPE_AGENT); }
__device__ __forceinline__ unsigned xb_add(unsigned* p, unsigned v) { return __hip_atomic_fetch_add(p, v, __ATOMIC_RELAXED, __HIP_MEMORY_SCOPE_AGENT); }
__device__ __forceinline__ unsigned xb_xcc_id() { return (unsigned)__builtin_amdgcn_s_getreg((3 << 11) | 20) & 0xFu; }
#define XB_SPIN(cond, bar) do { unsigned _sp = 0; while (cond) { __builtin_amdgcn_s_sleep(1); \
    if ((++_sp & 255u) == 0u) { if (xb_ld(&(bar)[XB_TMO])) break; if (_sp > XB_SPIN_CAP) { atomicAdd(&(bar)[XB_TMO], 1u); break; } } } } while (0)

struct XcdBarrier {
    unsigned* bar; unsigned x;
    volatile LAS unsigned* st;
};

__device__ __forceinline__ XcdBarrier xcd_barrier_post(unsigned* bar, volatile LAS unsigned* st) {
    XcdBarrier b; b.bar = bar; b.x = xb_xcc_id(); b.st = st;
    if (threadIdx.x == 0) (void)xb_add(&bar[XB_XCNT(b.x)], 1u);
    return b;
}
__device__ __forceinline__ void xcd_barrier_complete(unsigned* bar, unsigned x, unsigned& nloc, unsigned& nx) {
    const unsigned G = gridDim.x * gridDim.y * gridDim.z;
    unsigned sum, cnt, mine, sp = 0u;
    for (;;) {
        sum = 0u; cnt = 0u; mine = 0u;
#pragma unroll
        for (unsigned j = 0; j < 16; ++j) { const unsigned c = xb_ld(&bar[XB_XCNT(j)]); sum += c; cnt += (c > 0u) ? 1u : 0u; mine = (j == x) ? c : mine; }
        if (sum == G) break;
        __builtin_amdgcn_s_sleep(1);
        if ((++sp & 255u) == 0u) { if (xb_ld(&bar[XB_TMO])) break; if (sp > XB_SPIN_CAP) { atomicAdd(&bar[XB_TMO], 1u); break; } }
    }
    nloc = mine > 0u ? mine : 1u; nx = cnt > 0u ? cnt : 1u;
}

__device__ __forceinline__ void xcd_barrier(const XcdBarrier& b) {
    asm volatile("s_waitcnt vmcnt(0)" ::: "memory");
    __syncthreads();
    if (threadIdx.x == 0) {
        unsigned* bar = b.bar;
        __builtin_amdgcn_s_waitcnt(0);
        unsigned nloc = b.st[0], nx = b.st[1];
        if (nloc == 0u) { xcd_barrier_complete(bar, b.x, nloc, nx); b.st[0] = nloc; b.st[1] = nx; }
        const unsigned old = xb_add(&bar[XB_XSUB(b.x)], 1u);
        const unsigned gen = old / nloc;
        if (old + 1u == (gen + 1u) * nloc) {
            __builtin_amdgcn_fence(__ATOMIC_RELEASE, "agent");
            asm volatile("s_waitcnt vmcnt(0)" ::: "memory");
            const unsigned og = xb_add(&bar[XB_TOP], 1u);
            const unsigned tg = og / nx;
            if (og + 1u == (tg + 1u) * nx) xb_add(&bar[XB_TOPGEN], 1u);
            else XB_SPIN(xb_ld(&bar[XB_TOPGEN]) == tg, bar);
            __builtin_amdgcn_fence(__ATOMIC_ACQUIRE, "agent");
            xb_add(&bar[XB_XGEN(b.x)], 1u);
            asm volatile("s_waitcnt vmcnt(0)" ::: "memory");
        } else {
            XB_SPIN(xb_ld(&bar[XB_XGEN(b.x)]) == gen, bar);
            __builtin_amdgcn_fence(__ATOMIC_ACQUIRE, "agent");
            asm volatile("s_waitcnt vmcnt(0)" ::: "memory");
        }
    }
    __syncthreads();
}

struct Frame {
    LAS unsigned char* lds;
    volatile LAS unsigned* MISC;
    unsigned* ctl;
    int tid, lane, wave, vcu, G;
    float* out; unsigned char* ws;
};
__device__ __forceinline__ const float* inp(const Frame& F, int i) {
    const volatile LAS unsigned* t = (const volatile LAS unsigned*)(F.lds + LDSCTL_OFF + 64) + 2 * i;
    const unsigned lo = __builtin_amdgcn_readfirstlane(t[0]), hi = __builtin_amdgcn_readfirstlane(t[1]);
    return (const float*)(((unsigned long long)hi << 32) | lo);
}
enum { I_X = 0, I_C, I_CTX, I_CCTX, I_WMOD, I_BMOD, I_WIN, I_GQA, I_GKA, I_GQB, I_GKB, I_RPB, I_CONVW, I_CONVB, I_GOUT, I_WOUT, I_F1, I_F3, I_F2, I_ROUTER, I_ROUTERB, I_M1, I_M3, I_M2 };

__device__ __forceinline__ void p0_transpose_item(const float* W, int K, int N, bf16* WT, int row_off, int il, int half, LAS float* scr, int item, int lane) {
    const int nblk = N / 32, kb = item / nblk, nb = item % nblk, k0 = 64 * kb, n0 = 32 * nb;
#pragma unroll 8
    for (int i = 0; i < 32; ++i) { const int kk = 2 * i + (lane >> 5); scr[kk * 33 + (lane & 31)] = W[(size_t)(k0 + kk) * N + n0 + (lane & 31)]; }
    LDS_WAIT(); asm volatile("" ::: "memory");
    const int c = lane & 7;
    const int orow0 = il ? ((n0 >> 7) * 256 + half * 128 + (n0 & 127)) : (row_off + n0);
#pragma unroll
    for (int j = 0; j < 4; ++j) { const int n = (lane >> 3) + 8 * j; const LAS float* s = scr + (8 * c) * 33 + n;
        v4u o; o.x = pk2(s[0 * 33], s[1 * 33]); o.y = pk2(s[2 * 33], s[3 * 33]); o.z = pk2(s[4 * 33], s[5 * 33]); o.w = pk2(s[6 * 33], s[7 * 33]);
        *(GAS v4u*)(WT + (size_t)(orow0 + n) * K + k0 + 8 * c) = o; }
    LDS_WAIT(); asm volatile("" ::: "memory");
}
__device__ __forceinline__ float silu_f(float v) { return v / (1.0f + __expf(-v)); }

__device__ __forceinline__ void p0_prologue(Frame& F) {
    const int gw = F.vcu * NWAVES + F.wave, NGW = F.G * NWAVES;
    if (blockIdx.x == 0) {
        float* tab = (float*)(F.ws + WS_MISC + MS_ROPE);
        for (int idx = F.tid; idx < 1024; idx += NWAVES * 64) { const int pos = idx >> 4, i = idx & 15;
            const float inv = powf(10000.0f, -(float)(2 * i) / 32.0f); const float ang = (float)pos * inv;
            tab[2 * idx] = cosf(ang); tab[2 * idx + 1] = sinf(ang); }
    }
    {
        LAS float* sv = (LAS float*)F.lds;
        LAS float* red = (LAS float*)(F.lds + 17 * 1024 * 4);
        bool staged = false;
        for (int task = blockIdx.x; task < 192; task += F.G) {
            if (!staged) {
                for (int idx = F.tid; idx < 17 * 1024; idx += NWAVES * 64) { const int r = idx >> 10, k = idx & 1023; const float v = r < 16 ? inp(F, I_C)[r * 1024 + k] : inp(F, I_CCTX)[k]; sv[idx] = silu_f(v); }
                staged = true; __syncthreads();
            }
            const int l = task / 96, cb = task % 96, col = cb * 64 + F.lane;
            const float* W = inp(F, I_WMOD) + (size_t)l * 1024 * 6144 + col;
            float acc[17];
#pragma unroll
            for (int r = 0; r < 17; ++r) acc[r] = 0.f;
            const int kbeg = F.wave * 128;
#pragma unroll 4
            for (int k = kbeg; k < kbeg + 128; ++k) { const float wv = W[(size_t)k * 6144];
#pragma unroll
                for (int r = 0; r < 17; ++r) acc[r] += sv[r * 1024 + k] * wv; }
#pragma unroll
            for (int r = 0; r < 17; ++r) red[(F.wave * 17 + r) * 64 + F.lane] = acc[r];
            __syncthreads();
            for (int idx = F.tid; idx < 17 * 64; idx += NWAVES * 64) { const int r = idx >> 6, ln = idx & 63; float s = 0.f;
#pragma unroll
                for (int w = 0; w < 8; ++w) s += red[(w * 17 + r) * 64 + ln];
                const int n = cb * 64 + ln;
                ((float*)(F.ws + WS_MOD))[((size_t)l * 17 + r) * 6144 + n] = s + inp(F, I_BMOD)[l * 6144 + n]; }
            __syncthreads();
        }
        __syncthreads();
    }
    {
        LAS float* scr = (LAS float*)(F.lds + F.wave * 16384);
        constexpr int IT_IN = 16 * 72, IT_OUT = 16 * 32, IT_F = 1408;
        constexpr int NITEMS = 2 * IT_IN + 2 * IT_OUT + 3 * IT_F + 24 * IT_F;
        for (int it = gw; it < NITEMS; it += NGW) {
            int r = it;
            if (r < 2 * IT_IN) { const int l = r / IT_IN; p0_transpose_item(inp(F, I_WIN) + (size_t)l * 1024 * INW, 1024, INW, (bf16*)(F.ws + WS_WIN) + (size_t)l * INW * 1024, 0, 0, 0, scr, r % IT_IN, F.lane); continue; } r -= 2 * IT_IN;
            if (r < 2 * IT_OUT) { const int l = r / IT_OUT; p0_transpose_item(inp(F, I_WOUT) + (size_t)l * 1024 * 1024, 1024, 1024, (bf16*)(F.ws + WS_WOUT) + (size_t)l * 1024 * 1024, 0, 0, 0, scr, r % IT_OUT, F.lane); continue; } r -= 2 * IT_OUT;
            if (r < IT_F) { p0_transpose_item(inp(F, I_F1), 1024, DFF, (bf16*)(F.ws + WS_F13), 0, 1, 0, scr, r, F.lane); continue; } r -= IT_F;
            if (r < IT_F) { p0_transpose_item(inp(F, I_F3), 1024, DFF, (bf16*)(F.ws + WS_F13), 0, 1, 1, scr, r, F.lane); continue; } r -= IT_F;
            if (r < IT_F) { p0_transpose_item(inp(F, I_F2), DFF, 1024, (bf16*)(F.ws + WS_F2), 0, 0, 0, scr, r, F.lane); continue; } r -= IT_F;
            { const int e = r / (3 * IT_F), q = r % (3 * IT_F), which = q / IT_F, item = q % IT_F;
              if (which == 0) p0_transpose_item(inp(F, I_M1) + (size_t)e * 1024 * DFF, 1024, DFF, (bf16*)(F.ws + WS_M13) + (size_t)e * 5632 * 1024, 0, 1, 0, scr, item, F.lane);
              else if (which == 1) p0_transpose_item(inp(F, I_M3) + (size_t)e * 1024 * DFF, 1024, DFF, (bf16*)(F.ws + WS_M13) + (size_t)e * 5632 * 1024, 0, 1, 1, scr, item, F.lane);
              else p0_transpose_item(inp(F, I_M2) + (size_t)e * DFF * 1024, DFF, 1024, (bf16*)(F.ws + WS_M2) + (size_t)e * 1024 * DFF, 0, 0, 0, scr, item, F.lane); }
        }
    }
}

__device__ __forceinline__ const float* xrow_ptr(const float* lat, const float* ctx, int s) { const int b = s / TPB, j = s % TPB; return j < SEQ ? lat + (size_t)(b * SEQ + j) * DM : ctx + (size_t)(b * CTXL + j - SEQ) * DM; }

__device__ __forceinline__ void norm_mod_rows(Frame& F, const float* lat, const float* ctx, const float* mod, int shoff, int scoff, bf16* XN, bool with_ctx) {
    const int gw = F.vcu * NWAVES + F.wave, NGW = F.G * NWAVES;
    for (int s = gw; s < MROWS; s += NGW) {
        const int b = s / TPB, j = s % TPB; if (!with_ctx && j >= SEQ) continue;
        const GAS f32x4* xr = (const GAS f32x4*)xrow_ptr(lat, ctx, s) + F.lane;
        const float* mrow = mod + (size_t)(j < SEQ ? b : 16) * 6144;
        f32x4 v[4]; float ss = 0.f;
#pragma unroll
        for (int q = 0; q < 4; ++q) { v[q] = xr[64 * q]; ss += (v[q].x * v[q].x + v[q].y * v[q].y) + (v[q].z * v[q].z + v[q].w * v[q].w); }
        const float rstd = 1.0f / sqrtf(wave_sum(ss) * (1.0f / DM) + NORM_EPS);
        GAS v2u* o8 = (GAS v2u*)(XN + (size_t)s * DM) + F.lane;
#pragma unroll
        for (int q = 0; q < 4; ++q) { const f32x4 sh = *(const f32x4*)(mrow + shoff + 4 * F.lane + 256 * q), sc = *(const f32x4*)(mrow + scoff + 4 * F.lane + 256 * q);
            const f32x4 y = v[q] * rstd * (sc + 1.0f) + sh; v2u w; w.x = pk2(y.x, y.y); w.y = pk2(y.z, y.w); o8[64 * q] = w; }
    }
}

__device__ __forceinline__ void headnorm_rows(Frame& F, int l, bool ctx_q) {
    const int gw = F.vcu * NWAVES + F.wave, NGW = F.G * NWAVES; bf16* P = (bf16*)(F.ws + WS_P);
    const float* tab = (const float*)(F.ws + WS_MISC + MS_ROPE);
    const int d = F.lane;
    const float gqa = inp(F, I_GQA)[l * 64 + d], gka = inp(F, I_GKA)[l * 64 + d], gqb = inp(F, I_GQB)[l * 64 + d], gkb = inp(F, I_GKB)[l * 64 + d];
    for (int s = gw; s < MROWS; s += NGW) {
        const int j = s % TPB; const bool lat = j < SEQ; bf16* p = P + (size_t)s * INW;
        float cs = 1.f, sn = 0.f;
        if (lat) { const int pos = (d < 32) ? (j >> 6) : (j & 63); const int i = d & 15; cs = tab[2 * (pos * 16 + i)]; sn = tab[2 * (pos * 16 + i) + 1]; }
        const float sgn = (d & 16) ? 1.f : -1.f;
#pragma unroll 1
        for (int h = 0; h < 18; ++h) {
            int off; float g; bool rope, isq;
            if (h < 8) { off = QA_OFF + 64 * h; g = gqa; rope = true; isq = true; }
            else if (h < 12) { off = QB_OFF + 64 * (h - 8); g = gqb; rope = false; isq = true; }
            else if (h < 14) { off = KA_OFF + 64 * (h - 12); g = gka; rope = true; isq = false; }
            else { off = KB_OFF + 64 * (h - 14); g = gkb; rope = false; isq = false; }
            if (isq && !lat && !ctx_q) continue;
            const float v = bf1(p[off + d]);
            const float ss = wave_sum(v * v);
            float y = v * (1.0f / sqrtf(ss * (1.0f / 64.0f) + NORM_EPS)) * g;
            const float pr = __shfl_xor(y, 16);
            if (rope && lat) y = y * cs + sgn * pr * sn;
            if (isq) y *= C2;
            p[off + d] = (bf16)f2bf(y);
        }
    }
}

#ifdef ATTN_NAIVE
struct NaiveState { float q[64], o[64], m, l; };
__device__ __forceinline__ void na_load_q(NaiveState& S, const bf16* qp) {
#pragma unroll
    for (int c = 0; c < 8; ++c) { const v4u w = *(const v4u*)(qp + 8 * c);
        S.q[8 * c + 0] = bflo(w.x); S.q[8 * c + 1] = bfhi(w.x); S.q[8 * c + 2] = bflo(w.y); S.q[8 * c + 3] = bfhi(w.y);
        S.q[8 * c + 4] = bflo(w.z); S.q[8 * c + 5] = bfhi(w.z); S.q[8 * c + 6] = bflo(w.w); S.q[8 * c + 7] = bfhi(w.w); }
#pragma unroll
    for (int i = 0; i < 64; ++i) S.o[i] = 0.f;
    S.m = -1e30f; S.l = 0.f;
}
__device__ __forceinline__ float na_dot(const NaiveState& S, const bf16* kp) {
    float s = 0.f;
#pragma unroll
    for (int c = 0; c < 8; ++c) { const v4u w = *(const v4u*)(kp + 8 * c);
        s += S.q[8 * c + 0] * bflo(w.x) + S.q[8 * c + 1] * bfhi(w.x) + S.q[8 * c + 2] * bflo(w.y) + S.q[8 * c + 3] * bfhi(w.y)
           + S.q[8 * c + 4] * bflo(w.z) + S.q[8 * c + 5] * bfhi(w.z) + S.q[8 * c + 6] * bflo(w.w) + S.q[8 * c + 7] * bfhi(w.w); }
    return s;
}
__device__ __forceinline__ void na_acc(NaiveState& S, float p, const bf16* vp) {
#pragma unroll
    for (int c = 0; c < 8; ++c) { const v4u w = *(const v4u*)(vp + 8 * c);
        S.o[8 * c + 0] += p * bflo(w.x); S.o[8 * c + 1] += p * bfhi(w.x); S.o[8 * c + 2] += p * bflo(w.y); S.o[8 * c + 3] += p * bfhi(w.y);
        S.o[8 * c + 4] += p * bflo(w.z); S.o[8 * c + 5] += p * bfhi(w.z); S.o[8 * c + 6] += p * bflo(w.w); S.o[8 * c + 7] += p * bfhi(w.w); }
}
__device__ __forceinline__ void na_step2(NaiveState& S, float s0, float s1, const bf16* v0, const bf16* v1) {
    const float mn = fmaxf(S.m, fmaxf(s0, s1));
    const float sc = __builtin_amdgcn_exp2f(S.m - mn), p0 = __builtin_amdgcn_exp2f(s0 - mn), p1 = __builtin_amdgcn_exp2f(s1 - mn);
    S.l = S.l * sc + p0 + p1; S.m = mn;
#pragma unroll
    for (int i = 0; i < 64; ++i) S.o[i] *= sc;
    na_acc(S, p0, v0); na_acc(S, p1, v1);
}
__device__ __forceinline__ void na_store(const NaiveState& S, bf16* op) {
    const float inv = 1.0f / S.l;
#pragma unroll
    for (int c = 0; c < 8; ++c) { v4u w; w.x = pk2(S.o[8 * c + 0] * inv, S.o[8 * c + 1] * inv); w.y = pk2(S.o[8 * c + 2] * inv, S.o[8 * c + 3] * inv);
        w.z = pk2(S.o[8 * c + 4] * inv, S.o[8 * c + 5] * inv); w.w = pk2(S.o[8 * c + 6] * inv, S.o[8 * c + 7] * inv); *(v4u*)(op + 8 * c) = w; }
}
__device__ __forceinline__ void attn_naive_phase(Frame& F, int l, bool with_ctx) {
    const int gw = F.vcu * NWAVES + F.wave, NGW = F.G * NWAVES; bf16* P = (bf16*)(F.ws + WS_P);
    const float* rpb = inp(F, I_RPB) + (size_t)l * 4 * 15 * 31;
    const int ntask = with_ctx ? 6912 : 6144;
    for (int task = gw; task < ntask; task += NGW) {
        NaiveState S;
        if (task < 4096 || (task >= 6144 && task < 6656)) {
            int b, qh, j0, k0, k1;
            if (task < 4096) { b = task >> 8; qh = (task >> 5) & 7; j0 = (task & 31) * 64; k0 = 0; k1 = TPB; }
            else { const int t = task - 6144; b = t >> 5; qh = (t >> 2) & 7; j0 = SEQ + (t & 3) * 64; k0 = SEQ; k1 = TPB; }
            bf16* qp = P + (size_t)(b * TPB + j0 + F.lane) * INW + QA_OFF + qh * 64;
            na_load_q(S, qp);
            const bf16* Kb = P + (size_t)(b * TPB) * INW + KA_OFF + (qh >> 2) * 64; const bf16* Vb = P + (size_t)(b * TPB) * INW + VA_OFF + (qh >> 2) * 64;
            for (int k = k0; k < k1; k += 2) { const float s0 = na_dot(S, Kb + (size_t)k * INW), s1 = na_dot(S, Kb + (size_t)(k + 1) * INW); na_step2(S, s0, s1, Vb + (size_t)k * INW, Vb + (size_t)(k + 1) * INW); }
            na_store(S, qp);
        } else {
            int b, h, j; bool lat;
            if (task < 6144) { const int t = task - 4096; b = t >> 7; h = (t >> 5) & 3; j = (t & 31) * 64 + F.lane; lat = true; }
            else { const int t = task - 6656; b = t >> 4; h = (t >> 2) & 3; j = SEQ + (t & 3) * 64 + F.lane; lat = false; }
            bf16* qp = P + (size_t)(b * TPB + j) * INW + QB_OFF + h * 64;
            na_load_q(S, qp);
            const bf16* Kb = P + (size_t)(b * TPB) * INW + KB_OFF + h * 64; const bf16* Vb = P + (size_t)(b * TPB) * INW + VB_OFF + h * 64;
            if (lat) {
                const int r = j >> 6, c = j & 63; int rs = r - 4; rs = rs < 0 ? 0 : (rs > 24 ? 24 : rs); int cs = c - 8; cs = cs < 0 ? 0 : (cs > 48 ? 48 : cs);
                for (int i = 0; i < 8; ++i) { const int kr = rs + i; const float* brow = rpb + (h * 15 + (kr - r + 7)) * 31 + (15 - c);
                    for (int jc = 0; jc < 16; jc += 2) { const int kc = cs + jc; const int k = kr * 64 + kc;
                        const float s0 = na_dot(S, Kb + (size_t)k * INW) + brow[kc] * LOG2E, s1 = na_dot(S, Kb + (size_t)(k + 1) * INW) + brow[kc + 1] * LOG2E;
                        na_step2(S, s0, s1, Vb + (size_t)k * INW, Vb + (size_t)(k + 1) * INW); } }
            }
            for (int k = SEQ; k < TPB; k += 2) { const float s0 = na_dot(S, Kb + (size_t)k * INW), s1 = na_dot(S, Kb + (size_t)(k + 1) * INW); na_step2(S, s0, s1, Vb + (size_t)k * INW, Vb + (size_t)(k + 1) * INW); }
            na_store(S, qp);
        }
    }
}


#endif
__device__ __forceinline__ void attn_mfma_phase(Frame& F, int l, bool with_ctx, char* ldsg) {
    typedef attn_body::bf16 abf;
    abf* P = (abf*)(F.ws + WS_P); const int v = F.vcu;
    const int NA = 1024 + (with_ctx ? 192 : 0);
#pragma unroll 1
    for (int u = v; u < NA; u += F.G) {
        int b, qcol, kcol, vcol, qrow, NT, first0;
        if (u < 1024) { b = u >> 6; const int kvh = (u >> 5) & 1, qh = kvh * 4 + ((u >> 3) & 3); qrow = (u & 7) * 256; qcol = QA_OFF + qh * 64; kcol = KA_OFF + kvh * 64; vcol = VA_OFF + kvh * 64; NT = 36; first0 = 0; }
        else if (u < 1024 + 128) { const int t = u - 1024; b = t >> 3; const int qh = t & 7; qrow = SEQ; qcol = QA_OFF + qh * 64; kcol = KA_OFF + (qh >> 2) * 64; vcol = VA_OFF + (qh >> 2) * 64; NT = 4; first0 = 32; }
        else { const int t = u - 1152; b = t >> 2; const int h = t & 3; qrow = SEQ; qcol = QB_OFF + h * 64; kcol = KB_OFF + h * 64; vcol = VB_OFF + h * 64; NT = 4; first0 = 32; }
        abf* Qu = P + (size_t)(b * TPB + qrow) * INW + qcol; const abf* Kh = P + (size_t)(b * TPB) * INW + kcol; const abf* Vh = P + (size_t)(b * TPB) * INW + vcol;
        attn_body::attn_unit<8, false>(Qu, Kh, Vh, Qu, NT, NT, first0, 0, 0, nullptr, ldsg, F.wave);
    }
#ifndef NO_BSITE
    const float* rpbl = inp(F, I_RPB) + (size_t)l * 4 * 15 * 31;
#pragma unroll 1
    for (int u = v; u < 512; u += F.G) {
        const int b = u >> 5, h = (u >> 3) & 3, qb = u & 7, qg = 4 * qb;
        const int n0 = (qb == 0 || qb == 7) ? 8 : 12, s0 = qb == 0 ? 0 : (qb == 7 ? 24 : qg - 4);
        abf* Qu = P + (size_t)(b * TPB + qb * 256) * INW + QB_OFF + h * 64; const abf* Kh = P + (size_t)(b * TPB) * INW + KB_OFF + h * 64; const abf* Vh = P + (size_t)(b * TPB) * INW + VB_OFF + h * 64;
        attn_body::attn_unit<8, true>(Qu, Kh, Vh, Qu, 4 + n0, 4, 32, s0, qg, rpbl + h * 15 * 31, ldsg, F.wave);
    }
#endif
}

__device__ __forceinline__ void unpack8(const v4u w, float (&v)[8]) { v[0] = bflo(w.x); v[1] = bfhi(w.x); v[2] = bflo(w.y); v[3] = bfhi(w.y); v[4] = bflo(w.z); v[5] = bfhi(w.z); v[6] = bflo(w.w); v[7] = bfhi(w.w); }
__device__ __forceinline__ void merge_rows(Frame& F, int l, bool with_ctx) {
    const int gw = F.vcu * NWAVES + F.wave, NGW = F.G * NWAVES; const bf16* P = (const bf16*)(F.ws + WS_P); bf16* CAT = (bf16*)(F.ws + WS_XN);
    const float* gout = inp(F, I_GOUT) + l * 1024; const float* cw = inp(F, I_CONVW) + l * 3 * 256; const float* cb = inp(F, I_CONVB) + l * 256;
    const int lane = F.lane;
    for (int s = gw; s < MROWS; s += NGW) {
        const int j = s % TPB; const bool lat = j < SEQ; if (!with_ctx && !lat) continue;
        const bf16* p = P + (size_t)s * INW;
        float va[8], vb[8];
        unpack8(*(const v4u*)(p + 8 * lane), va);
        if (lane < 32) unpack8(*(const v4u*)(p + 512 + 8 * lane), vb);
        else {
            const int ch0 = 8 * (lane - 32); const int jlo = lat ? 0 : SEQ, jhi = lat ? SEQ : TPB;
            float post[8], y[8];
            unpack8(*(const v4u*)(p + CPOST_OFF + ch0), post);
#pragma unroll
            for (int k = 0; k < 8; ++k) y[k] = cb[ch0 + k];
#pragma unroll
            for (int tap = 0; tap < 3; ++tap) { const int jj = j + tap - 1;
                if (jj >= jlo && jj < jhi) { const bf16* pp = p + (ptrdiff_t)(tap - 1) * INW; float a[8], c[8]; unpack8(*(const v4u*)(pp + CPRE_OFF + ch0), a); unpack8(*(const v4u*)(pp + CVAL_OFF + ch0), c);
#pragma unroll
                    for (int k = 0; k < 8; ++k) y[k] += cw[tap * 256 + ch0 + k] * (a[k] * c[k]); } }
#pragma unroll
            for (int k = 0; k < 8; ++k) vb[k] = post[k] * y[k];
        }
        float sa = 0.f, sb = 0.f;
#pragma unroll
        for (int k = 0; k < 8; ++k) { sa += va[k] * va[k]; sb += vb[k] * vb[k]; }
        const float ra = 1.0f / sqrtf(wave_sum(sa) * (1.0f / 512.0f) + NORM_EPS), rb = 1.0f / sqrtf(half_sum(sb) * (1.0f / 256.0f) + NORM_EPS);
        v4u oa, ob; float g[8];
#pragma unroll
        for (int k = 0; k < 8; ++k) g[k] = gout[8 * lane + k];
        oa.x = pk2(va[0] * ra * g[0], va[1] * ra * g[1]); oa.y = pk2(va[2] * ra * g[2], va[3] * ra * g[3]); oa.z = pk2(va[4] * ra * g[4], va[5] * ra * g[5]); oa.w = pk2(va[6] * ra * g[6], va[7] * ra * g[7]);
#pragma unroll
        for (int k = 0; k < 8; ++k) g[k] = gout[512 + 8 * lane + k];
        ob.x = pk2(vb[0] * rb * g[0], vb[1] * rb * g[1]); ob.y = pk2(vb[2] * rb * g[2], vb[3] * rb * g[3]); ob.z = pk2(vb[4] * rb * g[4], vb[5] * rb * g[5]); ob.w = pk2(vb[6] * rb * g[6], vb[7] * rb * g[7]);
        *(v4u*)(CAT + (size_t)s * DM + 8 * lane) = oa; *(v4u*)(CAT + (size_t)s * DM + 512 + 8 * lane) = ob;
    }
}

__device__ __forceinline__ void moe_route(Frame& F, const float* mod) {
    const float* X = F.out; bf16* XT = (bf16*)(F.ws + WS_XT);
    int* tok_e = (int*)(F.ws + WS_MISC + MS_TOKE); float* tok_g = (float*)(F.ws + WS_MISC + MS_TOKG);
    const float* wr = inp(F, I_ROUTER); const float* br = inp(F, I_ROUTERB);
    LAS int* le = (LAS int*)F.lds;
    for (int ch = blockIdx.x; ch < NTOK / 128; ch += F.G) {
        for (int i = 0; i < 16; ++i) {
            const int tl = F.wave * 16 + i, tok = ch * 128 + tl, b = tok / SEQ;
            const GAS f32x4* xr = (const GAS f32x4*)(X + (size_t)tok * DM) + F.lane; const float* mrow = mod + (size_t)b * 6144;
            f32x4 v[4]; float ss = 0.f;
#pragma unroll
            for (int q = 0; q < 4; ++q) { v[q] = xr[64 * q]; ss += (v[q].x * v[q].x + v[q].y * v[q].y) + (v[q].z * v[q].z + v[q].w * v[q].w); }
            const float rstd = 1.0f / sqrtf(wave_sum(ss) * (1.0f / DM) + NORM_EPS);
            float lg[8];
#pragma unroll
            for (int e = 0; e < 8; ++e) lg[e] = 0.f;
            GAS v2u* o8 = (GAS v2u*)(XT + (size_t)tok * DM) + F.lane;
#pragma unroll
            for (int q = 0; q < 4; ++q) { const int col = 4 * F.lane + 256 * q; const f32x4 sh = *(const f32x4*)(mrow + 3072 + col), sc = *(const f32x4*)(mrow + 4096 + col);
                const f32x4 y = v[q] * rstd * (sc + 1.0f) + sh; v2u w; w.x = pk2(y.x, y.y); w.y = pk2(y.z, y.w); o8[64 * q] = w;
#pragma unroll
                for (int k = 0; k < 4; ++k) { const f32x4 w0 = *(const f32x4*)(wr + (size_t)(col + k) * 8), w1 = *(const f32x4*)(wr + (size_t)(col + k) * 8 + 4); const float yk = y[k];
                    lg[0] += yk * w0.x; lg[1] += yk * w0.y; lg[2] += yk * w0.z; lg[3] += yk * w0.w; lg[4] += yk * w1.x; lg[5] += yk * w1.y; lg[6] += yk * w1.z; lg[7] += yk * w1.w; } }
#pragma unroll
            for (int e = 0; e < 8; ++e) lg[e] = wave_sum(lg[e]) + br[e];
            int e0 = 0; float v0 = lg[0];
#pragma unroll
            for (int e = 1; e < 8; ++e) if (lg[e] > v0) { v0 = lg[e]; e0 = e; }
            int e1 = -1; float v1 = -3.0e38f;
#pragma unroll
            for (int e = 0; e < 8; ++e) if (e != e0 && lg[e] > v1) { v1 = lg[e]; e1 = e; }
            const float p1 = __expf(v1 - v0), g0 = 1.0f / (1.0f + p1), g1 = p1 / (1.0f + p1);
            if (F.lane == 0) { tok_e[2 * tok] = e0; tok_e[2 * tok + 1] = e1; tok_g[2 * tok] = g0; tok_g[2 * tok + 1] = g1; le[2 * tl] = e0; le[2 * tl + 1] = e1; }
        }
        __syncthreads();
        if (F.tid < 8) { int n = 0; for (int a = 0; a < 256; ++a) n += (le[a] == F.tid) ? 1 : 0; F.ctl[CW_CNT + ch * 8 + F.tid] = (unsigned)n; }
        __syncthreads();
    }
}
__device__ __forceinline__ void moe_sort_scatter(Frame& F) {
    const bf16* XT = (const bf16*)(F.ws + WS_XT); bf16* XS = (bf16*)(F.ws + WS_XN);
    const int* tok_e = (const int*)(F.ws + WS_MISC + MS_TOKE); const float* tok_g = (const float*)(F.ws + WS_MISC + MS_TOKG);
    int* tok_s = (int*)(F.ws + WS_MISC + MS_TOKS); float* slot_g = (float*)(F.ws + WS_MISC + MS_SLOTG); int* meta = (int*)(F.ws + WS_MISC + MS_META);
    LAS int* ltot = (LAS int*)F.lds; LAS int* lpre = ltot + 8; LAS int* lslot = ltot + 16; LAS int* lex = ltot + 16 + 256;
    for (int ch = blockIdx.x; ch < NTOK / 128; ch += F.G) {
        if (F.tid < 8) { int tot = 0, pre = 0; for (int c2 = 0; c2 < NTOK / 128; ++c2) { const int n = (int)F.ctl[CW_CNT + c2 * 8 + F.tid]; tot += n; pre += (c2 < ch) ? n : 0; } ltot[F.tid] = tot; lpre[F.tid] = pre; }
        if (F.tid < 256) lex[F.tid] = tok_e[2 * (ch * 128) + F.tid];
        __syncthreads();
        int pstart[9]; pstart[0] = 0;
#pragma unroll
        for (int e = 0; e < 8; ++e) pstart[e + 1] = pstart[e] + ((ltot[e] + 255) & ~255);
        if (F.tid < 8) { int base = 0;
#pragma unroll
            for (int e = 0; e < 8; ++e) if (e == F.tid) base = pstart[e] + lpre[e];
            for (int a = 0; a < 256; ++a) { if (lex[a] == F.tid) { lslot[a] = base; ++base; } } }
        __syncthreads();
        if (F.tid < 256) { const int slot = lslot[F.tid]; tok_s[2 * (ch * 128) + F.tid] = slot; slot_g[slot] = tok_g[2 * (ch * 128) + F.tid]; }
        for (int a = F.wave; a < 256; a += NWAVES) { const int tok = ch * 128 + (a >> 1), slot = lslot[a];
            const GAS v4u* src = (const GAS v4u*)(XT + (size_t)tok * DM) + F.lane; GAS v4u* dst = (GAS v4u*)(XS + (size_t)slot * DM) + F.lane;
            dst[0] = src[0]; dst[64] = src[64]; }
        if (ch < 8) {
            int p0 = 0, p1 = 0;
#pragma unroll
            for (int e = 0; e < 8; ++e) if (e == ch) { p0 = pstart[e] + ltot[e]; p1 = pstart[e + 1]; }
            for (int r = p0 + F.wave; r < p1; r += NWAVES) { GAS v4u* dst = (GAS v4u*)(XS + (size_t)r * DM) + F.lane; dst[0] = (v4u){0u, 0u, 0u, 0u}; dst[64] = (v4u){0u, 0u, 0u, 0u}; if (F.lane == 0) slot_g[r] = 0.f; }
        }
        if (ch == 0 && F.tid == 0) {
#pragma unroll
            for (int e = 0; e < 8; ++e) meta[e] = pstart[e + 1] >> 8;
        }
        __syncthreads();
    }
}
__device__ __forceinline__ void moe_combine(Frame& F, const float* mod) {
    const int gw = F.vcu * NWAVES + F.wave, NGW = F.G * NWAVES; const bf16* Y = (const bf16*)(F.ws + WS_XN); const int* tok_s = (const int*)(F.ws + WS_MISC + MS_TOKS);
    for (int tok = gw; tok < NTOK; tok += NGW) {
        const int b = tok / SEQ, s0 = tok_s[2 * tok], s1 = tok_s[2 * tok + 1];
        GAS f32x4* xr = (GAS f32x4*)(F.out + (size_t)tok * DM) + F.lane; const float* g = mod + (size_t)b * 6144 + 5120;
        const GAS v2u* y0 = (const GAS v2u*)(Y + (size_t)s0 * DM) + F.lane; const GAS v2u* y1 = (const GAS v2u*)(Y + (size_t)s1 * DM) + F.lane;
#pragma unroll
        for (int q = 0; q < 4; ++q) { const f32x4 x = xr[64 * q]; const f32x4 gv = *(const f32x4*)(g + 4 * F.lane + 256 * q); const v2u a = y0[64 * q], c = y1[64 * q];
            f32x4 y; y.x = bflo(a.x) + bflo(c.x); y.y = bfhi(a.x) + bfhi(c.x); y.z = bflo(a.y) + bflo(c.y); y.w = bfhi(a.y) + bfhi(c.y);
            xr[64 * q] = x + gv * y; }
    }
}

struct Args { const float* in[24]; float* out; unsigned char* ws; int ph_lo, ph_hi, li, pad; };
__global__ void __launch_bounds__(NWAVES * 64, 2) mk_fwd(Args args) {
    extern __shared__ __attribute__((aligned(16))) unsigned char lds[];
    Frame F;
    F.lds = (LAS unsigned char*)lds; F.MISC = (volatile LAS unsigned*)(F.lds + MISC_OFF);
    F.tid = threadIdx.x; F.lane = F.tid & 63; F.wave = __builtin_amdgcn_readfirstlane(F.tid >> 6);
    F.G = gridDim.x; { const int bx = blockIdx.x; F.vcu = (F.G % 8 == 0) ? (bx % 8) * (F.G / 8) + bx / 8 : bx; }
    F.out = args.out; F.ws = args.ws; F.ctl = (unsigned*)(args.ws + WS_CTL);
    for (int u = F.tid; u < (LDS_BYTES - LDSCTL_OFF) / 4; u += NWAVES * 64) ((LAS unsigned*)(F.lds + LDSCTL_OFF))[u] = 0u;
    __syncthreads();
    if (F.tid < 24) { const unsigned long long p = (unsigned long long)args.in[F.tid]; LAS unsigned* t = (LAS unsigned*)(F.lds + LDSCTL_OFF + 64) + 2 * F.tid; t[0] = (unsigned)p; t[1] = (unsigned)(p >> 32); }
    __syncthreads();
    XcdBarrier bar; bar.bar = F.ctl + CW_BAR; bar.x = 0; bar.st = nullptr;
    if (MK_N_LAUNCHES == 1) bar = xcd_barrier_post(F.ctl + CW_BAR, F.MISC + 8);
    const int lo = args.ph_lo, hi = args.ph_hi;
#ifndef PHMASK
#define PHMASK 0xFFFFFFFFu
#endif
#define PHON(k) (((PHMASK) >> (k)) & 1u)
#define IN(k) (PHON(k) && lo <= (k) && (k) < hi)
#define INL(x) ((((PHMASK) >> (1 + (x))) & 1u) && lo <= pb + (x) && pb + (x) < hi)
#define INR(k) (lo <= (k) && (k) < hi)
#define SEAM(k) do { if (INR(k) && INR((k) + 1)) xcd_barrier(bar); } while (0)
    float* XC = (float*)(F.ws + WS_XC); bf16* XN = (bf16*)(F.ws + WS_XN); bf16* P = (bf16*)(F.ws + WS_P);
    const float* MOD = (const float*)(F.ws + WS_MOD);
#define TABMEM (F.lds + LDSCTL_OFF + 448)
#define PF() do { int ln_ = (int)__builtin_amdgcn_mbcnt_hi(~0u, __builtin_amdgcn_mbcnt_lo(~0u, 0u)); asm volatile("" : "+v"(ln_)); F.lane = ln_; F.tid = F.wave * 64 + ln_; } while (0)

    if (IN(0)) { PF(); p0_prologue(F); } SEAM(0);

#pragma unroll 1
    for (int l = 0; l < 2; ++l) {
        const int pb = 1 + 9 * l; const bool last = (l == 1);
        const float* mod = MOD + (size_t)l * 17 * 6144;
        const float* xlat = last ? F.out : inp(F, I_X); const float* xctx = last ? XC : inp(F, I_CTX);
        if (INL(0)) { PF(); norm_mod_rows(F, xlat, xctx, mod, 0, 1024, XN, true); } SEAM(pb + 0);
        if (INL(1)) { PF();
            pg8::Gemm g{XN, (const bf16*)(F.ws + WS_WIN) + (size_t)l * INW * 1024, MROWS, INW, 1024};
            const pg8::TabOrder T = last ? pg8::build_units(TABMEM, 1024, XN, g.Bt, F.G, (int)blockIdx.x, 128, 9, 0, 1, 0, 16, 3, 6, 2, nullptr, 0, F.tid)
                                         : pg8::build_units(TABMEM, 1024, XN, g.Bt, F.G, (int)blockIdx.x, NPAN, 9, 0, 0, 0, 0, 1, 0, 0, nullptr, 0, F.tid);
            pg8::EpiRawBf16 E{P, INW};
            pg8::gemm_phase<pg8::EpiRawBf16, pg8::TabOrder, true, true>(F.lds, g, T, E, F.wave);
        } SEAM(pb + 1);
        if (INL(2)) { PF(); headnorm_rows(F, l, !last); } SEAM(pb + 2);
        #ifdef ATTN_NAIVE
        if (INL(3)) { PF(); attn_naive_phase(F, l, !last); } SEAM(pb + 3);
#else
        if (INL(3)) { PF(); attn_mfma_phase(F, l, !last, (char*)lds); } SEAM(pb + 3);
#endif
        if (INL(4)) { PF(); merge_rows(F, l, !last); } SEAM(pb + 4);
        if (INL(5)) { PF();
            pg8::Gemm g{XN, (const bf16*)(F.ws + WS_WOUT) + (size_t)l * 1024 * 1024, MROWS, 1024, 1024};
            const pg8::TabOrder T = pg8::build_units(TABMEM, 1024, XN, g.Bt, F.G, (int)blockIdx.x, last ? 128 : NPAN, 4, 0, last ? 1 : 0, 0, 0, 1, 0, 0, nullptr, 0, F.tid);
            pg8::EpiGateRes E{xlat, xctx, F.out, XC, mod, 2048};
            pg8::gemm_phase<pg8::EpiGateRes, pg8::TabOrder, true, true>(F.lds, g, T, E, F.wave);
        } SEAM(pb + 5);
        if (!last) {
            if (IN(7)) { PF(); norm_mod_rows(F, F.out, XC, mod, 3072, 4096, XN, true); } SEAM(7);
            if (IN(8)) { PF();
                pg8::Gemm g{XN, (const bf16*)(F.ws + WS_F13), MROWS, 5632, 1024};
                const pg8::TabOrder T = pg8::build_units(TABMEM, 1024, XN, g.Bt, F.G, (int)blockIdx.x, NPAN, 22, 0, 0, 0, 0, 1, 0, 0, nullptr, 0, F.tid);
                pg8::EpiSwiglu E{P, DFF, 0};
                pg8::gemm_phase<pg8::EpiSwiglu, pg8::TabOrder, true, true>(F.lds, g, T, E, F.wave);
            } SEAM(8);
            if (IN(9)) { PF();
                pg8::Gemm g{P, (const bf16*)(F.ws + WS_F2), MROWS, 1024, DFF};
                const pg8::TabOrder T = pg8::build_units(TABMEM, DFF, P, g.Bt, F.G, (int)blockIdx.x, NPAN, 4, 0, 0, 0, 0, 1, 0, 0, nullptr, 0, F.tid);
                pg8::EpiGateRes E{F.out, XC, F.out, XC, mod, 5120};
                pg8::gemm_phase<pg8::EpiGateRes, pg8::TabOrder, true, true>(F.lds, g, T, E, F.wave);
            } SEAM(9);
        }
    }
    {
        const float* mod = MOD + (size_t)17 * 6144;
        if (IN(16)) { PF(); moe_route(F, mod); } SEAM(16);
        if (IN(17)) { PF(); moe_sort_scatter(F); } SEAM(17);
        const int* meta = (const int*)(F.ws + WS_MISC + MS_META);
        bf16* XS = XN; bf16* HM = (bf16*)(F.ws + WS_XT);
#pragma unroll 1
        for (int c = 0; c < 2; ++c) {
            if (IN(18 + 2 * c) || IN(19 + 2 * c)) {
                const int TP = __builtin_amdgcn_readfirstlane(meta[7]), h0 = (TP + 1) >> 1; const int p0 = c == 0 ? 0 : h0, p1 = c == 0 ? h0 : TP;
                if (IN(18 + 2 * c)) { PF();
                    pg8::Gemm g{XS, (const bf16*)(F.ws + WS_M13), 0, 5632, 1024};
                    const pg8::TabOrder T = pg8::build_units(TABMEM, 1024, XS, g.Bt, F.G, (int)blockIdx.x, p1 - p0, 22, 0, 0, p0, 0, 1, 0, 0, meta, (size_t)5632 * 1024 * 2, F.tid);
                    pg8::EpiSwiglu E{HM, DFF, p0};
                    pg8::gemm_phase<pg8::EpiSwiglu, pg8::TabOrder, true, true>(F.lds, g, T, E, F.wave);
                }
                SEAM(18 + 2 * c);
                if (IN(19 + 2 * c)) { PF();
                    pg8::Gemm g{HM, (const bf16*)(F.ws + WS_M2), 0, 1024, DFF};
                    const pg8::TabOrder T = pg8::build_units(TABMEM, DFF, (const char*)HM - (size_t)p0 * 256 * DFF * 2, g.Bt, F.G, (int)blockIdx.x, p1 - p0, 4, 0, 0, p0, 0, 1, 0, 0, meta, (size_t)1024 * DFF * 2, F.tid);
                    pg8::EpiMoeOut E{XS, (const float*)(F.ws + WS_MISC + MS_SLOTG)};
                    pg8::gemm_phase<pg8::EpiMoeOut, pg8::TabOrder, true, true>(F.lds, g, T, E, F.wave);
                }
            }
            SEAM(19 + 2 * c);
        }
        if (IN(22)) { PF(); moe_combine(F, mod); }
    }
#undef IN
#undef SEAM
}

extern "C" void kernel_launch(void* const* d_in, const int* in_sizes, int n_in, void* d_out, int out_size, void* d_ws, size_t ws_size, hipStream_t stream) {
    static int grid = 0;
    if (grid == 0) {
        if (n_in != 24 || in_sizes[0] != BATCH * SEQ * DM || out_size != BATCH * SEQ * DM || ws_size < WS_END) { fprintf(stderr, "kernel_launch: unexpected shapes / workspace (n_in %d, ws %zu, need %zu); nothing launched\n", n_in, ws_size, (size_t)WS_END); grid = -1; return; }
        int dev = 0, cus = 0, per_cu = 0;
        if (hipGetDevice(&dev) != hipSuccess || hipDeviceGetAttribute(&cus, hipDeviceAttributeMultiprocessorCount, dev) != hipSuccess) { grid = -1; return; }
        if (hipFuncSetAttribute((const void*)mk_fwd, hipFuncAttributeMaxDynamicSharedMemorySize, LDS_BYTES) != hipSuccess) { fprintf(stderr, "kernel_launch: hipFuncSetAttribute failed\n"); grid = -1; return; }
        if (hipOccupancyMaxActiveBlocksPerMultiprocessor(&per_cu, (const void*)mk_fwd, NWAVES * 64, LDS_BYTES) != hipSuccess || per_cu < 1) fprintf(stderr, "kernel_launch: occupancy query reports %d\n", per_cu);
        (void)hipGetLastError();
        grid = cus;
    }
    if (grid < 0) return;
    if (hipMemsetAsync((char*)d_ws + WS_CTL, 0, CTL_ZERO_BYTES, stream) != hipSuccess) return;
    Args a{};
    for (int i = 0; i < 24; ++i) a.in[i] = (const float*)d_in[i];
    a.out = (float*)d_out; a.ws = (unsigned char*)d_ws; a.pad = 0;
    const int nl = MK_N_LAUNCHES == 1 ? 1 : NPH;
    for (int li = 0; li < nl; ++li) {
        a.ph_lo = nl == 1 ? 0 : li; a.ph_hi = nl == 1 ? NPH : li + 1; a.li = 0;
        hipLaunchKernelGGL(mk_fwd, dim3(grid), dim3(NWAVES * 64), LDS_BYTES, stream, a);
        const hipError_t le = hipPeekAtLastError();
        if (le != hipSuccess) { fprintf(stderr, "kernel_launch: launch %d failed: %s\n", li, hipGetErrorName(le)); break; }
    }
}
```

```cpp
#define MK_N_LAUNCHES 1
#include <hip/hip_runtime.h>
#include <cstdio>
#include <cstdint>
#include <cstddef>
#include <cmath>
namespace pg8 {
#define PG8_LAS __attribute__((address_space(3)))
typedef unsigned short bf16_t;
typedef short bf16x8 __attribute__((ext_vector_type(8)));
typedef float f32x4 __attribute__((ext_vector_type(4)));
typedef unsigned u32x4 __attribute__((ext_vector_type(4)));
constexpr int BM = 256, BK = 64, HALF = 128, HTB = HALF * BK * 2  , STAGE_BYTES = 8 * HTB, NXCD = 8, WGM = 8;

__host__ __device__ __forceinline__ int lds_byte(int r, int c) { const int st = (r >> 4) * 2 + (c >> 5), rr = r & 15, cc = c & 31, ob = rr * 64 + cc * 2; return st * 1024 + (ob ^ (((ob >> 9) & 1) << 5)); }
__host__ __device__ __forceinline__ void stage_rc(int b, int& R, int& C) { const int st = b / 1024, sb = b % 1024, swz = sb ^ (((sb >> 9) & 1) << 5); R = (st >> 1) * 16 + swz / 64; C = (st & 1) * 32 + (swz % 64) / 2; }
__host__ __device__ __forceinline__ int perm32(int rho) { const int n = rho >> 4, i = rho & 15; return 8 * (i >> 2) + 4 * n + (i & 3); }

struct Unit { int pm, pn, e; };
struct Gemm { const bf16_t* A; const bf16_t* Bt; int M, N, K; };

struct StaticOrder {
    int nM, nN, nwg, G, c;
    __host__ __device__ void init(int M, int N, int G_, int c_) { nM = M / BM; nN = N / BM; nwg = nM * nN; G = G_; c = c_; }
    __host__ __device__ bool next(int i, Unit& u) const {
        const long L = (long)i * G + c; if (L >= nwg) return false;
        int wgid = (int)L; { const int q = nwg / NXCD, r = nwg % NXCD, xcd = wgid % NXCD, off = wgid / NXCD; wgid = (xcd < r ? xcd * (q + 1) : r * (q + 1) + (xcd - r) * q) + off; }
        const int nig = WGM * nN, gid = wgid / nig, fm = gid * WGM, gsz = (nM - fm) < WGM ? (nM - fm) : WGM;
        u.pm = fm + ((wgid % nig) % gsz); u.pn = (wgid % nig) / gsz; return true;
    }
    __device__ __forceinline__ void a_ready(const Unit&) const {}
    __device__ __forceinline__ void done(const Unit&) const {}
};

__device__ __forceinline__ unsigned cvt_pk_bf16(float lo, float hi) { unsigned r; asm volatile("v_cvt_pk_bf16_f32 %0, %1, %2" : "=v"(r) : "v"(lo), "v"(hi)); return r; }
typedef float f32x2 __attribute__((ext_vector_type(2)));
__device__ __forceinline__ f32x2 gelu_pk(f32x2 v) {
    const f32x2 av = __builtin_elementwise_abs(v), d = av * 0.2316418882f + 1.0f;
    f32x2 t; t.x = __builtin_amdgcn_rcpf(d.x); t.y = __builtin_amdgcn_rcpf(d.y);
    f32x2 q = t * 0.5307027145f + (-0.7265760135f); q = q * t + 0.7107068705f; q = q * t + (-0.142248368f); q = q * t + 0.127414796f; q = q * t;
    const f32x2 s = (v * v) * (-0.72134752044f);
    f32x2 e; e.x = __builtin_amdgcn_exp2f(s.x); e.y = __builtin_amdgcn_exp2f(s.y);
    const f32x2 m = v * (q * e), r = v - m;
    f32x2 o; o.x = v.x < 0.f ? m.x : r.x; o.y = v.y < 0.f ? m.y : r.y; return o;
}

template <int ACT  > struct EpiBf16 {
    static constexpr bool PERM = true, AFTER_DRAIN = false, HEADMAP = false; static_assert(ACT == 0 || ACT == 1, "EpiBf16: ACT is 0 (none) or 1 (gelu_pk)");
    bf16_t* O; int ldc; const float* bias; int split_cols; size_t split_stride; float scale0;
    __device__ __forceinline__ void operator()(const f32x4 (&acc)[2][2][4][2], const Unit& u, int wr, int wc, int fr, int fq) const {
        const int row0 = u.pm * BM + wr * 64 + fr; int colt = u.pn * BM; bf16_t* base = O;
        float sc = 1.f; if (split_cols) { const int t = colt / split_cols; base += (size_t)t * split_stride; colt -= t * split_cols; if (t == 0) sc = scale0; }
        const int col0 = colt + wc * 32 + 8 * fq, bcol0 = u.pn * BM + wc * 32 + 8 * fq;
        f32x4 bv[2][2];
#pragma unroll
        for (int bj = 0; bj < 2; ++bj)
#pragma unroll
            for (int n = 0; n < 2; ++n) bv[bj][n] = bias ? *(const f32x4*)(bias + bcol0 + bj * HALF + 4 * n) : (f32x4){0.f, 0.f, 0.f, 0.f};
#pragma unroll
        for (int ai = 0; ai < 2; ++ai)
#pragma unroll
            for (int m = 0; m < 4; ++m) { bf16_t* rowp = base + (size_t)(row0 + ai * HALF + m * 16) * ldc + col0;
#pragma unroll
                for (int bj = 0; bj < 2; ++bj) { f32x4 v0 = acc[ai][bj][m][0] + bv[bj][0], v1 = acc[ai][bj][m][1] + bv[bj][1];
                    if (ACT == 1) { f32x2 a = gelu_pk((f32x2){v0[0], v0[1]}), b = gelu_pk((f32x2){v0[2], v0[3]}), c = gelu_pk((f32x2){v1[0], v1[1]}), d = gelu_pk((f32x2){v1[2], v1[3]});
                        v0 = (f32x4){a.x, a.y, b.x, b.y}; v1 = (f32x4){c.x, c.y, d.x, d.y}; }
                    v0 = v0 * sc; v1 = v1 * sc; u32x4 w; w.x = cvt_pk_bf16(v0[0], v0[1]); w.y = cvt_pk_bf16(v0[2], v0[3]); w.z = cvt_pk_bf16(v1[0], v1[1]); w.w = cvt_pk_bf16(v1[2], v1[3]);
                    *(u32x4*)(rowp + bj * HALF) = w; } }
    }
};

struct TabOrder {
    const volatile PG8_LAS unsigned* tab;
    __device__ __forceinline__ bool next(int i, Unit& u) const {
        if (i >= 32) return false;
        const volatile PG8_LAS unsigned* r = tab + 8 * i;
        if (__builtin_amdgcn_readfirstlane(r[6]) == 0u) return false;
        u.pm = (int)__builtin_amdgcn_readfirstlane(r[4]); u.pn = (int)__builtin_amdgcn_readfirstlane(r[5]); u.e = i; return true;
    }
    __device__ __forceinline__ const char* abase(const Unit& u, size_t) const { const volatile PG8_LAS unsigned* r = tab + 8 * u.e; const unsigned lo = __builtin_amdgcn_readfirstlane(r[0]), hi = __builtin_amdgcn_readfirstlane(r[1]); return (const char*)(((unsigned long long)hi << 32) | lo); }
    __device__ __forceinline__ const char* bbase(const Unit& u, size_t) const { const volatile PG8_LAS unsigned* r = tab + 8 * u.e; const unsigned lo = __builtin_amdgcn_readfirstlane(r[2]), hi = __builtin_amdgcn_readfirstlane(r[3]); return (const char*)(((unsigned long long)hi << 32) | lo); }
    __device__ __forceinline__ void a_ready(const Unit&) const {}
    __device__ __forceinline__ void done(const Unit&) const {}
};
__device__ __forceinline__ TabOrder build_units(PG8_LAS unsigned char* tabmem, int K, const void* A, const void* B, int G, int c,
                                                int np0, int nn0, int cn0, int mode0, int poff0, int np1, int nn1, int cn1, int mode1, const int* pend, size_t estride, const int tid) {
    __syncthreads();
    if (tid < 32) {
        int i_ = tid; asm volatile("" : "+v"(i_)); const int i = i_;
        const int n0 = np0 * nn0, nwg = n0 + np1 * nn1; const long L = (long)i * G + c; const bool ok = L < nwg;
        int w = ok ? (int)L : 0; { const int q = nwg / NXCD, r = nwg % NXCD, xcd = w % NXCD, off = w / NXCD; w = (xcd < r ? xcd * (q + 1) : r * (q + 1) + (xcd - r) * q) + off; }
        const bool s0 = w < n0; const int ww = s0 ? w : w - n0; const int np = s0 ? np0 : np1, nn = s0 ? nn0 : nn1, cn = s0 ? cn0 : cn1, mode = s0 ? mode0 : mode1;
        const int nig = WGM * nn, gid = ww / nig, fm = gid * WGM, gsz = (np - fm) < WGM ? (np - fm) : WGM;
        const int pv = fm + ((ww % nig) % gsz), pn = cn + (ww % nig) / gsz;
        const int pm0 = pv + poff0, pm1 = pv + (pv >> 3), pm2 = 9 * pv + 8; const int pm = mode == 0 ? pm0 : (mode == 1 ? pm1 : pm2);
        int e = 0;
        if (pend) {
#pragma unroll
            for (int k = 0; k < 8; ++k) e += (pend[k] <= pm) ? 1 : 0;
        }
        const size_t tstep = (size_t)256 * K * 2;
        const unsigned long long a = (unsigned long long)((const char*)A + (size_t)pm * tstep), b = (unsigned long long)((const char*)B + (size_t)e * estride + (size_t)pn * tstep);
        PG8_LAS unsigned* r = (PG8_LAS unsigned*)tabmem + 8 * i;
        r[0] = (unsigned)a; r[1] = (unsigned)(a >> 32); r[2] = (unsigned)b; r[3] = (unsigned)(b >> 32); r[4] = (unsigned)pm; r[5] = (unsigned)pn; r[6] = ok ? 1u : 0u; r[7] = 0u; }
    __syncthreads();
    TabOrder T; T.tab = (const volatile PG8_LAS unsigned*)tabmem; return T;
}

struct EpiRawBf16 {
    static constexpr bool PERM = true, AFTER_DRAIN = false, HEADMAP = false;
    bf16_t* O; int ldc;
    __device__ __forceinline__ void operator()(const f32x4 (&acc)[2][2][4][2], const Unit& u, int wr, int wc, int fr, int fq) const {
        const int row0 = u.pm * BM + wr * 64 + fr, col0 = u.pn * BM + wc * 32 + 8 * fq;
#pragma unroll
        for (int ai = 0; ai < 2; ++ai)
#pragma unroll
            for (int m = 0; m < 4; ++m) { bf16_t* rowp = O + (size_t)(row0 + ai * HALF + m * 16) * ldc + col0;
#pragma unroll
                for (int bj = 0; bj < 2; ++bj) { const f32x4 v0 = acc[ai][bj][m][0], v1 = acc[ai][bj][m][1];
                    u32x4 w; w.x = cvt_pk_bf16(v0[0], v0[1]); w.y = cvt_pk_bf16(v0[2], v0[3]); w.z = cvt_pk_bf16(v1[0], v1[1]); w.w = cvt_pk_bf16(v1[2], v1[3]);
                    *(u32x4*)(rowp + bj * HALF) = w; } }
    }
};

struct EpiHeads {
    static constexpr bool PERM = false, AFTER_DRAIN = false, HEADMAP = true;
    bf16_t* P; const float* gqa; const float* gka; const float* gqb; const float* gkb; const float* tab;
    __device__ __forceinline__ void operator()(const f32x4 (&acc)[2][2][4][2], const Unit& u, int wr, int wc, int fr, int fq) const {
        const int pn = u.pn, jpan = u.pm % 9; const bool lat = jpan < 8;
        int mode = 0; const float* g = gqa; float sc = 1.f;
        if (pn < 2) { mode = 2; g = gqa; sc = 0.125f * 1.4426950408889634f; }
        else if (pn == 2) { mode = 1; g = gqb; sc = 0.125f * 1.4426950408889634f; }
        else if (pn == 6) { mode = wc < 2 ? 2 : 0; g = gka; }
        else if (pn == 7) { mode = 1; g = gkb; }
        if (mode == 2 && !lat) mode = 1;
        f32x4 gv[2][2];
#pragma unroll
        for (int bj = 0; bj < 2; ++bj)
#pragma unroll
            for (int n = 0; n < 2; ++n) gv[bj][n] = mode ? *(const f32x4*)(g + 32 * bj + 16 * n + 4 * fq) * sc : (f32x4){1.f, 1.f, 1.f, 1.f};
        const int colb = pn * BM + wc * 64 + 4 * fq;
#pragma unroll
        for (int ai = 0; ai < 2; ++ai)
#pragma unroll
            for (int m = 0; m < 4; ++m) {
                const int lr = ai * HALF + wr * 64 + m * 16 + fr, j = jpan * 256 + lr;
                f32x4 v[2][2];
#pragma unroll
                for (int bj = 0; bj < 2; ++bj)
#pragma unroll
                    for (int n = 0; n < 2; ++n) v[bj][n] = acc[ai][bj][m][n];
                if (mode) {
                    float ss = 0.f;
#pragma unroll
                    for (int bj = 0; bj < 2; ++bj)
#pragma unroll
                        for (int n = 0; n < 2; ++n) ss += (v[bj][n][0] * v[bj][n][0] + v[bj][n][1] * v[bj][n][1]) + (v[bj][n][2] * v[bj][n][2] + v[bj][n][3] * v[bj][n][3]);
                    ss += __shfl_xor(ss, 16); ss += __shfl_xor(ss, 32);
                    const float rs = 1.0f / sqrtf(ss * (1.0f / 64.0f) + 1e-6f);
#pragma unroll
                    for (int bj = 0; bj < 2; ++bj)
#pragma unroll
                        for (int n = 0; n < 2; ++n) v[bj][n] = v[bj][n] * rs * gv[bj][n];
                    if (mode == 2) {
#pragma unroll
                        for (int bj = 0; bj < 2; ++bj) { const int pos = bj == 0 ? (j >> 6) : (j & 63);
                            const f32x4 t0 = *(const f32x4*)(tab + (pos * 16 + 4 * fq) * 2), t1 = *(const f32x4*)(tab + (pos * 16 + 4 * fq) * 2 + 4);
                            const f32x4 cs = {t0[0], t0[2], t1[0], t1[2]}, sn = {t0[1], t0[3], t1[1], t1[3]};
                            const f32x4 u1 = v[bj][0], u2 = v[bj][1];
                            v[bj][0] = u1 * cs - u2 * sn; v[bj][1] = u2 * cs + u1 * sn; }
                    }
                }
                bf16_t* rowp = P + (size_t)(u.pm * BM + lr) * 2304 + colb;
#pragma unroll
                for (int bj = 0; bj < 2; ++bj)
#pragma unroll
                    for (int n = 0; n < 2; ++n) { typedef unsigned u32x2 __attribute__((ext_vector_type(2))); u32x2 w; w.x = cvt_pk_bf16(v[bj][n][0], v[bj][n][1]); w.y = cvt_pk_bf16(v[bj][n][2], v[bj][n][3]);
                        *(u32x2*)(rowp + 32 * bj + 16 * n) = w; }
            }
    }
};
struct EpiGateRes {
    static constexpr bool PERM = false, AFTER_DRAIN = false, HEADMAP = false;
    const float* xin_lat; const float* xin_ctx; float* xout_lat; float* xout_ctx; const float* mod; int goff;
    __device__ __forceinline__ void operator()(const f32x4 (&acc)[2][2][4][2], const Unit& u, int wr, int wc, int fr, int fq) const {
        const int b = u.pm / 9, j = u.pm % 9;
        const float* bi; float* bo; const float* g;
        if (j < 8) { const size_t r0 = (size_t)(b * 2048 + j * 256) * 1024; bi = xin_lat + r0; bo = xout_lat + r0; g = mod + b * 6144 + goff; }
        else { const size_t r0 = (size_t)(b * 256) * 1024; bi = xin_ctx + r0; bo = xout_ctx + r0; g = mod + 16 * 6144 + goff; }
        const int col0 = u.pn * BM + wc * 32 + 4 * fq;
        f32x4 gv[2][2];
#pragma unroll
        for (int bj = 0; bj < 2; ++bj)
#pragma unroll
            for (int n = 0; n < 2; ++n) gv[bj][n] = *(const f32x4*)(g + col0 + bj * HALF + n * 16);
#pragma unroll
        for (int ai = 0; ai < 2; ++ai)
#pragma unroll
            for (int m = 0; m < 4; ++m) { const size_t off = (size_t)(ai * HALF + wr * 64 + m * 16 + fr) * 1024 + col0;
#pragma unroll
                for (int bj = 0; bj < 2; ++bj)
#pragma unroll
                    for (int n = 0; n < 2; ++n) { const f32x4 xi = *(const f32x4*)(bi + off + bj * HALF + n * 16);
                        *(f32x4*)(bo + off + bj * HALF + n * 16) = xi + gv[bj][n] * acc[ai][bj][m][n]; }
                if (m & 1) asm volatile("" ::: "memory"); }
    }
};
struct EpiSwiglu {
    static constexpr bool PERM = true, AFTER_DRAIN = false, HEADMAP = false;
    bf16_t* H; int ldh; int p0;
    __device__ __forceinline__ void operator()(const f32x4 (&acc)[2][2][4][2], const Unit& u, int wr, int wc, int fr, int fq) const {
        const int row0 = (u.pm - p0) * BM + wr * 64 + fr, col0 = u.pn * HALF + wc * 32 + 8 * fq;
#pragma unroll
        for (int ai = 0; ai < 2; ++ai)
#pragma unroll
            for (int m = 0; m < 4; ++m) { bf16_t* rowp = H + (size_t)(row0 + ai * HALF + m * 16) * ldh + col0;
                float h[8];
#pragma unroll
                for (int n = 0; n < 2; ++n)
#pragma unroll
                    for (int k = 0; k < 4; ++k) { const float a = acc[ai][0][m][n][k], b3 = acc[ai][1][m][n][k];
                        const float sg = __builtin_amdgcn_rcpf(1.0f + __builtin_amdgcn_exp2f(-1.4426950408889634f * a)); h[n * 4 + k] = a * sg * b3; }
                u32x4 w; w.x = cvt_pk_bf16(h[0], h[1]); w.y = cvt_pk_bf16(h[2], h[3]); w.z = cvt_pk_bf16(h[4], h[5]); w.w = cvt_pk_bf16(h[6], h[7]);
                *(u32x4*)rowp = w; }
    }
};
struct EpiMoeOut {
    static constexpr bool PERM = true, AFTER_DRAIN = false, HEADMAP = false;
    bf16_t* Y; const float* sgate;
    __device__ __forceinline__ void operator()(const f32x4 (&acc)[2][2][4][2], const Unit& u, int wr, int wc, int fr, int fq) const {
        const int row0 = u.pm * BM + wr * 64 + fr, col0 = u.pn * BM + wc * 32 + 8 * fq;
#pragma unroll
        for (int ai = 0; ai < 2; ++ai)
#pragma unroll
            for (int m = 0; m < 4; ++m) { const int row = row0 + ai * HALF + m * 16; const float gt = sgate[row]; bf16_t* rowp = Y + (size_t)row * 1024 + col0;
#pragma unroll
                for (int bj = 0; bj < 2; ++bj) { const f32x4 v0 = acc[ai][bj][m][0] * gt, v1 = acc[ai][bj][m][1] * gt;
                    u32x4 w; w.x = cvt_pk_bf16(v0[0], v0[1]); w.y = cvt_pk_bf16(v0[2], v0[3]); w.z = cvt_pk_bf16(v1[0], v1[1]); w.w = cvt_pk_bf16(v1[2], v1[3]);
                    *(u32x4*)(rowp + bj * HALF) = w; } }
    }
};
template <class Epi, class Sched, bool ALIGN_EPI = false, bool SP2 = false>
__device__ __forceinline__ void gemm_phase(PG8_LAS unsigned char* lds, const Gemm g, const Sched& S, const Epi& E, const int wave_sgpr) {
    int ln_ = (int)__builtin_amdgcn_mbcnt_hi(~0u, __builtin_amdgcn_mbcnt_lo(~0u, 0u)); asm volatile("" : "+v"(ln_)); const int tid_ = wave_sgpr * 64 + ln_;
    const int tid = tid_, wid = __builtin_amdgcn_readfirstlane(tid >> 6), lane = tid & 63, wr = wid >> 2, wc = wid & 3, fr = lane & 15, fq = lane >> 4;
    const int K = g.K, nt = K / BK;
    unsigned voffA[2], voffB[2];
#pragma unroll
    for (int i = 0; i < 2; ++i) { int R, C; stage_rc(tid * 16 + i * 8192, R, C); const int Rb = Epi::HEADMAP ? ((R >> 5) * 64 + (R & 31)) : (Epi::PERM ? ((R & ~31) + perm32(R & 31)) : R);
        voffA[i] = (unsigned)(R * K + C) * 2u; voffB[i] = (unsigned)(Rb * K + C) * 2u; }
    const size_t kstep = (size_t)(BK * 2);
    const size_t hstep = (size_t)HALF * K * 2;
    const size_t hstepB = Epi::HEADMAP ? (size_t)32 * K * 2 : hstep;
    const size_t tstep = 2 * hstep;
    const unsigned ldsw = (unsigned)wid * 1024u;
    const int aoff = lds_byte(wr * 64 + fr, fq * 8), boff = lds_byte(wc * 32 + fr, fq * 8);
#define PG8_SA(b, h) (((b) * 2 + (h)) * HTB)
#define PG8_SB(b, h) ((4 + (b) * 2 + (h)) * HTB)
#define PG8_STAGE(bufoff, gbase, voff) do { _Pragma("unroll") for (int _i = 0; _i < 2; ++_i) \
        __builtin_amdgcn_global_load_lds((const unsigned*)((const char*)(gbase) + (voff)[_i]), (PG8_LAS unsigned*)(lds + (bufoff) + ldsw + _i * 8192), 16, 0, 0); } while (0)
#define PG8_LDA(dst, b, h) do { _Pragma("unroll") for (int m = 0; m < 4; ++m) _Pragma("unroll") for (int k = 0; k < 2; ++k) dst[m][k] = *(const PG8_LAS bf16x8*)(lds + PG8_SA(b, h) + aoff + m * 2048 + k * 1024); } while (0)
#define PG8_LDB(dst, b, h) do { _Pragma("unroll") for (int n = 0; n < 2; ++n) _Pragma("unroll") for (int k = 0; k < 2; ++k) dst[n][k] = *(const PG8_LAS bf16x8*)(lds + PG8_SB(b, h) + boff + n * 2048 + k * 1024); } while (0)
#define PG8_MMA(ai, bj, At, Bt) do { __builtin_amdgcn_s_setprio(1); _Pragma("unroll") for (int m = 0; m < 4; ++m) _Pragma("unroll") for (int n = 0; n < 2; ++n) _Pragma("unroll") for (int k = 0; k < 2; ++k) \
        acc[ai][bj][m][n] = __builtin_amdgcn_mfma_f32_16x16x32_bf16(Bt[n][k], At[m][k], acc[ai][bj][m][n], 0, 0, 0); __builtin_amdgcn_s_setprio(0); } while (0)
#define PG8_WAIT_V(n) asm volatile("s_waitcnt vmcnt(" #n ")" ::: "memory")
#define PG8_WAIT_L(n) asm volatile("s_waitcnt lgkmcnt(" #n ")" ::: "memory")
#define PG8_BAR __builtin_amdgcn_s_barrier()
#define PG8_SCHED __builtin_amdgcn_sched_barrier(0)
    Unit cur, nxt; int ui = 0;
    if (!S.next(0, cur)) return;
    f32x4 acc[2][2][4][2];
#pragma unroll
    for (int a = 0; a < 2; ++a)
#pragma unroll
        for (int b = 0; b < 2; ++b)
#pragma unroll
            for (int m = 0; m < 4; ++m)
#pragma unroll
                for (int n = 0; n < 2; ++n) acc[a][b][m][n] = (f32x4){0.f, 0.f, 0.f, 0.f};
    bf16x8 At[4][2], B0[2][2], B1[2][2];
    const char* cA = S.abase(cur, tstep); const char* cB = S.bbase(cur, tstep);
    S.a_ready(cur);
    if constexpr (SP2) {
        PG8_STAGE(PG8_SB(0, 0), cB, voffB); PG8_STAGE(PG8_SB(0, 1), cB + hstepB, voffB); PG8_STAGE(PG8_SA(0, 0), cA, voffA); PG8_STAGE(PG8_SA(0, 1), cA + hstep, voffA);
        if (wr == 1) PG8_BAR;
        PG8_WAIT_V(2); PG8_BAR;
        PG8_STAGE(PG8_SB(1, 0), cB + kstep, voffB); PG8_STAGE(PG8_SA(1, 0), cA + kstep, voffA); PG8_STAGE(PG8_SB(1, 1), cB + hstepB + kstep, voffB);
        PG8_WAIT_V(6); PG8_BAR;
    } else {
        PG8_STAGE(PG8_SB(0, 0), cB, voffB); PG8_STAGE(PG8_SA(0, 0), cA, voffA); PG8_STAGE(PG8_SB(0, 1), cB + hstepB, voffB); PG8_STAGE(PG8_SA(0, 1), cA + hstep, voffA);
        if (wr == 1) PG8_BAR;
        PG8_WAIT_V(4); PG8_BAR;
        PG8_STAGE(PG8_SB(1, 0), cB + kstep, voffB); PG8_STAGE(PG8_SA(1, 0), cA + kstep, voffA); PG8_STAGE(PG8_SB(1, 1), cB + hstepB + kstep, voffB);
        PG8_WAIT_V(6); PG8_BAR;
    }
    for (;;) {
        const bool has_next = S.next(ui + 1, nxt);
        const char* nA = has_next ? S.abase(nxt, tstep) : cA; const char* nB = has_next ? S.bbase(nxt, tstep) : cB;
        for (int t = 0; t < nt; t += 2) {
            const bool last = (t == nt - 2);
            const char* a1 = cA + (size_t)(t + 1) * kstep;
            const char* a2 = last ? nA : cA + (size_t)(t + 2) * kstep; const char* b2 = last ? nB : cB + (size_t)(t + 2) * kstep;
            const char* a3 = a2 + kstep; const char* b3 = b2 + kstep;
            if (last && has_next) S.a_ready(nxt);
            if constexpr (SP2) {
            PG8_LDB(B0, 0, 0); PG8_LDB(B1, 0, 1); PG8_SCHED; PG8_LDA(At, 0, 0); PG8_STAGE(PG8_SA(1, 1), a1 + hstep, voffA);
            PG8_WAIT_V(8); PG8_WAIT_L(0); PG8_BAR; PG8_MMA(0, 0, At, B0); PG8_MMA(0, 1, At, B1); PG8_BAR; PG8_SCHED;
            PG8_LDA(At, 0, 1); PG8_STAGE(PG8_SB(0, 0), b2, voffB); PG8_STAGE(PG8_SB(0, 1), b2 + hstepB, voffB); PG8_STAGE(PG8_SA(0, 0), a2, voffA);
            PG8_WAIT_V(8); PG8_WAIT_L(0); PG8_BAR; PG8_MMA(1, 0, At, B0); PG8_MMA(1, 1, At, B1); PG8_BAR; PG8_SCHED;
            PG8_LDB(B0, 1, 0); PG8_LDB(B1, 1, 1); PG8_SCHED; PG8_LDA(At, 1, 0); PG8_STAGE(PG8_SA(0, 1), a2 + hstep, voffA);
            PG8_WAIT_V(8); PG8_WAIT_L(0); PG8_BAR; PG8_MMA(0, 0, At, B0); PG8_MMA(0, 1, At, B1); PG8_BAR; PG8_SCHED;
            PG8_LDA(At, 1, 1); PG8_STAGE(PG8_SB(1, 0), b3, voffB); PG8_STAGE(PG8_SB(1, 1), b3 + hstepB, voffB); PG8_STAGE(PG8_SA(1, 0), a3, voffA);
            PG8_WAIT_V(8); PG8_WAIT_L(0); PG8_BAR; PG8_MMA(1, 0, At, B0); PG8_MMA(1, 1, At, B1); PG8_BAR; PG8_SCHED;
            } else {
            PG8_LDB(B0, 0, 0); PG8_SCHED; PG8_LDA(At, 0, 0); PG8_STAGE(PG8_SA(1, 1), a1 + hstep, voffA);
            PG8_WAIT_L(8); PG8_BAR; PG8_WAIT_L(0); PG8_MMA(0, 0, At, B0); PG8_BAR; PG8_SCHED;
            PG8_LDB(B1, 0, 1); PG8_STAGE(PG8_SB(0, 0), b2, voffB);
            PG8_BAR; PG8_WAIT_L(0); PG8_MMA(0, 1, At, B1); PG8_BAR;
            PG8_LDA(At, 0, 1); PG8_STAGE(PG8_SA(0, 0), a2, voffA);
            PG8_BAR; PG8_WAIT_L(0); PG8_MMA(1, 0, At, B0); PG8_BAR; PG8_SCHED;
            PG8_STAGE(PG8_SB(0, 1), b2 + hstepB, voffB);
            PG8_WAIT_V(6); PG8_BAR; PG8_MMA(1, 1, At, B1); PG8_BAR;
            PG8_LDB(B0, 1, 0); PG8_SCHED; PG8_LDA(At, 1, 0); PG8_STAGE(PG8_SA(0, 1), a2 + hstep, voffA);
            PG8_WAIT_L(8); PG8_BAR; PG8_WAIT_L(0); PG8_MMA(0, 0, At, B0); PG8_BAR; PG8_SCHED;
            PG8_LDB(B1, 1, 1); PG8_STAGE(PG8_SB(1, 0), b3, voffB);
            PG8_BAR; PG8_WAIT_L(0); PG8_MMA(0, 1, At, B1); PG8_BAR;
            PG8_LDA(At, 1, 1); PG8_STAGE(PG8_SA(1, 0), a3, voffA);
            PG8_BAR; PG8_WAIT_L(0); PG8_MMA(1, 0, At, B0); PG8_BAR; PG8_SCHED;
            PG8_STAGE(PG8_SB(1, 1), b3 + hstepB, voffB);
            PG8_WAIT_V(6); PG8_BAR; PG8_MMA(1, 1, At, B1); PG8_BAR;
            }
        }
        if constexpr (ALIGN_EPI) { if (wr == 0) PG8_BAR; }
        if constexpr (!Epi::AFTER_DRAIN) { E(acc, cur, wr, wc, fr, fq); S.done(cur); }
        if (!has_next) break;
#pragma unroll
        for (int a = 0; a < 2; ++a)
#pragma unroll
            for (int b = 0; b < 2; ++b)
#pragma unroll
                for (int m = 0; m < 4; ++m)
#pragma unroll
                    for (int n = 0; n < 2; ++n) acc[a][b][m][n] = (f32x4){0.f, 0.f, 0.f, 0.f};
        cur = nxt; cA = nA; cB = nB; ++ui;
        if constexpr (ALIGN_EPI) { if (wr == 1) PG8_BAR; }
    }
    PG8_WAIT_V(0);
    if constexpr (!ALIGN_EPI) { if (wr == 0) PG8_BAR; }
    PG8_BAR;
    if constexpr (Epi::AFTER_DRAIN) { E.fused(acc, cur, wr, wc, fr, fq, lds, wid, lane); S.done(cur); }
#undef PG8_SA
#undef PG8_SB
#undef PG8_STAGE
#undef PG8_LDA
#undef PG8_LDB
#undef PG8_MMA
#undef PG8_WAIT_V
#undef PG8_WAIT_L
#undef PG8_BAR
#undef PG8_SCHED
}
}

constexpr int NWAVES = 8;
#ifndef MK_N_LAUNCHES
#define MK_N_LAUNCHES 1
#endif
constexpr int NPH = 23;
constexpr int BATCH = 16, SEQ = 2048, DM = 1024, CTXL = 256, TPB = SEQ + CTXL, MROWS = BATCH * TPB, NPAN = MROWS / 256;
constexpr int INW = 2304, DFF = 2816, NEXP = 8, NTOK = BATCH * SEQ;
constexpr int QA_OFF = 0, QB_OFF = 512, CPOST_OFF = 768, CPRE_OFF = 1024, CVAL_OFF = 1280, KA_OFF = 1536, VA_OFF = 1664, KB_OFF = 1792, VB_OFF = 2048;
constexpr float NORM_EPS = 1e-6f, LOG2E = 1.4426950408889634f, C2 = 0.125f * 1.4426950408889634f;
constexpr int MOE_HCAP = 136;
constexpr int SLOT_CAP = 2 * NTOK + NEXP * 256;

constexpr size_t MiB = 1u << 20;
constexpr size_t WS_CTL = 0, CTL_ZERO_BYTES = 1 * MiB;
constexpr size_t WS_MOD = 1 * MiB;
constexpr size_t WS_MISC = 2 * MiB;
constexpr size_t WS_WIN = 6 * MiB;
constexpr size_t WS_WOUT = 15 * MiB;
constexpr size_t WS_F13 = 19 * MiB;
constexpr size_t WS_F2 = 30 * MiB;
constexpr size_t WS_M13 = 36 * MiB;
constexpr size_t WS_M2 = 124 * MiB;
constexpr size_t WS_XC = 168 * MiB;
constexpr size_t WS_XN = 184 * MiB;
constexpr size_t WS_P = 256 * MiB;
constexpr size_t WS_XT = 316 * MiB;
constexpr size_t WS_END = 504 * MiB;
static_assert(WS_P + (size_t)MROWS * DFF * 2 <= WS_END && WS_XT + (size_t)MOE_HCAP * 256 * DFF * 2 <= WS_END && WS_XN + (size_t)SLOT_CAP * DM * 2 <= WS_XT, "ws map");
constexpr size_t MS_TOKE = 0, MS_TOKG = 256 * 1024, MS_TOKS = 512 * 1024, MS_SLOTG = 768 * 1024, MS_META = 1088 * 1024, MS_ROPE = 1152 * 1024;
constexpr int CW_TMO = 0, CW_CODE = 1, CW_BAR = 4096, CW_CNT = 16384;

constexpr int RING_BYTES = 131072, LDSCTL_OFF = RING_BYTES, MISC_OFF = LDSCTL_OFF + 320, LDS_BYTES = 147456;

#define GAS __attribute__((address_space(1)))
#define LAS __attribute__((address_space(3)))
typedef unsigned short bf16;
typedef unsigned v4u __attribute__((ext_vector_type(4)));
typedef unsigned v2u __attribute__((ext_vector_type(2)));
typedef float f32x4 __attribute__((ext_vector_type(4)));
#define LDS_WAIT() asm volatile("s_waitcnt lgkmcnt(0)" ::: "memory")
#define VM_WAIT() asm volatile("s_waitcnt vmcnt(0)" ::: "memory")
__device__ __forceinline__ unsigned f2bf(float f) { unsigned u = __builtin_bit_cast(unsigned, f); return (u + 0x7fffu + ((u >> 16) & 1u)) >> 16; }
__device__ __forceinline__ unsigned pk2(float lo, float hi) { return f2bf(lo) | (f2bf(hi) << 16); }
__device__ __forceinline__ float bflo(unsigned w) { return __uint_as_float(w << 16); }
__device__ __forceinline__ float bfhi(unsigned w) { return __uint_as_float(w & 0xffff0000u); }
__device__ __forceinline__ float bf1(bf16 h) { return __uint_as_float((unsigned)h << 16); }
__device__ __forceinline__ float wave_sum(float v) {
#pragma unroll
    for (int o = 1; o < 64; o <<= 1) v += __shfl_xor(v, o);
    return v;
}
__device__ __forceinline__ float half_sum(float v) {
#pragma unroll
    for (int o = 1; o < 32; o <<= 1) v += __shfl_xor(v, o);
    return v;
}
#include <hip/hip_bf16.h>
#include <cmath>
namespace attn_body {
using bf16=__hip_bfloat16;
using bf16x8=__attribute__((ext_vector_type(8)))short;
using s16x4=__attribute__((ext_vector_type(4)))short;
using f32x16=__attribute__((ext_vector_type(16)))float;
using u32x4=__attribute__((ext_vector_type(4)))unsigned;
constexpr int D=64,DM=2304;
constexpr int NW=8,QBLK=32,QB=QBLK*NW,KVBLK=64;
constexpr int LDS_BT=86016, BT_STRIDE=128, BT_PAD=48;
__device__ __forceinline__ int crow(int r,int hi){return (r&3)+8*(r>>2)+4*hi;}
#define SBAR() __builtin_amdgcn_sched_barrier(0)
__device__ __forceinline__ void bias_apply(f32x16&p0,f32x16&p1,const __attribute__((address_space(3))) char*tb,unsigned m0,unsigned m1,float mh){
  const unsigned NEGB=0xf149f2cau;
  #pragma unroll
  for(int g=0;g<4;++g){
    #pragma unroll
    for(int k=0;k<4;++k){ const int r=4*g+k; const int o=((r&3)+8*(r>>2))*4; const float b0=*(const __attribute__((address_space(3))) float*)(tb+o),b1=*(const __attribute__((address_space(3))) float*)(tb+o+128);
      const unsigned s0=(unsigned)__builtin_amdgcn_sbfe((int)m0,r,1), s1=(unsigned)__builtin_amdgcn_sbfe((int)m1,r,1);
      const unsigned x0=__float_as_uint(p0[r]+(b0-mh)), x1=__float_as_uint(p1[r]+(b1-mh));
      float y0=__uint_as_float((x0&s0)|(NEGB&~s0)), y1=__uint_as_float((x1&s1)|(NEGB&~s1)); asm volatile("":"+v"(y0),"+v"(y1)); p0[r]=y0; p1[r]=y1; }
    __builtin_amdgcn_sched_barrier(0); }
}
constexpr int NSLOT=3, SLOTB=8192;
constexpr int LDS_K=0, LDS_V=NSLOT*SLOTB, LDS_WS=2*NSLOT*SLOTB, LDS_OST=LDS_WS+NW*64*4, LDS_BYTES=LDS_OST+NW*4096;
constexpr float C2=0.125f*1.4426950408889634f;
__device__ __forceinline__ void glds16(const void*gsrc,unsigned lds_dst){unsigned keep;
  asm volatile("s_mov_b32 %0, m0\n\ts_mov_b32 m0, %2\n\ts_nop 0\n\tglobal_load_lds_dwordx4 %1, off\n\ts_mov_b32 m0, %0":"=&s"(keep):"v"(gsrc),"s"(lds_dst):"memory");}
__device__ __forceinline__ float max3f(float a,float b,float c){float r;asm("v_max3_f32 %0, %1, %2, %3":"=v"(r):"v"(a),"v"(b),"v"(c));return r;}
__device__ __forceinline__ float max2f(float a,float b){float r;asm("v_max_f32_e32 %0, %1, %2":"=v"(r):"v"(a),"v"(b));return r;}
__device__ __forceinline__ float fadd_s(float a,float b){float r;asm("v_add_f32_e32 %0, %1, %2":"=v"(r):"v"(a),"v"(b));return r;}
__device__ __forceinline__ float fsub_s(float a,float b){float r;asm("v_sub_f32_e32 %0, %1, %2":"=v"(r):"v"(a),"v"(b));return r;}
typedef float f32x2_t __attribute__((ext_vector_type(2))); typedef __bf16 bf16x2_t __attribute__((ext_vector_type(2)));
__device__ __forceinline__ unsigned cvtpk_s(float lo,float hi){f32x2_t v={lo,hi};bf16x2_t b=__builtin_convertvector(v,bf16x2_t);return __builtin_bit_cast(unsigned,b);}
#define WAIT_BAR(N) asm volatile("s_waitcnt vmcnt(" #N ") lgkmcnt(0)\n\ts_barrier":::"memory")

template<bool ZERO> __device__ __forceinline__ f32x16 cinit(const f32x16&negm){ if constexpr(ZERO) return f32x16{}; else return negm; }
__device__ __forceinline__ void qkt(f32x16&p0,f32x16&p1,const char*Kslot,const bf16x8*qr,const f32x16 negm,int r32,int hi){
  const char*kb=Kslot+hi*1024+r32*16;
  #pragma unroll
  for(int d0=0;d0<4;++d0){
    const bf16x8 b0=*reinterpret_cast<const bf16x8*>(kb+d0*2048);
    const bf16x8 b1=*reinterpret_cast<const bf16x8*>(kb+d0*2048+512);
    if(d0==0){p0=__builtin_amdgcn_mfma_f32_32x32x16_bf16(b0,qr[0],negm,0,0,0);p1=__builtin_amdgcn_mfma_f32_32x32x16_bf16(b1,qr[0],negm,0,0,0);}
    else{p0=__builtin_amdgcn_mfma_f32_32x32x16_bf16(b0,qr[d0],p0,0,0,0);p1=__builtin_amdgcn_mfma_f32_32x32x16_bf16(b1,qr[d0],p1,0,0,0);}}
}
typedef __attribute__((address_space(3))) const char* lds_cptr;
typedef short v4i16_t __attribute__((ext_vector_type(4)));
__device__ __forceinline__ void kload8(bf16x8*kf,lds_cptr kp){
  kf[0]=*(const __attribute__((address_space(3))) bf16x8*)(kp);      kf[1]=*(const __attribute__((address_space(3))) bf16x8*)(kp+512);
  kf[2]=*(const __attribute__((address_space(3))) bf16x8*)(kp+2048); kf[3]=*(const __attribute__((address_space(3))) bf16x8*)(kp+2560);
  kf[4]=*(const __attribute__((address_space(3))) bf16x8*)(kp+4096); kf[5]=*(const __attribute__((address_space(3))) bf16x8*)(kp+4608);
  kf[6]=*(const __attribute__((address_space(3))) bf16x8*)(kp+6144); kf[7]=*(const __attribute__((address_space(3))) bf16x8*)(kp+6656);
}
__device__ __forceinline__ void kload2(bf16x8*kf,lds_cptr kp,int j){ kf[2*j]=*(const __attribute__((address_space(3))) bf16x8*)(kp+j*2048); kf[2*j+1]=*(const __attribute__((address_space(3))) bf16x8*)(kp+j*2048+512); }
__device__ __forceinline__ s16x4 vtr(lds_cptr p){ return __builtin_bit_cast(s16x4,__builtin_amdgcn_ds_read_tr16_b64_v4i16((__attribute__((address_space(3))) v4i16_t*)p)); }
__device__ __forceinline__ float rowmax(const f32x16&p0,const f32x16&p1){
  float a=max3f(p0[0],p0[1],p1[0]),b=max3f(p0[2],p0[3],p1[1]);a=max3f(a,p1[2],p1[3]);
  #pragma unroll
  for(int r=4;r<16;r+=4){a=max3f(a,p0[r],p0[r+1]);b=max3f(b,p0[r+2],p0[r+3]);a=max3f(a,p1[r],p1[r+1]);b=max3f(b,p1[r+2],p1[r+3]);}
  const float m=max2f(a,b);
  auto rr=__builtin_amdgcn_permlane32_swap(__float_as_uint(m),__float_as_uint(m),false,false);
  return max2f(__uint_as_float(rr[0]),__uint_as_float(rr[1]));
}
__device__ __forceinline__ void pv(f32x16*o,int vb,bf16x8 pa0,bf16x8 pa1,bf16x8 pa2,bf16x8 pa3){
  #pragma unroll
  for(int d0=0;d0<2;++d0){s16x4 lo[4],hi[4];
    #pragma unroll
    for(int ks=0;ks<4;++ks){
      asm volatile("ds_read_b64_tr_b16 %0,%1 offset:%c2":"=&v"(lo[ks]):"v"(vb),"i"(d0*4096+ks*1024):"memory");
      asm volatile("ds_read_b64_tr_b16 %0,%1 offset:%c2":"=&v"(hi[ks]):"v"(vb),"i"(d0*4096+ks*1024+512):"memory");}
    asm volatile("s_waitcnt lgkmcnt(0)":::"memory");SBAR();
    #define PK(k) (bf16x8){lo[k][0],lo[k][1],lo[k][2],lo[k][3],hi[k][0],hi[k][1],hi[k][2],hi[k][3]}
    o[d0]=__builtin_amdgcn_mfma_f32_32x32x16_bf16(pa0,PK(0),o[d0],0,0,0);
    o[d0]=__builtin_amdgcn_mfma_f32_32x32x16_bf16(pa1,PK(1),o[d0],0,0,0);
    o[d0]=__builtin_amdgcn_mfma_f32_32x32x16_bf16(pa2,PK(2),o[d0],0,0,0);
    o[d0]=__builtin_amdgcn_mfma_f32_32x32x16_bf16(pa3,PK(3),o[d0],0,0,0);
    #undef PK
  }
}

#ifndef ATTN_STORE16
#define ATTN_STORE16(p,v) (*(u32x4*)(p)=(v))
#endif
template<int THRL,bool BMODE> __device__ __forceinline__ void attn_unit(const bf16*Qu,const bf16*__restrict__ Kh,const bf16*__restrict__ Vh,bf16*Ou,const int NT,const int nfirst,const int first0,const int second0,const int qg,const float*rpbh,char*shm,const int wave_sgpr){
  int ln_=(int)__builtin_amdgcn_mbcnt_hi(~0u,__builtin_amdgcn_mbcnt_lo(~0u,0u)); asm volatile("":"+v"(ln_));
  const int wid=wave_sgpr,lane=ln_,tid=wid*64+lane,r32=lane&31,hi=lane>>5;
  const bf16*Qw=Qu+(long)(wid*QBLK)*DM;
  const unsigned lds0=(unsigned)(uintptr_t)shm;
  float*wsf=(float*)(shm+LDS_WS)+wid*64;
  const bf16*ksrc=Kh+(long)lane*DM+wid*8;
  const bf16*vsrc=Vh+(long)(16*(wid&3)+(lane>>2))*DM+(wid>>2)*32+(lane&3)*8;
  const unsigned kdst=lds0+LDS_K+wid*1024, vdst=lds0+LDS_V+wid*1024;
  #define TILE(t) (((t)<nfirst)?(first0+(t)):(second0+(t)-nfirst))
  #define DMA_K(t,slot) glds16(ksrc+(long)TILE(t)*KVBLK*DM,(unsigned)__builtin_amdgcn_readfirstlane(kdst+(slot)))
  #define DMA_V(t,slot) glds16(vsrc+(long)TILE(t)*KVBLK*DM,(unsigned)__builtin_amdgcn_readfirstlane(vdst+(slot)))
  const int vb0=(int)(lds0+LDS_V)+((lane>>4)&1)*32+(lane&3)*8+(4*hi+((lane&15)>>2))*64;
  const char*Kbase=shm+LDS_K; bf16x8 kf[8];
  const lds_cptr shm3=(lds_cptr)shm; const lds_cptr kp0=shm3+LDS_K+hi*1024+r32*16; const lds_cptr vp0=shm3+LDS_V+((lane>>4)&1)*32+(lane&3)*8+(4*hi+((lane&15)>>2))*64;
  unsigned bm0=0u,bm1=0u; int blane=0,bqr=0,brs=0;
  if constexpr(BMODE){ const int qc=(wid&1)*32+r32; int cs=qc-8; cs=cs<0?0:(cs>48?48:cs);
    _Pragma("unroll") for(int r=0;r<16;++r){ const int kc=(r&3)+8*(r>>2)+4*hi; bm0|=(kc>=cs&&kc<cs+16)?(1u<<r):0u; bm1|=(kc+32>=cs&&kc+32<cs+16)?(1u<<r):0u; }
    blane=(BT_PAD+15-qc+4*hi)*4; bqr=qg+(wid>>1); brs=bqr-4; brs=brs<0?0:(brs>24?24:brs);
    __attribute__((address_space(3))) float*bt=(__attribute__((address_space(3))) float*)(shm3+LDS_BT); for(int idx=tid;idx<15*BT_STRIDE;idx+=NW*64){ const int dr=idx/BT_STRIDE,j=idx%BT_STRIDE; bt[idx]=(j>=BT_PAD&&j<=BT_PAD+30)?rpbh[dr*31+j-BT_PAD]*1.4426950408889634f:0.f; } }
  DMA_K(0,0);DMA_V(0,0);DMA_K(1,SLOTB);
  bf16x8 qr[4];
  #pragma unroll
  for(int d0=0;d0<4;++d0)qr[d0]=*reinterpret_cast<const bf16x8*>(&Qw[(long)r32*DM+d0*16+hi*8]);
  float mhat=0.f,l_reg=0.f;f32x16 o[2];o[0]=f32x16{};o[1]=f32x16{};f32x16 negm=f32x16{}; if constexpr(!BMODE){asm volatile("":"+v"(negm));}
  #define CMASK(P0,P1,t) do{ if constexpr(BMODE){ if((t)>=nfirst){ const int kr_=second0+(t)-nfirst; const bool rv_=(kr_>=brs)&&(kr_<brs+8); int dr_=kr_-bqr+7; dr_=dr_<0?0:(dr_>14?14:dr_); \
      bias_apply(P0,P1,shm3+LDS_BT+dr_*(BT_STRIDE*4)+blane,rv_?bm0:0u,rv_?bm1:0u,mhat); } else { _Pragma("unroll") for(int r_=0;r_<16;++r_){P0[r_]-=mhat;P1[r_]-=mhat;} } } }while(0)
  bool resc=false;
  #define START(P0,P1) do{ const float rm=rowmax(P0,P1); resc=false; \
    { const float dl=rm; mhat=fadd_s(mhat,dl); \
      _Pragma("unroll") for(int r=0;r<16;++r){P0[r]=fsub_s(P0[r],dl);P1[r]=fsub_s(P1[r],dl);} \
      if constexpr(!BMODE){ _Pragma("unroll") for(int r=0;r<16;++r)negm[r]=-mhat; asm volatile("":"+v"(negm)); } } \
    _Pragma("unroll") for(int r=0;r<16;++r)P0[r]=__builtin_amdgcn_exp2f(P0[r]); }while(0)
  #define RESC() do{ if(resc){ asm volatile("s_waitcnt lgkmcnt(0)":::"memory"); \
      _Pragma("unroll") for(int d_=0;d_<2;++d_) _Pragma("unroll") for(int r=0;r<16;++r)o[d_][r]*=wsf[crow(r,hi)]; } }while(0)
  f32x16 pA0,pA1,pB0,pB1;
  int sl_prev=0,sl_cur=0,sl_next=SLOTB;
  #define ROT() do{sl_prev=sl_cur;sl_cur=sl_next;sl_next=(sl_next==(NSLOT-1)*SLOTB)?0:sl_next+SLOTB;}while(0)
  DMA_K(2,2*SLOTB);
  WAIT_BAR(3);
  qkt(pA0,pA1,Kbase,qr,cinit<BMODE>(negm),r32,hi);asm volatile("s_nop 15\n\ts_nop 7":"+v"(pA0),"+v"(pA1));CMASK(pA0,pA1,0);
  START(pA0,pA1);
  _Pragma("unroll") for(int r=0;r<16;++r)pA1[r]=__builtin_amdgcn_exp2f(pA1[r]);
  WAIT_BAR(0);
  DMA_K(3,0);DMA_V(1,SLOTB);
  ROT();
  kload8(kf,kp0+sl_cur);
  WAIT_BAR(2);
  s16x4 vlo[8],vhi[8]; u32x4 pw0,pw1,pw2,pw3;
  #define PKW(P,B) cvtpk_s(P[B],P[B+1])
  #define PAF(k) __builtin_bit_cast(bf16x8,pw##k)
  #define VFR(i) (bf16x8){vlo[i][0],vlo[i][1],vlo[i][2],vlo[i][3],vhi[i][0],vhi[i][1],vhi[i][2],vhi[i][3]}
  #define PIN(x) asm volatile("":"+v"(x))
  #define MX3(a,b,c) __builtin_fmaxf(__builtin_fmaxf((a),(b)),(c))
  #define GAPA(MF,A0,A1,A2,A3,W0,W1,PW) do{ MF; sacc+=A0; sacc+=A1; sacc+=A2; sacc+=A3; PIN(sacc); W0; W1; PIN(PW); SBAR(); }while(0)
  #define EX(v) __builtin_amdgcn_exp2f(v)
  #define GAPB(MF,X,B) do{ MF; X[B]=EX(X[B]); X[B+1]=EX(X[B+1]); X[B+2]=EX(X[B+2]); X[B+3]=EX(X[B+3]); PIN(X); SBAR(); }while(0)
  #define VRD(i) do{ vlo[i]=vtr(vp_+(((i)>>2)*4096+((i)&3)*1024)); vhi[i]=vtr(vp_+(((i)>>2)*4096+((i)&3)*1024+512)); }while(0)
  #define KRD(G,j) do{ if(G){ kload2(kf,kp0+sl_next,j); SBAR(); } }while(0)
  #define STEP(C0,C1,P0,P1,t,GK,GV,GL) do{ SBAR(); \
    const lds_cptr vp_=vp0+sl_prev; \
    VRD(0); SBAR(); float sacc=(P0[0]+P0[1]); \
    GAPA(C0=__builtin_amdgcn_mfma_f32_32x32x16_bf16(kf[0],qr[0],cinit<BMODE>(negm),0,0,0), P0[2],P0[3],P0[4],P0[5],     pw0[0]=PKW(P0,0), pw0[1]=PKW(P0,2), pw0); \
    VRD(4); SBAR(); GAPA(C1=__builtin_amdgcn_mfma_f32_32x32x16_bf16(kf[1],qr[0],cinit<BMODE>(negm),0,0,0), P0[6],P0[7],P0[8],P0[9],     pw0[2]=PKW(P0,4), pw0[3]=PKW(P0,6), pw0); \
    VRD(1); SBAR(); GAPA(C0=__builtin_amdgcn_mfma_f32_32x32x16_bf16(kf[2],qr[1],C0,0,0,0),   P0[10],P0[11],P0[12],P0[13], pw1[0]=PKW(P0,8), pw1[1]=PKW(P0,10), pw1); \
    VRD(5); SBAR(); GAPA(C1=__builtin_amdgcn_mfma_f32_32x32x16_bf16(kf[3],qr[1],C1,0,0,0),   P0[14],P0[15],P1[0],P1[1],   pw1[2]=PKW(P0,12),pw1[3]=PKW(P0,14), pw1); \
    VRD(2); SBAR(); GAPA(C0=__builtin_amdgcn_mfma_f32_32x32x16_bf16(kf[4],qr[2],C0,0,0,0),   P1[2],P1[3],P1[4],P1[5],     pw2[0]=PKW(P1,0), pw2[1]=PKW(P1,2), pw2); \
    VRD(6); SBAR(); GAPA(C1=__builtin_amdgcn_mfma_f32_32x32x16_bf16(kf[5],qr[2],C1,0,0,0),   P1[6],P1[7],P1[8],P1[9],     pw2[2]=PKW(P1,4), pw2[3]=PKW(P1,6), pw2); \
    VRD(3); SBAR(); GAPA(C0=__builtin_amdgcn_mfma_f32_32x32x16_bf16(kf[6],qr[3],C0,0,0,0),   P1[10],P1[11],P1[12],P1[13], pw3[0]=PKW(P1,8), pw3[1]=PKW(P1,10), pw3); \
    VRD(7); SBAR(); GAPA(C1=__builtin_amdgcn_mfma_f32_32x32x16_bf16(kf[7],qr[3],C1,0,0,0),   P1[14],P1[15],0.f,0.f,       pw3[2]=PKW(P1,12),pw3[3]=PKW(P1,14), pw3); \
    l_reg+=sacc; \
    if(GK){DMA_K((t)+3,sl_cur);} if(GV){DMA_V((t)+1,sl_next);} \
    CMASK(C0,C1,t); \
    { float a=MX3(C0[0],C0[1],C1[0]),b=MX3(C0[2],C0[3],C1[1]); a=MX3(a,C1[2],C1[3]); \
      _Pragma("unroll") for(int r=4;r<16;r+=4){a=MX3(a,C0[r],C0[r+1]);b=MX3(b,C0[r+2],C0[r+3]);a=MX3(a,C1[r],C1[r+1]);b=MX3(b,C1[r+2],C1[r+3]);} \
      float rm=__builtin_fmaxf(a,b); { auto rr=__builtin_amdgcn_permlane32_swap(__float_as_uint(rm),__float_as_uint(rm),false,false); rm=__builtin_fmaxf(__uint_as_float(rr[0]),__uint_as_float(rr[1])); } \
      resc=false; \
      if(__builtin_expect(__any(rm>(float)THRL),0)){ const float dl=__builtin_fmaxf(rm,0.f); mhat+=dl; \
        _Pragma("unroll") for(int r=0;r<16;++r){C0[r]-=dl;C1[r]-=dl;} \
        if constexpr(!BMODE){ _Pragma("unroll") for(int r=0;r<16;++r)negm[r]=-mhat; asm volatile("":"+v"(negm)); } \
        const float f=__builtin_amdgcn_exp2f(-dl); l_reg*=f; if(hi==0)wsf[r32]=f; resc=true; } } \
    SBAR(); \
    GAPB(o[0]=__builtin_amdgcn_mfma_f32_32x32x16_bf16(PAF(0),VFR(0),o[0],0,0,0), C0,0); \
    GAPB(o[1]=__builtin_amdgcn_mfma_f32_32x32x16_bf16(PAF(0),VFR(4),o[1],0,0,0), C0,4); \
    KRD(GL,0); GAPB(o[0]=__builtin_amdgcn_mfma_f32_32x32x16_bf16(PAF(1),VFR(1),o[0],0,0,0), C0,8); \
    KRD(GL,1); GAPB(o[1]=__builtin_amdgcn_mfma_f32_32x32x16_bf16(PAF(1),VFR(5),o[1],0,0,0), C0,12); \
    KRD(GL,2); GAPB(o[0]=__builtin_amdgcn_mfma_f32_32x32x16_bf16(PAF(2),VFR(2),o[0],0,0,0), C1,0); \
    KRD(GL,3); GAPB(o[1]=__builtin_amdgcn_mfma_f32_32x32x16_bf16(PAF(2),VFR(6),o[1],0,0,0), C1,4); \
    GAPB(o[0]=__builtin_amdgcn_mfma_f32_32x32x16_bf16(PAF(3),VFR(3),o[0],0,0,0), C1,8); \
    GAPB(o[1]=__builtin_amdgcn_mfma_f32_32x32x16_bf16(PAF(3),VFR(7),o[1],0,0,0), C1,12); \
    }while(0)
  int t=1;
  for(;t+5<NT;t+=2){
    STEP(pB0,pB1,pA0,pA1,t,true,true,true);     WAIT_BAR(2); RESC(); ROT();
    STEP(pA0,pA1,pB0,pB1,t+1,true,true,true);   WAIT_BAR(2); RESC(); ROT();
  }
  #define ENDW(tt) do{ if((tt)+3<NT){WAIT_BAR(2);} else if((tt)+2<NT){WAIT_BAR(1);} else {WAIT_BAR(0);} }while(0)
  for(;t+1<NT;t+=2){
    STEP(pB0,pB1,pA0,pA1,t,(t+3<NT),(t+1<NT),(t+1<NT));       ENDW(t);   RESC(); ROT();
    STEP(pA0,pA1,pB0,pB1,t+1,(t+4<NT),(t+2<NT),(t+2<NT));     ENDW(t+1); RESC(); ROT();
  }
  STEP(pB0,pB1,pA0,pA1,NT-1,false,false,false); RESC();
  { float sacc=pB0[0]+pB0[1]; _Pragma("unroll") for(int r=2;r<16;++r)sacc+=pB0[r]; _Pragma("unroll") for(int r=0;r<16;++r)sacc+=pB1[r]; l_reg+=sacc;
    pw0=(u32x4){PKW(pB0,0),PKW(pB0,2),PKW(pB0,4),PKW(pB0,6)};pw1=(u32x4){PKW(pB0,8),PKW(pB0,10),PKW(pB0,12),PKW(pB0,14)};pw2=(u32x4){PKW(pB1,0),PKW(pB1,2),PKW(pB1,4),PKW(pB1,6)};pw3=(u32x4){PKW(pB1,8),PKW(pB1,10),PKW(pB1,12),PKW(pB1,14)};
    SBAR(); pv(o,vb0+sl_cur,PAF(0),PAF(1),PAF(2),PAF(3)); }
  #undef PKW
  #undef PAF
  #undef VFR
  #undef PIN
  #undef MX3
  #undef GAPA
  #undef GAPB
  #undef EX
  #undef VRD
  #undef KRD
  #undef STEP
  #undef ENDW
  {auto rr=__builtin_amdgcn_permlane32_swap(__float_as_uint(l_reg),__float_as_uint(l_reg),false,false);l_reg=__uint_as_float(rr[0])+__uint_as_float(rr[1]);}
  if(hi==0)wsf[32+r32]=l_reg;asm volatile("s_waitcnt lgkmcnt(0)":::"memory");
  float rli[16];
  #pragma unroll
  for(int r=0;r<16;++r)rli[r]=__builtin_amdgcn_rcpf(wsf[32+crow(r,hi)]);
  bf16*Ow=Ou+(long)(wid*QBLK)*DM;
  { bf16*stg=(bf16*)(shm+LDS_OST)+wid*2048;
    #pragma unroll
    for(int r=0;r<16;++r){const int orow=crow(r,hi);
      #pragma unroll
      for(int d0=0;d0<2;++d0)stg[orow*64+d0*32+r32]=__float2bfloat16(o[d0][r]*rli[r]);}
    asm volatile("s_waitcnt lgkmcnt(0)":::"memory");
    #pragma unroll
    for(int i=0;i<4;++i){const int row=i*8+(lane>>3),ch=lane&7; const u32x4 v=*(const u32x4*)(stg+row*64+ch*8); ATTN_STORE16(Ow+(long)row*DM+ch*8,v);} }
  asm volatile("s_waitcnt lgkmcnt(0)\n\ts_barrier":::"memory");
  #undef TILE
  #undef DMA_K
  #undef DMA_V
  #undef CMASK
  #undef START
  #undef RESC
  #undef ROT
}
constexpr int ATTN_LDS_BYTES=LDS_BT+15*BT_STRIDE*4;
#undef SBAR
#undef WAIT_BAR
}
#define XB_TMO      128
#define XB_XCNT(j)  (256  + 64 * (j))
#define XB_XSUB(j)  (1280 + 64 * (j))
#define XB_XGEN(j)  (2304 + 64 * (j))
#define XB_TOP      3328
#define XB_TOPGEN   3392
#define XCD_BAR_WORDS 3456
#define XB_SPIN_CAP (1u << 18)

__device__ __forceinline__ unsigned xb_ld(unsigned* p)              { return __hip_atomic_load(p, __ATOMIC_RELAXED, __HIP_MEMORY_SCOPE_AGENT); }
__device__ __forceinline__ unsigned xb_add(unsigned* p, unsigned v) { return __hip_atomic_fetch_add(p, v, __ATOMIC_RELAXED, __HIP_MEMORY_SCOPE_AGENT); }
__device__ __forceinline__ unsigned xb_xcc_id() { return (unsigned)__builtin_amdgcn_s_getreg((3 << 11) | 20) & 0xFu; }
#define XB_SPIN(cond, bar) do { unsigned _sp = 0; while (cond) { __builtin_amdgcn_s_sleep(1); \
    if ((++_sp & 255u) == 0u) { if (xb_ld(&(bar)[XB_TMO])) break; if (_sp > XB_SPIN_CAP) { atomicAdd(&(bar)[XB_TMO], 1u); break; } } } } while (0)

struct XcdBarrier {
    unsigned* bar; unsigned x;
    volatile LAS unsigned* st;
};

__device__ __forceinline__ XcdBarrier xcd_barrier_post(unsigned* bar, volatile LAS unsigned* st) {
    XcdBarrier b; b.bar = bar; b.x = xb_xcc_id(); b.st = st;
    if (threadIdx.x == 0) (void)xb_add(&bar[XB_XCNT(b.x)], 1u);
    return b;
}
__device__ __forceinline__ void xcd_barrier_complete(unsigned* bar, unsigned x, unsigned& nloc, unsigned& nx) {
    const unsigned G = gridDim.x * gridDim.y * gridDim.z;
    unsigned sum, cnt, mine, sp = 0u;
    for (;;) {
        sum = 0u; cnt = 0u; mine = 0u;
#pragma unroll
        for (unsigned j = 0; j < 16; ++j) { const unsigned c = xb_ld(&bar[XB_XCNT(j)]); sum += c; cnt += (c > 0u) ? 1u : 0u; mine = (j == x) ? c : mine; }
        if (sum == G) break;
        __builtin_amdgcn_s_sleep(1);
        if ((++sp & 255u) == 0u) { if (xb_ld(&bar[XB_TMO])) break; if (sp > XB_SPIN_CAP) { atomicAdd(&bar[XB_TMO], 1u); break; } }
    }
    nloc = mine > 0u ? mine : 1u; nx = cnt > 0u ? cnt : 1u;
}

__device__ __forceinline__ void xcd_barrier(const XcdBarrier& b) {
    asm volatile("s_waitcnt vmcnt(0)" ::: "memory");
    __syncthreads();
    if (threadIdx.x == 0) {
        unsigned* bar = b.bar;
        __builtin_amdgcn_s_waitcnt(0);
        unsigned nloc = b.st[0], nx = b.st[1];
        if (nloc == 0u) { xcd_barrier_complete(bar, b.x, nloc, nx); b.st[0] = nloc; b.st[1] = nx; }
        const unsigned old = xb_add(&bar[XB_XSUB(b.x)], 1u);
        const unsigned gen = old / nloc;
        if (old + 1u == (gen + 1u) * nloc) {
            __builtin_amdgcn_fence(__ATOMIC_RELEASE, "agent");
            asm volatile("s_waitcnt vmcnt(0)" ::: "memory");
            const unsigned og = xb_add(&bar[XB_TOP], 1u);
            const unsigned tg = og / nx;
            if (og + 1u == (tg + 1u) * nx) xb_add(&bar[XB_TOPGEN], 1u);
            else XB_SPIN(xb_ld(&bar[XB_TOPGEN]) == tg, bar);
            __builtin_amdgcn_fence(__ATOMIC_ACQUIRE, "agent");
            xb_add(&bar[XB_XGEN(b.x)], 1u);
            asm volatile("s_waitcnt vmcnt(0)" ::: "memory");
        } else {
            XB_SPIN(xb_ld(&bar[XB_XGEN(b.x)]) == gen, bar);
            __builtin_amdgcn_fence(__ATOMIC_ACQUIRE, "agent");
            asm volatile("s_waitcnt vmcnt(0)" ::: "memory");
        }
    }
    __syncthreads();
}

struct Frame {
    LAS unsigned char* lds;
    volatile LAS unsigned* MISC;
    unsigned* ctl;
    int tid, lane, wave, vcu, G;
    float* out; unsigned char* ws;
};
__device__ __forceinline__ const float* inp(const Frame& F, int i) {
    const volatile LAS unsigned* t = (const volatile LAS unsigned*)(F.lds + LDSCTL_OFF + 64) + 2 * i;
    const unsigned lo = __builtin_amdgcn_readfirstlane(t[0]), hi = __builtin_amdgcn_readfirstlane(t[1]);
    return (const float*)(((unsigned long long)hi << 32) | lo);
}
enum { I_X = 0, I_C, I_CTX, I_CCTX, I_WMOD, I_BMOD, I_WIN, I_GQA, I_GKA, I_GQB, I_GKB, I_RPB, I_CONVW, I_CONVB, I_GOUT, I_WOUT, I_F1, I_F3, I_F2, I_ROUTER, I_ROUTERB, I_M1, I_M3, I_M2 };

__device__ __forceinline__ void p0_transpose_item(const float* W, int K, int N, bf16* WT, int row_off, int il, int half, LAS float* scr, int item, int lane) {
    const int nblk = N / 32, kb = item / nblk, nb = item % nblk, k0 = 64 * kb, n0 = 32 * nb;
#pragma unroll 8
    for (int i = 0; i < 32; ++i) { const int kk = 2 * i + (lane >> 5); scr[kk * 33 + (lane & 31)] = W[(size_t)(k0 + kk) * N + n0 + (lane & 31)]; }
    LDS_WAIT(); asm volatile("" ::: "memory");
    const int c = lane & 7;
    const int orow0 = il ? ((n0 >> 7) * 256 + half * 128 + (n0 & 127)) : (row_off + n0);
#pragma unroll
    for (int j = 0; j < 4; ++j) { const int n = (lane >> 3) + 8 * j; const LAS float* s = scr + (8 * c) * 33 + n;
        v4u o; o.x = pk2(s[0 * 33], s[1 * 33]); o.y = pk2(s[2 * 33], s[3 * 33]); o.z = pk2(s[4 * 33], s[5 * 33]); o.w = pk2(s[6 * 33], s[7 * 33]);
        *(GAS v4u*)(WT + (size_t)(orow0 + n) * K + k0 + 8 * c) = o; }
    LDS_WAIT(); asm volatile("" ::: "memory");
}
__device__ __forceinline__ float silu_f(float v) { return v / (1.0f + __expf(-v)); }

__device__ __forceinline__ void p0_prologue(Frame& F) {
    const int gw = F.vcu * NWAVES + F.wave, NGW = F.G * NWAVES;
    if (blockIdx.x == 0) {
        float* tab = (float*)(F.ws + WS_MISC + MS_ROPE);
        for (int idx = F.tid; idx < 1024; idx += NWAVES * 64) { const int pos = idx >> 4, i = idx & 15;
            const float inv = powf(10000.0f, -(float)(2 * i) / 32.0f); const float ang = (float)pos * inv;
            tab[2 * idx] = cosf(ang); tab[2 * idx + 1] = sinf(ang); }
    }
    {
        LAS float* sv = (LAS float*)F.lds;
        LAS float* red = (LAS float*)(F.lds + 17 * 1024 * 4);
        bool staged = false;
        for (int task = blockIdx.x; task < 192; task += F.G) {
            if (!staged) {
                for (int idx = F.tid; idx < 17 * 1024; idx += NWAVES * 64) { const int r = idx >> 10, k = idx & 1023; const float v = r < 16 ? inp(F, I_C)[r * 1024 + k] : inp(F, I_CCTX)[k]; sv[idx] = silu_f(v); }
                staged = true; __syncthreads();
            }
            const int l = task / 96, cb = task % 96, col = cb * 64 + F.lane;
            const float* W = inp(F, I_WMOD) + (size_t)l * 1024 * 6144 + col;
            float acc[17];
#pragma unroll
            for (int r = 0; r < 17; ++r) acc[r] = 0.f;
            const int kbeg = F.wave * 128;
#pragma unroll 4
            for (int k = kbeg; k < kbeg + 128; ++k) { const float wv = W[(size_t)k * 6144];
#pragma unroll
                for (int r = 0; r < 17; ++r) acc[r] += sv[r * 1024 + k] * wv; }
#pragma unroll
            for (int r = 0; r < 17; ++r) red[(F.wave * 17 + r) * 64 + F.lane] = acc[r];
            __syncthreads();
            for (int idx = F.tid; idx < 17 * 64; idx += NWAVES * 64) { const int r = idx >> 6, ln = idx & 63; float s = 0.f;
#pragma unroll
                for (int w = 0; w < 8; ++w) s += red[(w * 17 + r) * 64 + ln];
                const int n = cb * 64 + ln;
                ((float*)(F.ws + WS_MOD))[((size_t)l * 17 + r) * 6144 + n] = s + inp(F, I_BMOD)[l * 6144 + n]; }
            __syncthreads();
        }
        __syncthreads();
    }
    {
        LAS float* scr = (LAS float*)(F.lds + F.wave * 16384);
        constexpr int IT_IN = 16 * 72, IT_OUT = 16 * 32, IT_F = 1408;
        constexpr int NITEMS = 2 * IT_IN + 2 * IT_OUT + 3 * IT_F + 24 * IT_F;
        for (int it = gw; it < NITEMS; it += NGW) {
            int r = it;
            if (r < 2 * IT_IN) { const int l = r / IT_IN; p0_transpose_item(inp(F, I_WIN) + (size_t)l * 1024 * INW, 1024, INW, (bf16*)(F.ws + WS_WIN) + (size_t)l * INW * 1024, 0, 0, 0, scr, r % IT_IN, F.lane); continue; } r -= 2 * IT_IN;
            if (r < 2 * IT_OUT) { const int l = r / IT_OUT; p0_transpose_item(inp(F, I_WOUT) + (size_t)l * 1024 * 1024, 1024, 1024, (bf16*)(F.ws + WS_WOUT) + (size_t)l * 1024 * 1024, 0, 0, 0, scr, r % IT_OUT, F.lane); continue; } r -= 2 * IT_OUT;
            if (r < IT_F) { p0_transpose_item(inp(F, I_F1), 1024, DFF, (bf16*)(F.ws + WS_F13), 0, 1, 0, scr, r, F.lane); continue; } r -= IT_F;
            if (r < IT_F) { p0_transpose_item(inp(F, I_F3), 1024, DFF, (bf16*)(F.ws + WS_F13), 0, 1, 1, scr, r, F.lane); continue; } r -= IT_F;
            if (r < IT_F) { p0_transpose_item(inp(F, I_F2), DFF, 1024, (bf16*)(F.ws + WS_F2), 0, 0, 0, scr, r, F.lane); continue; } r -= IT_F;
            { const int e = r / (3 * IT_F), q = r % (3 * IT_F), which = q / IT_F, item = q % IT_F;
              if (which == 0) p0_transpose_item(inp(F, I_M1) + (size_t)e * 1024 * DFF, 1024, DFF, (bf16*)(F.ws + WS_M13) + (size_t)e * 5632 * 1024, 0, 1, 0, scr, item, F.lane);
              else if (which == 1) p0_transpose_item(inp(F, I_M3) + (size_t)e * 1024 * DFF, 1024, DFF, (bf16*)(F.ws + WS_M13) + (size_t)e * 5632 * 1024, 0, 1, 1, scr, item, F.lane);
              else p0_transpose_item(inp(F, I_M2) + (size_t)e * DFF * 1024, DFF, 1024, (bf16*)(F.ws + WS_M2) + (size_t)e * 1024 * DFF, 0, 0, 0, scr, item, F.lane); }
        }
    }
}

__device__ __forceinline__ const float* xrow_ptr(const float* lat, const float* ctx, int s) { const int b = s / TPB, j = s % TPB; return j < SEQ ? lat + (size_t)(b * SEQ + j) * DM : ctx + (size_t)(b * CTXL + j - SEQ) * DM; }

__device__ __forceinline__ void norm_mod_rows(Frame& F, const float* lat, const float* ctx, const float* mod, int shoff, int scoff, bf16* XN, bool with_ctx) {
    const int gw = F.vcu * NWAVES + F.wave, NGW = F.G * NWAVES;
    for (int s = gw; s < MROWS; s += NGW) {
        const int b = s / TPB, j = s % TPB; if (!with_ctx && j >= SEQ) continue;
        const GAS f32x4* xr = (const GAS f32x4*)xrow_ptr(lat, ctx, s) + F.lane;
        const float* mrow = mod + (size_t)(j < SEQ ? b : 16) * 6144;
        f32x4 v[4]; float ss = 0.f;
#pragma unroll
        for (int q = 0; q < 4; ++q) { v[q] = xr[64 * q]; ss += (v[q].x * v[q].x + v[q].y * v[q].y) + (v[q].z * v[q].z + v[q].w * v[q].w); }
        const float rstd = 1.0f / sqrtf(wave_sum(ss) * (1.0f / DM) + NORM_EPS);
        GAS v2u* o8 = (GAS v2u*)(XN + (size_t)s * DM) + F.lane;
#pragma unroll
        for (int q = 0; q < 4; ++q) { const f32x4 sh = *(const f32x4*)(mrow + shoff + 4 * F.lane + 256 * q), sc = *(const f32x4*)(mrow + scoff + 4 * F.lane + 256 * q);
            const f32x4 y = v[q] * rstd * (sc + 1.0f) + sh; v2u w; w.x = pk2(y.x, y.y); w.y = pk2(y.z, y.w); o8[64 * q] = w; }
    }
}

__device__ __forceinline__ void headnorm_rows(Frame& F, int l, bool ctx_q) {
    const int gw = F.vcu * NWAVES + F.wave, NGW = F.G * NWAVES; bf16* P = (bf16*)(F.ws + WS_P);
    const float* tab = (const float*)(F.ws + WS_MISC + MS_ROPE);
    const int d = F.lane;
    const float gqa = inp(F, I_GQA)[l * 64 + d], gka = inp(F, I_GKA)[l * 64 + d], gqb = inp(F, I_GQB)[l * 64 + d], gkb = inp(F, I_GKB)[l * 64 + d];
    for (int s = gw; s < MROWS; s += NGW) {
        const int j = s % TPB; const bool lat = j < SEQ; bf16* p = P + (size_t)s * INW;
        float cs = 1.f, sn = 0.f;
        if (lat) { const int pos = (d < 32) ? (j >> 6) : (j & 63); const int i = d & 15; cs = tab[2 * (pos * 16 + i)]; sn = tab[2 * (pos * 16 + i) + 1]; }
        const float sgn = (d & 16) ? 1.f : -1.f;
#pragma unroll 1
        for (int h = 0; h < 18; ++h) {
            int off; float g; bool rope, isq;
            if (h < 8) { off = QA_OFF + 64 * h; g = gqa; rope = true; isq = true; }
            else if (h < 12) { off = QB_OFF + 64 * (h - 8); g = gqb; rope = false; isq = true; }
            else if (h < 14) { off = KA_OFF + 64 * (h - 12); g = gka; rope = true; isq = false; }
            else { off = KB_OFF + 64 * (h - 14); g = gkb; rope = false; isq = false; }
            if (isq && !lat && !ctx_q) continue;
            const float v = bf1(p[off + d]);
            const float ss = wave_sum(v * v);
            float y = v * (1.0f / sqrtf(ss * (1.0f / 64.0f) + NORM_EPS)) * g;
            const float pr = __shfl_xor(y, 16);
            if (rope && lat) y = y * cs + sgn * pr * sn;
            if (isq) y *= C2;
            p[off + d] = (bf16)f2bf(y);
        }
    }
}

#ifdef ATTN_NAIVE
struct NaiveState { float q[64], o[64], m, l; };
__device__ __forceinline__ void na_load_q(NaiveState& S, const bf16* qp) {
#pragma unroll
    for (int c = 0; c < 8; ++c) { const v4u w = *(const v4u*)(qp + 8 * c);
        S.q[8 * c + 0] = bflo(w.x); S.q[8 * c + 1] = bfhi(w.x); S.q[8 * c + 2] = bflo(w.y); S.q[8 * c + 3] = bfhi(w.y);
        S.q[8 * c + 4] = bflo(w.z); S.q[8 * c + 5] = bfhi(w.z); S.q[8 * c + 6] = bflo(w.w); S.q[8 * c + 7] = bfhi(w.w); }
#pragma unroll
    for (int i = 0; i < 64; ++i) S.o[i] = 0.f;
    S.m = -1e30f; S.l = 0.f;
}
__device__ __forceinline__ float na_dot(const NaiveState& S, const bf16* kp) {
    float s = 0.f;
#pragma unroll
    for (int c = 0; c < 8; ++c) { const v4u w = *(const v4u*)(kp + 8 * c);
        s += S.q[8 * c + 0] * bflo(w.x) + S.q[8 * c + 1] * bfhi(w.x) + S.q[8 * c + 2] * bflo(w.y) + S.q[8 * c + 3] * bfhi(w.y)
           + S.q[8 * c + 4] * bflo(w.z) + S.q[8 * c + 5] * bfhi(w.z) + S.q[8 * c + 6] * bflo(w.w) + S.q[8 * c + 7] * bfhi(w.w); }
    return s;
}
__device__ __forceinline__ void na_acc(NaiveState& S, float p, const bf16* vp) {
#pragma unroll
    for (int c = 0; c < 8; ++c) { const v4u w = *(const v4u*)(vp + 8 * c);
        S.o[8 * c + 0] += p * bflo(w.x); S.o[8 * c + 1] += p * bfhi(w.x); S.o[8 * c + 2] += p * bflo(w.y); S.o[8 * c + 3] += p * bfhi(w.y);
        S.o[8 * c + 4] += p * bflo(w.z); S.o[8 * c + 5] += p * bfhi(w.z); S.o[8 * c + 6] += p * bflo(w.w); S.o[8 * c + 7] += p * bfhi(w.w); }
}
__device__ __forceinline__ void na_step2(NaiveState& S, float s0, float s1, const bf16* v0, const bf16* v1) {
    const float mn = fmaxf(S.m, fmaxf(s0, s1));
    const float sc = __builtin_amdgcn_exp2f(S.m - mn), p0 = __builtin_amdgcn_exp2f(s0 - mn), p1 = __builtin_amdgcn_exp2f(s1 - mn);
    S.l = S.l * sc + p0 + p1; S.m = mn;
#pragma unroll
    for (int i = 0; i < 64; ++i) S.o[i] *= sc;
    na_acc(S, p0, v0); na_acc(S, p1, v1);
}
__device__ __forceinline__ void na_store(const NaiveState& S, bf16* op) {
    const float inv = 1.0f / S.l;
#pragma unroll
    for (int c = 0; c < 8; ++c) { v4u w; w.x = pk2(S.o[8 * c + 0] * inv, S.o[8 * c + 1] * inv); w.y = pk2(S.o[8 * c + 2] * inv, S.o[8 * c + 3] * inv);
        w.z = pk2(S.o[8 * c + 4] * inv, S.o[8 * c + 5] * inv); w.w = pk2(S.o[8 * c + 6] * inv, S.o[8 * c + 7] * inv); *(v4u*)(op + 8 * c) = w; }
}
__device__ __forceinline__ void attn_naive_phase(Frame& F, int l, bool with_ctx) {
    const int gw = F.vcu * NWAVES + F.wave, NGW = F.G * NWAVES; bf16* P = (bf16*)(F.ws + WS_P);
    const float* rpb = inp(F, I_RPB) + (size_t)l * 4 * 15 * 31;
    const int ntask = with_ctx ? 6912 : 6144;
    for (int task = gw; task < ntask; task += NGW) {
        NaiveState S;
        if (task < 4096 || (task >= 6144 && task < 6656)) {
            int b, qh, j0, k0, k1;
            if (task < 4096) { b = task >> 8; qh = (task >> 5) & 7; j0 = (task & 31) * 64; k0 = 0; k1 = TPB; }
            else { const int t = task - 6144; b = t >> 5; qh = (t >> 2) & 7; j0 = SEQ + (t & 3) * 64; k0 = SEQ; k1 = TPB; }
            bf16* qp = P + (size_t)(b * TPB + j0 + F.lane) * INW + QA_OFF + qh * 64;
            na_load_q(S, qp);
            const bf16* Kb = P + (size_t)(b * TPB) * INW + KA_OFF + (qh >> 2) * 64; const bf16* Vb = P + (size_t)(b * TPB) * INW + VA_OFF + (qh >> 2) * 64;
            for (int k = k0; k < k1; k += 2) { const float s0 = na_dot(S, Kb + (size_t)k * INW), s1 = na_dot(S, Kb + (size_t)(k + 1) * INW); na_step2(S, s0, s1, Vb + (size_t)k * INW, Vb + (size_t)(k + 1) * INW); }
            na_store(S, qp);
        } else {
            int b, h, j; bool lat;
            if (task < 6144) { const int t = task - 4096; b = t >> 7; h = (t >> 5) & 3; j = (t & 31) * 64 + F.lane; lat = true; }
            else { const int t = task - 6656; b = t >> 4; h = (t >> 2) & 3; j = SEQ + (t & 3) * 64 + F.lane; lat = false; }
            bf16* qp = P + (size_t)(b * TPB + j) * INW + QB_OFF + h * 64;
            na_load_q(S, qp);
            const bf16* Kb = P + (size_t)(b * TPB) * INW + KB_OFF + h * 64; const bf16* Vb = P + (size_t)(b * TPB) * INW + VB_OFF + h * 64;
            if (lat) {
                const int r = j >> 6, c = j & 63; int rs = r - 4; rs = rs < 0 ? 0 : (rs > 24 ? 24 : rs); int cs = c - 8; cs = cs < 0 ? 0 : (cs > 48 ? 48 : cs);
                for (int i = 0; i < 8; ++i) { const int kr = rs + i; const float* brow = rpb + (h * 15 + (kr - r + 7)) * 31 + (15 - c);
                    for (int jc = 0; jc < 16; jc += 2) { const int kc = cs + jc; const int k = kr * 64 + kc;
                        const float s0 = na_dot(S, Kb + (size_t)k * INW) + brow[kc] * LOG2E, s1 = na_dot(S, Kb + (size_t)(k + 1) * INW) + brow[kc + 1] * LOG2E;
                        na_step2(S, s0, s1, Vb + (size_t)k * INW, Vb + (size_t)(k + 1) * INW); } }
            }
            for (int k = SEQ; k < TPB; k += 2) { const float s0 = na_dot(S, Kb + (size_t)k * INW), s1 = na_dot(S, Kb + (size_t)(k + 1) * INW); na_step2(S, s0, s1, Vb + (size_t)k * INW, Vb + (size_t)(k + 1) * INW); }
            na_store(S, qp);
        }
    }
}


#endif
__device__ __forceinline__ void attn_mfma_phase(Frame& F, int l, bool with_ctx, char* ldsg) {
    typedef attn_body::bf16 abf;
    abf* P = (abf*)(F.ws + WS_P); const int v = F.vcu;
    const int NA = 1024 + (with_ctx ? 192 : 0);
#pragma unroll 1
    for (int u = v; u < NA; u += F.G) {
        int b, qcol, kcol, vcol, qrow, NT, first0;
        if (u < 1024) { b = u >> 6; const int kvh = (u >> 5) & 1, qh = kvh * 4 + ((u >> 3) & 3); qrow = (u & 7) * 256; qcol = QA_OFF + qh * 64; kcol = KA_OFF + kvh * 64; vcol = VA_OFF + kvh * 64; NT = 36; first0 = 0; }
        else if (u < 1024 + 128) { const int t = u - 1024; b = t >> 3; const int qh = t & 7; qrow = SEQ; qcol = QA_OFF + qh * 64; kcol = KA_OFF + (qh >> 2) * 64; vcol = VA_OFF + (qh >> 2) * 64; NT = 4; first0 = 32; }
        else { const int t = u - 1152; b = t >> 2; const int h = t & 3; qrow = SEQ; qcol = QB_OFF + h * 64; kcol = KB_OFF + h * 64; vcol = VB_OFF + h * 64; NT = 4; first0 = 32; }
        abf* Qu = P + (size_t)(b * TPB + qrow) * INW + qcol; const abf* Kh = P + (size_t)(b * TPB) * INW + kcol; const abf* Vh = P + (size_t)(b * TPB) * INW + vcol;
        attn_body::attn_unit<8, false>(Qu, Kh, Vh, Qu, NT, NT, first0, 0, 0, nullptr, ldsg, F.wave);
    }
#ifndef NO_BSITE
    const float* rpbl = inp(F, I_RPB) + (size_t)l * 4 * 15 * 31;
#pragma unroll 1
    for (int u = v; u < 512; u += F.G) {
        const int b = u >> 5, h = (u >> 3) & 3, qb = u & 7, qg = 4 * qb;
        const int n0 = (qb == 0 || qb == 7) ? 8 : 12, s0 = qb == 0 ? 0 : (qb == 7 ? 24 : qg - 4);
        abf* Qu = P + (size_t)(b * TPB + qb * 256) * INW + QB_OFF + h * 64; const abf* Kh = P + (size_t)(b * TPB) * INW + KB_OFF + h * 64; const abf* Vh = P + (size_t)(b * TPB) * INW + VB_OFF + h * 64;
        attn_body::attn_unit<8, true>(Qu, Kh, Vh, Qu, 4 + n0, 4, 32, s0, qg, rpbl + h * 15 * 31, ldsg, F.wave);
    }
#endif
}

__device__ __forceinline__ void unpack8(const v4u w, float (&v)[8]) { v[0] = bflo(w.x); v[1] = bfhi(w.x); v[2] = bflo(w.y); v[3] = bfhi(w.y); v[4] = bflo(w.z); v[5] = bfhi(w.z); v[6] = bflo(w.w); v[7] = bfhi(w.w); }
__device__ __forceinline__ void merge_rows(Frame& F, int l, bool with_ctx) {
    const int gw = F.vcu * NWAVES + F.wave, NGW = F.G * NWAVES; const bf16* P = (const bf16*)(F.ws + WS_P); bf16* CAT = (bf16*)(F.ws + WS_XN);
    const float* gout = inp(F, I_GOUT) + l * 1024; const float* cw = inp(F, I_CONVW) + l * 3 * 256; const float* cb = inp(F, I_CONVB) + l * 256;
    const int lane = F.lane;
    for (int s = gw; s < MROWS; s += NGW) {
        const int j = s % TPB; const bool lat = j < SEQ; if (!with_ctx && !lat) continue;
        const bf16* p = P + (size_t)s * INW;
        float va[8], vb[8];
        unpack8(*(const v4u*)(p + 8 * lane), va);
        if (lane < 32) unpack8(*(const v4u*)(p + 512 + 8 * lane), vb);
        else {
            const int ch0 = 8 * (lane - 32); const int jlo = lat ? 0 : SEQ, jhi = lat ? SEQ : TPB;
            float post[8], y[8];
            unpack8(*(const v4u*)(p + CPOST_OFF + ch0), post);
#pragma unroll
            for (int k = 0; k < 8; ++k) y[k] = cb[ch0 + k];
#pragma unroll
            for (int tap = 0; tap < 3; ++tap) { const int jj = j + tap - 1;
                if (jj >= jlo && jj < jhi) { const bf16* pp = p + (ptrdiff_t)(tap - 1) * INW; float a[8], c[8]; unpack8(*(const v4u*)(pp + CPRE_OFF + ch0), a); unpack8(*(const v4u*)(pp + CVAL_OFF + ch0), c);
#pragma unroll
                    for (int k = 0; k < 8; ++k) y[k] += cw[tap * 256 + ch0 + k] * (a[k] * c[k]); } }
#pragma unroll
            for (int k = 0; k < 8; ++k) vb[k] = post[k] * y[k];
        }
        float sa = 0.f, sb = 0.f;
#pragma unroll
        for (int k = 0; k < 8; ++k) { sa += va[k] * va[k]; sb += vb[k] * vb[k]; }
        const float ra = 1.0f / sqrtf(wave_sum(sa) * (1.0f / 512.0f) + NORM_EPS), rb = 1.0f / sqrtf(half_sum(sb) * (1.0f / 256.0f) + NORM_EPS);
        v4u oa, ob; float g[8];
#pragma unroll
        for (int k = 0; k < 8; ++k) g[k] = gout[8 * lane + k];
        oa.x = pk2(va[0] * ra * g[0], va[1] * ra * g[1]); oa.y = pk2(va[2] * ra * g[2], va[3] * ra * g[3]); oa.z = pk2(va[4] * ra * g[4], va[5] * ra * g[5]); oa.w = pk2(va[6] * ra * g[6], va[7] * ra * g[7]);
#pragma unroll
        for (int k = 0; k < 8; ++k) g[k] = gout[512 + 8 * lane + k];
        ob.x = pk2(vb[0] * rb * g[0], vb[1] * rb * g[1]); ob.y = pk2(vb[2] * rb * g[2], vb[3] * rb * g[3]); ob.z = pk2(vb[4] * rb * g[4], vb[5] * rb * g[5]); ob.w = pk2(vb[6] * rb * g[6], vb[7] * rb * g[7]);
        *(v4u*)(CAT + (size_t)s * DM + 8 * lane) = oa; *(v4u*)(CAT + (size_t)s * DM + 512 + 8 * lane) = ob;
    }
}

__device__ __forceinline__ void moe_route(Frame& F, const float* mod) {
    const float* X = F.out; bf16* XT = (bf16*)(F.ws + WS_XT);
    int* tok_e = (int*)(F.ws + WS_MISC + MS_TOKE); float* tok_g = (float*)(F.ws + WS_MISC + MS_TOKG);
    const float* wr = inp(F, I_ROUTER); const float* br = inp(F, I_ROUTERB);
    LAS int* le = (LAS int*)F.lds;
    for (int ch = blockIdx.x; ch < NTOK / 128; ch += F.G) {
        for (int i = 0; i < 16; ++i) {
            const int tl = F.wave * 16 + i, tok = ch * 128 + tl, b = tok / SEQ;
            const GAS f32x4* xr = (const GAS f32x4*)(X + (size_t)tok * DM) + F.lane; const float* mrow = mod + (size_t)b * 6144;
            f32x4 v[4]; float ss = 0.f;
#pragma unroll
            for (int q = 0; q < 4; ++q) { v[q] = xr[64 * q]; ss += (v[q].x * v[q].x + v[q].y * v[q].y) + (v[q].z * v[q].z + v[q].w * v[q].w); }
            const float rstd = 1.0f / sqrtf(wave_sum(ss) * (1.0f / DM) + NORM_EPS);
            float lg[8];
#pragma unroll
            for (int e = 0; e < 8; ++e) lg[e] = 0.f;
            GAS v2u* o8 = (GAS v2u*)(XT + (size_t)tok * DM) + F.lane;
#pragma unroll
            for (int q = 0; q < 4; ++q) { const int col = 4 * F.lane + 256 * q; const f32x4 sh = *(const f32x4*)(mrow + 3072 + col), sc = *(const f32x4*)(mrow + 4096 + col);
                const f32x4 y = v[q] * rstd * (sc + 1.0f) + sh; v2u w; w.x = pk2(y.x, y.y); w.y = pk2(y.z, y.w); o8[64 * q] = w;
#pragma unroll
                for (int k = 0; k < 4; ++k) { const f32x4 w0 = *(const f32x4*)(wr + (size_t)(col + k) * 8), w1 = *(const f32x4*)(wr + (size_t)(col + k) * 8 + 4); const float yk = y[k];
                    lg[0] += yk * w0.x; lg[1] += yk * w0.y; lg[2] += yk * w0.z; lg[3] += yk * w0.w; lg[4] += yk * w1.x; lg[5] += yk * w1.y; lg[6] += yk * w1.z; lg[7] += yk * w1.w; } }
#pragma unroll
            for (int e = 0; e < 8; ++e) lg[e] = wave_sum(lg[e]) + br[e];
            int e0 = 0; float v0 = lg[0];
#pragma unroll
            for (int e = 1; e < 8; ++e) if (lg[e] > v0) { v0 = lg[e]; e0 = e; }
            int e1 = -1; float v1 = -3.0e38f;
#pragma unroll
            for (int e = 0; e < 8; ++e) if (e != e0 && lg[e] > v1) { v1 = lg[e]; e1 = e; }
            const float p1 = __expf(v1 - v0), g0 = 1.0f / (1.0f + p1), g1 = p1 / (1.0f + p1);
            if (F.lane == 0) { tok_e[2 * tok] = e0; tok_e[2 * tok + 1] = e1; tok_g[2 * tok] = g0; tok_g[2 * tok + 1] = g1; le[2 * tl] = e0; le[2 * tl + 1] = e1; }
        }
        __syncthreads();
        if (F.tid < 8) { int n = 0; for (int a = 0; a < 256; ++a) n += (le[a] == F.tid) ? 1 : 0; F.ctl[CW_CNT + ch * 8 + F.tid] = (unsigned)n; }
        __syncthreads();
    }
}
__device__ __forceinline__ void moe_sort_scatter(Frame& F) {
    const bf16* XT = (const bf16*)(F.ws + WS_XT); bf16* XS = (bf16*)(F.ws + WS_XN);
    const int* tok_e = (const int*)(F.ws + WS_MISC + MS_TOKE); const float* tok_g = (const float*)(F.ws + WS_MISC + MS_TOKG);
    int* tok_s = (int*)(F.ws + WS_MISC + MS_TOKS); float* slot_g = (float*)(F.ws + WS_MISC + MS_SLOTG); int* meta = (int*)(F.ws + WS_MISC + MS_META);
    LAS int* ltot = (LAS int*)F.lds; LAS int* lpre = ltot + 8; LAS int* lslot = ltot + 16; LAS int* lex = ltot + 16 + 256;
    for (int ch = blockIdx.x; ch < NTOK / 128; ch += F.G) {
        if (F.tid < 8) { int tot = 0, pre = 0; for (int c2 = 0; c2 < NTOK / 128; ++c2) { const int n = (int)F.ctl[CW_CNT + c2 * 8 + F.tid]; tot += n; pre += (c2 < ch) ? n : 0; } ltot[F.tid] = tot; lpre[F.tid] = pre; }
        if (F.tid < 256) lex[F.tid] = tok_e[2 * (ch * 128) + F.tid];
        __syncthreads();
        int pstart[9]; pstart[0] = 0;
#pragma unroll
        for (int e = 0; e < 8; ++e) pstart[e + 1] = pstart[e] + ((ltot[e] + 255) & ~255);
        if (F.tid < 8) { int base = 0;
#pragma unroll
            for (int e = 0; e < 8; ++e) if (e == F.tid) base = pstart[e] + lpre[e];
            for (int a = 0; a < 256; ++a) { if (lex[a] == F.tid) { lslot[a] = base; ++base; } } }
        __syncthreads();
        if (F.tid < 256) { const int slot = lslot[F.tid]; tok_s[2 * (ch * 128) + F.tid] = slot; slot_g[slot] = tok_g[2 * (ch * 128) + F.tid]; }
        for (int a = F.wave; a < 256; a += NWAVES) { const int tok = ch * 128 + (a >> 1), slot = lslot[a];
            const GAS v4u* src = (const GAS v4u*)(XT + (size_t)tok * DM) + F.lane; GAS v4u* dst = (GAS v4u*)(XS + (size_t)slot * DM) + F.lane;
            dst[0] = src[0]; dst[64] = src[64]; }
        if (ch < 8) {
            int p0 = 0, p1 = 0;
#pragma unroll
            for (int e = 0; e < 8; ++e) if (e == ch) { p0 = pstart[e] + ltot[e]; p1 = pstart[e + 1]; }
            for (int r = p0 + F.wave; r < p1; r += NWAVES) { GAS v4u* dst = (GAS v4u*)(XS + (size_t)r * DM) + F.lane; dst[0] = (v4u){0u, 0u, 0u, 0u}; dst[64] = (v4u){0u, 0u, 0u, 0u}; if (F.lane == 0) slot_g[r] = 0.f; }
        }
        if (ch == 0 && F.tid == 0) {
#pragma unroll
            for (int e = 0; e < 8; ++e) meta[e] = pstart[e + 1] >> 8;
        }
        __syncthreads();
    }
}
__device__ __forceinline__ void moe_combine(Frame& F, const float* mod) {
    const int gw = F.vcu * NWAVES + F.wave, NGW = F.G * NWAVES; const bf16* Y = (const bf16*)(F.ws + WS_XN); const int* tok_s = (const int*)(F.ws + WS_MISC + MS_TOKS);
    for (int tok = gw; tok < NTOK; tok += NGW) {
        const int b = tok / SEQ, s0 = tok_s[2 * tok], s1 = tok_s[2 * tok + 1];
        GAS f32x4* xr = (GAS f32x4*)(F.out + (size_t)tok * DM) + F.lane; const float* g = mod + (size_t)b * 6144 + 5120;
        const GAS v2u* y0 = (const GAS v2u*)(Y + (size_t)s0 * DM) + F.lane; const GAS v2u* y1 = (const GAS v2u*)(Y + (size_t)s1 * DM) + F.lane;
#pragma unroll
        for (int q = 0; q < 4; ++q) { const f32x4 x = xr[64 * q]; const f32x4 gv = *(const f32x4*)(g + 4 * F.lane + 256 * q); const v2u a = y0[64 * q], c = y1[64 * q];
            f32x4 y; y.x = bflo(a.x) + bflo(c.x); y.y = bfhi(a.x) + bfhi(c.x); y.z = bflo(a.y) + bflo(c.y); y.w = bfhi(a.y) + bfhi(c.y);
            xr[64 * q] = x + gv * y; }
    }
}

struct Args { const float* in[24]; float* out; unsigned char* ws; int ph_lo, ph_hi, li, pad; };
__global__ void __launch_bounds__(NWAVES * 64, 2) mk_fwd(Args args) {
    extern __shared__ __attribute__((aligned(16))) unsigned char lds[];
    Frame F;
    F.lds = (LAS unsigned char*)lds; F.MISC = (volatile LAS unsigned*)(F.lds + MISC_OFF);
    F.tid = threadIdx.x; F.lane = F.tid & 63; F.wave = __builtin_amdgcn_readfirstlane(F.tid >> 6);
    F.G = gridDim.x; { const int bx = blockIdx.x; F.vcu = (F.G % 8 == 0) ? (bx % 8) * (F.G / 8) + bx / 8 : bx; }
    F.out = args.out; F.ws = args.ws; F.ctl = (unsigned*)(args.ws + WS_CTL);
    for (int u = F.tid; u < (LDS_BYTES - LDSCTL_OFF) / 4; u += NWAVES * 64) ((LAS unsigned*)(F.lds + LDSCTL_OFF))[u] = 0u;
    __syncthreads();
    if (F.tid < 24) { const unsigned long long p = (unsigned long long)args.in[F.tid]; LAS unsigned* t = (LAS unsigned*)(F.lds + LDSCTL_OFF + 64) + 2 * F.tid; t[0] = (unsigned)p; t[1] = (unsigned)(p >> 32); }
    __syncthreads();
    XcdBarrier bar; bar.bar = F.ctl + CW_BAR; bar.x = 0; bar.st = nullptr;
    if (MK_N_LAUNCHES == 1) bar = xcd_barrier_post(F.ctl + CW_BAR, F.MISC + 8);
    const int lo = args.ph_lo, hi = args.ph_hi;
#ifndef PHMASK
#define PHMASK 0xFFFFFFFFu
#endif
#define PHON(k) (((PHMASK) >> (k)) & 1u)
#define IN(k) (PHON(k) && lo <= (k) && (k) < hi)
#define INL(x) ((((PHMASK) >> (1 + (x))) & 1u) && lo <= pb + (x) && pb + (x) < hi)
#define INR(k) (lo <= (k) && (k) < hi)
#define SEAM(k) do { if (INR(k) && INR((k) + 1)) xcd_barrier(bar); } while (0)
    float* XC = (float*)(F.ws + WS_XC); bf16* XN = (bf16*)(F.ws + WS_XN); bf16* P = (bf16*)(F.ws + WS_P);
    const float* MOD = (const float*)(F.ws + WS_MOD);
#define TABMEM (F.lds + LDSCTL_OFF + 448)
#define PF() do { int ln_ = (int)__builtin_amdgcn_mbcnt_hi(~0u, __builtin_amdgcn_mbcnt_lo(~0u, 0u)); asm volatile("" : "+v"(ln_)); F.lane = ln_; F.tid = F.wave * 64 + ln_; } while (0)

    if (IN(0)) { PF(); p0_prologue(F); } SEAM(0);

#pragma unroll 1
    for (int l = 0; l < 2; ++l) {
        const int pb = 1 + 9 * l; const bool last = (l == 1);
        const float* mod = MOD + (size_t)l * 17 * 6144;
        const float* xlat = last ? F.out : inp(F, I_X); const float* xctx = last ? XC : inp(F, I_CTX);
        if (INL(0)) { PF(); norm_mod_rows(F, xlat, xctx, mod, 0, 1024, XN, true); } SEAM(pb + 0);
        if (INL(1)) { PF();
            pg8::Gemm g{XN, (const bf16*)(F.ws + WS_WIN) + (size_t)l * INW * 1024, MROWS, INW, 1024};
            const pg8::TabOrder T = last ? pg8::build_units(TABMEM, 1024, XN, g.Bt, F.G, (int)blockIdx.x, 128, 9, 0, 1, 0, 16, 3, 6, 2, nullptr, 0, F.tid)
                                         : pg8::build_units(TABMEM, 1024, XN, g.Bt, F.G, (int)blockIdx.x, NPAN, 9, 0, 0, 0, 0, 1, 0, 0, nullptr, 0, F.tid);
#ifdef SEPARATE_HN
            pg8::EpiRawBf16 E{P, INW};
            pg8::gemm_phase<pg8::EpiRawBf16, pg8::TabOrder, true, true>(F.lds, g, T, E, F.wave);
#else
            pg8::EpiHeads E{P, inp(F, I_GQA) + l * 64, inp(F, I_GKA) + l * 64, inp(F, I_GQB) + l * 64, inp(F, I_GKB) + l * 64, (const float*)(F.ws + WS_MISC + MS_ROPE)};
            pg8::gemm_phase<pg8::EpiHeads, pg8::TabOrder, true, true>(F.lds, g, T, E, F.wave);
#endif
        } SEAM(pb + 1);
#ifdef SEPARATE_HN
        if (INL(2)) { PF(); headnorm_rows(F, l, !last); } SEAM(pb + 2);
#endif
        #ifdef ATTN_NAIVE
        if (INL(3)) { PF(); attn_naive_phase(F, l, !last); } SEAM(pb + 3);
#else
        if (INL(3)) { PF(); attn_mfma_phase(F, l, !last, (char*)lds); } SEAM(pb + 3);
#endif
        if (INL(4)) { PF(); merge_rows(F, l, !last); } SEAM(pb + 4);
        if (INL(5)) { PF();
            pg8::Gemm g{XN, (const bf16*)(F.ws + WS_WOUT) + (size_t)l * 1024 * 1024, MROWS, 1024, 1024};
            const pg8::TabOrder T = pg8::build_units(TABMEM, 1024, XN, g.Bt, F.G, (int)blockIdx.x, last ? 128 : NPAN, 4, 0, last ? 1 : 0, 0, 0, 1, 0, 0, nullptr, 0, F.tid);
            pg8::EpiGateRes E{xlat, xctx, F.out, XC, mod, 2048};
            pg8::gemm_phase<pg8::EpiGateRes, pg8::TabOrder, true, true>(F.lds, g, T, E, F.wave);
        } SEAM(pb + 5);
        if (!last) {
            if (IN(7)) { PF(); norm_mod_rows(F, F.out, XC, mod, 3072, 4096, XN, true); } SEAM(7);
            if (IN(8)) { PF();
                pg8::Gemm g{XN, (const bf16*)(F.ws + WS_F13), MROWS, 5632, 1024};
                const pg8::TabOrder T = pg8::build_units(TABMEM, 1024, XN, g.Bt, F.G, (int)blockIdx.x, NPAN, 22, 0, 0, 0, 0, 1, 0, 0, nullptr, 0, F.tid);
                pg8::EpiSwiglu E{P, DFF, 0};
                pg8::gemm_phase<pg8::EpiSwiglu, pg8::TabOrder, true, true>(F.lds, g, T, E, F.wave);
            } SEAM(8);
            if (IN(9)) { PF();
                pg8::Gemm g{P, (const bf16*)(F.ws + WS_F2), MROWS, 1024, DFF};
                const pg8::TabOrder T = pg8::build_units(TABMEM, DFF, P, g.Bt, F.G, (int)blockIdx.x, NPAN, 4, 0, 0, 0, 0, 1, 0, 0, nullptr, 0, F.tid);
                pg8::EpiGateRes E{F.out, XC, F.out, XC, mod, 5120};
                pg8::gemm_phase<pg8::EpiGateRes, pg8::TabOrder, true, true>(F.lds, g, T, E, F.wave);
            } SEAM(9);
        }
    }
    {
        const float* mod = MOD + (size_t)17 * 6144;
        if (IN(16)) { PF(); moe_route(F, mod); } SEAM(16);
        if (IN(17)) { PF(); moe_sort_scatter(F); } SEAM(17);
        const int* meta = (const int*)(F.ws + WS_MISC + MS_META);
        bf16* XS = XN; bf16* HM = (bf16*)(F.ws + WS_XT);
#pragma unroll 1
        for (int c = 0; c < 2; ++c) {
            if (IN(18 + 2 * c) || IN(19 + 2 * c)) {
                const int TP = __builtin_amdgcn_readfirstlane(meta[7]), h0 = (TP + 1) >> 1; const int p0 = c == 0 ? 0 : h0, p1 = c == 0 ? h0 : TP;
                if (IN(18 + 2 * c)) { PF();
                    pg8::Gemm g{XS, (const bf16*)(F.ws + WS_M13), 0, 5632, 1024};
                    const pg8::TabOrder T = pg8::build_units(TABMEM, 1024, XS, g.Bt, F.G, (int)blockIdx.x, p1 - p0, 22, 0, 0, p0, 0, 1, 0, 0, meta, (size_t)5632 * 1024 * 2, F.tid);
                    pg8::EpiSwiglu E{HM, DFF, p0};
                    pg8::gemm_phase<pg8::EpiSwiglu, pg8::TabOrder, true, true>(F.lds, g, T, E, F.wave);
                }
                SEAM(18 + 2 * c);
                if (IN(19 + 2 * c)) { PF();
                    pg8::Gemm g{HM, (const bf16*)(F.ws + WS_M2), 0, 1024, DFF};
                    const pg8::TabOrder T = pg8::build_units(TABMEM, DFF, (const char*)HM - (size_t)p0 * 256 * DFF * 2, g.Bt, F.G, (int)blockIdx.x, p1 - p0, 4, 0, 0, p0, 0, 1, 0, 0, meta, (size_t)1024 * DFF * 2, F.tid);
                    pg8::EpiMoeOut E{XS, (const float*)(F.ws + WS_MISC + MS_SLOTG)};
                    pg8::gemm_phase<pg8::EpiMoeOut, pg8::TabOrder, true, true>(F.lds, g, T, E, F.wave);
                }
            }
            SEAM(19 + 2 * c);
        }
        if (IN(22)) { PF(); moe_combine(F, mod); }
    }
#undef IN
#undef SEAM
}

extern "C" void kernel_launch(void* const* d_in, const int* in_sizes, int n_in, void* d_out, int out_size, void* d_ws, size_t ws_size, hipStream_t stream) {
    static int grid = 0;
    if (grid == 0) {
        if (n_in != 24 || in_sizes[0] != BATCH * SEQ * DM || out_size != BATCH * SEQ * DM || ws_size < WS_END) { fprintf(stderr, "kernel_launch: unexpected shapes / workspace (n_in %d, ws %zu, need %zu); nothing launched\n", n_in, ws_size, (size_t)WS_END); grid = -1; return; }
        int dev = 0, cus = 0, per_cu = 0;
        if (hipGetDevice(&dev) != hipSuccess || hipDeviceGetAttribute(&cus, hipDeviceAttributeMultiprocessorCount, dev) != hipSuccess) { grid = -1; return; }
        if (hipFuncSetAttribute((const void*)mk_fwd, hipFuncAttributeMaxDynamicSharedMemorySize, LDS_BYTES) != hipSuccess) { fprintf(stderr, "kernel_launch: hipFuncSetAttribute failed\n"); grid = -1; return; }
        if (hipOccupancyMaxActiveBlocksPerMultiprocessor(&per_cu, (const void*)mk_fwd, NWAVES * 64, LDS_BYTES) != hipSuccess || per_cu < 1) fprintf(stderr, "kernel_launch: occupancy query reports %d\n", per_cu);
        (void)hipGetLastError();
        grid = cus;
    }
    if (grid < 0) return;
    if (hipMemsetAsync((char*)d_ws + WS_CTL, 0, CTL_ZERO_BYTES, stream) != hipSuccess) return;
    Args a{};
    for (int i = 0; i < 24; ++i) a.in[i] = (const float*)d_in[i];
    a.out = (float*)d_out; a.ws = (unsigned char*)d_ws; a.pad = 0;
    const int nl = MK_N_LAUNCHES == 1 ? 1 : NPH;
    for (int li = 0; li < nl; ++li) {
        a.ph_lo = nl == 1 ? 0 : li; a.ph_hi = nl == 1 ? NPH : li + 1; a.li = 0;
        hipLaunchKernelGGL(mk_fwd, dim3(grid), dim3(NWAVES * 64), LDS_BYTES, stream, a);
        const hipError_t le = hipPeekAtLastError();
        if (le != hipSuccess) { fprintf(stderr, "kernel_launch: launch %d failed: %s\n", li, hipGetErrorName(le)); break; }
    }
}
```

```cpp
#define MK_N_LAUNCHES 1
#include <hip/hip_runtime.h>
#include <cstdio>
#include <cstdint>
#include <cstddef>
#include <cmath>
namespace pg8 {
#define PG8_LAS __attribute__((address_space(3)))
typedef unsigned short bf16_t;
typedef short bf16x8 __attribute__((ext_vector_type(8)));
typedef float f32x4 __attribute__((ext_vector_type(4)));
typedef unsigned u32x4 __attribute__((ext_vector_type(4)));
constexpr int BM = 256, BK = 64, HALF = 128, HTB = HALF * BK * 2  , STAGE_BYTES = 8 * HTB, NXCD = 8, WGM = 8;

__host__ __device__ __forceinline__ int lds_byte(int r, int c) { const int st = (r >> 4) * 2 + (c >> 5), rr = r & 15, cc = c & 31, ob = rr * 64 + cc * 2; return st * 1024 + (ob ^ (((ob >> 9) & 1) << 5)); }
__host__ __device__ __forceinline__ void stage_rc(int b, int& R, int& C) { const int st = b / 1024, sb = b % 1024, swz = sb ^ (((sb >> 9) & 1) << 5); R = (st >> 1) * 16 + swz / 64; C = (st & 1) * 32 + (swz % 64) / 2; }
__host__ __device__ __forceinline__ int perm32(int rho) { const int n = rho >> 4, i = rho & 15; return 8 * (i >> 2) + 4 * n + (i & 3); }

struct Unit { int pm, pn, e; };
struct Gemm { const bf16_t* A; const bf16_t* Bt; int M, N, K; };

struct StaticOrder {
    int nM, nN, nwg, G, c;
    __host__ __device__ void init(int M, int N, int G_, int c_) { nM = M / BM; nN = N / BM; nwg = nM * nN; G = G_; c = c_; }
    __host__ __device__ bool next(int i, Unit& u) const {
        const long L = (long)i * G + c; if (L >= nwg) return false;
        int wgid = (int)L; { const int q = nwg / NXCD, r = nwg % NXCD, xcd = wgid % NXCD, off = wgid / NXCD; wgid = (xcd < r ? xcd * (q + 1) : r * (q + 1) + (xcd - r) * q) + off; }
        const int nig = WGM * nN, gid = wgid / nig, fm = gid * WGM, gsz = (nM - fm) < WGM ? (nM - fm) : WGM;
        u.pm = fm + ((wgid % nig) % gsz); u.pn = (wgid % nig) / gsz; return true;
    }
    __device__ __forceinline__ void a_ready(const Unit&) const {}
    __device__ __forceinline__ void done(const Unit&) const {}
};

__device__ __forceinline__ unsigned cvt_pk_bf16(float lo, float hi) { unsigned r; asm volatile("v_cvt_pk_bf16_f32 %0, %1, %2" : "=v"(r) : "v"(lo), "v"(hi)); return r; }
typedef float f32x2 __attribute__((ext_vector_type(2)));
__device__ __forceinline__ f32x2 gelu_pk(f32x2 v) {
    const f32x2 av = __builtin_elementwise_abs(v), d = av * 0.2316418882f + 1.0f;
    f32x2 t; t.x = __builtin_amdgcn_rcpf(d.x); t.y = __builtin_amdgcn_rcpf(d.y);
    f32x2 q = t * 0.5307027145f + (-0.7265760135f); q = q * t + 0.7107068705f; q = q * t + (-0.142248368f); q = q * t + 0.127414796f; q = q * t;
    const f32x2 s = (v * v) * (-0.72134752044f);
    f32x2 e; e.x = __builtin_amdgcn_exp2f(s.x); e.y = __builtin_amdgcn_exp2f(s.y);
    const f32x2 m = v * (q * e), r = v - m;
    f32x2 o; o.x = v.x < 0.f ? m.x : r.x; o.y = v.y < 0.f ? m.y : r.y; return o;
}

template <int ACT  > struct EpiBf16 {
    static constexpr bool PERM = true, AFTER_DRAIN = false, HEADMAP = false; static_assert(ACT == 0 || ACT == 1, "EpiBf16: ACT is 0 (none) or 1 (gelu_pk)");
    bf16_t* O; int ldc; const float* bias; int split_cols; size_t split_stride; float scale0;
    __device__ __forceinline__ void operator()(const f32x4 (&acc)[2][2][4][2], const Unit& u, int wr, int wc, int fr, int fq) const {
        const int row0 = u.pm * BM + wr * 64 + fr; int colt = u.pn * BM; bf16_t* base = O;
        float sc = 1.f; if (split_cols) { const int t = colt / split_cols; base += (size_t)t * split_stride; colt -= t * split_cols; if (t == 0) sc = scale0; }
        const int col0 = colt + wc * 32 + 8 * fq, bcol0 = u.pn * BM + wc * 32 + 8 * fq;
        f32x4 bv[2][2];
#pragma unroll
        for (int bj = 0; bj < 2; ++bj)
#pragma unroll
            for (int n = 0; n < 2; ++n) bv[bj][n] = bias ? *(const f32x4*)(bias + bcol0 + bj * HALF + 4 * n) : (f32x4){0.f, 0.f, 0.f, 0.f};
#pragma unroll
        for (int ai = 0; ai < 2; ++ai)
#pragma unroll
            for (int m = 0; m < 4; ++m) { bf16_t* rowp = base + (size_t)(row0 + ai * HALF + m * 16) * ldc + col0;
#pragma unroll
                for (int bj = 0; bj < 2; ++bj) { f32x4 v0 = acc[ai][bj][m][0] + bv[bj][0], v1 = acc[ai][bj][m][1] + bv[bj][1];
                    if (ACT == 1) { f32x2 a = gelu_pk((f32x2){v0[0], v0[1]}), b = gelu_pk((f32x2){v0[2], v0[3]}), c = gelu_pk((f32x2){v1[0], v1[1]}), d = gelu_pk((f32x2){v1[2], v1[3]});
                        v0 = (f32x4){a.x, a.y, b.x, b.y}; v1 = (f32x4){c.x, c.y, d.x, d.y}; }
                    v0 = v0 * sc; v1 = v1 * sc; u32x4 w; w.x = cvt_pk_bf16(v0[0], v0[1]); w.y = cvt_pk_bf16(v0[2], v0[3]); w.z = cvt_pk_bf16(v1[0], v1[1]); w.w = cvt_pk_bf16(v1[2], v1[3]);
                    *(u32x4*)(rowp + bj * HALF) = w; } }
    }
};

struct TabOrder {
    const volatile PG8_LAS unsigned* tab;
    __device__ __forceinline__ bool next(int i, Unit& u) const {
        if (i >= 32) return false;
        const volatile PG8_LAS unsigned* r = tab + 8 * i;
        if (__builtin_amdgcn_readfirstlane(r[6]) == 0u) return false;
        u.pm = (int)__builtin_amdgcn_readfirstlane(r[4]); u.pn = (int)__builtin_amdgcn_readfirstlane(r[5]); u.e = i; return true;
    }
    __device__ __forceinline__ const char* abase(const Unit& u, size_t) const { const volatile PG8_LAS unsigned* r = tab + 8 * u.e; const unsigned lo = __builtin_amdgcn_readfirstlane(r[0]), hi = __builtin_amdgcn_readfirstlane(r[1]); return (const char*)(((unsigned long long)hi << 32) | lo); }
    __device__ __forceinline__ const char* bbase(const Unit& u, size_t) const { const volatile PG8_LAS unsigned* r = tab + 8 * u.e; const unsigned lo = __builtin_amdgcn_readfirstlane(r[2]), hi = __builtin_amdgcn_readfirstlane(r[3]); return (const char*)(((unsigned long long)hi << 32) | lo); }
    __device__ __forceinline__ void a_ready(const Unit&) const {}
    __device__ __forceinline__ void done(const Unit&) const {}
};
__device__ __forceinline__ TabOrder build_units(PG8_LAS unsigned char* tabmem, int K, const void* A, const void* B, int G, int c,
                                                int np0, int nn0, int cn0, int mode0, int poff0, int np1, int nn1, int cn1, int mode1, const int* pend, size_t estride, const int tid) {
    __syncthreads();
    if (tid < 32) {
        int i_ = tid; asm volatile("" : "+v"(i_)); const int i = i_;
        const int n0 = np0 * nn0, nwg = n0 + np1 * nn1; const long L = (long)i * G + c; const bool ok = L < nwg;
        int w = ok ? (int)L : 0; { const int q = nwg / NXCD, r = nwg % NXCD, xcd = w % NXCD, off = w / NXCD; w = (xcd < r ? xcd * (q + 1) : r * (q + 1) + (xcd - r) * q) + off; }
        const bool s0 = w < n0; const int ww = s0 ? w : w - n0; const int np = s0 ? np0 : np1, nn = s0 ? nn0 : nn1, cn = s0 ? cn0 : cn1, mode = s0 ? mode0 : mode1;
        const int nig = WGM * nn, gid = ww / nig, fm = gid * WGM, gsz = (np - fm) < WGM ? (np - fm) : WGM;
        const int pv = fm + ((ww % nig) % gsz), pn = cn + (ww % nig) / gsz;
        const int pm0 = pv + poff0, pm1 = pv + (pv >> 3), pm2 = 9 * pv + 8; const int pm = mode == 0 ? pm0 : (mode == 1 ? pm1 : pm2);
        int e = 0;
        if (pend) {
#pragma unroll
            for (int k = 0; k < 8; ++k) e += (pend[k] <= pm) ? 1 : 0;
        }
        const size_t tstep = (size_t)256 * K * 2;
        const unsigned long long a = (unsigned long long)((const char*)A + (size_t)pm * tstep), b = (unsigned long long)((const char*)B + (size_t)e * estride + (size_t)pn * tstep);
        PG8_LAS unsigned* r = (PG8_LAS unsigned*)tabmem + 8 * i;
        r[0] = (unsigned)a; r[1] = (unsigned)(a >> 32); r[2] = (unsigned)b; r[3] = (unsigned)(b >> 32); r[4] = (unsigned)pm; r[5] = (unsigned)pn; r[6] = ok ? 1u : 0u; r[7] = 0u; }
    __syncthreads();
    TabOrder T; T.tab = (const volatile PG8_LAS unsigned*)tabmem; return T;
}

struct EpiRawBf16 {
    static constexpr bool PERM = true, AFTER_DRAIN = false, HEADMAP = false;
    bf16_t* O; int ldc;
    __device__ __forceinline__ void operator()(const f32x4 (&acc)[2][2][4][2], const Unit& u, int wr, int wc, int fr, int fq) const {
        const int row0 = u.pm * BM + wr * 64 + fr, col0 = u.pn * BM + wc * 32 + 8 * fq;
#pragma unroll
        for (int ai = 0; ai < 2; ++ai)
#pragma unroll
            for (int m = 0; m < 4; ++m) { bf16_t* rowp = O + (size_t)(row0 + ai * HALF + m * 16) * ldc + col0;
#pragma unroll
                for (int bj = 0; bj < 2; ++bj) { const f32x4 v0 = acc[ai][bj][m][0], v1 = acc[ai][bj][m][1];
                    u32x4 w; w.x = cvt_pk_bf16(v0[0], v0[1]); w.y = cvt_pk_bf16(v0[2], v0[3]); w.z = cvt_pk_bf16(v1[0], v1[1]); w.w = cvt_pk_bf16(v1[2], v1[3]);
                    *(u32x4*)(rowp + bj * HALF) = w; } }
    }
};

struct EpiHeads {
    static constexpr bool PERM = false, AFTER_DRAIN = false, HEADMAP = true;
    bf16_t* P; const float* gqa; const float* gka; const float* gqb; const float* gkb; const float* tab;
    __device__ __forceinline__ void operator()(const f32x4 (&acc)[2][2][4][2], const Unit& u, int wr, int wc, int fr, int fq) const {
        const int pn = u.pn, jpan = u.pm % 9; const bool lat = jpan < 8;
        int mode = 0; const float* g = gqa; float sc = 1.f;
        if (pn < 2) { mode = 2; g = gqa; sc = 0.125f * 1.4426950408889634f; }
        else if (pn == 2) { mode = 1; g = gqb; sc = 0.125f * 1.4426950408889634f; }
        else if (pn == 6) { mode = wc < 2 ? 2 : 0; g = gka; }
        else if (pn == 7) { mode = 1; g = gkb; }
        if (mode == 2 && !lat) mode = 1;
        f32x4 gv[2][2];
#pragma unroll
        for (int bj = 0; bj < 2; ++bj)
#pragma unroll
            for (int n = 0; n < 2; ++n) gv[bj][n] = mode ? *(const f32x4*)(g + 32 * bj + 16 * n + 4 * fq) * sc : (f32x4){1.f, 1.f, 1.f, 1.f};
        const int colb = pn * BM + wc * 64 + 4 * fq;
#pragma unroll
        for (int ai = 0; ai < 2; ++ai)
#pragma unroll
            for (int m = 0; m < 4; ++m) {
                const int lr = ai * HALF + wr * 64 + m * 16 + fr, j = jpan * 256 + lr;
                f32x4 v[2][2];
#pragma unroll
                for (int bj = 0; bj < 2; ++bj)
#pragma unroll
                    for (int n = 0; n < 2; ++n) v[bj][n] = acc[ai][bj][m][n];
                if (mode) {
                    float ss = 0.f;
#pragma unroll
                    for (int bj = 0; bj < 2; ++bj)
#pragma unroll
                        for (int n = 0; n < 2; ++n) ss += (v[bj][n][0] * v[bj][n][0] + v[bj][n][1] * v[bj][n][1]) + (v[bj][n][2] * v[bj][n][2] + v[bj][n][3] * v[bj][n][3]);
                    ss += __shfl_xor(ss, 16); ss += __shfl_xor(ss, 32);
                    const float rs = 1.0f / sqrtf(ss * (1.0f / 64.0f) + 1e-6f);
#pragma unroll
                    for (int bj = 0; bj < 2; ++bj)
#pragma unroll
                        for (int n = 0; n < 2; ++n) v[bj][n] = v[bj][n] * rs * gv[bj][n];
                    if (mode == 2) {
#pragma unroll
                        for (int bj = 0; bj < 2; ++bj) { const int pos = bj == 0 ? (j >> 6) : (j & 63);
                            const f32x4 t0 = *(const f32x4*)(tab + (pos * 16 + 4 * fq) * 2), t1 = *(const f32x4*)(tab + (pos * 16 + 4 * fq) * 2 + 4);
                            const f32x4 cs = {t0[0], t0[2], t1[0], t1[2]}, sn = {t0[1], t0[3], t1[1], t1[3]};
                            const f32x4 u1 = v[bj][0], u2 = v[bj][1];
                            v[bj][0] = u1 * cs - u2 * sn; v[bj][1] = u2 * cs + u1 * sn; }
                    }
                }
                bf16_t* rowp = P + (size_t)(u.pm * BM + lr) * 2304 + colb;
#pragma unroll
                for (int bj = 0; bj < 2; ++bj)
#pragma unroll
                    for (int n = 0; n < 2; ++n) { typedef unsigned u32x2 __attribute__((ext_vector_type(2))); u32x2 w; w.x = cvt_pk_bf16(v[bj][n][0], v[bj][n][1]); w.y = cvt_pk_bf16(v[bj][n][2], v[bj][n][3]);
                        *(u32x2*)(rowp + 32 * bj + 16 * n) = w; }
            }
    }
};
struct EpiGateRes {
    static constexpr bool PERM = false, AFTER_DRAIN = false, HEADMAP = false;
    const float* xin_lat; const float* xin_ctx; float* xout_lat; float* xout_ctx; const float* mod; int goff;
    __device__ __forceinline__ void operator()(const f32x4 (&acc)[2][2][4][2], const Unit& u, int wr, int wc, int fr, int fq) const {
        const int b = u.pm / 9, j = u.pm % 9;
        const float* bi; float* bo; const float* g;
        if (j < 8) { const size_t r0 = (size_t)(b * 2048 + j * 256) * 1024; bi = xin_lat + r0; bo = xout_lat + r0; g = mod + b * 6144 + goff; }
        else { const size_t r0 = (size_t)(b * 256) * 1024; bi = xin_ctx + r0; bo = xout_ctx + r0; g = mod + 16 * 6144 + goff; }
        const int col0 = u.pn * BM + wc * 32 + 4 * fq;
        f32x4 gv[2][2];
#pragma unroll
        for (int bj = 0; bj < 2; ++bj)
#pragma unroll
            for (int n = 0; n < 2; ++n) gv[bj][n] = *(const f32x4*)(g + col0 + bj * HALF + n * 16);
#pragma unroll
        for (int ai = 0; ai < 2; ++ai)
#pragma unroll
            for (int m = 0; m < 4; ++m) { const size_t off = (size_t)(ai * HALF + wr * 64 + m * 16 + fr) * 1024 + col0;
#pragma unroll
                for (int bj = 0; bj < 2; ++bj)
#pragma unroll
                    for (int n = 0; n < 2; ++n) { const f32x4 xi = *(const f32x4*)(bi + off + bj * HALF + n * 16);
                        *(f32x4*)(bo + off + bj * HALF + n * 16) = xi + gv[bj][n] * acc[ai][bj][m][n]; }
                if (m & 1) asm volatile("" ::: "memory"); }
    }
};
struct EpiSwiglu {
    static constexpr bool PERM = true, AFTER_DRAIN = false, HEADMAP = false;
    bf16_t* H; int ldh; int p0;
    __device__ __forceinline__ void operator()(const f32x4 (&acc)[2][2][4][2], const Unit& u, int wr, int wc, int fr, int fq) const {
        const int row0 = (u.pm - p0) * BM + wr * 64 + fr, col0 = u.pn * HALF + wc * 32 + 8 * fq;
#pragma unroll
        for (int ai = 0; ai < 2; ++ai)
#pragma unroll
            for (int m = 0; m < 4; ++m) { bf16_t* rowp = H + (size_t)(row0 + ai * HALF + m * 16) * ldh + col0;
                float h[8];
#pragma unroll
                for (int n = 0; n < 2; ++n)
#pragma unroll
                    for (int k = 0; k < 4; ++k) { const float a = acc[ai][0][m][n][k], b3 = acc[ai][1][m][n][k];
                        const float sg = __builtin_amdgcn_rcpf(1.0f + __builtin_amdgcn_exp2f(-1.4426950408889634f * a)); h[n * 4 + k] = a * sg * b3; }
                u32x4 w; w.x = cvt_pk_bf16(h[0], h[1]); w.y = cvt_pk_bf16(h[2], h[3]); w.z = cvt_pk_bf16(h[4], h[5]); w.w = cvt_pk_bf16(h[6], h[7]);
                *(u32x4*)rowp = w; }
    }
};
struct EpiSwigluF8 {
    static constexpr bool PERM = true, AFTER_DRAIN = false, HEADMAP = false;
    unsigned char* H; int ldh; float isc;
    __device__ __forceinline__ void operator()(const f32x4 (&acc)[2][2][4][2], const Unit& u, int wr, int wc, int fr, int fq) const {
        const int row0 = u.pm * BM + wr * 64 + fr, col0 = u.pn * HALF + wc * 32 + 8 * fq;
#pragma unroll
        for (int ai = 0; ai < 2; ++ai)
#pragma unroll
            for (int m = 0; m < 4; ++m) { unsigned char* rowp = H + (size_t)(row0 + ai * HALF + m * 16) * ldh + col0;
                float h[8];
#pragma unroll
                for (int n = 0; n < 2; ++n)
#pragma unroll
                    for (int k = 0; k < 4; ++k) { const float a = acc[ai][0][m][n][k] * isc, b3 = acc[ai][1][m][n][k] * isc;
                        const float sg = __builtin_amdgcn_rcpf(1.0f + __builtin_amdgcn_exp2f(-1.4426950408889634f * a)); h[n * 4 + k] = a * sg * b3; }
                typedef unsigned u32x2 __attribute__((ext_vector_type(2))); u32x2 w;
                { int t = __builtin_amdgcn_cvt_pk_fp8_f32(h[0], h[1], 0, false); t = __builtin_amdgcn_cvt_pk_fp8_f32(h[2], h[3], t, true); w.x = (unsigned)t; }
                { int t = __builtin_amdgcn_cvt_pk_fp8_f32(h[4], h[5], 0, false); t = __builtin_amdgcn_cvt_pk_fp8_f32(h[6], h[7], t, true); w.y = (unsigned)t; }
                *(u32x2*)rowp = w; }
    }
};
struct EpiMoeOut {
    static constexpr bool PERM = true, AFTER_DRAIN = false, HEADMAP = false;
    bf16_t* Y; const float* sgate; float osc;
    __device__ __forceinline__ void operator()(const f32x4 (&acc)[2][2][4][2], const Unit& u, int wr, int wc, int fr, int fq) const {
        const int row0 = u.pm * BM + wr * 64 + fr, col0 = u.pn * BM + wc * 32 + 8 * fq;
#pragma unroll
        for (int ai = 0; ai < 2; ++ai)
#pragma unroll
            for (int m = 0; m < 4; ++m) { const int row = row0 + ai * HALF + m * 16; const float gt = sgate[row] * osc; bf16_t* rowp = Y + (size_t)row * 1024 + col0;
#pragma unroll
                for (int bj = 0; bj < 2; ++bj) { const f32x4 v0 = acc[ai][bj][m][0] * gt, v1 = acc[ai][bj][m][1] * gt;
                    u32x4 w; w.x = cvt_pk_bf16(v0[0], v0[1]); w.y = cvt_pk_bf16(v0[2], v0[3]); w.z = cvt_pk_bf16(v1[0], v1[1]); w.w = cvt_pk_bf16(v1[2], v1[3]);
                    *(u32x4*)(rowp + bj * HALF) = w; } }
    }
};
template <class Epi, class Sched, bool ALIGN_EPI = false, bool SP2 = false, bool F8 = false>
__device__ __forceinline__ void gemm_phase(PG8_LAS unsigned char* lds, const Gemm g, const Sched& S, const Epi& E, const int wave_sgpr) {
    int ln_ = (int)__builtin_amdgcn_mbcnt_hi(~0u, __builtin_amdgcn_mbcnt_lo(~0u, 0u)); asm volatile("" : "+v"(ln_)); const int tid_ = wave_sgpr * 64 + ln_;
    const int tid = tid_, wid = __builtin_amdgcn_readfirstlane(tid >> 6), lane = tid & 63, wr = wid >> 2, wc = wid & 3, fr = lane & 15, fq = lane >> 4;
    const int K = g.K, nt = K / BK;
    unsigned voffA[2], voffB[2];
#pragma unroll
    for (int i = 0; i < 2; ++i) { int R, C; stage_rc(tid * 16 + i * 8192, R, C); const int Rb = Epi::HEADMAP ? ((R >> 5) * 64 + (R & 31)) : (Epi::PERM ? ((R & ~31) + perm32(R & 31)) : R);
        voffA[i] = (unsigned)(R * K + C) * 2u; voffB[i] = (unsigned)(Rb * K + C) * 2u; }
    const size_t kstep = (size_t)(BK * 2);
    const size_t hstep = (size_t)HALF * K * 2;
    const size_t hstepB = Epi::HEADMAP ? (size_t)32 * K * 2 : hstep;
    const size_t tstep = 2 * hstep;
    const unsigned ldsw = (unsigned)wid * 1024u;
    const int aoff = lds_byte(wr * 64 + fr, fq * 8), boff = lds_byte(wc * 32 + fr, fq * 8);
#define PG8_SA(b, h) (((b) * 2 + (h)) * HTB)
#define PG8_SB(b, h) ((4 + (b) * 2 + (h)) * HTB)
#define PG8_STAGE(bufoff, gbase, voff) do { _Pragma("unroll") for (int _i = 0; _i < 2; ++_i) \
        __builtin_amdgcn_global_load_lds((const unsigned*)((const char*)(gbase) + (voff)[_i]), (PG8_LAS unsigned*)(lds + (bufoff) + ldsw + _i * 8192), 16, 0, 0); } while (0)
#define PG8_LDA(dst, b, h) do { _Pragma("unroll") for (int m = 0; m < 4; ++m) { if constexpr (F8) { dst##8[m].lo = *(const PG8_LAS i32x4_*)(lds + PG8_SA(b, h) + aoff + m * 2048); dst##8[m].hi = *(const PG8_LAS i32x4_*)(lds + PG8_SA(b, h) + aoff + m * 2048 + 1024); } \
        else { _Pragma("unroll") for (int k = 0; k < 2; ++k) dst[m][k] = *(const PG8_LAS bf16x8*)(lds + PG8_SA(b, h) + aoff + m * 2048 + k * 1024); } } } while (0)
#define PG8_LDB(dst, b, h) do { _Pragma("unroll") for (int n = 0; n < 2; ++n) { if constexpr (F8) { dst##8[n].lo = *(const PG8_LAS i32x4_*)(lds + PG8_SB(b, h) + boff + n * 2048); dst##8[n].hi = *(const PG8_LAS i32x4_*)(lds + PG8_SB(b, h) + boff + n * 2048 + 1024); } \
        else { _Pragma("unroll") for (int k = 0; k < 2; ++k) dst[n][k] = *(const PG8_LAS bf16x8*)(lds + PG8_SB(b, h) + boff + n * 2048 + k * 1024); } } } while (0)
#define PG8_MMA(ai, bj, At, Bt) do { __builtin_amdgcn_s_setprio(1); _Pragma("unroll") for (int m = 0; m < 4; ++m) _Pragma("unroll") for (int n = 0; n < 2; ++n) { \
        if constexpr (F8) asm("v_mfma_f32_16x16x128_f8f6f4 %0, %1, %2, %0" : "+v"(acc[ai][bj][m][n]) : "v"(Bt##8[n]), "v"(At##8[m]));     \
        else { _Pragma("unroll") for (int k = 0; k < 2; ++k) acc[ai][bj][m][n] = __builtin_amdgcn_mfma_f32_16x16x32_bf16(Bt[n][k], At[m][k], acc[ai][bj][m][n], 0, 0, 0); } } \
        __builtin_amdgcn_s_setprio(0); } while (0)
#define PG8_WAIT_V(n) asm volatile("s_waitcnt vmcnt(" #n ")" ::: "memory")
#define PG8_WAIT_L(n) asm volatile("s_waitcnt lgkmcnt(" #n ")" ::: "memory")
#define PG8_BAR __builtin_amdgcn_s_barrier()
#define PG8_SCHED __builtin_amdgcn_sched_barrier(0)
    Unit cur, nxt; int ui = 0;
    if (!S.next(0, cur)) return;
    f32x4 acc[2][2][4][2];
#pragma unroll
    for (int a = 0; a < 2; ++a)
#pragma unroll
        for (int b = 0; b < 2; ++b)
#pragma unroll
            for (int m = 0; m < 4; ++m)
#pragma unroll
                for (int n = 0; n < 2; ++n) acc[a][b][m][n] = (f32x4){0.f, 0.f, 0.f, 0.f};
    typedef int i32x4_ __attribute__((ext_vector_type(4))); typedef int i32x8_ __attribute__((ext_vector_type(8)));
    bf16x8 At[4][2], B0[2][2], B1[2][2];
    i32x8_ At8[4], B08[2], B18[2];
    const char* cA = S.abase(cur, tstep); const char* cB = S.bbase(cur, tstep);
    S.a_ready(cur);
    if constexpr (SP2) {
        PG8_STAGE(PG8_SB(0, 0), cB, voffB); PG8_STAGE(PG8_SB(0, 1), cB + hstepB, voffB); PG8_STAGE(PG8_SA(0, 0), cA, voffA); PG8_STAGE(PG8_SA(0, 1), cA + hstep, voffA);
        if (wr == 1) PG8_BAR;
        PG8_WAIT_V(2); PG8_BAR;
        PG8_STAGE(PG8_SB(1, 0), cB + kstep, voffB); PG8_STAGE(PG8_SA(1, 0), cA + kstep, voffA); PG8_STAGE(PG8_SB(1, 1), cB + hstepB + kstep, voffB);
        PG8_WAIT_V(6); PG8_BAR;
    } else {
        PG8_STAGE(PG8_SB(0, 0), cB, voffB); PG8_STAGE(PG8_SA(0, 0), cA, voffA); PG8_STAGE(PG8_SB(0, 1), cB + hstepB, voffB); PG8_STAGE(PG8_SA(0, 1), cA + hstep, voffA);
        if (wr == 1) PG8_BAR;
        PG8_WAIT_V(4); PG8_BAR;
        PG8_STAGE(PG8_SB(1, 0), cB + kstep, voffB); PG8_STAGE(PG8_SA(1, 0), cA + kstep, voffA); PG8_STAGE(PG8_SB(1, 1), cB + hstepB + kstep, voffB);
        PG8_WAIT_V(6); PG8_BAR;
    }
    for (;;) {
        const bool has_next = S.next(ui + 1, nxt);
        const char* nA = has_next ? S.abase(nxt, tstep) : cA; const char* nB = has_next ? S.bbase(nxt, tstep) : cB;
#pragma unroll 1
        for (int t = 0; t < nt; t += 2) {
            const bool last = (t == nt - 2);
            const char* a1 = cA + (size_t)(t + 1) * kstep;
            const char* a2 = last ? nA : cA + (size_t)(t + 2) * kstep; const char* b2 = last ? nB : cB + (size_t)(t + 2) * kstep;
            const char* a3 = a2 + kstep; const char* b3 = b2 + kstep;
            if (last && has_next) S.a_ready(nxt);
            if constexpr (SP2) {
            PG8_LDB(B0, 0, 0); PG8_LDB(B1, 0, 1); PG8_SCHED; PG8_LDA(At, 0, 0); PG8_STAGE(PG8_SA(1, 1), a1 + hstep, voffA);
            PG8_WAIT_V(8); PG8_WAIT_L(0); PG8_BAR; PG8_MMA(0, 0, At, B0); PG8_MMA(0, 1, At, B1); PG8_BAR; PG8_SCHED;
            PG8_LDA(At, 0, 1); PG8_STAGE(PG8_SB(0, 0), b2, voffB); PG8_STAGE(PG8_SB(0, 1), b2 + hstepB, voffB); PG8_STAGE(PG8_SA(0, 0), a2, voffA);
            PG8_WAIT_V(8); PG8_WAIT_L(0); PG8_BAR; PG8_MMA(1, 0, At, B0); PG8_MMA(1, 1, At, B1); PG8_BAR; PG8_SCHED;
            PG8_LDB(B0, 1, 0); PG8_LDB(B1, 1, 1); PG8_SCHED; PG8_LDA(At, 1, 0); PG8_STAGE(PG8_SA(0, 1), a2 + hstep, voffA);
            PG8_WAIT_V(8); PG8_WAIT_L(0); PG8_BAR; PG8_MMA(0, 0, At, B0); PG8_MMA(0, 1, At, B1); PG8_BAR; PG8_SCHED;
            PG8_LDA(At, 1, 1); PG8_STAGE(PG8_SB(1, 0), b3, voffB); PG8_STAGE(PG8_SB(1, 1), b3 + hstepB, voffB); PG8_STAGE(PG8_SA(1, 0), a3, voffA);
            PG8_WAIT_V(8); PG8_WAIT_L(0); PG8_BAR; PG8_MMA(1, 0, At, B0); PG8_MMA(1, 1, At, B1); PG8_BAR; PG8_SCHED;
            } else {
            PG8_LDB(B0, 0, 0); PG8_SCHED; PG8_LDA(At, 0, 0); PG8_STAGE(PG8_SA(1, 1), a1 + hstep, voffA);
            PG8_WAIT_L(8); PG8_BAR; PG8_WAIT_L(0); PG8_MMA(0, 0, At, B0); PG8_BAR; PG8_SCHED;
            PG8_LDB(B1, 0, 1); PG8_STAGE(PG8_SB(0, 0), b2, voffB);
            PG8_BAR; PG8_WAIT_L(0); PG8_MMA(0, 1, At, B1); PG8_BAR;
            PG8_LDA(At, 0, 1); PG8_STAGE(PG8_SA(0, 0), a2, voffA);
            PG8_BAR; PG8_WAIT_L(0); PG8_MMA(1, 0, At, B0); PG8_BAR; PG8_SCHED;
            PG8_STAGE(PG8_SB(0, 1), b2 + hstepB, voffB);
            PG8_WAIT_V(6); PG8_BAR; PG8_MMA(1, 1, At, B1); PG8_BAR;
            PG8_LDB(B0, 1, 0); PG8_SCHED; PG8_LDA(At, 1, 0); PG8_STAGE(PG8_SA(0, 1), a2 + hstep, voffA);
            PG8_WAIT_L(8); PG8_BAR; PG8_WAIT_L(0); PG8_MMA(0, 0, At, B0); PG8_BAR; PG8_SCHED;
            PG8_LDB(B1, 1, 1); PG8_STAGE(PG8_SB(1, 0), b3, voffB);
            PG8_BAR; PG8_WAIT_L(0); PG8_MMA(0, 1, At, B1); PG8_BAR;
            PG8_LDA(At, 1, 1); PG8_STAGE(PG8_SA(1, 0), a3, voffA);
            PG8_BAR; PG8_WAIT_L(0); PG8_MMA(1, 0, At, B0); PG8_BAR; PG8_SCHED;
            PG8_STAGE(PG8_SB(1, 1), b3 + hstepB, voffB);
            PG8_WAIT_V(6); PG8_BAR; PG8_MMA(1, 1, At, B1); PG8_BAR;
            }
        }
        if constexpr (ALIGN_EPI) { if (wr == 0) PG8_BAR; }
        if constexpr (F8) asm volatile("s_nop 15\n\ts_nop 15\n\ts_nop 7" ::: "memory");
        if constexpr (!Epi::AFTER_DRAIN) { E(acc, cur, wr, wc, fr, fq); S.done(cur); }
        if (!has_next) break;
#pragma unroll
        for (int a = 0; a < 2; ++a)
#pragma unroll
            for (int b = 0; b < 2; ++b)
#pragma unroll
                for (int m = 0; m < 4; ++m)
#pragma unroll
                    for (int n = 0; n < 2; ++n) acc[a][b][m][n] = (f32x4){0.f, 0.f, 0.f, 0.f};
        cur = nxt; cA = nA; cB = nB; ++ui;
        if constexpr (ALIGN_EPI) { if (wr == 1) PG8_BAR; }
    }
    PG8_WAIT_V(0);
    if constexpr (!ALIGN_EPI) { if (wr == 0) PG8_BAR; }
    PG8_BAR;
    if constexpr (Epi::AFTER_DRAIN) { E.fused(acc, cur, wr, wc, fr, fq, lds, wid, lane); S.done(cur); }
#undef PG8_SA
#undef PG8_SB
#undef PG8_STAGE
#undef PG8_LDA
#undef PG8_LDB
#undef PG8_MMA
#undef PG8_WAIT_V
#undef PG8_WAIT_L
#undef PG8_BAR
#undef PG8_SCHED
}
}

constexpr int NWAVES = 8;
#ifndef MK_N_LAUNCHES
#define MK_N_LAUNCHES 1
#endif
constexpr int NPH = 23;
constexpr int BATCH = 16, SEQ = 2048, DM = 1024, CTXL = 256, TPB = SEQ + CTXL, MROWS = BATCH * TPB, NPAN = MROWS / 256;
constexpr int INW = 2304, DFF = 2816, NEXP = 8, NTOK = BATCH * SEQ;
constexpr int QA_OFF = 0, QB_OFF = 512, CPOST_OFF = 768, CPRE_OFF = 1024, CVAL_OFF = 1280, KA_OFF = 1536, VA_OFF = 1664, KB_OFF = 1792, VB_OFF = 2048;
constexpr float NORM_EPS = 1e-6f, LOG2E = 1.4426950408889634f, C2 = 0.125f * 1.4426950408889634f;
constexpr int MOE_HCAP = 136;
constexpr int SLOT_CAP = 2 * NTOK + NEXP * 256;

constexpr size_t MiB = 1u << 20;
constexpr size_t WS_CTL = 0, CTL_ZERO_BYTES = 1 * MiB;
constexpr size_t WS_MOD = 1 * MiB;
constexpr size_t WS_MISC = 2 * MiB;
constexpr size_t WS_WIN = 6 * MiB;
constexpr size_t WS_WOUT = 15 * MiB;
constexpr size_t WS_F13 = 19 * MiB;
constexpr size_t WS_F2 = 30 * MiB;
constexpr size_t WS_M13 = 36 * MiB;
constexpr size_t WS_M2 = 124 * MiB;
constexpr size_t WS_XC = 168 * MiB;
constexpr size_t WS_XN = 184 * MiB;
constexpr size_t WS_P = 256 * MiB;
constexpr size_t WS_XT = 316 * MiB;
constexpr size_t WS_END = 504 * MiB;
constexpr size_t WS_XS8 = WS_XN, WS_XT8 = WS_XN + 66 * MiB, WS_H8 = WS_XT;
static_assert(WS_P + (size_t)MROWS * DFF * 2 <= WS_END && WS_H8 + (size_t)SLOT_CAP * DFF <= WS_END && WS_XN + (size_t)SLOT_CAP * DM * 2 <= WS_XT && WS_XT8 + (size_t)NTOK * DM <= WS_XT && (size_t)SLOT_CAP * DM <= 66 * MiB, "ws map");
constexpr size_t MS_TOKE = 0, MS_TOKG = 256 * 1024, MS_TOKS = 512 * 1024, MS_SLOTG = 768 * 1024, MS_META = 1088 * 1024, MS_ROPE = 1152 * 1024;
constexpr int CW_TMO = 0, CW_CODE = 1, CW_BAR = 4096, CW_CNT = 16384;

constexpr int RING_BYTES = 131072, LDSCTL_OFF = RING_BYTES, MISC_OFF = LDSCTL_OFF + 320, LDS_BYTES = 147456;

#define GAS __attribute__((address_space(1)))
#define LAS __attribute__((address_space(3)))
typedef unsigned short bf16;
typedef unsigned v4u __attribute__((ext_vector_type(4)));
typedef unsigned v2u __attribute__((ext_vector_type(2)));
typedef float f32x4 __attribute__((ext_vector_type(4)));
#define LDS_WAIT() asm volatile("s_waitcnt lgkmcnt(0)" ::: "memory")
#define VM_WAIT() asm volatile("s_waitcnt vmcnt(0)" ::: "memory")
__device__ __forceinline__ unsigned f2bf(float f) { unsigned u = __builtin_bit_cast(unsigned, f); return (u + 0x7fffu + ((u >> 16) & 1u)) >> 16; }
__device__ __forceinline__ unsigned pk2(float lo, float hi) { return f2bf(lo) | (f2bf(hi) << 16); }
__device__ __forceinline__ unsigned pk4_f8(float a, float b, float c, float d) { int w = __builtin_amdgcn_cvt_pk_fp8_f32(a, b, 0, false); w = __builtin_amdgcn_cvt_pk_fp8_f32(c, d, w, true); return (unsigned)w; }
__device__ __forceinline__ float bflo(unsigned w) { return __uint_as_float(w << 16); }
__device__ __forceinline__ float bfhi(unsigned w) { return __uint_as_float(w & 0xffff0000u); }
__device__ __forceinline__ float bf1(bf16 h) { return __uint_as_float((unsigned)h << 16); }
__device__ __forceinline__ float wave_sum(float v) {
#pragma unroll
    for (int o = 1; o < 64; o <<= 1) v += __shfl_xor(v, o);
    return v;
}
__device__ __forceinline__ float half_sum(float v) {
#pragma unroll
    for (int o = 1; o < 32; o <<= 1) v += __shfl_xor(v, o);
    return v;
}
#include <hip/hip_bf16.h>
#include <cmath>
namespace attn_body {
using bf16=__hip_bfloat16;
using bf16x8=__attribute__((ext_vector_type(8)))short;
using s16x4=__attribute__((ext_vector_type(4)))short;
using f32x16=__attribute__((ext_vector_type(16)))float;
using u32x4=__attribute__((ext_vector_type(4)))unsigned;
constexpr int D=64,DM=2304;
constexpr int NW=8,QBLK=32,QB=QBLK*NW,KVBLK=64;
constexpr int LDS_BT=86016, BT_STRIDE=128, BT_PAD=48;
__device__ __forceinline__ int crow(int r,int hi){return (r&3)+8*(r>>2)+4*hi;}
#define SBAR() __builtin_amdgcn_sched_barrier(0)
__device__ __forceinline__ void bias_apply(f32x16&p0,f32x16&p1,const __attribute__((address_space(3))) char*tb,unsigned m0,unsigned m1,float mh){
  const unsigned NEGB=0xf149f2cau;
  #pragma unroll
  for(int g=0;g<4;++g){
    #pragma unroll
    for(int k=0;k<4;++k){ const int r=4*g+k; const int o=((r&3)+8*(r>>2))*4; const float b0=*(const __attribute__((address_space(3))) float*)(tb+o),b1=*(const __attribute__((address_space(3))) float*)(tb+o+128);
      const unsigned s0=(unsigned)__builtin_amdgcn_sbfe((int)m0,r,1), s1=(unsigned)__builtin_amdgcn_sbfe((int)m1,r,1);
      const unsigned x0=__float_as_uint(p0[r]+(b0-mh)), x1=__float_as_uint(p1[r]+(b1-mh));
      float y0=__uint_as_float((x0&s0)|(NEGB&~s0)), y1=__uint_as_float((x1&s1)|(NEGB&~s1)); asm volatile("":"+v"(y0),"+v"(y1)); p0[r]=y0; p1[r]=y1; }
    __builtin_amdgcn_sched_barrier(0); }
}
constexpr int NSLOT=3, SLOTB=8192;
constexpr int LDS_K=0, LDS_V=NSLOT*SLOTB, LDS_WS=2*NSLOT*SLOTB, LDS_OST=LDS_WS+NW*64*4, LDS_BYTES=LDS_OST+NW*4096;
constexpr float C2=0.125f*1.4426950408889634f;
__device__ __forceinline__ void glds16(const void*gsrc,unsigned lds_dst){unsigned keep;
  asm volatile("s_mov_b32 %0, m0\n\ts_mov_b32 m0, %2\n\ts_nop 0\n\tglobal_load_lds_dwordx4 %1, off\n\ts_mov_b32 m0, %0":"=&s"(keep):"v"(gsrc),"s"(lds_dst):"memory");}
__device__ __forceinline__ float max3f(float a,float b,float c){float r;asm("v_max3_f32 %0, %1, %2, %3":"=v"(r):"v"(a),"v"(b),"v"(c));return r;}
__device__ __forceinline__ float max2f(float a,float b){float r;asm("v_max_f32_e32 %0, %1, %2":"=v"(r):"v"(a),"v"(b));return r;}
__device__ __forceinline__ float fadd_s(float a,float b){float r;asm("v_add_f32_e32 %0, %1, %2":"=v"(r):"v"(a),"v"(b));return r;}
__device__ __forceinline__ float fsub_s(float a,float b){float r;asm("v_sub_f32_e32 %0, %1, %2":"=v"(r):"v"(a),"v"(b));return r;}
typedef float f32x2_t __attribute__((ext_vector_type(2))); typedef __bf16 bf16x2_t __attribute__((ext_vector_type(2)));
__device__ __forceinline__ unsigned cvtpk_s(float lo,float hi){f32x2_t v={lo,hi};bf16x2_t b=__builtin_convertvector(v,bf16x2_t);return __builtin_bit_cast(unsigned,b);}
#define WAIT_BAR(N) asm volatile("s_waitcnt vmcnt(" #N ") lgkmcnt(0)\n\ts_barrier":::"memory")

template<bool ZERO> __device__ __forceinline__ f32x16 cinit(const f32x16&negm){ if constexpr(ZERO) return f32x16{}; else return negm; }
__device__ __forceinline__ void qkt(f32x16&p0,f32x16&p1,const char*Kslot,const bf16x8*qr,const f32x16 negm,int r32,int hi){
  const char*kb=Kslot+hi*1024+r32*16;
  #pragma unroll
  for(int d0=0;d0<4;++d0){
    const bf16x8 b0=*reinterpret_cast<const bf16x8*>(kb+d0*2048);
    const bf16x8 b1=*reinterpret_cast<const bf16x8*>(kb+d0*2048+512);
    if(d0==0){p0=__builtin_amdgcn_mfma_f32_32x32x16_bf16(b0,qr[0],negm,0,0,0);p1=__builtin_amdgcn_mfma_f32_32x32x16_bf16(b1,qr[0],negm,0,0,0);}
    else{p0=__builtin_amdgcn_mfma_f32_32x32x16_bf16(b0,qr[d0],p0,0,0,0);p1=__builtin_amdgcn_mfma_f32_32x32x16_bf16(b1,qr[d0],p1,0,0,0);}}
}
typedef __attribute__((address_space(3))) const char* lds_cptr;
typedef short v4i16_t __attribute__((ext_vector_type(4)));
__device__ __forceinline__ void kload8(bf16x8*kf,lds_cptr kp){
  kf[0]=*(const __attribute__((address_space(3))) bf16x8*)(kp);      kf[1]=*(const __attribute__((address_space(3))) bf16x8*)(kp+512);
  kf[2]=*(const __attribute__((address_space(3))) bf16x8*)(kp+2048); kf[3]=*(const __attribute__((address_space(3))) bf16x8*)(kp+2560);
  kf[4]=*(const __attribute__((address_space(3))) bf16x8*)(kp+4096); kf[5]=*(const __attribute__((address_space(3))) bf16x8*)(kp+4608);
  kf[6]=*(const __attribute__((address_space(3))) bf16x8*)(kp+6144); kf[7]=*(const __attribute__((address_space(3))) bf16x8*)(kp+6656);
}
__device__ __forceinline__ void kload2(bf16x8*kf,lds_cptr kp,int j){ kf[2*j]=*(const __attribute__((address_space(3))) bf16x8*)(kp+j*2048); kf[2*j+1]=*(const __attribute__((address_space(3))) bf16x8*)(kp+j*2048+512); }
__device__ __forceinline__ s16x4 vtr(lds_cptr p){ return __builtin_bit_cast(s16x4,__builtin_amdgcn_ds_read_tr16_b64_v4i16((__attribute__((address_space(3))) v4i16_t*)p)); }
__device__ __forceinline__ float rowmax(const f32x16&p0,const f32x16&p1){
  float a=max3f(p0[0],p0[1],p1[0]),b=max3f(p0[2],p0[3],p1[1]);a=max3f(a,p1[2],p1[3]);
  #pragma unroll
  for(int r=4;r<16;r+=4){a=max3f(a,p0[r],p0[r+1]);b=max3f(b,p0[r+2],p0[r+3]);a=max3f(a,p1[r],p1[r+1]);b=max3f(b,p1[r+2],p1[r+3]);}
  const float m=max2f(a,b);
  auto rr=__builtin_amdgcn_permlane32_swap(__float_as_uint(m),__float_as_uint(m),false,false);
  return max2f(__uint_as_float(rr[0]),__uint_as_float(rr[1]));
}
__device__ __forceinline__ void pv(f32x16*o,int vb,bf16x8 pa0,bf16x8 pa1,bf16x8 pa2,bf16x8 pa3){
  #pragma unroll
  for(int d0=0;d0<2;++d0){s16x4 lo[4],hi[4];
    #pragma unroll
    for(int ks=0;ks<4;++ks){
      asm volatile("ds_read_b64_tr_b16 %0,%1 offset:%c2":"=&v"(lo[ks]):"v"(vb),"i"(d0*4096+ks*1024):"memory");
      asm volatile("ds_read_b64_tr_b16 %0,%1 offset:%c2":"=&v"(hi[ks]):"v"(vb),"i"(d0*4096+ks*1024+512):"memory");}
    asm volatile("s_waitcnt lgkmcnt(0)":::"memory");SBAR();
    #define PK(k) (bf16x8){lo[k][0],lo[k][1],lo[k][2],lo[k][3],hi[k][0],hi[k][1],hi[k][2],hi[k][3]}
    o[d0]=__builtin_amdgcn_mfma_f32_32x32x16_bf16(pa0,PK(0),o[d0],0,0,0);
    o[d0]=__builtin_amdgcn_mfma_f32_32x32x16_bf16(pa1,PK(1),o[d0],0,0,0);
    o[d0]=__builtin_amdgcn_mfma_f32_32x32x16_bf16(pa2,PK(2),o[d0],0,0,0);
    o[d0]=__builtin_amdgcn_mfma_f32_32x32x16_bf16(pa3,PK(3),o[d0],0,0,0);
    #undef PK
  }
}

#ifndef ATTN_STORE16
#define ATTN_STORE16(p,v) (*(u32x4*)(p)=(v))
#endif
template<int THRL,bool BMODE> __device__ __forceinline__ void attn_unit(const bf16*Qu,const bf16*__restrict__ Kh,const bf16*__restrict__ Vh,bf16*Ou,const int NT,const int nfirst,const int first0,const int second0,const int qg,const float*rpbh,char*shm,const int wave_sgpr){
  int ln_=(int)__builtin_amdgcn_mbcnt_hi(~0u,__builtin_amdgcn_mbcnt_lo(~0u,0u)); asm volatile("":"+v"(ln_));
  const int wid=wave_sgpr,lane=ln_,tid=wid*64+lane,r32=lane&31,hi=lane>>5;
  const bf16*Qw=Qu+(long)(wid*QBLK)*DM;
  const unsigned lds0=(unsigned)(uintptr_t)shm;
  float*wsf=(float*)(shm+LDS_WS)+wid*64;
  const bf16*ksrc=Kh+(long)lane*DM+wid*8;
  const bf16*vsrc=Vh+(long)(16*(wid&3)+(lane>>2))*DM+(wid>>2)*32+(lane&3)*8;
  const unsigned kdst=lds0+LDS_K+wid*1024, vdst=lds0+LDS_V+wid*1024;
  #define TILE(t) (((t)<nfirst)?(first0+(t)):(second0+(t)-nfirst))
  #define DMA_K(t,slot) glds16(ksrc+(long)TILE(t)*KVBLK*DM,(unsigned)__builtin_amdgcn_readfirstlane(kdst+(slot)))
  #define DMA_V(t,slot) glds16(vsrc+(long)TILE(t)*KVBLK*DM,(unsigned)__builtin_amdgcn_readfirstlane(vdst+(slot)))
  const int vb0=(int)(lds0+LDS_V)+((lane>>4)&1)*32+(lane&3)*8+(4*hi+((lane&15)>>2))*64;
  const char*Kbase=shm+LDS_K; bf16x8 kf[8];
  const lds_cptr shm3=(lds_cptr)shm; const lds_cptr kp0=shm3+LDS_K+hi*1024+r32*16; const lds_cptr vp0=shm3+LDS_V+((lane>>4)&1)*32+(lane&3)*8+(4*hi+((lane&15)>>2))*64;
  unsigned bm0=0u,bm1=0u; int blane=0,bqr=0,brs=0;
  if constexpr(BMODE){ const int qc=(wid&1)*32+r32; int cs=qc-8; cs=cs<0?0:(cs>48?48:cs);
    _Pragma("unroll") for(int r=0;r<16;++r){ const int kc=(r&3)+8*(r>>2)+4*hi; bm0|=(kc>=cs&&kc<cs+16)?(1u<<r):0u; bm1|=(kc+32>=cs&&kc+32<cs+16)?(1u<<r):0u; }
    blane=(BT_PAD+15-qc+4*hi)*4; bqr=qg+(wid>>1); brs=bqr-4; brs=brs<0?0:(brs>24?24:brs);
    __attribute__((address_space(3))) float*bt=(__attribute__((address_space(3))) float*)(shm3+LDS_BT); for(int idx=tid;idx<15*BT_STRIDE;idx+=NW*64){ const int dr=idx/BT_STRIDE,j=idx%BT_STRIDE; bt[idx]=(j>=BT_PAD&&j<=BT_PAD+30)?rpbh[dr*31+j-BT_PAD]*1.4426950408889634f:0.f; } }
  DMA_K(0,0);DMA_V(0,0);DMA_K(1,SLOTB);
  bf16x8 qr[4];
  #pragma unroll
  for(int d0=0;d0<4;++d0)qr[d0]=*reinterpret_cast<const bf16x8*>(&Qw[(long)r32*DM+d0*16+hi*8]);
  float mhat=0.f,l_reg=0.f;f32x16 o[2];o[0]=f32x16{};o[1]=f32x16{};f32x16 negm=f32x16{}; if constexpr(!BMODE){asm volatile("":"+v"(negm));}
  #define CMASK(P0,P1,t) do{ if constexpr(BMODE){ if((t)>=nfirst){ const int kr_=second0+(t)-nfirst; const bool rv_=(kr_>=brs)&&(kr_<brs+8); int dr_=kr_-bqr+7; dr_=dr_<0?0:(dr_>14?14:dr_); \
      bias_apply(P0,P1,shm3+LDS_BT+dr_*(BT_STRIDE*4)+blane,rv_?bm0:0u,rv_?bm1:0u,mhat); } else { _Pragma("unroll") for(int r_=0;r_<16;++r_){P0[r_]-=mhat;P1[r_]-=mhat;} } } }while(0)
  bool resc=false;
  #define START(P0,P1) do{ const float rm=rowmax(P0,P1); resc=false; \
    { const float dl=rm; mhat=fadd_s(mhat,dl); \
      _Pragma("unroll") for(int r=0;r<16;++r){P0[r]=fsub_s(P0[r],dl);P1[r]=fsub_s(P1[r],dl);} \
      if constexpr(!BMODE){ _Pragma("unroll") for(int r=0;r<16;++r)negm[r]=-mhat; asm volatile("":"+v"(negm)); } } \
    _Pragma("unroll") for(int r=0;r<16;++r)P0[r]=__builtin_amdgcn_exp2f(P0[r]); }while(0)
  #define RESC() do{ if(resc){ asm volatile("s_waitcnt lgkmcnt(0)":::"memory"); \
      _Pragma("unroll") for(int d_=0;d_<2;++d_) _Pragma("unroll") for(int r=0;r<16;++r)o[d_][r]*=wsf[crow(r,hi)]; } }while(0)
  f32x16 pA0,pA1,pB0,pB1;
  int sl_prev=0,sl_cur=0,sl_next=SLOTB;
  #define ROT() do{sl_prev=sl_cur;sl_cur=sl_next;sl_next=(sl_next==(NSLOT-1)*SLOTB)?0:sl_next+SLOTB;}while(0)
  DMA_K(2,2*SLOTB);
  WAIT_BAR(3);
  qkt(pA0,pA1,Kbase,qr,cinit<BMODE>(negm),r32,hi);asm volatile("s_nop 15\n\ts_nop 7":"+v"(pA0),"+v"(pA1));CMASK(pA0,pA1,0);
  START(pA0,pA1);
  _Pragma("unroll") for(int r=0;r<16;++r)pA1[r]=__builtin_amdgcn_exp2f(pA1[r]);
  WAIT_BAR(0);
  DMA_K(3,0);DMA_V(1,SLOTB);
  ROT();
  kload8(kf,kp0+sl_cur);
  WAIT_BAR(2);
  s16x4 vlo[8],vhi[8]; u32x4 pw0,pw1,pw2,pw3;
  #define PKW(P,B) cvtpk_s(P[B],P[B+1])
  #define PAF(k) __builtin_bit_cast(bf16x8,pw##k)
  #define VFR(i) (bf16x8){vlo[i][0],vlo[i][1],vlo[i][2],vlo[i][3],vhi[i][0],vhi[i][1],vhi[i][2],vhi[i][3]}
  #define PIN(x) asm volatile("":"+v"(x))
  #define MX3(a,b,c) __builtin_fmaxf(__builtin_fmaxf((a),(b)),(c))
  #define GAPA(MF,A0,A1,A2,A3,W0,W1,PW) do{ MF; sacc+=A0; sacc+=A1; sacc+=A2; sacc+=A3; PIN(sacc); W0; W1; PIN(PW); SBAR(); }while(0)
  #define EX(v) __builtin_amdgcn_exp2f(v)
  #define GAPB(MF,X,B) do{ MF; X[B]=EX(X[B]); X[B+1]=EX(X[B+1]); X[B+2]=EX(X[B+2]); X[B+3]=EX(X[B+3]); PIN(X); SBAR(); }while(0)
  #define VRD(i) do{ vlo[i]=vtr(vp_+(((i)>>2)*4096+((i)&3)*1024)); vhi[i]=vtr(vp_+(((i)>>2)*4096+((i)&3)*1024+512)); }while(0)
  #define KRD(G,j) do{ if(G){ kload2(kf,kp0+sl_next,j); SBAR(); } }while(0)
  #define STEP(C0,C1,P0,P1,t,GK,GV,GL) do{ SBAR(); \
    const lds_cptr vp_=vp0+sl_prev; \
    VRD(0); SBAR(); float sacc=(P0[0]+P0[1]); \
    GAPA(C0=__builtin_amdgcn_mfma_f32_32x32x16_bf16(kf[0],qr[0],cinit<BMODE>(negm),0,0,0), P0[2],P0[3],P0[4],P0[5],     pw0[0]=PKW(P0,0), pw0[1]=PKW(P0,2), pw0); \
    VRD(4); SBAR(); GAPA(C1=__builtin_amdgcn_mfma_f32_32x32x16_bf16(kf[1],qr[0],cinit<BMODE>(negm),0,0,0), P0[6],P0[7],P0[8],P0[9],     pw0[2]=PKW(P0,4), pw0[3]=PKW(P0,6), pw0); \
    VRD(1); SBAR(); GAPA(C0=__builtin_amdgcn_mfma_f32_32x32x16_bf16(kf[2],qr[1],C0,0,0,0),   P0[10],P0[11],P0[12],P0[13], pw1[0]=PKW(P0,8), pw1[1]=PKW(P0,10), pw1); \
    VRD(5); SBAR(); GAPA(C1=__builtin_amdgcn_mfma_f32_32x32x16_bf16(kf[3],qr[1],C1,0,0,0),   P0[14],P0[15],P1[0],P1[1],   pw1[2]=PKW(P0,12),pw1[3]=PKW(P0,14), pw1); \
    VRD(2); SBAR(); GAPA(C0=__builtin_amdgcn_mfma_f32_32x32x16_bf16(kf[4],qr[2],C0,0,0,0),   P1[2],P1[3],P1[4],P1[5],     pw2[0]=PKW(P1,0), pw2[1]=PKW(P1,2), pw2); \
    VRD(6); SBAR(); GAPA(C1=__builtin_amdgcn_mfma_f32_32x32x16_bf16(kf[5],qr[2],C1,0,0,0),   P1[6],P1[7],P1[8],P1[9],     pw2[2]=PKW(P1,4), pw2[3]=PKW(P1,6), pw2); \
    VRD(3); SBAR(); GAPA(C0=__builtin_amdgcn_mfma_f32_32x32x16_bf16(kf[6],qr[3],C0,0,0,0),   P1[10],P1[11],P1[12],P1[13], pw3[0]=PKW(P1,8), pw3[1]=PKW(P1,10), pw3); \
    VRD(7); SBAR(); GAPA(C1=__builtin_amdgcn_mfma_f32_32x32x16_bf16(kf[7],qr[3],C1,0,0,0),   P1[14],P1[15],0.f,0.f,       pw3[2]=PKW(P1,12),pw3[3]=PKW(P1,14), pw3); \
    l_reg+=sacc; \
    if(GK){DMA_K((t)+3,sl_cur);} if(GV){DMA_V((t)+1,sl_next);} \
    CMASK(C0,C1,t); \
    { float a=MX3(C0[0],C0[1],C1[0]),b=MX3(C0[2],C0[3],C1[1]); a=MX3(a,C1[2],C1[3]); \
      _Pragma("unroll") for(int r=4;r<16;r+=4){a=MX3(a,C0[r],C0[r+1]);b=MX3(b,C0[r+2],C0[r+3]);a=MX3(a,C1[r],C1[r+1]);b=MX3(b,C1[r+2],C1[r+3]);} \
      float rm=__builtin_fmaxf(a,b); { auto rr=__builtin_amdgcn_permlane32_swap(__float_as_uint(rm),__float_as_uint(rm),false,false); rm=__builtin_fmaxf(__uint_as_float(rr[0]),__uint_as_float(rr[1])); } \
      resc=false; \
      if(__builtin_expect(__any(rm>(float)THRL),0)){ const float dl=__builtin_fmaxf(rm,0.f); mhat+=dl; \
        _Pragma("unroll") for(int r=0;r<16;++r){C0[r]-=dl;C1[r]-=dl;} \
        if constexpr(!BMODE){ _Pragma("unroll") for(int r=0;r<16;++r)negm[r]=-mhat; asm volatile("":"+v"(negm)); } \
        const float f=__builtin_amdgcn_exp2f(-dl); l_reg*=f; if(hi==0)wsf[r32]=f; resc=true; } } \
    SBAR(); \
    GAPB(o[0]=__builtin_amdgcn_mfma_f32_32x32x16_bf16(PAF(0),VFR(0),o[0],0,0,0), C0,0); \
    GAPB(o[1]=__builtin_amdgcn_mfma_f32_32x32x16_bf16(PAF(0),VFR(4),o[1],0,0,0), C0,4); \
    KRD(GL,0); GAPB(o[0]=__builtin_amdgcn_mfma_f32_32x32x16_bf16(PAF(1),VFR(1),o[0],0,0,0), C0,8); \
    KRD(GL,1); GAPB(o[1]=__builtin_amdgcn_mfma_f32_32x32x16_bf16(PAF(1),VFR(5),o[1],0,0,0), C0,12); \
    KRD(GL,2); GAPB(o[0]=__builtin_amdgcn_mfma_f32_32x32x16_bf16(PAF(2),VFR(2),o[0],0,0,0), C1,0); \
    KRD(GL,3); GAPB(o[1]=__builtin_amdgcn_mfma_f32_32x32x16_bf16(PAF(2),VFR(6),o[1],0,0,0), C1,4); \
    GAPB(o[0]=__builtin_amdgcn_mfma_f32_32x32x16_bf16(PAF(3),VFR(3),o[0],0,0,0), C1,8); \
    GAPB(o[1]=__builtin_amdgcn_mfma_f32_32x32x16_bf16(PAF(3),VFR(7),o[1],0,0,0), C1,12); \
    }while(0)
  int t=1;
  for(;t+5<NT;t+=2){
    STEP(pB0,pB1,pA0,pA1,t,true,true,true);     WAIT_BAR(2); RESC(); ROT();
    STEP(pA0,pA1,pB0,pB1,t+1,true,true,true);   WAIT_BAR(2); RESC(); ROT();
  }
  #define ENDW(tt) do{ if((tt)+3<NT){WAIT_BAR(2);} else if((tt)+2<NT){WAIT_BAR(1);} else {WAIT_BAR(0);} }while(0)
  for(;t+1<NT;t+=2){
    STEP(pB0,pB1,pA0,pA1,t,(t+3<NT),(t+1<NT),(t+1<NT));       ENDW(t);   RESC(); ROT();
    STEP(pA0,pA1,pB0,pB1,t+1,(t+4<NT),(t+2<NT),(t+2<NT));     ENDW(t+1); RESC(); ROT();
  }
  STEP(pB0,pB1,pA0,pA1,NT-1,false,false,false); RESC();
  { float sacc=pB0[0]+pB0[1]; _Pragma("unroll") for(int r=2;r<16;++r)sacc+=pB0[r]; _Pragma("unroll") for(int r=0;r<16;++r)sacc+=pB1[r]; l_reg+=sacc;
    pw0=(u32x4){PKW(pB0,0),PKW(pB0,2),PKW(pB0,4),PKW(pB0,6)};pw1=(u32x4){PKW(pB0,8),PKW(pB0,10),PKW(pB0,12),PKW(pB0,14)};pw2=(u32x4){PKW(pB1,0),PKW(pB1,2),PKW(pB1,4),PKW(pB1,6)};pw3=(u32x4){PKW(pB1,8),PKW(pB1,10),PKW(pB1,12),PKW(pB1,14)};
    SBAR(); pv(o,vb0+sl_cur,PAF(0),PAF(1),PAF(2),PAF(3)); }
  #undef PKW
  #undef PAF
  #undef VFR
  #undef PIN
  #undef MX3
  #undef GAPA
  #undef GAPB
  #undef EX
  #undef VRD
  #undef KRD
  #undef STEP
  #undef ENDW
  {auto rr=__builtin_amdgcn_permlane32_swap(__float_as_uint(l_reg),__float_as_uint(l_reg),false,false);l_reg=__uint_as_float(rr[0])+__uint_as_float(rr[1]);}
  if(hi==0)wsf[32+r32]=l_reg;asm volatile("s_waitcnt lgkmcnt(0)":::"memory");
  float rli[16];
  #pragma unroll
  for(int r=0;r<16;++r)rli[r]=__builtin_amdgcn_rcpf(wsf[32+crow(r,hi)]);
  bf16*Ow=Ou+(long)(wid*QBLK)*DM;
  { bf16*stg=(bf16*)(shm+LDS_OST)+wid*2048;
    #pragma unroll
    for(int r=0;r<16;++r){const int orow=crow(r,hi);
      #pragma unroll
      for(int d0=0;d0<2;++d0)stg[orow*64+d0*32+r32]=__float2bfloat16(o[d0][r]*rli[r]);}
    asm volatile("s_waitcnt lgkmcnt(0)":::"memory");
    #pragma unroll
    for(int i=0;i<4;++i){const int row=i*8+(lane>>3),ch=lane&7; const u32x4 v=*(const u32x4*)(stg+row*64+ch*8); ATTN_STORE16(Ow+(long)row*DM+ch*8,v);} }
  asm volatile("s_waitcnt lgkmcnt(0)\n\ts_barrier":::"memory");
  #undef TILE
  #undef DMA_K
  #undef DMA_V
  #undef CMASK
  #undef START
  #undef RESC
  #undef ROT
}
constexpr int ATTN_LDS_BYTES=LDS_BT+15*BT_STRIDE*4;
#undef SBAR
#undef WAIT_BAR
}
#define XB_TMO      128
#define XB_XCNT(j)  (256  + 64 * (j))
#define XB_XSUB(j)  (1280 + 64 * (j))
#define XB_XGEN(j)  (2304 + 64 * (j))
#define XB_TOP      3328
#define XB_TOPGEN   3392
#define XCD_BAR_WORDS 3456
#define XB_SPIN_CAP (1u << 18)

__device__ __forceinline__ unsigned xb_ld(unsigned* p)              { return __hip_atomic_load(p, __ATOMIC_RELAXED, __HIP_MEMORY_SCOPE_AGENT); }
__device__ __forceinline__ unsigned xb_add(unsigned* p, unsigned v) { return __hip_atomic_fetch_add(p, v, __ATOMIC_RELAXED, __HIP_MEMORY_SCOPE_AGENT); }
__device__ __forceinline__ unsigned xb_xcc_id() { return (unsigned)__builtin_amdgcn_s_getreg((3 << 11) | 20) & 0xFu; }
#define XB_SPIN(cond, bar) do { unsigned _sp = 0; while (cond) { __builtin_amdgcn_s_sleep(1); \
    if ((++_sp & 255u) == 0u) { if (xb_ld(&(bar)[XB_TMO])) break; if (_sp > XB_SPIN_CAP) { atomicAdd(&(bar)[XB_TMO], 1u); break; } } } } while (0)

struct XcdBarrier {
    unsigned* bar; unsigned x;
    volatile LAS unsigned* st;
};

__device__ __forceinline__ XcdBarrier xcd_barrier_post(unsigned* bar, volatile LAS unsigned* st) {
    XcdBarrier b; b.bar = bar; b.x = xb_xcc_id(); b.st = st;
    if (threadIdx.x == 0) (void)xb_add(&bar[XB_XCNT(b.x)], 1u);
    return b;
}
__device__ __forceinline__ void xcd_barrier_complete(unsigned* bar, unsigned x, unsigned& nloc, unsigned& nx) {
    const unsigned G = gridDim.x * gridDim.y * gridDim.z;
    unsigned sum, cnt, mine, sp = 0u;
    for (;;) {
        sum = 0u; cnt = 0u; mine = 0u;
#pragma unroll
        for (unsigned j = 0; j < 16; ++j) { const unsigned c = xb_ld(&bar[XB_XCNT(j)]); sum += c; cnt += (c > 0u) ? 1u : 0u; mine = (j == x) ? c : mine; }
        if (sum == G) break;
        __builtin_amdgcn_s_sleep(1);
        if ((++sp & 255u) == 0u) { if (xb_ld(&bar[XB_TMO])) break; if (sp > XB_SPIN_CAP) { atomicAdd(&bar[XB_TMO], 1u); break; } }
    }
    nloc = mine > 0u ? mine : 1u; nx = cnt > 0u ? cnt : 1u;
}

__device__ __forceinline__ void xcd_barrier(const XcdBarrier& b) {
    asm volatile("s_waitcnt vmcnt(0)" ::: "memory");
    __syncthreads();
    if (threadIdx.x == 0) {
        unsigned* bar = b.bar;
        __builtin_amdgcn_s_waitcnt(0);
        unsigned nloc = b.st[0], nx = b.st[1];
        if (nloc == 0u) { xcd_barrier_complete(bar, b.x, nloc, nx); b.st[0] = nloc; b.st[1] = nx; }
        const unsigned old = xb_add(&bar[XB_XSUB(b.x)], 1u);
        const unsigned gen = old / nloc;
        if (old + 1u == (gen + 1u) * nloc) {
            __builtin_amdgcn_fence(__ATOMIC_RELEASE, "agent");
            asm volatile("s_waitcnt vmcnt(0)" ::: "memory");
            const unsigned og = xb_add(&bar[XB_TOP], 1u);
            const unsigned tg = og / nx;
            if (og + 1u == (tg + 1u) * nx) xb_add(&bar[XB_TOPGEN], 1u);
            else XB_SPIN(xb_ld(&bar[XB_TOPGEN]) == tg, bar);
            __builtin_amdgcn_fence(__ATOMIC_ACQUIRE, "agent");
            xb_add(&bar[XB_XGEN(b.x)], 1u);
            asm volatile("s_waitcnt vmcnt(0)" ::: "memory");
        } else {
            XB_SPIN(xb_ld(&bar[XB_XGEN(b.x)]) == gen, bar);
            __builtin_amdgcn_fence(__ATOMIC_ACQUIRE, "agent");
            asm volatile("s_waitcnt vmcnt(0)" ::: "memory");
        }
    }
    __syncthreads();
}

struct Frame {
    LAS unsigned char* lds;
    volatile LAS unsigned* MISC;
    unsigned* ctl;
    int tid, lane, wave, vcu, G;
    float* out; unsigned char* ws;
};
__device__ __forceinline__ const float* inp(const Frame& F, int i) {
    const volatile LAS unsigned* t = (const volatile LAS unsigned*)(F.lds + LDSCTL_OFF + 64) + 2 * i;
    const unsigned lo = __builtin_amdgcn_readfirstlane(t[0]), hi = __builtin_amdgcn_readfirstlane(t[1]);
    return (const float*)(((unsigned long long)hi << 32) | lo);
}
enum { I_X = 0, I_C, I_CTX, I_CCTX, I_WMOD, I_BMOD, I_WIN, I_GQA, I_GKA, I_GQB, I_GKB, I_RPB, I_CONVW, I_CONVB, I_GOUT, I_WOUT, I_F1, I_F3, I_F2, I_ROUTER, I_ROUTERB, I_M1, I_M3, I_M2 };

__device__ __forceinline__ void p0_transpose_item(const float* W, int K, int N, bf16* WT, int row_off, int il, int half, LAS float* scr, int item, int lane) {
    const int nblk = N / 32, kb = item / nblk, nb = item % nblk, k0 = 64 * kb, n0 = 32 * nb;
#pragma unroll 8
    for (int i = 0; i < 32; ++i) { const int kk = 2 * i + (lane >> 5); scr[kk * 33 + (lane & 31)] = W[(size_t)(k0 + kk) * N + n0 + (lane & 31)]; }
    LDS_WAIT(); asm volatile("" ::: "memory");
    const int c = lane & 7;
    const int orow0 = il ? ((n0 >> 7) * 256 + half * 128 + (n0 & 127)) : (row_off + n0);
#pragma unroll
    for (int j = 0; j < 4; ++j) { const int n = (lane >> 3) + 8 * j; const LAS float* s = scr + (8 * c) * 33 + n;
        v4u o; o.x = pk2(s[0 * 33], s[1 * 33]); o.y = pk2(s[2 * 33], s[3 * 33]); o.z = pk2(s[4 * 33], s[5 * 33]); o.w = pk2(s[6 * 33], s[7 * 33]);
        *(GAS v4u*)(WT + (size_t)(orow0 + n) * K + k0 + 8 * c) = o; }
    LDS_WAIT(); asm volatile("" ::: "memory");
}
__device__ __forceinline__ void p0_transpose_item_f8(const float* W, int K, int N, unsigned char* WT, int il, int half, LAS float* scr, int item, int lane) {
    const int nblk = N / 32, kb = item / nblk, nb = item % nblk, k0 = 64 * kb, n0 = 32 * nb;
#pragma unroll 8
    for (int i = 0; i < 32; ++i) { const int kk = 2 * i + (lane >> 5); scr[kk * 33 + (lane & 31)] = W[(size_t)(k0 + kk) * N + n0 + (lane & 31)]; }
    LDS_WAIT(); asm volatile("" ::: "memory");
    const int c = lane & 7;
    const int orow0 = il ? ((n0 >> 7) * 256 + half * 128 + (n0 & 127)) : n0;
#pragma unroll
    for (int j = 0; j < 4; ++j) { const int n = (lane >> 3) + 8 * j; const LAS float* s = scr + (8 * c) * 33 + n;
        v2u o; o.x = pk4_f8(s[0 * 33] * 64.f, s[1 * 33] * 64.f, s[2 * 33] * 64.f, s[3 * 33] * 64.f); o.y = pk4_f8(s[4 * 33] * 64.f, s[5 * 33] * 64.f, s[6 * 33] * 64.f, s[7 * 33] * 64.f);
        *(GAS v2u*)(WT + (size_t)(orow0 + n) * K + k0 + 8 * c) = o; }
    LDS_WAIT(); asm volatile("" ::: "memory");
}
__device__ __forceinline__ float silu_f(float v) { return v / (1.0f + __expf(-v)); }

__device__ __forceinline__ void p0_prologue(Frame& F) {
    const int gw = F.vcu * NWAVES + F.wave, NGW = F.G * NWAVES;
    if (blockIdx.x == 0) {
        float* tab = (float*)(F.ws + WS_MISC + MS_ROPE);
        for (int idx = F.tid; idx < 1024; idx += NWAVES * 64) { const int pos = idx >> 4, i = idx & 15;
            const float inv = powf(10000.0f, -(float)(2 * i) / 32.0f); const float ang = (float)pos * inv;
            tab[2 * idx] = cosf(ang); tab[2 * idx + 1] = sinf(ang); }
    }
    {
        LAS float* sv = (LAS float*)F.lds;
        LAS float* red = (LAS float*)(F.lds + 17 * 1024 * 4);
        bool staged = false;
        for (int task = blockIdx.x; task < 192; task += F.G) {
            if (!staged) {
                for (int idx = F.tid; idx < 17 * 1024; idx += NWAVES * 64) { const int r = idx >> 10, k = idx & 1023; const float v = r < 16 ? inp(F, I_C)[r * 1024 + k] : inp(F, I_CCTX)[k]; sv[idx] = silu_f(v); }
                staged = true; __syncthreads();
            }
            const int l = task / 96, cb = task % 96, col = cb * 64 + F.lane;
            const float* W = inp(F, I_WMOD) + (size_t)l * 1024 * 6144 + col;
            float acc[17];
#pragma unroll
            for (int r = 0; r < 17; ++r) acc[r] = 0.f;
            const int kbeg = F.wave * 128;
#pragma unroll 4
            for (int k = kbeg; k < kbeg + 128; ++k) { const float wv = W[(size_t)k * 6144];
#pragma unroll
                for (int r = 0; r < 17; ++r) acc[r] += sv[r * 1024 + k] * wv; }
#pragma unroll
            for (int r = 0; r < 17; ++r) red[(F.wave * 17 + r) * 64 + F.lane] = acc[r];
            __syncthreads();
            for (int idx = F.tid; idx < 17 * 64; idx += NWAVES * 64) { const int r = idx >> 6, ln = idx & 63; float s = 0.f;
#pragma unroll
                for (int w = 0; w < 8; ++w) s += red[(w * 17 + r) * 64 + ln];
                const int n = cb * 64 + ln;
                ((float*)(F.ws + WS_MOD))[((size_t)l * 17 + r) * 6144 + n] = s + inp(F, I_BMOD)[l * 6144 + n]; }
            __syncthreads();
        }
        __syncthreads();
    }
    {
        LAS float* scr = (LAS float*)(F.lds + F.wave * 16384);
        constexpr int IT_IN = 16 * 72, IT_OUT = 16 * 32, IT_F = 1408;
        constexpr int NITEMS = 2 * IT_IN + 2 * IT_OUT + 3 * IT_F + 24 * IT_F;
        for (int it = gw; it < NITEMS; it += NGW) {
            int r = it;
            if (r < 2 * IT_IN) { const int l = r / IT_IN; p0_transpose_item(inp(F, I_WIN) + (size_t)l * 1024 * INW, 1024, INW, (bf16*)(F.ws + WS_WIN) + (size_t)l * INW * 1024, 0, 0, 0, scr, r % IT_IN, F.lane); continue; } r -= 2 * IT_IN;
            if (r < 2 * IT_OUT) { const int l = r / IT_OUT; p0_transpose_item(inp(F, I_WOUT) + (size_t)l * 1024 * 1024, 1024, 1024, (bf16*)(F.ws + WS_WOUT) + (size_t)l * 1024 * 1024, 0, 0, 0, scr, r % IT_OUT, F.lane); continue; } r -= 2 * IT_OUT;
            if (r < IT_F) { p0_transpose_item(inp(F, I_F1), 1024, DFF, (bf16*)(F.ws + WS_F13), 0, 1, 0, scr, r, F.lane); continue; } r -= IT_F;
            if (r < IT_F) { p0_transpose_item(inp(F, I_F3), 1024, DFF, (bf16*)(F.ws + WS_F13), 0, 1, 1, scr, r, F.lane); continue; } r -= IT_F;
            if (r < IT_F) { p0_transpose_item(inp(F, I_F2), DFF, 1024, (bf16*)(F.ws + WS_F2), 0, 0, 0, scr, r, F.lane); continue; } r -= IT_F;
            { const int e = r / (3 * IT_F), q = r % (3 * IT_F), which = q / IT_F, item = q % IT_F;
              if (which == 0) p0_transpose_item_f8(inp(F, I_M1) + (size_t)e * 1024 * DFF, 1024, DFF, F.ws + WS_M13 + (size_t)e * 5632 * 1024, 1, 0, scr, item, F.lane);
              else if (which == 1) p0_transpose_item_f8(inp(F, I_M3) + (size_t)e * 1024 * DFF, 1024, DFF, F.ws + WS_M13 + (size_t)e * 5632 * 1024, 1, 1, scr, item, F.lane);
              else p0_transpose_item_f8(inp(F, I_M2) + (size_t)e * DFF * 1024, DFF, 1024, F.ws + WS_M2 + (size_t)e * 1024 * DFF, 0, 0, scr, item, F.lane); }
        }
    }
}

__device__ __forceinline__ const float* xrow_ptr(const float* lat, const float* ctx, int s) { const int b = s / TPB, j = s % TPB; return j < SEQ ? lat + (size_t)(b * SEQ + j) * DM : ctx + (size_t)(b * CTXL + j - SEQ) * DM; }

__device__ __forceinline__ void norm_mod_rows(Frame& F, const float* lat, const float* ctx, const float* mod, int shoff, int scoff, bf16* XN, bool with_ctx) {
    const int gw = F.vcu * NWAVES + F.wave, NGW = F.G * NWAVES;
    for (int s = gw; s < MROWS; s += NGW) {
        const int b = s / TPB, j = s % TPB; if (!with_ctx && j >= SEQ) continue;
        const GAS f32x4* xr = (const GAS f32x4*)xrow_ptr(lat, ctx, s) + F.lane;
        const float* mrow = mod + (size_t)(j < SEQ ? b : 16) * 6144;
        f32x4 v[4]; float ss = 0.f;
#pragma unroll
        for (int q = 0; q < 4; ++q) { v[q] = xr[64 * q]; ss += (v[q].x * v[q].x + v[q].y * v[q].y) + (v[q].z * v[q].z + v[q].w * v[q].w); }
        const float rstd = 1.0f / sqrtf(wave_sum(ss) * (1.0f / DM) + NORM_EPS);
        GAS v2u* o8 = (GAS v2u*)(XN + (size_t)s * DM) + F.lane;
#pragma unroll
        for (int q = 0; q < 4; ++q) { const f32x4 sh = *(const f32x4*)(mrow + shoff + 4 * F.lane + 256 * q), sc = *(const f32x4*)(mrow + scoff + 4 * F.lane + 256 * q);
            const f32x4 y = v[q] * rstd * (sc + 1.0f) + sh; v2u w; w.x = pk2(y.x, y.y); w.y = pk2(y.z, y.w); o8[64 * q] = w; }
    }
}

__device__ __forceinline__ void headnorm_rows(Frame& F, int l, bool ctx_q) {
    const int gw = F.vcu * NWAVES + F.wave, NGW = F.G * NWAVES; bf16* P = (bf16*)(F.ws + WS_P);
    const float* tab = (const float*)(F.ws + WS_MISC + MS_ROPE);
    const int d = F.lane;
    const float gqa = inp(F, I_GQA)[l * 64 + d], gka = inp(F, I_GKA)[l * 64 + d], gqb = inp(F, I_GQB)[l * 64 + d], gkb = inp(F, I_GKB)[l * 64 + d];
    for (int s = gw; s < MROWS; s += NGW) {
        const int j = s % TPB; const bool lat = j < SEQ; bf16* p = P + (size_t)s * INW;
        float cs = 1.f, sn = 0.f;
        if (lat) { const int pos = (d < 32) ? (j >> 6) : (j & 63); const int i = d & 15; cs = tab[2 * (pos * 16 + i)]; sn = tab[2 * (pos * 16 + i) + 1]; }
        const float sgn = (d & 16) ? 1.f : -1.f;
#pragma unroll 1
        for (int h = 0; h < 18; ++h) {
            int off; float g; bool rope, isq;
            if (h < 8) { off = QA_OFF + 64 * h; g = gqa; rope = true; isq = true; }
            else if (h < 12) { off = QB_OFF + 64 * (h - 8); g = gqb; rope = false; isq = true; }
            else if (h < 14) { off = KA_OFF + 64 * (h - 12); g = gka; rope = true; isq = false; }
            else { off = KB_OFF + 64 * (h - 14); g = gkb; rope = false; isq = false; }
            if (isq && !lat && !ctx_q) continue;
            const float v = bf1(p[off + d]);
            const float ss = wave_sum(v * v);
            float y = v * (1.0f / sqrtf(ss * (1.0f / 64.0f) + NORM_EPS)) * g;
            const float pr = __shfl_xor(y, 16);
            if (rope && lat) y = y * cs + sgn * pr * sn;
            if (isq) y *= C2;
            p[off + d] = (bf16)f2bf(y);
        }
    }
}

#ifdef ATTN_NAIVE
struct NaiveState { float q[64], o[64], m, l; };
__device__ __forceinline__ void na_load_q(NaiveState& S, const bf16* qp) {
#pragma unroll
    for (int c = 0; c < 8; ++c) { const v4u w = *(const v4u*)(qp + 8 * c);
        S.q[8 * c + 0] = bflo(w.x); S.q[8 * c + 1] = bfhi(w.x); S.q[8 * c + 2] = bflo(w.y); S.q[8 * c + 3] = bfhi(w.y);
        S.q[8 * c + 4] = bflo(w.z); S.q[8 * c + 5] = bfhi(w.z); S.q[8 * c + 6] = bflo(w.w); S.q[8 * c + 7] = bfhi(w.w); }
#pragma unroll
    for (int i = 0; i < 64; ++i) S.o[i] = 0.f;
    S.m = -1e30f; S.l = 0.f;
}
__device__ __forceinline__ float na_dot(const NaiveState& S, const bf16* kp) {
    float s = 0.f;
#pragma unroll
    for (int c = 0; c < 8; ++c) { const v4u w = *(const v4u*)(kp + 8 * c);
        s += S.q[8 * c + 0] * bflo(w.x) + S.q[8 * c + 1] * bfhi(w.x) + S.q[8 * c + 2] * bflo(w.y) + S.q[8 * c + 3] * bfhi(w.y)
           + S.q[8 * c + 4] * bflo(w.z) + S.q[8 * c + 5] * bfhi(w.z) + S.q[8 * c + 6] * bflo(w.w) + S.q[8 * c + 7] * bfhi(w.w); }
    return s;
}
__device__ __forceinline__ void na_acc(NaiveState& S, float p, const bf16* vp) {
#pragma unroll
    for (int c = 0; c < 8; ++c) { const v4u w = *(const v4u*)(vp + 8 * c);
        S.o[8 * c + 0] += p * bflo(w.x); S.o[8 * c + 1] += p * bfhi(w.x); S.o[8 * c + 2] += p * bflo(w.y); S.o[8 * c + 3] += p * bfhi(w.y);
        S.o[8 * c + 4] += p * bflo(w.z); S.o[8 * c + 5] += p * bfhi(w.z); S.o[8 * c + 6] += p * bflo(w.w); S.o[8 * c + 7] += p * bfhi(w.w); }
}
__device__ __forceinline__ void na_step2(NaiveState& S, float s0, float s1, const bf16* v0, const bf16* v1) {
    const float mn = fmaxf(S.m, fmaxf(s0, s1));
    const float sc = __builtin_amdgcn_exp2f(S.m - mn), p0 = __builtin_amdgcn_exp2f(s0 - mn), p1 = __builtin_amdgcn_exp2f(s1 - mn);
    S.l = S.l * sc + p0 + p1; S.m = mn;
#pragma unroll
    for (int i = 0; i < 64; ++i) S.o[i] *= sc;
    na_acc(S, p0, v0); na_acc(S, p1, v1);
}
__device__ __forceinline__ void na_store(const NaiveState& S, bf16* op) {
    const float inv = 1.0f / S.l;
#pragma unroll
    for (int c = 0; c < 8; ++c) { v4u w; w.x = pk2(S.o[8 * c + 0] * inv, S.o[8 * c + 1] * inv); w.y = pk2(S.o[8 * c + 2] * inv, S.o[8 * c + 3] * inv);
        w.z = pk2(S.o[8 * c + 4] * inv, S.o[8 * c + 5] * inv); w.w = pk2(S.o[8 * c + 6] * inv, S.o[8 * c + 7] * inv); *(v4u*)(op + 8 * c) = w; }
}
__device__ __forceinline__ void attn_naive_phase(Frame& F, int l, bool with_ctx) {
    const int gw = F.vcu * NWAVES + F.wave, NGW = F.G * NWAVES; bf16* P = (bf16*)(F.ws + WS_P);
    const float* rpb = inp(F, I_RPB) + (size_t)l * 4 * 15 * 31;
    const int ntask = with_ctx ? 6912 : 6144;
    for (int task = gw; task < ntask; task += NGW) {
        NaiveState S;
        if (task < 4096 || (task >= 6144 && task < 6656)) {
            int b, qh, j0, k0, k1;
            if (task < 4096) { b = task >> 8; qh = (task >> 5) & 7; j0 = (task & 31) * 64; k0 = 0; k1 = TPB; }
            else { const int t = task - 6144; b = t >> 5; qh = (t >> 2) & 7; j0 = SEQ + (t & 3) * 64; k0 = SEQ; k1 = TPB; }
            bf16* qp = P + (size_t)(b * TPB + j0 + F.lane) * INW + QA_OFF + qh * 64;
            na_load_q(S, qp);
            const bf16* Kb = P + (size_t)(b * TPB) * INW + KA_OFF + (qh >> 2) * 64; const bf16* Vb = P + (size_t)(b * TPB) * INW + VA_OFF + (qh >> 2) * 64;
            for (int k = k0; k < k1; k += 2) { const float s0 = na_dot(S, Kb + (size_t)k * INW), s1 = na_dot(S, Kb + (size_t)(k + 1) * INW); na_step2(S, s0, s1, Vb + (size_t)k * INW, Vb + (size_t)(k + 1) * INW); }
            na_store(S, qp);
        } else {
            int b, h, j; bool lat;
            if (task < 6144) { const int t = task - 4096; b = t >> 7; h = (t >> 5) & 3; j = (t & 31) * 64 + F.lane; lat = true; }
            else { const int t = task - 6656; b = t >> 4; h = (t >> 2) & 3; j = SEQ + (t & 3) * 64 + F.lane; lat = false; }
            bf16* qp = P + (size_t)(b * TPB + j) * INW + QB_OFF + h * 64;
            na_load_q(S, qp);
            const bf16* Kb = P + (size_t)(b * TPB) * INW + KB_OFF + h * 64; const bf16* Vb = P + (size_t)(b * TPB) * INW + VB_OFF + h * 64;
            if (lat) {
                const int r = j >> 6, c = j & 63; int rs = r - 4; rs = rs < 0 ? 0 : (rs > 24 ? 24 : rs); int cs = c - 8; cs = cs < 0 ? 0 : (cs > 48 ? 48 : cs);
                for (int i = 0; i < 8; ++i) { const int kr = rs + i; const float* brow = rpb + (h * 15 + (kr - r + 7)) * 31 + (15 - c);
                    for (int jc = 0; jc < 16; jc += 2) { const int kc = cs + jc; const int k = kr * 64 + kc;
                        const float s0 = na_dot(S, Kb + (size_t)k * INW) + brow[kc] * LOG2E, s1 = na_dot(S, Kb + (size_t)(k + 1) * INW) + brow[kc + 1] * LOG2E;
                        na_step2(S, s0, s1, Vb + (size_t)k * INW, Vb + (size_t)(k + 1) * INW); } }
            }
            for (int k = SEQ; k < TPB; k += 2) { const float s0 = na_dot(S, Kb + (size_t)k * INW), s1 = na_dot(S, Kb + (size_t)(k + 1) * INW); na_step2(S, s0, s1, Vb + (size_t)k * INW, Vb + (size_t)(k + 1) * INW); }
            na_store(S, qp);
        }
    }
}


#endif
__device__ __forceinline__ void attn_mfma_phase(Frame& F, int l, bool with_ctx, char* ldsg) {
    typedef attn_body::bf16 abf;
    abf* P = (abf*)(F.ws + WS_P); const int v = F.vcu;
    const int NA = 1024 + (with_ctx ? 192 : 0);
#pragma unroll 1
    for (int u = v; u < NA; u += F.G) {
        int b, qcol, kcol, vcol, qrow, NT, first0;
        if (u < 1024) { b = u >> 6; const int kvh = (u >> 5) & 1, qh = kvh * 4 + ((u >> 3) & 3); qrow = (u & 7) * 256; qcol = QA_OFF + qh * 64; kcol = KA_OFF + kvh * 64; vcol = VA_OFF + kvh * 64; NT = 36; first0 = 0; }
        else if (u < 1024 + 128) { const int t = u - 1024; b = t >> 3; const int qh = t & 7; qrow = SEQ; qcol = QA_OFF + qh * 64; kcol = KA_OFF + (qh >> 2) * 64; vcol = VA_OFF + (qh >> 2) * 64; NT = 4; first0 = 32; }
        else { const int t = u - 1152; b = t >> 2; const int h = t & 3; qrow = SEQ; qcol = QB_OFF + h * 64; kcol = KB_OFF + h * 64; vcol = VB_OFF + h * 64; NT = 4; first0 = 32; }
        abf* Qu = P + (size_t)(b * TPB + qrow) * INW + qcol; const abf* Kh = P + (size_t)(b * TPB) * INW + kcol; const abf* Vh = P + (size_t)(b * TPB) * INW + vcol;
        attn_body::attn_unit<8, false>(Qu, Kh, Vh, Qu, NT, NT, first0, 0, 0, nullptr, ldsg, F.wave);
    }
#ifndef NO_BSITE
    const float* rpbl = inp(F, I_RPB) + (size_t)l * 4 * 15 * 31;
#pragma unroll 1
    for (int u = v; u < 512; u += F.G) {
        const int b = u >> 5, h = (u >> 3) & 3, qb = u & 7, qg = 4 * qb;
        const int n0 = (qb == 0 || qb == 7) ? 8 : 12, s0 = qb == 0 ? 0 : (qb == 7 ? 24 : qg - 4);
        abf* Qu = P + (size_t)(b * TPB + qb * 256) * INW + QB_OFF + h * 64; const abf* Kh = P + (size_t)(b * TPB) * INW + KB_OFF + h * 64; const abf* Vh = P + (size_t)(b * TPB) * INW + VB_OFF + h * 64;
        attn_body::attn_unit<8, true>(Qu, Kh, Vh, Qu, 4 + n0, 4, 32, s0, qg, rpbl + h * 15 * 31, ldsg, F.wave);
    }
#endif
}

__device__ __forceinline__ void unpack8(const v4u w, float (&v)[8]) { v[0] = bflo(w.x); v[1] = bfhi(w.x); v[2] = bflo(w.y); v[3] = bfhi(w.y); v[4] = bflo(w.z); v[5] = bfhi(w.z); v[6] = bflo(w.w); v[7] = bfhi(w.w); }
__device__ __forceinline__ void merge_rows(Frame& F, int l, bool with_ctx) {
    const int gw = F.vcu * NWAVES + F.wave, NGW = F.G * NWAVES; const bf16* P = (const bf16*)(F.ws + WS_P); bf16* CAT = (bf16*)(F.ws + WS_XN);
    const float* gout = inp(F, I_GOUT) + l * 1024; const float* cw = inp(F, I_CONVW) + l * 3 * 256; const float* cb = inp(F, I_CONVB) + l * 256;
    const int lane = F.lane;
    for (int s = gw; s < MROWS; s += NGW) {
        const int j = s % TPB; const bool lat = j < SEQ; if (!with_ctx && !lat) continue;
        const bf16* p = P + (size_t)s * INW;
        float va[8], vb[8];
        unpack8(*(const v4u*)(p + 8 * lane), va);
        if (lane < 32) unpack8(*(const v4u*)(p + 512 + 8 * lane), vb);
        else {
            const int ch0 = 8 * (lane - 32); const int jlo = lat ? 0 : SEQ, jhi = lat ? SEQ : TPB;
            float post[8], y[8];
            unpack8(*(const v4u*)(p + CPOST_OFF + ch0), post);
#pragma unroll
            for (int k = 0; k < 8; ++k) y[k] = cb[ch0 + k];
#pragma unroll
            for (int tap = 0; tap < 3; ++tap) { const int jj = j + tap - 1;
                if (jj >= jlo && jj < jhi) { const bf16* pp = p + (ptrdiff_t)(tap - 1) * INW; float a[8], c[8]; unpack8(*(const v4u*)(pp + CPRE_OFF + ch0), a); unpack8(*(const v4u*)(pp + CVAL_OFF + ch0), c);
#pragma unroll
                    for (int k = 0; k < 8; ++k) y[k] += cw[tap * 256 + ch0 + k] * (a[k] * c[k]); } }
#pragma unroll
            for (int k = 0; k < 8; ++k) vb[k] = post[k] * y[k];
        }
        float sa = 0.f, sb = 0.f;
#pragma unroll
        for (int k = 0; k < 8; ++k) { sa += va[k] * va[k]; sb += vb[k] * vb[k]; }
        const float ra = 1.0f / sqrtf(wave_sum(sa) * (1.0f / 512.0f) + NORM_EPS), rb = 1.0f / sqrtf(half_sum(sb) * (1.0f / 256.0f) + NORM_EPS);
        v4u oa, ob; float g[8];
#pragma unroll
        for (int k = 0; k < 8; ++k) g[k] = gout[8 * lane + k];
        oa.x = pk2(va[0] * ra * g[0], va[1] * ra * g[1]); oa.y = pk2(va[2] * ra * g[2], va[3] * ra * g[3]); oa.z = pk2(va[4] * ra * g[4], va[5] * ra * g[5]); oa.w = pk2(va[6] * ra * g[6], va[7] * ra * g[7]);
#pragma unroll
        for (int k = 0; k < 8; ++k) g[k] = gout[512 + 8 * lane + k];
        ob.x = pk2(vb[0] * rb * g[0], vb[1] * rb * g[1]); ob.y = pk2(vb[2] * rb * g[2], vb[3] * rb * g[3]); ob.z = pk2(vb[4] * rb * g[4], vb[5] * rb * g[5]); ob.w = pk2(vb[6] * rb * g[6], vb[7] * rb * g[7]);
        *(v4u*)(CAT + (size_t)s * DM + 8 * lane) = oa; *(v4u*)(CAT + (size_t)s * DM + 512 + 8 * lane) = ob;
    }
}

__device__ __forceinline__ void moe_route(Frame& F, const float* mod) {
    const float* X = F.out; unsigned char* XT = F.ws + WS_XT8;
    int* tok_e = (int*)(F.ws + WS_MISC + MS_TOKE); float* tok_g = (float*)(F.ws + WS_MISC + MS_TOKG);
    const float* wr = inp(F, I_ROUTER); const float* br = inp(F, I_ROUTERB);
    LAS int* le = (LAS int*)F.lds;
    for (int ch = blockIdx.x; ch < NTOK / 128; ch += F.G) {
        for (int i = 0; i < 16; ++i) {
            const int tl = F.wave * 16 + i, tok = ch * 128 + tl, b = tok / SEQ;
            const GAS f32x4* xr = (const GAS f32x4*)(X + (size_t)tok * DM) + F.lane; const float* mrow = mod + (size_t)b * 6144;
            f32x4 v[4]; float ss = 0.f;
#pragma unroll
            for (int q = 0; q < 4; ++q) { v[q] = xr[64 * q]; ss += (v[q].x * v[q].x + v[q].y * v[q].y) + (v[q].z * v[q].z + v[q].w * v[q].w); }
            const float rstd = 1.0f / sqrtf(wave_sum(ss) * (1.0f / DM) + NORM_EPS);
            float lg[8];
#pragma unroll
            for (int e = 0; e < 8; ++e) lg[e] = 0.f;
            GAS unsigned* o4 = (GAS unsigned*)(XT + (size_t)tok * DM) + F.lane;
#pragma unroll
            for (int q = 0; q < 4; ++q) { const int col = 4 * F.lane + 256 * q; const f32x4 sh = *(const f32x4*)(mrow + 3072 + col), sc = *(const f32x4*)(mrow + 4096 + col);
                const f32x4 y = v[q] * rstd * (sc + 1.0f) + sh; o4[64 * q] = pk4_f8(y.x, y.y, y.z, y.w);
#pragma unroll
                for (int k = 0; k < 4; ++k) { const f32x4 w0 = *(const f32x4*)(wr + (size_t)(col + k) * 8), w1 = *(const f32x4*)(wr + (size_t)(col + k) * 8 + 4); const float yk = y[k];
                    lg[0] += yk * w0.x; lg[1] += yk * w0.y; lg[2] += yk * w0.z; lg[3] += yk * w0.w; lg[4] += yk * w1.x; lg[5] += yk * w1.y; lg[6] += yk * w1.z; lg[7] += yk * w1.w; } }
#pragma unroll
            for (int e = 0; e < 8; ++e) lg[e] = wave_sum(lg[e]) + br[e];
            int e0 = 0; float v0 = lg[0];
#pragma unroll
            for (int e = 1; e < 8; ++e) if (lg[e] > v0) { v0 = lg[e]; e0 = e; }
            int e1 = -1; float v1 = -3.0e38f;
#pragma unroll
            for (int e = 0; e < 8; ++e) if (e != e0 && lg[e] > v1) { v1 = lg[e]; e1 = e; }
            const float p1 = __expf(v1 - v0), g0 = 1.0f / (1.0f + p1), g1 = p1 / (1.0f + p1);
            if (F.lane == 0) { tok_e[2 * tok] = e0; tok_e[2 * tok + 1] = e1; tok_g[2 * tok] = g0; tok_g[2 * tok + 1] = g1; le[2 * tl] = e0; le[2 * tl + 1] = e1; }
        }
        __syncthreads();
        if (F.tid < 8) { int n = 0; for (int a = 0; a < 256; ++a) n += (le[a] == F.tid) ? 1 : 0; F.ctl[CW_CNT + ch * 8 + F.tid] = (unsigned)n; }
        __syncthreads();
    }
}
__device__ __forceinline__ void moe_sort_scatter(Frame& F) {
    const unsigned char* XT = F.ws + WS_XT8; unsigned char* XS = F.ws + WS_XS8;
    const int* tok_e = (const int*)(F.ws + WS_MISC + MS_TOKE); const float* tok_g = (const float*)(F.ws + WS_MISC + MS_TOKG);
    int* tok_s = (int*)(F.ws + WS_MISC + MS_TOKS); float* slot_g = (float*)(F.ws + WS_MISC + MS_SLOTG); int* meta = (int*)(F.ws + WS_MISC + MS_META);
    LAS int* ltot = (LAS int*)F.lds; LAS int* lpre = ltot + 8; LAS int* lslot = ltot + 16; LAS int* lex = ltot + 16 + 256;
    for (int ch = blockIdx.x; ch < NTOK / 128; ch += F.G) {
        if (F.tid < 8) { int tot = 0, pre = 0; for (int c2 = 0; c2 < NTOK / 128; ++c2) { const int n = (int)F.ctl[CW_CNT + c2 * 8 + F.tid]; tot += n; pre += (c2 < ch) ? n : 0; } ltot[F.tid] = tot; lpre[F.tid] = pre; }
        if (F.tid < 256) lex[F.tid] = tok_e[2 * (ch * 128) + F.tid];
        __syncthreads();
        int pstart[9]; pstart[0] = 0;
#pragma unroll
        for (int e = 0; e < 8; ++e) pstart[e + 1] = pstart[e] + ((ltot[e] + 255) & ~255);
        if (F.tid < 8) { int base = 0;
#pragma unroll
            for (int e = 0; e < 8; ++e) if (e == F.tid) base = pstart[e] + lpre[e];
            for (int a = 0; a < 256; ++a) { if (lex[a] == F.tid) { lslot[a] = base; ++base; } } }
        __syncthreads();
        if (F.tid < 256) { const int slot = lslot[F.tid]; tok_s[2 * (ch * 128) + F.tid] = slot; slot_g[slot] = tok_g[2 * (ch * 128) + F.tid]; }
        for (int a = F.wave; a < 256; a += NWAVES) { const int tok = ch * 128 + (a >> 1), slot = lslot[a];
            const GAS v4u* src = (const GAS v4u*)(XT + (size_t)tok * DM) + F.lane; GAS v4u* dst = (GAS v4u*)(XS + (size_t)slot * DM) + F.lane;
            dst[0] = src[0]; }
        if (ch < 8) {
            int p0 = 0, p1 = 0;
#pragma unroll
            for (int e = 0; e < 8; ++e) if (e == ch) { p0 = pstart[e] + ltot[e]; p1 = pstart[e + 1]; }
            for (int r = p0 + F.wave; r < p1; r += NWAVES) { GAS v4u* dst = (GAS v4u*)(XS + (size_t)r * DM) + F.lane; dst[0] = (v4u){0u, 0u, 0u, 0u}; if (F.lane == 0) slot_g[r] = 0.f; }
        }
        if (ch == 0 && F.tid == 0) {
#pragma unroll
            for (int e = 0; e < 8; ++e) meta[e] = pstart[e + 1] >> 8;
        }
        __syncthreads();
    }
}
__device__ __forceinline__ void moe_combine(Frame& F, const float* mod) {
    const int gw = F.vcu * NWAVES + F.wave, NGW = F.G * NWAVES; const bf16* Y = (const bf16*)(F.ws + WS_XN); const int* tok_s = (const int*)(F.ws + WS_MISC + MS_TOKS);
    for (int tok = gw; tok < NTOK; tok += NGW) {
        const int b = tok / SEQ, s0 = tok_s[2 * tok], s1 = tok_s[2 * tok + 1];
        GAS f32x4* xr = (GAS f32x4*)(F.out + (size_t)tok * DM) + F.lane; const float* g = mod + (size_t)b * 6144 + 5120;
        const GAS v2u* y0 = (const GAS v2u*)(Y + (size_t)s0 * DM) + F.lane; const GAS v2u* y1 = (const GAS v2u*)(Y + (size_t)s1 * DM) + F.lane;
#pragma unroll
        for (int q = 0; q < 4; ++q) { const f32x4 x = xr[64 * q]; const f32x4 gv = *(const f32x4*)(g + 4 * F.lane + 256 * q); const v2u a = y0[64 * q], c = y1[64 * q];
            f32x4 y; y.x = bflo(a.x) + bflo(c.x); y.y = bfhi(a.x) + bfhi(c.x); y.z = bflo(a.y) + bflo(c.y); y.w = bfhi(a.y) + bfhi(c.y);
            xr[64 * q] = x + gv * y; }
    }
}

struct Args { const float* in[24]; float* out; unsigned char* ws; int ph_lo, ph_hi, li, pad; };
__global__ void __launch_bounds__(NWAVES * 64, 2) mk_fwd(Args args) {
    extern __shared__ __attribute__((aligned(16))) unsigned char lds[];
    Frame F;
    F.lds = (LAS unsigned char*)lds; F.MISC = (volatile LAS unsigned*)(F.lds + MISC_OFF);
    F.tid = threadIdx.x; F.lane = F.tid & 63; F.wave = __builtin_amdgcn_readfirstlane(F.tid >> 6);
    F.G = gridDim.x; { const int bx = blockIdx.x; F.vcu = (F.G % 8 == 0) ? (bx % 8) * (F.G / 8) + bx / 8 : bx; }
    F.out = args.out; F.ws = args.ws; F.ctl = (unsigned*)(args.ws + WS_CTL);
    for (int u = F.tid; u < (LDS_BYTES - LDSCTL_OFF) / 4; u += NWAVES * 64) ((LAS unsigned*)(F.lds + LDSCTL_OFF))[u] = 0u;
    __syncthreads();
    if (F.tid < 24) { const unsigned long long p = (unsigned long long)args.in[F.tid]; LAS unsigned* t = (LAS unsigned*)(F.lds + LDSCTL_OFF + 64) + 2 * F.tid; t[0] = (unsigned)p; t[1] = (unsigned)(p >> 32); }
    __syncthreads();
    XcdBarrier bar; bar.bar = F.ctl + CW_BAR; bar.x = 0; bar.st = nullptr;
    if (MK_N_LAUNCHES == 1) bar = xcd_barrier_post(F.ctl + CW_BAR, F.MISC + 8);
    const int lo = args.ph_lo, hi = args.ph_hi;
#ifndef PHMASK
#define PHMASK 0xFFFFFFFFu
#endif
#define PHON(k) (((PHMASK) >> (k)) & 1u)
#define IN(k) (PHON(k) && lo <= (k) && (k) < hi)
#define INL(x) ((((PHMASK) >> (1 + (x))) & 1u) && lo <= pb + (x) && pb + (x) < hi)
#define INR(k) (lo <= (k) && (k) < hi)
#define SEAM(k) do { if (INR(k) && INR((k) + 1)) xcd_barrier(bar); } while (0)
    float* XC = (float*)(F.ws + WS_XC); bf16* XN = (bf16*)(F.ws + WS_XN); bf16* P = (bf16*)(F.ws + WS_P);
    const float* MOD = (const float*)(F.ws + WS_MOD);
#define TABMEM (F.lds + LDSCTL_OFF + 448)
#define PF() do { int ln_ = (int)__builtin_amdgcn_mbcnt_hi(~0u, __builtin_amdgcn_mbcnt_lo(~0u, 0u)); asm volatile("" : "+v"(ln_)); F.lane = ln_; F.tid = F.wave * 64 + ln_; } while (0)

    if (IN(0)) { PF(); p0_prologue(F); } SEAM(0);

#pragma unroll 1
    for (int l = 0; l < 2; ++l) {
        const int pb = 1 + 9 * l; const bool last = (l == 1);
        const float* mod = MOD + (size_t)l * 17 * 6144;
        const float* xlat = last ? F.out : inp(F, I_X); const float* xctx = last ? XC : inp(F, I_CTX);
        if (INL(0)) { PF(); norm_mod_rows(F, xlat, xctx, mod, 0, 1024, XN, true); } SEAM(pb + 0);
        if (INL(1)) { PF();
            pg8::Gemm g{XN, (const bf16*)(F.ws + WS_WIN) + (size_t)l * INW * 1024, MROWS, INW, 1024};
            const pg8::TabOrder T = last ? pg8::build_units(TABMEM, 1024, XN, g.Bt, F.G, (int)blockIdx.x, 128, 9, 0, 1, 0, 16, 3, 6, 2, nullptr, 0, F.tid)
                                         : pg8::build_units(TABMEM, 1024, XN, g.Bt, F.G, (int)blockIdx.x, NPAN, 9, 0, 0, 0, 0, 1, 0, 0, nullptr, 0, F.tid);
#ifdef SEPARATE_HN
            pg8::EpiRawBf16 E{P, INW};
            pg8::gemm_phase<pg8::EpiRawBf16, pg8::TabOrder, true, true>(F.lds, g, T, E, F.wave);
#else
            pg8::EpiHeads E{P, inp(F, I_GQA) + l * 64, inp(F, I_GKA) + l * 64, inp(F, I_GQB) + l * 64, inp(F, I_GKB) + l * 64, (const float*)(F.ws + WS_MISC + MS_ROPE)};
            pg8::gemm_phase<pg8::EpiHeads, pg8::TabOrder, true, true>(F.lds, g, T, E, F.wave);
#endif
        } SEAM(pb + 1);
#ifdef SEPARATE_HN
        if (INL(2)) { PF(); headnorm_rows(F, l, !last); } SEAM(pb + 2);
#endif
        #ifdef ATTN_NAIVE
        if (INL(3)) { PF(); attn_naive_phase(F, l, !last); } SEAM(pb + 3);
#else
        if (INL(3)) { PF(); attn_mfma_phase(F, l, !last, (char*)lds); } SEAM(pb + 3);
#endif
        if (INL(4)) { PF(); merge_rows(F, l, !last); } SEAM(pb + 4);
        if (INL(5)) { PF();
            pg8::Gemm g{XN, (const bf16*)(F.ws + WS_WOUT) + (size_t)l * 1024 * 1024, MROWS, 1024, 1024};
            const pg8::TabOrder T = pg8::build_units(TABMEM, 1024, XN, g.Bt, F.G, (int)blockIdx.x, last ? 128 : NPAN, 4, 0, last ? 1 : 0, 0, 0, 1, 0, 0, nullptr, 0, F.tid);
            pg8::EpiGateRes E{xlat, xctx, F.out, XC, mod, 2048};
            pg8::gemm_phase<pg8::EpiGateRes, pg8::TabOrder, true, true>(F.lds, g, T, E, F.wave);
        } SEAM(pb + 5);
        if (!last) {
            if (IN(7)) { PF(); norm_mod_rows(F, F.out, XC, mod, 3072, 4096, XN, true); } SEAM(7);
            if (IN(8)) { PF();
                pg8::Gemm g{XN, (const bf16*)(F.ws + WS_F13), MROWS, 5632, 1024};
                const pg8::TabOrder T = pg8::build_units(TABMEM, 1024, XN, g.Bt, F.G, (int)blockIdx.x, NPAN, 22, 0, 0, 0, 0, 1, 0, 0, nullptr, 0, F.tid);
                pg8::EpiSwiglu E{P, DFF, 0};
                pg8::gemm_phase<pg8::EpiSwiglu, pg8::TabOrder, true, true>(F.lds, g, T, E, F.wave);
            } SEAM(8);
            if (IN(9)) { PF();
                pg8::Gemm g{P, (const bf16*)(F.ws + WS_F2), MROWS, 1024, DFF};
                const pg8::TabOrder T = pg8::build_units(TABMEM, DFF, P, g.Bt, F.G, (int)blockIdx.x, NPAN, 4, 0, 0, 0, 0, 1, 0, 0, nullptr, 0, F.tid);
                pg8::EpiGateRes E{F.out, XC, F.out, XC, mod, 5120};
                pg8::gemm_phase<pg8::EpiGateRes, pg8::TabOrder, true, true>(F.lds, g, T, E, F.wave);
            } SEAM(9);
        }
    }
    {
        const float* mod = MOD + (size_t)17 * 6144;
        if (IN(16)) { PF(); moe_route(F, mod); } SEAM(16);
        if (IN(17)) { PF(); moe_sort_scatter(F); } SEAM(17);
        const int* meta = (const int*)(F.ws + WS_MISC + MS_META);
        if (IN(18)) { PF();
            const int TP = __builtin_amdgcn_readfirstlane(meta[7]);
            pg8::Gemm g{(const bf16*)(F.ws + WS_XS8), (const bf16*)(F.ws + WS_M13), 0, 5632, 512};
            const pg8::TabOrder T = pg8::build_units(TABMEM, 512, g.A, g.Bt, F.G, (int)blockIdx.x, TP, 22, 0, 0, 0, 0, 1, 0, 0, meta, (size_t)5632 * 1024, F.tid);
            pg8::EpiSwigluF8 E{F.ws + WS_H8, DFF, 1.0f / 64.0f};
            pg8::gemm_phase<pg8::EpiSwigluF8, pg8::TabOrder, true, true, true>(F.lds, g, T, E, F.wave);
        } SEAM(18);
        if (IN(19)) { PF();
            const int TP = __builtin_amdgcn_readfirstlane(meta[7]);
            pg8::Gemm g{(const bf16*)(F.ws + WS_H8), (const bf16*)(F.ws + WS_M2), 0, 1024, DFF / 2};
            const pg8::TabOrder T = pg8::build_units(TABMEM, DFF / 2, g.A, g.Bt, F.G, (int)blockIdx.x, TP, 4, 0, 0, 0, 0, 1, 0, 0, meta, (size_t)1024 * DFF, F.tid);
            pg8::EpiMoeOut E{XN, (const float*)(F.ws + WS_MISC + MS_SLOTG), 1.0f / 64.0f};
            pg8::gemm_phase<pg8::EpiMoeOut, pg8::TabOrder, true, true, true>(F.lds, g, T, E, F.wave);
        } SEAM(19); SEAM(20); SEAM(21);
        if (IN(22)) { PF(); moe_combine(F, mod); }
    }
#undef IN
#undef SEAM
}

extern "C" void kernel_launch(void* const* d_in, const int* in_sizes, int n_in, void* d_out, int out_size, void* d_ws, size_t ws_size, hipStream_t stream) {
    static int grid = 0;
    if (grid == 0) {
        if (n_in != 24 || in_sizes[0] != BATCH * SEQ * DM || out_size != BATCH * SEQ * DM || ws_size < WS_END) { fprintf(stderr, "kernel_launch: unexpected shapes / workspace (n_in %d, ws %zu, need %zu); nothing launched\n", n_in, ws_size, (size_t)WS_END); grid = -1; return; }
        int dev = 0, cus = 0, per_cu = 0;
        if (hipGetDevice(&dev) != hipSuccess || hipDeviceGetAttribute(&cus, hipDeviceAttributeMultiprocessorCount, dev) != hipSuccess) { grid = -1; return; }
        if (hipFuncSetAttribute((const void*)mk_fwd, hipFuncAttributeMaxDynamicSharedMemorySize, LDS_BYTES) != hipSuccess) { fprintf(stderr, "kernel_launch: hipFuncSetAttribute failed\n"); grid = -1; return; }
        if (hipOccupancyMaxActiveBlocksPerMultiprocessor(&per_cu, (const void*)mk_fwd, NWAVES * 64, LDS_BYTES) != hipSuccess || per_cu < 1) fprintf(stderr, "kernel_launch: occupancy query reports %d\n", per_cu);
        (void)hipGetLastError();
        grid = cus;
    }
    if (grid < 0) return;
    if (hipMemsetAsync((char*)d_ws + WS_CTL, 0, CTL_ZERO_BYTES, stream) != hipSuccess) return;
    Args a{};
    for (int i = 0; i < 24; ++i) a.in[i] = (const float*)d_in[i];
    a.out = (float*)d_out; a.ws = (unsigned char*)d_ws; a.pad = 0;
    const int nl = MK_N_LAUNCHES == 1 ? 1 : NPH;
    for (int li = 0; li < nl; ++li) {
        a.ph_lo = nl == 1 ? 0 : li; a.ph_hi = nl == 1 ? NPH : li + 1; a.li = 0;
        hipLaunchKernelGGL(mk_fwd, dim3(grid), dim3(NWAVES * 64), LDS_BYTES, stream, a);
        const hipError_t le = hipPeekAtLastError();
        if (le != hipSuccess) { fprintf(stderr, "kernel_launch: launch %d failed: %s\n", li, hipGetErrorName(le)); break; }
    }
}
```

```cpp
#define MK_N_LAUNCHES 1
#include <hip/hip_runtime.h>
#include <cstdio>
#include <cstdint>
#include <cstddef>
#include <cmath>
namespace pg8 {
#define PG8_LAS __attribute__((address_space(3)))
typedef unsigned short bf16_t;
typedef short bf16x8 __attribute__((ext_vector_type(8)));
typedef float f32x4 __attribute__((ext_vector_type(4)));
typedef unsigned u32x4 __attribute__((ext_vector_type(4)));
constexpr int BM = 256, BK = 64, HALF = 128, HTB = HALF * BK * 2  , STAGE_BYTES = 8 * HTB, NXCD = 8, WGM = 8;

__host__ __device__ __forceinline__ int lds_byte(int r, int c) { const int st = (r >> 4) * 2 + (c >> 5), rr = r & 15, cc = c & 31, ob = rr * 64 + cc * 2; return st * 1024 + (ob ^ (((ob >> 9) & 1) << 5)); }
__host__ __device__ __forceinline__ void stage_rc(int b, int& R, int& C) { const int st = b / 1024, sb = b % 1024, swz = sb ^ (((sb >> 9) & 1) << 5); R = (st >> 1) * 16 + swz / 64; C = (st & 1) * 32 + (swz % 64) / 2; }
__host__ __device__ __forceinline__ int perm32(int rho) { const int n = rho >> 4, i = rho & 15; return 8 * (i >> 2) + 4 * n + (i & 3); }

struct Unit { int pm, pn, e; };
struct Gemm { const bf16_t* A; const bf16_t* Bt; int M, N, K; };

struct StaticOrder {
    int nM, nN, nwg, G, c;
    __host__ __device__ void init(int M, int N, int G_, int c_) { nM = M / BM; nN = N / BM; nwg = nM * nN; G = G_; c = c_; }
    __host__ __device__ bool next(int i, Unit& u) const {
        const long L = (long)i * G + c; if (L >= nwg) return false;
        int wgid = (int)L; { const int q = nwg / NXCD, r = nwg % NXCD, xcd = wgid % NXCD, off = wgid / NXCD; wgid = (xcd < r ? xcd * (q + 1) : r * (q + 1) + (xcd - r) * q) + off; }
        const int nig = WGM * nN, gid = wgid / nig, fm = gid * WGM, gsz = (nM - fm) < WGM ? (nM - fm) : WGM;
        u.pm = fm + ((wgid % nig) % gsz); u.pn = (wgid % nig) / gsz; return true;
    }
    __device__ __forceinline__ void a_ready(const Unit&) const {}
    __device__ __forceinline__ void done(const Unit&) const {}
};

__device__ __forceinline__ unsigned cvt_pk_bf16(float lo, float hi) { unsigned r; asm volatile("v_cvt_pk_bf16_f32 %0, %1, %2" : "=v"(r) : "v"(lo), "v"(hi)); return r; }
typedef float f32x2 __attribute__((ext_vector_type(2)));
__device__ __forceinline__ f32x2 gelu_pk(f32x2 v) {
    const f32x2 av = __builtin_elementwise_abs(v), d = av * 0.2316418882f + 1.0f;
    f32x2 t; t.x = __builtin_amdgcn_rcpf(d.x); t.y = __builtin_amdgcn_rcpf(d.y);
    f32x2 q = t * 0.5307027145f + (-0.7265760135f); q = q * t + 0.7107068705f; q = q * t + (-0.142248368f); q = q * t + 0.127414796f; q = q * t;
    const f32x2 s = (v * v) * (-0.72134752044f);
    f32x2 e; e.x = __builtin_amdgcn_exp2f(s.x); e.y = __builtin_amdgcn_exp2f(s.y);
    const f32x2 m = v * (q * e), r = v - m;
    f32x2 o; o.x = v.x < 0.f ? m.x : r.x; o.y = v.y < 0.f ? m.y : r.y; return o;
}

template <int ACT  > struct EpiBf16 {
    static constexpr bool PERM = true, AFTER_DRAIN = false, HEADMAP = false; static_assert(ACT == 0 || ACT == 1, "EpiBf16: ACT is 0 (none) or 1 (gelu_pk)");
    bf16_t* O; int ldc; const float* bias; int split_cols; size_t split_stride; float scale0;
    __device__ __forceinline__ void operator()(const f32x4 (&acc)[2][2][4][2], const Unit& u, int wr, int wc, int fr, int fq) const {
        const int row0 = u.pm * BM + wr * 64 + fr; int colt = u.pn * BM; bf16_t* base = O;
        float sc = 1.f; if (split_cols) { const int t = colt / split_cols; base += (size_t)t * split_stride; colt -= t * split_cols; if (t == 0) sc = scale0; }
        const int col0 = colt + wc * 32 + 8 * fq, bcol0 = u.pn * BM + wc * 32 + 8 * fq;
        f32x4 bv[2][2];
#pragma unroll
        for (int bj = 0; bj < 2; ++bj)
#pragma unroll
            for (int n = 0; n < 2; ++n) bv[bj][n] = bias ? *(const f32x4*)(bias + bcol0 + bj * HALF + 4 * n) : (f32x4){0.f, 0.f, 0.f, 0.f};
#pragma unroll
        for (int ai = 0; ai < 2; ++ai)
#pragma unroll
            for (int m = 0; m < 4; ++m) { bf16_t* rowp = base + (size_t)(row0 + ai * HALF + m * 16) * ldc + col0;
#pragma unroll
                for (int bj = 0; bj < 2; ++bj) { f32x4 v0 = acc[ai][bj][m][0] + bv[bj][0], v1 = acc[ai][bj][m][1] + bv[bj][1];
                    if (ACT == 1) { f32x2 a = gelu_pk((f32x2){v0[0], v0[1]}), b = gelu_pk((f32x2){v0[2], v0[3]}), c = gelu_pk((f32x2){v1[0], v1[1]}), d = gelu_pk((f32x2){v1[2], v1[3]});
                        v0 = (f32x4){a.x, a.y, b.x, b.y}; v1 = (f32x4){c.x, c.y, d.x, d.y}; }
                    v0 = v0 * sc; v1 = v1 * sc; u32x4 w; w.x = cvt_pk_bf16(v0[0], v0[1]); w.y = cvt_pk_bf16(v0[2], v0[3]); w.z = cvt_pk_bf16(v1[0], v1[1]); w.w = cvt_pk_bf16(v1[2], v1[3]);
                    *(u32x4*)(rowp + bj * HALF) = w; } }
    }
};

struct TabOrder {
    const volatile PG8_LAS unsigned* tab;
    __device__ __forceinline__ bool next(int i, Unit& u) const {
        if (i >= 32) return false;
        const volatile PG8_LAS unsigned* r = tab + 8 * i;
        if (__builtin_amdgcn_readfirstlane(r[6]) == 0u) return false;
        u.pm = (int)__builtin_amdgcn_readfirstlane(r[4]); u.pn = (int)__builtin_amdgcn_readfirstlane(r[5]); u.e = i; return true;
    }
    __device__ __forceinline__ const char* abase(const Unit& u, size_t) const { const volatile PG8_LAS unsigned* r = tab + 8 * u.e; const unsigned lo = __builtin_amdgcn_readfirstlane(r[0]), hi = __builtin_amdgcn_readfirstlane(r[1]); return (const char*)(((unsigned long long)hi << 32) | lo); }
    __device__ __forceinline__ const char* bbase(const Unit& u, size_t) const { const volatile PG8_LAS unsigned* r = tab + 8 * u.e; const unsigned lo = __builtin_amdgcn_readfirstlane(r[2]), hi = __builtin_amdgcn_readfirstlane(r[3]); return (const char*)(((unsigned long long)hi << 32) | lo); }
    __device__ __forceinline__ void a_ready(const Unit&) const {}
    __device__ __forceinline__ void done(const Unit&) const {}
};
__device__ __forceinline__ TabOrder build_units(PG8_LAS unsigned char* tabmem, int K, const void* A, const void* B, int G, int c,
                                                int np0, int nn0, int cn0, int mode0, int poff0, int np1, int nn1, int cn1, int mode1, const int* pend, size_t estride, const int tid) {
    __syncthreads();
    if (tid < 32) {
        int i_ = tid; asm volatile("" : "+v"(i_)); const int i = i_;
        const int n0 = np0 * nn0, nwg = n0 + np1 * nn1; const long L = (long)i * G + c; const bool ok = L < nwg;
        int w = ok ? (int)L : 0; { const int q = nwg / NXCD, r = nwg % NXCD, xcd = w % NXCD, off = w / NXCD; w = (xcd < r ? xcd * (q + 1) : r * (q + 1) + (xcd - r) * q) + off; }
        const bool s0 = w < n0; const int ww = s0 ? w : w - n0; const int np = s0 ? np0 : np1, nn = s0 ? nn0 : nn1, cn = s0 ? cn0 : cn1, mode = s0 ? mode0 : mode1;
        const int nig = WGM * nn, gid = ww / nig, fm = gid * WGM, gsz = (np - fm) < WGM ? (np - fm) : WGM;
        const int pv = fm + ((ww % nig) % gsz), pn = cn + (ww % nig) / gsz;
        const int pm0 = pv + poff0, pm1 = pv + (pv >> 3), pm2 = 9 * pv + 8; const int pm = mode == 0 ? pm0 : (mode == 1 ? pm1 : pm2);
        int e = 0;
        if (pend) {
#pragma unroll
            for (int k = 0; k < 8; ++k) e += (pend[k] <= pm) ? 1 : 0;
        }
        const size_t tstep = (size_t)256 * K * 2;
        const unsigned long long a = (unsigned long long)((const char*)A + (size_t)pm * tstep), b = (unsigned long long)((const char*)B + (size_t)e * estride + (size_t)pn * tstep);
        PG8_LAS unsigned* r = (PG8_LAS unsigned*)tabmem + 8 * i;
        r[0] = (unsigned)a; r[1] = (unsigned)(a >> 32); r[2] = (unsigned)b; r[3] = (unsigned)(b >> 32); r[4] = (unsigned)pm; r[5] = (unsigned)pn; r[6] = ok ? 1u : 0u; r[7] = 0u; }
    __syncthreads();
    TabOrder T; T.tab = (const volatile PG8_LAS unsigned*)tabmem; return T;
}

struct EpiRawBf16 {
    static constexpr bool PERM = true, AFTER_DRAIN = false, HEADMAP = false;
    bf16_t* O; int ldc;
    __device__ __forceinline__ void operator()(const f32x4 (&acc)[2][2][4][2], const Unit& u, int wr, int wc, int fr, int fq) const {
        const int row0 = u.pm * BM + wr * 64 + fr, col0 = u.pn * BM + wc * 32 + 8 * fq;
#pragma unroll
        for (int ai = 0; ai < 2; ++ai)
#pragma unroll
            for (int m = 0; m < 4; ++m) { bf16_t* rowp = O + (size_t)(row0 + ai * HALF + m * 16) * ldc + col0;
#pragma unroll
                for (int bj = 0; bj < 2; ++bj) { const f32x4 v0 = acc[ai][bj][m][0], v1 = acc[ai][bj][m][1];
                    u32x4 w; w.x = cvt_pk_bf16(v0[0], v0[1]); w.y = cvt_pk_bf16(v0[2], v0[3]); w.z = cvt_pk_bf16(v1[0], v1[1]); w.w = cvt_pk_bf16(v1[2], v1[3]);
                    *(u32x4*)(rowp + bj * HALF) = w; } }
    }
};

struct EpiHeads {
    static constexpr bool PERM = false, AFTER_DRAIN = false, HEADMAP = true;
    bf16_t* P; const PG8_LAS float* gl; const PG8_LAS float* tab;
    __device__ __forceinline__ void operator()(const f32x4 (&acc)[2][2][4][2], const Unit& u, int wr, int wc, int fr, int fq) const {
        const int pn = u.pn, jpan = u.pm % 9; const bool lat = jpan < 8;
        int mode = 0, gi = 0; float sc = 1.f;
        if (pn < 2) { mode = 2; gi = 0; sc = 0.125f * 1.4426950408889634f; }
        else if (pn == 2) { mode = 1; gi = 2; sc = 0.125f * 1.4426950408889634f; }
        else if (pn == 6) { mode = wc < 2 ? 2 : 0; gi = 1; }
        else if (pn == 7) { mode = 1; gi = 3; }
        if (mode == 2 && !lat) mode = 1;
        const PG8_LAS float* gp = gl + gi * 64 + 4 * fq;
        const int colb = pn * BM + wc * 64 + 4 * fq;
#pragma unroll
        for (int ai = 0; ai < 2; ++ai)
#pragma unroll
            for (int m = 0; m < 4; ++m) {
                const int lr = ai * HALF + wr * 64 + m * 16 + fr, j = jpan * 256 + lr;
                f32x4 v[2][2];
#pragma unroll
                for (int bj = 0; bj < 2; ++bj)
#pragma unroll
                    for (int n = 0; n < 2; ++n) v[bj][n] = acc[ai][bj][m][n];
                if (mode) {
                    float ss = 0.f;
#pragma unroll
                    for (int bj = 0; bj < 2; ++bj)
#pragma unroll
                        for (int n = 0; n < 2; ++n) ss += (v[bj][n][0] * v[bj][n][0] + v[bj][n][1] * v[bj][n][1]) + (v[bj][n][2] * v[bj][n][2] + v[bj][n][3] * v[bj][n][3]);
                    { const int ln_ = fq * 16 + fr; ss += __int_as_float(__builtin_amdgcn_ds_bpermute((ln_ ^ 16) << 2, __float_as_int(ss))); ss += __int_as_float(__builtin_amdgcn_ds_bpermute((ln_ ^ 32) << 2, __float_as_int(ss))); }
                    const float rs = 1.0f / sqrtf(ss * (1.0f / 64.0f) + 1e-6f);
#pragma unroll
                    for (int bj = 0; bj < 2; ++bj)
#pragma unroll
                        for (int n = 0; n < 2; ++n) v[bj][n] = v[bj][n] * (rs * sc) * *(const PG8_LAS f32x4*)(gp + 32 * bj + 16 * n);
                    if (mode == 2) {
#pragma unroll
                        for (int bj = 0; bj < 2; ++bj) { const int pos = bj == 0 ? (j >> 6) : (j & 63);
                            const f32x4 t0 = *(const PG8_LAS f32x4*)(tab + (pos * 16 + 4 * fq) * 2), t1 = *(const PG8_LAS f32x4*)(tab + (pos * 16 + 4 * fq) * 2 + 4);
                            const f32x4 cs = {t0[0], t0[2], t1[0], t1[2]}, sn = {t0[1], t0[3], t1[1], t1[3]};
                            const f32x4 u1 = v[bj][0], u2 = v[bj][1];
                            v[bj][0] = u1 * cs - u2 * sn; v[bj][1] = u2 * cs + u1 * sn; }
                    }
                }
                bf16_t* rowp = P + (size_t)(u.pm * BM + lr) * 2304 + pn * BM + wc * 64 + 4 * (fq & 2) + 16 * (fq & 1);
#pragma unroll
                for (int bj = 0; bj < 2; ++bj) {
                    const unsigned a0 = cvt_pk_bf16(v[bj][0][0], v[bj][0][1]), a1 = cvt_pk_bf16(v[bj][0][2], v[bj][0][3]), b0 = cvt_pk_bf16(v[bj][1][0], v[bj][1][1]), b1 = cvt_pk_bf16(v[bj][1][2], v[bj][1][3]);
                    const bool odd = fq & 1;
                    const unsigned s0 = odd ? a0 : b0, s1 = odd ? a1 : b1;
                    const unsigned r0 = (unsigned)__builtin_amdgcn_ds_swizzle((int)s0, 0x401F), r1 = (unsigned)__builtin_amdgcn_ds_swizzle((int)s1, 0x401F);
                    u32x4 w; if (odd) { w.x = r0; w.y = r1; w.z = b0; w.w = b1; } else { w.x = a0; w.y = a1; w.z = r0; w.w = r1; }
                    *(u32x4*)(rowp + 32 * bj) = w; }
                __builtin_amdgcn_sched_barrier(0);
            }
    }
};
template <bool NEXT> struct EpiGateRes {
    static constexpr bool PERM = true, AFTER_DRAIN = false, HEADMAP = false;
    bf16_t* xb; const float* mod; int goff; float asc;
    bf16_t* xs; float* part; int nsc; PG8_LAS float* pl;
    __device__ __forceinline__ void operator()(const f32x4 (&acc)[2][2][4][2], const Unit& u, int wr, int wc, int fr_in, int fq) const {
        int fr = fr_in; asm volatile("" : "+v"(fr));
        const int b = u.pm / 9, j = u.pm % 9; const bool lat = j < 8;
        bf16_t* bo = xb + (size_t)(u.pm * BM) * 1024;
        const float* g = mod + (lat ? b : 16) * 6144;
        const int colw = wc * 32 + 8 * fq, col0 = u.pn * BM + colw;
        f32x4 gv[2][2];
        if constexpr (NEXT) {
            const int t = (wr * 4 + wc) * 64 + fq * 16 + fr;
            if (t < 128) { const int which = t >> 6, c4 = (t & 63) * 4; f32x4 v = *(const f32x4*)(g + (which ? nsc : goff) + u.pn * BM + c4); v = which ? v + 1.0f : v * asc; *(PG8_LAS f32x4*)(pl + 1024 + which * 256 + c4) = v; }
            asm volatile("s_waitcnt lgkmcnt(0)" ::: "memory"); __builtin_amdgcn_s_barrier(); asm volatile("" ::: "memory");
        } else {
#pragma unroll
            for (int bj = 0; bj < 2; ++bj)
#pragma unroll
                for (int n = 0; n < 2; ++n) gv[bj][n] = *(const f32x4*)(g + goff + col0 + bj * HALF + 4 * n) * asc;
        }
        constexpr int GB = 4;
#pragma unroll
        for (int g0 = 0; g0 < 8; g0 += GB) { const int ai = g0 >> 2;
            u32x4 xh[4][2];
#pragma unroll
            for (int m = g0 & 3; m < (g0 & 3) + GB; ++m) { const unsigned off = (unsigned)(ai * HALF + wr * 64 + m * 16 + fr) * 1024u + (unsigned)col0;
#pragma unroll
                for (int bj = 0; bj < 2; ++bj) xh[m][bj] = *(const u32x4*)(bo + off + bj * HALF); }
#pragma unroll
            for (int m = g0 & 3; m < (g0 & 3) + GB; ++m) { const unsigned off = (unsigned)(ai * HALF + wr * 64 + m * 16 + fr) * 1024u + (unsigned)col0; float ssq = 0.f;
                if constexpr (NEXT) asm volatile("" ::: "memory");
#pragma unroll
                for (int bj = 0; bj < 2; ++bj) { const u32x4 w = xh[m][bj];
                    const f32x4 x0 = {__uint_as_float(w.x << 16), __uint_as_float(w.x & 0xffff0000u), __uint_as_float(w.y << 16), __uint_as_float(w.y & 0xffff0000u)};
                    const f32x4 x1 = {__uint_as_float(w.z << 16), __uint_as_float(w.z & 0xffff0000u), __uint_as_float(w.w << 16), __uint_as_float(w.w & 0xffff0000u)};
                    f32x4 g0v, g1v;
                    if constexpr (NEXT) { g0v = *(const PG8_LAS f32x4*)(pl + 1024 + colw + bj * HALF); g1v = *(const PG8_LAS f32x4*)(pl + 1024 + colw + bj * HALF + 4); } else { g0v = gv[bj][0]; g1v = gv[bj][1]; }
                    const f32x4 o0 = x0 + g0v * acc[ai][bj][m][0], o1 = x1 + g1v * acc[ai][bj][m][1];
                    u32x4 wo; wo.x = cvt_pk_bf16(o0[0], o0[1]); wo.y = cvt_pk_bf16(o0[2], o0[3]); wo.z = cvt_pk_bf16(o1[0], o1[1]); wo.w = cvt_pk_bf16(o1[2], o1[3]);
                    *(u32x4*)(bo + off + bj * HALF) = wo;
                    if constexpr (NEXT) { const f32x4 s0v = *(const PG8_LAS f32x4*)(pl + 1280 + colw + bj * HALF), s1v = *(const PG8_LAS f32x4*)(pl + 1280 + colw + bj * HALF + 4);
                        const f32x4 y0 = o0 * s0v, y1 = o1 * s1v;
                        u32x4 ws; ws.x = cvt_pk_bf16(y0[0], y0[1]); ws.y = cvt_pk_bf16(y0[2], y0[3]); ws.z = cvt_pk_bf16(y1[0], y1[1]); ws.w = cvt_pk_bf16(y1[2], y1[3]);
                        *(u32x4*)(xs + (size_t)(u.pm * BM) * 1024 + off + bj * HALF) = ws;
                        ssq += ((o0[0] * o0[0] + o0[1] * o0[1]) + (o0[2] * o0[2] + o0[3] * o0[3])) + ((o1[0] * o1[0] + o1[1] * o1[1]) + (o1[2] * o1[2] + o1[3] * o1[3])); } }
                if constexpr (NEXT) { const int ln_ = fq * 16 + fr; ssq += __int_as_float(__builtin_amdgcn_ds_bpermute((ln_ ^ 16) << 2, __float_as_int(ssq))); ssq += __int_as_float(__builtin_amdgcn_ds_bpermute((ln_ ^ 32) << 2, __float_as_int(ssq)));
                    if (fq == 0) pl[(ai * HALF + wr * 64 + m * 16 + fr) * 4 + wc] = ssq; } }
            asm volatile("" ::: "memory"); }
        if constexpr (NEXT) {
            asm volatile("s_waitcnt lgkmcnt(0)" ::: "memory"); __builtin_amdgcn_s_barrier(); asm volatile("" ::: "memory");
            const int t = (wr * 4 + wc) * 64 + fq * 16 + fr;
            if (t < 256) { const f32x4 p = *(const PG8_LAS f32x4*)(pl + 4 * t); part[(size_t)(u.pm * BM + t) * 4 + u.pn] = (p[0] + p[1]) + (p[2] + p[3]); }
            asm volatile("s_waitcnt lgkmcnt(0)" ::: "memory"); __builtin_amdgcn_s_barrier(); asm volatile("" ::: "memory");
        }
    }
};
struct EpiSwiglu {
    static constexpr bool PERM = true, AFTER_DRAIN = false, HEADMAP = false;
    bf16_t* H; int ldh; int p0;
    __device__ __forceinline__ void operator()(const f32x4 (&acc)[2][2][4][2], const Unit& u, int wr, int wc, int fr, int fq) const {
        const int row0 = (u.pm - p0) * BM + wr * 64 + fr, col0 = u.pn * HALF + wc * 32 + 8 * fq;
#pragma unroll
        for (int ai = 0; ai < 2; ++ai)
#pragma unroll
            for (int m = 0; m < 4; ++m) { bf16_t* rowp = H + (size_t)(row0 + ai * HALF + m * 16) * ldh + col0;
                float h[8];
#pragma unroll
                for (int n = 0; n < 2; ++n)
#pragma unroll
                    for (int k = 0; k < 4; ++k) { const float a = acc[ai][0][m][n][k], b3 = acc[ai][1][m][n][k];
                        const float sg = __builtin_amdgcn_rcpf(1.0f + __builtin_amdgcn_exp2f(-1.4426950408889634f * a)); h[n * 4 + k] = a * sg * b3; }
                u32x4 w; w.x = cvt_pk_bf16(h[0], h[1]); w.y = cvt_pk_bf16(h[2], h[3]); w.z = cvt_pk_bf16(h[4], h[5]); w.w = cvt_pk_bf16(h[6], h[7]);
                *(u32x4*)rowp = w; }
    }
};
template <bool NORM> struct EpiSwigluF8 {
    static constexpr bool PERM = true, AFTER_DRAIN = false, HEADMAP = false;
    unsigned char* H; int ldh; float isc; const float* part; const float* shw;
    __device__ __forceinline__ void operator()(const f32x4 (&acc)[2][2][4][2], const Unit& u, int wr, int wc, int fr, int fq) const {
        const int row0 = u.pm * BM + wr * 64 + fr, col0 = u.pn * HALF + wc * 32 + 8 * fq;
        const float c1 = -1.4426950408889634f * isc, c2 = isc * isc;
        f32x4 shv[2][2]; float rsv[8];
        if constexpr (NORM) { const float* sp = shw + (size_t)((u.pm % 9) < 8 ? u.pm / 9 : 16) * 5632 + u.pn * BM + wc * 32 + 8 * fq;
#pragma unroll
            for (int bj = 0; bj < 2; ++bj)
#pragma unroll
                for (int n = 0; n < 2; ++n) shv[bj][n] = *(const f32x4*)(sp + bj * HALF + 4 * n);
#pragma unroll
            for (int i = 0; i < 8; ++i) { const f32x4 p = *(const f32x4*)(part + (size_t)(row0 + (i >> 2) * HALF + (i & 3) * 16) * 4); rsv[i] = 1.0f / sqrtf(((p[0] + p[1]) + (p[2] + p[3])) * (1.0f / 1024.0f) + 1e-6f); } }
#pragma unroll
        for (int ai = 0; ai < 2; ++ai)
#pragma unroll
            for (int m = 0; m < 4; ++m) { unsigned char* rowp = H + (size_t)(row0 + ai * HALF + m * 16) * ldh + col0;
                f32x2 h[4];
#pragma unroll
                for (int n = 0; n < 2; ++n)
#pragma unroll
                    for (int k = 0; k < 2; ++k) { f32x2 a = {acc[ai][0][m][n][2 * k], acc[ai][0][m][n][2 * k + 1]}, b3 = {acc[ai][1][m][n][2 * k], acc[ai][1][m][n][2 * k + 1]};
                        if constexpr (NORM) { const float rs = rsv[ai * 4 + m]; a = a * rs + (f32x2){shv[0][n][2 * k], shv[0][n][2 * k + 1]}; b3 = b3 * rs + (f32x2){shv[1][n][2 * k], shv[1][n][2 * k + 1]}; }
                        const f32x2 t = a * c1; f32x2 ex; ex.x = __builtin_amdgcn_exp2f(t.x); ex.y = __builtin_amdgcn_exp2f(t.y);
                        const f32x2 d = ex + 1.0f; f32x2 r; r.x = __builtin_amdgcn_rcpf(d.x); r.y = __builtin_amdgcn_rcpf(d.y);
                        h[n * 2 + k] = ((a * b3) * c2) * r; }
                typedef unsigned u32x2 __attribute__((ext_vector_type(2))); u32x2 w;
                { int t = __builtin_amdgcn_cvt_pk_fp8_f32(h[0].x, h[0].y, 0, false); t = __builtin_amdgcn_cvt_pk_fp8_f32(h[1].x, h[1].y, t, true); w.x = (unsigned)t; }
                { int t = __builtin_amdgcn_cvt_pk_fp8_f32(h[2].x, h[2].y, 0, false); t = __builtin_amdgcn_cvt_pk_fp8_f32(h[3].x, h[3].y, t, true); w.y = (unsigned)t; }
                *(u32x2*)rowp = w; }
    }
};
struct EpiMoeOut {
    static constexpr bool PERM = true, AFTER_DRAIN = false, HEADMAP = false;
    bf16_t* Y; const float* sgate; float osc;
    __device__ __forceinline__ void operator()(const f32x4 (&acc)[2][2][4][2], const Unit& u, int wr, int wc, int fr, int fq) const {
        const int row0 = u.pm * BM + wr * 64 + fr, col0 = u.pn * BM + wc * 32 + 8 * fq;
        float gts[8];
#pragma unroll
        for (int i = 0; i < 8; ++i) gts[i] = sgate[row0 + (i >> 2) * HALF + (i & 3) * 16] * osc;
#pragma unroll
        for (int ai = 0; ai < 2; ++ai)
#pragma unroll
            for (int m = 0; m < 4; ++m) { const int row = row0 + ai * HALF + m * 16; const float gt = gts[ai * 4 + m]; bf16_t* rowp = Y + (size_t)row * 1024 + col0;
#pragma unroll
                for (int bj = 0; bj < 2; ++bj) { const f32x4 v0 = acc[ai][bj][m][0] * gt, v1 = acc[ai][bj][m][1] * gt;
                    u32x4 w; w.x = cvt_pk_bf16(v0[0], v0[1]); w.y = cvt_pk_bf16(v0[2], v0[3]); w.z = cvt_pk_bf16(v1[0], v1[1]); w.w = cvt_pk_bf16(v1[2], v1[3]);
                    *(u32x4*)(rowp + bj * HALF) = w; } }
    }
};
template <class Epi, class Sched, bool ALIGN_EPI = false, bool SP2 = false, bool F8 = false>
__device__ __forceinline__ void gemm_phase(PG8_LAS unsigned char* lds, const Gemm g, const Sched& S, const Epi& E, const int wave_sgpr) {
    int ln_ = (int)__builtin_amdgcn_mbcnt_hi(~0u, __builtin_amdgcn_mbcnt_lo(~0u, 0u)); asm volatile("" : "+v"(ln_)); const int tid_ = wave_sgpr * 64 + ln_;
    const int tid = tid_, wid = __builtin_amdgcn_readfirstlane(tid >> 6), lane = tid & 63, wr = wid >> 2, wc = wid & 3, fr = lane & 15, fq = lane >> 4;
    const int K = g.K, nt = K / BK;
    unsigned voffA[2], voffB[2];
#pragma unroll
    for (int i = 0; i < 2; ++i) { int R, C; stage_rc(tid * 16 + i * 8192, R, C); const int Rb = Epi::HEADMAP ? ((R >> 5) * 64 + (R & 31)) : (Epi::PERM ? ((R & ~31) + perm32(R & 31)) : R);
        voffA[i] = (unsigned)(R * K + C) * 2u; voffB[i] = (unsigned)(Rb * K + C) * 2u; }
    const size_t kstep = (size_t)(BK * 2);
    const size_t hstep = (size_t)HALF * K * 2;
    const size_t hstepB = Epi::HEADMAP ? (size_t)32 * K * 2 : hstep;
    const size_t tstep = 2 * hstep;
    const unsigned ldsw = (unsigned)wid * 1024u;
    const int aoff = lds_byte(wr * 64 + fr, fq * 8), boff = lds_byte(wc * 32 + fr, fq * 8);
#define PG8_SA(b, h) (((b) * 2 + (h)) * HTB)
#define PG8_SB(b, h) ((4 + (b) * 2 + (h)) * HTB)
#define PG8_STAGE(bufoff, gbase, voff) do { _Pragma("unroll") for (int _i = 0; _i < 2; ++_i) \
        __builtin_amdgcn_global_load_lds((const unsigned*)((const char*)(gbase) + (voff)[_i]), (PG8_LAS unsigned*)(lds + (bufoff) + ldsw + _i * 8192), 16, 0, 0); } while (0)
#define PG8_LDA(dst, b, h) do { _Pragma("unroll") for (int m = 0; m < 4; ++m) { if constexpr (F8) { dst##8[m].lo = *(const PG8_LAS i32x4_*)(lds + PG8_SA(b, h) + aoff + m * 2048); dst##8[m].hi = *(const PG8_LAS i32x4_*)(lds + PG8_SA(b, h) + aoff + m * 2048 + 1024); } \
        else { _Pragma("unroll") for (int k = 0; k < 2; ++k) dst[m][k] = *(const PG8_LAS bf16x8*)(lds + PG8_SA(b, h) + aoff + m * 2048 + k * 1024); } } } while (0)
#define PG8_LDB(dst, b, h) do { _Pragma("unroll") for (int n = 0; n < 2; ++n) { if constexpr (F8) { dst##8[n].lo = *(const PG8_LAS i32x4_*)(lds + PG8_SB(b, h) + boff + n * 2048); dst##8[n].hi = *(const PG8_LAS i32x4_*)(lds + PG8_SB(b, h) + boff + n * 2048 + 1024); } \
        else { _Pragma("unroll") for (int k = 0; k < 2; ++k) dst[n][k] = *(const PG8_LAS bf16x8*)(lds + PG8_SB(b, h) + boff + n * 2048 + k * 1024); } } } while (0)
#define PG8_MMA(ai, bj, At, Bt) do { __builtin_amdgcn_s_setprio(1); _Pragma("unroll") for (int m = 0; m < 4; ++m) _Pragma("unroll") for (int n = 0; n < 2; ++n) { \
        if constexpr (F8) asm("v_mfma_f32_16x16x128_f8f6f4 %0, %1, %2, %0" : "+v"(acc[ai][bj][m][n]) : "v"(Bt##8[n]), "v"(At##8[m]));     \
        else { _Pragma("unroll") for (int k = 0; k < 2; ++k) acc[ai][bj][m][n] = __builtin_amdgcn_mfma_f32_16x16x32_bf16(Bt[n][k], At[m][k], acc[ai][bj][m][n], 0, 0, 0); } } \
        __builtin_amdgcn_s_setprio(0); } while (0)
#define PG8_WAIT_V(n) asm volatile("s_waitcnt vmcnt(" #n ")" ::: "memory")
#define PG8_WAIT_L(n) asm volatile("s_waitcnt lgkmcnt(" #n ")" ::: "memory")
#define PG8_BAR __builtin_amdgcn_s_barrier()
#define PG8_SCHED __builtin_amdgcn_sched_barrier(0)
    Unit cur, nxt; int ui = 0;
    if (!S.next(0, cur)) return;
    f32x4 acc[2][2][4][2];
#pragma unroll
    for (int a = 0; a < 2; ++a)
#pragma unroll
        for (int b = 0; b < 2; ++b)
#pragma unroll
            for (int m = 0; m < 4; ++m)
#pragma unroll
                for (int n = 0; n < 2; ++n) acc[a][b][m][n] = (f32x4){0.f, 0.f, 0.f, 0.f};
    typedef int i32x4_ __attribute__((ext_vector_type(4))); typedef int i32x8_ __attribute__((ext_vector_type(8)));
    bf16x8 At[4][2], B0[2][2], B1[2][2];
    i32x8_ At8[4], B08[2], B18[2];
    const char* cA = S.abase(cur, tstep); const char* cB = S.bbase(cur, tstep);
    S.a_ready(cur);
    if constexpr (SP2) {
        PG8_STAGE(PG8_SB(0, 0), cB, voffB); PG8_STAGE(PG8_SB(0, 1), cB + hstepB, voffB); PG8_STAGE(PG8_SA(0, 0), cA, voffA); PG8_STAGE(PG8_SA(0, 1), cA + hstep, voffA);
        if (wr == 1) PG8_BAR;
        PG8_WAIT_V(2); PG8_BAR;
        PG8_STAGE(PG8_SB(1, 0), cB + kstep, voffB); PG8_STAGE(PG8_SA(1, 0), cA + kstep, voffA); PG8_STAGE(PG8_SB(1, 1), cB + hstepB + kstep, voffB);
        PG8_WAIT_V(6); PG8_BAR;
    } else {
        PG8_STAGE(PG8_SB(0, 0), cB, voffB); PG8_STAGE(PG8_SA(0, 0), cA, voffA); PG8_STAGE(PG8_SB(0, 1), cB + hstepB, voffB); PG8_STAGE(PG8_SA(0, 1), cA + hstep, voffA);
        if (wr == 1) PG8_BAR;
        PG8_WAIT_V(4); PG8_BAR;
        PG8_STAGE(PG8_SB(1, 0), cB + kstep, voffB); PG8_STAGE(PG8_SA(1, 0), cA + kstep, voffA); PG8_STAGE(PG8_SB(1, 1), cB + hstepB + kstep, voffB);
        PG8_WAIT_V(6); PG8_BAR;
    }
    for (;;) {
        const bool has_next = S.next(ui + 1, nxt);
        const char* nA = has_next ? S.abase(nxt, tstep) : cA; const char* nB = has_next ? S.bbase(nxt, tstep) : cB;
#pragma unroll 1
        for (int t = 0; t < nt; t += 2) {
            const bool last = (t == nt - 2);
            const char* a1 = cA + (size_t)(t + 1) * kstep;
            const char* a2 = last ? nA : cA + (size_t)(t + 2) * kstep; const char* b2 = last ? nB : cB + (size_t)(t + 2) * kstep;
            const char* a3 = a2 + kstep; const char* b3 = b2 + kstep;
            if (last && has_next) S.a_ready(nxt);
            if constexpr (SP2) {
            PG8_LDB(B0, 0, 0); PG8_LDB(B1, 0, 1); PG8_SCHED; PG8_LDA(At, 0, 0); PG8_STAGE(PG8_SA(1, 1), a1 + hstep, voffA);
            PG8_WAIT_V(8); PG8_WAIT_L(0); PG8_BAR; PG8_MMA(0, 0, At, B0); PG8_MMA(0, 1, At, B1); PG8_BAR; PG8_SCHED;
            PG8_LDA(At, 0, 1); PG8_STAGE(PG8_SB(0, 0), b2, voffB); PG8_STAGE(PG8_SB(0, 1), b2 + hstepB, voffB); PG8_STAGE(PG8_SA(0, 0), a2, voffA);
            PG8_WAIT_V(8); PG8_WAIT_L(0); PG8_BAR; PG8_MMA(1, 0, At, B0); PG8_MMA(1, 1, At, B1); PG8_BAR; PG8_SCHED;
            PG8_LDB(B0, 1, 0); PG8_LDB(B1, 1, 1); PG8_SCHED; PG8_LDA(At, 1, 0); PG8_STAGE(PG8_SA(0, 1), a2 + hstep, voffA);
            PG8_WAIT_V(8); PG8_WAIT_L(0); PG8_BAR; PG8_MMA(0, 0, At, B0); PG8_MMA(0, 1, At, B1); PG8_BAR; PG8_SCHED;
            PG8_LDA(At, 1, 1); PG8_STAGE(PG8_SB(1, 0), b3, voffB); PG8_STAGE(PG8_SB(1, 1), b3 + hstepB, voffB); PG8_STAGE(PG8_SA(1, 0), a3, voffA);
            PG8_WAIT_V(8); PG8_WAIT_L(0); PG8_BAR; PG8_MMA(1, 0, At, B0); PG8_MMA(1, 1, At, B1); PG8_BAR; PG8_SCHED;
            } else {
            PG8_LDB(B0, 0, 0); PG8_SCHED; PG8_LDA(At, 0, 0); PG8_STAGE(PG8_SA(1, 1), a1 + hstep, voffA);
            PG8_WAIT_L(8); PG8_BAR; PG8_WAIT_L(0); PG8_MMA(0, 0, At, B0); PG8_BAR; PG8_SCHED;
            PG8_LDB(B1, 0, 1); PG8_STAGE(PG8_SB(0, 0), b2, voffB);
            PG8_BAR; PG8_WAIT_L(0); PG8_MMA(0, 1, At, B1); PG8_BAR;
            PG8_LDA(At, 0, 1); PG8_STAGE(PG8_SA(0, 0), a2, voffA);
            PG8_BAR; PG8_WAIT_L(0); PG8_MMA(1, 0, At, B0); PG8_BAR; PG8_SCHED;
            PG8_STAGE(PG8_SB(0, 1), b2 + hstepB, voffB);
            PG8_WAIT_V(6); PG8_BAR; PG8_MMA(1, 1, At, B1); PG8_BAR;
            PG8_LDB(B0, 1, 0); PG8_SCHED; PG8_LDA(At, 1, 0); PG8_STAGE(PG8_SA(0, 1), a2 + hstep, voffA);
            PG8_WAIT_L(8); PG8_BAR; PG8_WAIT_L(0); PG8_MMA(0, 0, At, B0); PG8_BAR; PG8_SCHED;
            PG8_LDB(B1, 1, 1); PG8_STAGE(PG8_SB(1, 0), b3, voffB);
            PG8_BAR; PG8_WAIT_L(0); PG8_MMA(0, 1, At, B1); PG8_BAR;
            PG8_LDA(At, 1, 1); PG8_STAGE(PG8_SA(1, 0), a3, voffA);
            PG8_BAR; PG8_WAIT_L(0); PG8_MMA(1, 0, At, B0); PG8_BAR; PG8_SCHED;
            PG8_STAGE(PG8_SB(1, 1), b3 + hstepB, voffB);
            PG8_WAIT_V(6); PG8_BAR; PG8_MMA(1, 1, At, B1); PG8_BAR;
            }
        }
        if constexpr (ALIGN_EPI) { if (wr == 0) PG8_BAR; }
        if constexpr (F8) asm volatile("s_nop 15\n\ts_nop 15\n\ts_nop 7" ::: "memory");
        if constexpr (!Epi::AFTER_DRAIN) { E(acc, cur, wr, wc, fr, fq); S.done(cur); }
        if (!has_next) break;
#pragma unroll
        for (int a = 0; a < 2; ++a)
#pragma unroll
            for (int b = 0; b < 2; ++b)
#pragma unroll
                for (int m = 0; m < 4; ++m)
#pragma unroll
                    for (int n = 0; n < 2; ++n) acc[a][b][m][n] = (f32x4){0.f, 0.f, 0.f, 0.f};
        cur = nxt; cA = nA; cB = nB; ++ui;
        if constexpr (ALIGN_EPI) { if (wr == 1) PG8_BAR; }
    }
    PG8_WAIT_V(0);
    if constexpr (!ALIGN_EPI) { if (wr == 0) PG8_BAR; }
    PG8_BAR;
    if constexpr (Epi::AFTER_DRAIN) { E.fused(acc, cur, wr, wc, fr, fq, lds, wid, lane); S.done(cur); }
#undef PG8_SA
#undef PG8_SB
#undef PG8_STAGE
#undef PG8_LDA
#undef PG8_LDB
#undef PG8_MMA
#undef PG8_WAIT_V
#undef PG8_WAIT_L
#undef PG8_BAR
#undef PG8_SCHED
}
}

constexpr int NWAVES = 8;
#ifndef MK_N_LAUNCHES
#define MK_N_LAUNCHES 1
#endif
constexpr int NPH = 23;
constexpr int BATCH = 16, SEQ = 2048, DM = 1024, CTXL = 256, TPB = SEQ + CTXL, MROWS = BATCH * TPB, NPAN = MROWS / 256;
constexpr int INW = 2304, DFF = 2816, NEXP = 8, NTOK = BATCH * SEQ;
constexpr int QA_OFF = 0, QB_OFF = 512, CPOST_OFF = 768, CPRE_OFF = 1024, CVAL_OFF = 1280, KA_OFF = 1536, VA_OFF = 1664, KB_OFF = 1792, VB_OFF = 2048;
constexpr float NORM_EPS = 1e-6f, LOG2E = 1.4426950408889634f, C2 = 0.125f * 1.4426950408889634f;
constexpr int MOE_HCAP = 136;
constexpr int SLOT_CAP = 2 * NTOK + NEXP * 256;

constexpr size_t MiB = 1u << 20;
constexpr size_t WS_CTL = 0, CTL_ZERO_BYTES = 128 * 1024;
constexpr size_t WS_MOD = 1 * MiB;
constexpr size_t WS_MISC = 2 * MiB;
constexpr size_t WS_WIN = 6 * MiB;
constexpr size_t WS_WOUT = 15 * MiB;
constexpr size_t WS_F13 = 19 * MiB;
constexpr size_t WS_F2 = 30 * MiB;
constexpr size_t WS_M13 = 36 * MiB;
constexpr size_t WS_M2 = 80 * MiB;
constexpr size_t WS_XB = 104 * MiB;
constexpr size_t WS_XN = 184 * MiB;
constexpr size_t WS_P = 256 * MiB;
constexpr size_t WS_XT = 316 * MiB;
constexpr size_t WS_END = 504 * MiB;
constexpr size_t WS_PART = 176 * MiB, WS_SHW13 = 177 * MiB;
constexpr size_t WS_XS8 = WS_XN, WS_XT8 = WS_XN + 66 * MiB, WS_H8 = WS_XT;
static_assert(WS_P + (size_t)MROWS * DFF * 2 <= WS_END && WS_H8 + (size_t)SLOT_CAP * DFF <= WS_END && WS_XN + (size_t)SLOT_CAP * DM * 2 <= WS_XT && WS_XT8 + (size_t)NTOK * DM <= WS_XT && (size_t)SLOT_CAP * DM <= 66 * MiB, "ws map");
constexpr size_t MS_TOKE = 0, MS_TOKG = 256 * 1024, MS_TOKS = 512 * 1024, MS_SLOTG = 768 * 1024, MS_META = 1088 * 1024, MS_ROPE = 1152 * 1024;
constexpr int CW_TMO = 0, CW_CODE = 1, CW_BAR = 4096, CW_CNT = 16384;

constexpr int RING_BYTES = 139264, LDSCTL_OFF = RING_BYTES, MISC_OFF = LDSCTL_OFF + 320, LDS_BYTES = 147456;

#define GAS __attribute__((address_space(1)))
#define LAS __attribute__((address_space(3)))
typedef unsigned short bf16;
typedef unsigned v4u __attribute__((ext_vector_type(4)));
typedef unsigned v2u __attribute__((ext_vector_type(2)));
typedef float f32x4 __attribute__((ext_vector_type(4)));
#define LDS_WAIT() asm volatile("s_waitcnt lgkmcnt(0)" ::: "memory")
#define VM_WAIT() asm volatile("s_waitcnt vmcnt(0)" ::: "memory")
__device__ __forceinline__ unsigned f2bf(float f) { unsigned u = __builtin_bit_cast(unsigned, f); return (u + 0x7fffu + ((u >> 16) & 1u)) >> 16; }
__device__ __forceinline__ unsigned pk2(float lo, float hi) { return f2bf(lo) | (f2bf(hi) << 16); }
__device__ __forceinline__ unsigned pk4_f8(float a, float b, float c, float d) { int w = __builtin_amdgcn_cvt_pk_fp8_f32(a, b, 0, false); w = __builtin_amdgcn_cvt_pk_fp8_f32(c, d, w, true); return (unsigned)w; }
__device__ __forceinline__ float bflo(unsigned w) { return __uint_as_float(w << 16); }
__device__ __forceinline__ float bfhi(unsigned w) { return __uint_as_float(w & 0xffff0000u); }
__device__ __forceinline__ float bf1(bf16 h) { return __uint_as_float((unsigned)h << 16); }
__device__ __forceinline__ float xshfl(float v, int mask, int lane) { return __int_as_float(__builtin_amdgcn_ds_bpermute((lane ^ mask) << 2, __float_as_int(v))); }
__device__ __forceinline__ float wave_sum(float v, int lane) {
#pragma unroll
    for (int o = 1; o < 64; o <<= 1) v += xshfl(v, o, lane);
    return v;
}
__device__ __forceinline__ float half_sum(float v, int lane) {
#pragma unroll
    for (int o = 1; o < 32; o <<= 1) v += xshfl(v, o, lane);
    return v;
}
#include <hip/hip_bf16.h>
#include <cmath>
namespace attn_body {
using bf16=__hip_bfloat16;
using bf16x8=__attribute__((ext_vector_type(8)))short;
using s16x4=__attribute__((ext_vector_type(4)))short;
using f32x16=__attribute__((ext_vector_type(16)))float;
using u32x4=__attribute__((ext_vector_type(4)))unsigned;
constexpr int D=64,DM=2304;
constexpr int NW=8,QBLK=32,QB=QBLK*NW,KVBLK=64;
constexpr int LDS_BT=86016, BT_STRIDE=128, BT_PAD=48;
__device__ __forceinline__ int crow(int r,int hi){return (r&3)+8*(r>>2)+4*hi;}
#define SBAR() __builtin_amdgcn_sched_barrier(0)
__device__ __forceinline__ void bias_apply(f32x16&p0,f32x16&p1,const __attribute__((address_space(3))) char*tb,unsigned m0,unsigned m1,float mh){
  const unsigned NEGB=0xf149f2cau;
  #pragma unroll
  for(int g=0;g<4;++g){
    #pragma unroll
    for(int k=0;k<4;++k){ const int r=4*g+k; const int o=((r&3)+8*(r>>2))*4; const float b0=*(const __attribute__((address_space(3))) float*)(tb+o),b1=*(const __attribute__((address_space(3))) float*)(tb+o+128);
      const unsigned s0=(unsigned)__builtin_amdgcn_sbfe((int)m0,r,1), s1=(unsigned)__builtin_amdgcn_sbfe((int)m1,r,1);
      const unsigned x0=__float_as_uint(p0[r]+(b0-mh)), x1=__float_as_uint(p1[r]+(b1-mh));
      float y0=__uint_as_float((x0&s0)|(NEGB&~s0)), y1=__uint_as_float((x1&s1)|(NEGB&~s1)); asm volatile("":"+v"(y0),"+v"(y1)); p0[r]=y0; p1[r]=y1; }
    __builtin_amdgcn_sched_barrier(0); }
}
constexpr int NSLOT=3, SLOTB=8192;
constexpr int LDS_K=0, LDS_V=NSLOT*SLOTB, LDS_WS=2*NSLOT*SLOTB, LDS_OST=LDS_WS+NW*64*4, LDS_BYTES=LDS_OST+NW*4096;
constexpr float C2=0.125f*1.4426950408889634f;
__device__ __forceinline__ void glds16(const void*gsrc,unsigned lds_dst){unsigned keep;
  asm volatile("s_mov_b32 %0, m0\n\ts_mov_b32 m0, %2\n\ts_nop 0\n\tglobal_load_lds_dwordx4 %1, off\n\ts_mov_b32 m0, %0":"=&s"(keep):"v"(gsrc),"s"(lds_dst):"memory");}
__device__ __forceinline__ float max3f(float a,float b,float c){float r;asm("v_max3_f32 %0, %1, %2, %3":"=v"(r):"v"(a),"v"(b),"v"(c));return r;}
__device__ __forceinline__ float max2f(float a,float b){float r;asm("v_max_f32_e32 %0, %1, %2":"=v"(r):"v"(a),"v"(b));return r;}
__device__ __forceinline__ float fadd_s(float a,float b){float r;asm("v_add_f32_e32 %0, %1, %2":"=v"(r):"v"(a),"v"(b));return r;}
__device__ __forceinline__ float fsub_s(float a,float b){float r;asm("v_sub_f32_e32 %0, %1, %2":"=v"(r):"v"(a),"v"(b));return r;}
typedef float f32x2_t __attribute__((ext_vector_type(2))); typedef __bf16 bf16x2_t __attribute__((ext_vector_type(2)));
__device__ __forceinline__ unsigned cvtpk_s(float lo,float hi){f32x2_t v={lo,hi};bf16x2_t b=__builtin_convertvector(v,bf16x2_t);return __builtin_bit_cast(unsigned,b);}
#define WAIT_BAR(N) asm volatile("s_waitcnt vmcnt(" #N ") lgkmcnt(0)\n\ts_barrier":::"memory")

template<bool ZERO> __device__ __forceinline__ f32x16 cinit(const f32x16&negm){ if constexpr(ZERO) return f32x16{}; else return negm; }
__device__ __forceinline__ void qkt(f32x16&p0,f32x16&p1,const char*Kslot,const bf16x8*qr,const f32x16 negm,int r32,int hi){
  const char*kb=Kslot+hi*1024+r32*16;
  #pragma unroll
  for(int d0=0;d0<4;++d0){
    const bf16x8 b0=*reinterpret_cast<const bf16x8*>(kb+d0*2048);
    const bf16x8 b1=*reinterpret_cast<const bf16x8*>(kb+d0*2048+512);
    if(d0==0){p0=__builtin_amdgcn_mfma_f32_32x32x16_bf16(b0,qr[0],negm,0,0,0);p1=__builtin_amdgcn_mfma_f32_32x32x16_bf16(b1,qr[0],negm,0,0,0);}
    else{p0=__builtin_amdgcn_mfma_f32_32x32x16_bf16(b0,qr[d0],p0,0,0,0);p1=__builtin_amdgcn_mfma_f32_32x32x16_bf16(b1,qr[d0],p1,0,0,0);}}
}
typedef __attribute__((address_space(3))) const char* lds_cptr;
typedef short v4i16_t __attribute__((ext_vector_type(4)));
__device__ __forceinline__ void kload8(bf16x8*kf,lds_cptr kp){
  kf[0]=*(const __attribute__((address_space(3))) bf16x8*)(kp);      kf[1]=*(const __attribute__((address_space(3))) bf16x8*)(kp+512);
  kf[2]=*(const __attribute__((address_space(3))) bf16x8*)(kp+2048); kf[3]=*(const __attribute__((address_space(3))) bf16x8*)(kp+2560);
  kf[4]=*(const __attribute__((address_space(3))) bf16x8*)(kp+4096); kf[5]=*(const __attribute__((address_space(3))) bf16x8*)(kp+4608);
  kf[6]=*(const __attribute__((address_space(3))) bf16x8*)(kp+6144); kf[7]=*(const __attribute__((address_space(3))) bf16x8*)(kp+6656);
}
__device__ __forceinline__ void kload2(bf16x8*kf,lds_cptr kp,int j){ kf[2*j]=*(const __attribute__((address_space(3))) bf16x8*)(kp+j*2048); kf[2*j+1]=*(const __attribute__((address_space(3))) bf16x8*)(kp+j*2048+512); }
__device__ __forceinline__ s16x4 vtr(lds_cptr p){ return __builtin_bit_cast(s16x4,__builtin_amdgcn_ds_read_tr16_b64_v4i16((__attribute__((address_space(3))) v4i16_t*)p)); }
__device__ __forceinline__ float rowmax(const f32x16&p0,const f32x16&p1){
  float a=max3f(p0[0],p0[1],p1[0]),b=max3f(p0[2],p0[3],p1[1]);a=max3f(a,p1[2],p1[3]);
  #pragma unroll
  for(int r=4;r<16;r+=4){a=max3f(a,p0[r],p0[r+1]);b=max3f(b,p0[r+2],p0[r+3]);a=max3f(a,p1[r],p1[r+1]);b=max3f(b,p1[r+2],p1[r+3]);}
  const float m=max2f(a,b);
  auto rr=__builtin_amdgcn_permlane32_swap(__float_as_uint(m),__float_as_uint(m),false,false);
  return max2f(__uint_as_float(rr[0]),__uint_as_float(rr[1]));
}
__device__ __forceinline__ void pv(f32x16*o,int vb,bf16x8 pa0,bf16x8 pa1,bf16x8 pa2,bf16x8 pa3){
  #pragma unroll
  for(int d0=0;d0<2;++d0){s16x4 lo[4],hi[4];
    #pragma unroll
    for(int ks=0;ks<4;++ks){
      asm volatile("ds_read_b64_tr_b16 %0,%1 offset:%c2":"=&v"(lo[ks]):"v"(vb),"i"(d0*4096+ks*1024):"memory");
      asm volatile("ds_read_b64_tr_b16 %0,%1 offset:%c2":"=&v"(hi[ks]):"v"(vb),"i"(d0*4096+ks*1024+512):"memory");}
    asm volatile("s_waitcnt lgkmcnt(0)":::"memory");SBAR();
    #define PK(k) (bf16x8){lo[k][0],lo[k][1],lo[k][2],lo[k][3],hi[k][0],hi[k][1],hi[k][2],hi[k][3]}
    o[d0]=__builtin_amdgcn_mfma_f32_32x32x16_bf16(pa0,PK(0),o[d0],0,0,0);
    o[d0]=__builtin_amdgcn_mfma_f32_32x32x16_bf16(pa1,PK(1),o[d0],0,0,0);
    o[d0]=__builtin_amdgcn_mfma_f32_32x32x16_bf16(pa2,PK(2),o[d0],0,0,0);
    o[d0]=__builtin_amdgcn_mfma_f32_32x32x16_bf16(pa3,PK(3),o[d0],0,0,0);
    #undef PK
  }
}

#ifndef ATTN_STORE16
#define ATTN_STORE16(p,v) (*(u32x4*)(p)=(v))
#endif
template<int THRL,bool BMODE> __device__ __forceinline__ void attn_unit(const bf16*Qu,const bf16*__restrict__ Kh,const bf16*__restrict__ Vh,bf16*Ou,const int NT,const int nfirst,const int first0,const int second0,const int qg,const float*rpbh,char*shm,const int wave_sgpr){
  int ln_=(int)__builtin_amdgcn_mbcnt_hi(~0u,__builtin_amdgcn_mbcnt_lo(~0u,0u)); asm volatile("":"+v"(ln_));
  const int wid=wave_sgpr,lane=ln_,tid=wid*64+lane,r32=lane&31,hi=lane>>5;
  const bf16*Qw=Qu+(long)(wid*QBLK)*DM;
  const unsigned lds0=(unsigned)(uintptr_t)shm;
  float*wsf=(float*)(shm+LDS_WS)+wid*64;
  const bf16*ksrc=Kh+(long)lane*DM+wid*8;
  const bf16*vsrc=Vh+(long)(16*(wid&3)+(lane>>2))*DM+(wid>>2)*32+(lane&3)*8;
  const unsigned kdst=lds0+LDS_K+wid*1024, vdst=lds0+LDS_V+wid*1024;
  #define TILE(t) (((t)<nfirst)?(first0+(t)):(second0+(t)-nfirst))
  #define DMA_K(t,slot) glds16(ksrc+(long)TILE(t)*KVBLK*DM,(unsigned)__builtin_amdgcn_readfirstlane(kdst+(slot)))
  #define DMA_V(t,slot) glds16(vsrc+(long)TILE(t)*KVBLK*DM,(unsigned)__builtin_amdgcn_readfirstlane(vdst+(slot)))
  const int vb0=(int)(lds0+LDS_V)+((lane>>4)&1)*32+(lane&3)*8+(4*hi+((lane&15)>>2))*64;
  const char*Kbase=shm+LDS_K; bf16x8 kf[8];
  const lds_cptr shm3=(lds_cptr)shm; const lds_cptr kp0=shm3+LDS_K+hi*1024+r32*16; const lds_cptr vp0=shm3+LDS_V+((lane>>4)&1)*32+(lane&3)*8+(4*hi+((lane&15)>>2))*64;
  unsigned bm0=0u,bm1=0u; int blane=0,bqr=0,brs=0;
  if constexpr(BMODE){ const int qc=(wid&1)*32+r32; int cs=qc-8; cs=cs<0?0:(cs>48?48:cs);
    _Pragma("unroll") for(int r=0;r<16;++r){ const int kc=(r&3)+8*(r>>2)+4*hi; bm0|=(kc>=cs&&kc<cs+16)?(1u<<r):0u; bm1|=(kc+32>=cs&&kc+32<cs+16)?(1u<<r):0u; }
    blane=(BT_PAD+15-qc+4*hi)*4; bqr=qg+(wid>>1); brs=bqr-4; brs=brs<0?0:(brs>24?24:brs);
    __attribute__((address_space(3))) float*bt=(__attribute__((address_space(3))) float*)(shm3+LDS_BT); for(int idx=tid;idx<15*BT_STRIDE;idx+=NW*64){ const int dr=idx/BT_STRIDE,j=idx%BT_STRIDE; bt[idx]=(j>=BT_PAD&&j<=BT_PAD+30)?rpbh[dr*31+j-BT_PAD]*1.4426950408889634f:0.f; } }
  DMA_K(0,0);DMA_V(0,0);DMA_K(1,SLOTB);
  bf16x8 qr[4];
  #pragma unroll
  for(int d0=0;d0<4;++d0)qr[d0]=*reinterpret_cast<const bf16x8*>(&Qw[(long)r32*DM+d0*16+hi*8]);
  float mhat=0.f,l_reg=0.f;f32x16 o[2];o[0]=f32x16{};o[1]=f32x16{};f32x16 negm=f32x16{}; if constexpr(!BMODE){asm volatile("":"+v"(negm));}
  #define CMASK(P0,P1,t) do{ if constexpr(BMODE){ if((t)>=nfirst){ const int kr_=second0+(t)-nfirst; const bool rv_=(kr_>=brs)&&(kr_<brs+8); int dr_=kr_-bqr+7; dr_=dr_<0?0:(dr_>14?14:dr_); \
      bias_apply(P0,P1,shm3+LDS_BT+dr_*(BT_STRIDE*4)+blane,rv_?bm0:0u,rv_?bm1:0u,mhat); } else { _Pragma("unroll") for(int r_=0;r_<16;++r_){P0[r_]-=mhat;P1[r_]-=mhat;} } } }while(0)
  bool resc=false;
  #define START(P0,P1) do{ const float rm=rowmax(P0,P1); resc=false; \
    { const float dl=rm; mhat=fadd_s(mhat,dl); \
      _Pragma("unroll") for(int r=0;r<16;++r){P0[r]=fsub_s(P0[r],dl);P1[r]=fsub_s(P1[r],dl);} \
      if constexpr(!BMODE){ _Pragma("unroll") for(int r=0;r<16;++r)negm[r]=-mhat; asm volatile("":"+v"(negm)); } } \
    _Pragma("unroll") for(int r=0;r<16;++r)P0[r]=__builtin_amdgcn_exp2f(P0[r]); }while(0)
  #define RESC() do{ if(resc){ asm volatile("s_waitcnt lgkmcnt(0)":::"memory"); \
      _Pragma("unroll") for(int d_=0;d_<2;++d_) _Pragma("unroll") for(int r=0;r<16;++r)o[d_][r]*=wsf[crow(r,hi)]; } }while(0)
  f32x16 pA0,pA1,pB0,pB1;
  int sl_prev=0,sl_cur=0,sl_next=SLOTB;
  #define ROT() do{sl_prev=sl_cur;sl_cur=sl_next;sl_next=(sl_next==(NSLOT-1)*SLOTB)?0:sl_next+SLOTB;}while(0)
  DMA_K(2,2*SLOTB);
  WAIT_BAR(3);
  qkt(pA0,pA1,Kbase,qr,cinit<BMODE>(negm),r32,hi);asm volatile("s_nop 15\n\ts_nop 7":"+v"(pA0),"+v"(pA1));CMASK(pA0,pA1,0);
  START(pA0,pA1);
  _Pragma("unroll") for(int r=0;r<16;++r)pA1[r]=__builtin_amdgcn_exp2f(pA1[r]);
  WAIT_BAR(0);
  DMA_K(3,0);DMA_V(1,SLOTB);
  ROT();
  kload8(kf,kp0+sl_cur);
  WAIT_BAR(2);
  s16x4 vlo[8],vhi[8]; u32x4 pw0,pw1,pw2,pw3;
  #define PKW(P,B) cvtpk_s(P[B],P[B+1])
  #define PAF(k) __builtin_bit_cast(bf16x8,pw##k)
  #define VFR(i) (bf16x8){vlo[i][0],vlo[i][1],vlo[i][2],vlo[i][3],vhi[i][0],vhi[i][1],vhi[i][2],vhi[i][3]}
  #define PIN(x) asm volatile("":"+v"(x))
  #define MX3(a,b,c) __builtin_fmaxf(__builtin_fmaxf((a),(b)),(c))
  #define GAPA(MF,A0,A1,A2,A3,W0,W1,PW) do{ MF; sacc+=A0; sacc+=A1; sacc+=A2; sacc+=A3; PIN(sacc); W0; W1; PIN(PW); SBAR(); }while(0)
  #define EX(v) __builtin_amdgcn_exp2f(v)
  #define GAPB(MF,X,B) do{ MF; X[B]=EX(X[B]); X[B+1]=EX(X[B+1]); X[B+2]=EX(X[B+2]); X[B+3]=EX(X[B+3]); PIN(X); SBAR(); }while(0)
  #define VRD(i) do{ vlo[i]=vtr(vp_+(((i)>>2)*4096+((i)&3)*1024)); vhi[i]=vtr(vp_+(((i)>>2)*4096+((i)&3)*1024+512)); }while(0)
  #define KRD(G,j) do{ if(G){ kload2(kf,kp0+sl_next,j); SBAR(); } }while(0)
  #define STEP(C0,C1,P0,P1,t,GK,GV,GL) do{ SBAR(); \
    const lds_cptr vp_=vp0+sl_prev; \
    VRD(0); SBAR(); float sacc=(P0[0]+P0[1]); \
    GAPA(C0=__builtin_amdgcn_mfma_f32_32x32x16_bf16(kf[0],qr[0],cinit<BMODE>(negm),0,0,0), P0[2],P0[3],P0[4],P0[5],     pw0[0]=PKW(P0,0), pw0[1]=PKW(P0,2), pw0); \
    VRD(4); SBAR(); GAPA(C1=__builtin_amdgcn_mfma_f32_32x32x16_bf16(kf[1],qr[0],cinit<BMODE>(negm),0,0,0), P0[6],P0[7],P0[8],P0[9],     pw0[2]=PKW(P0,4), pw0[3]=PKW(P0,6), pw0); \
    VRD(1); SBAR(); GAPA(C0=__builtin_amdgcn_mfma_f32_32x32x16_bf16(kf[2],qr[1],C0,0,0,0),   P0[10],P0[11],P0[12],P0[13], pw1[0]=PKW(P0,8), pw1[1]=PKW(P0,10), pw1); \
    VRD(5); SBAR(); GAPA(C1=__builtin_amdgcn_mfma_f32_32x32x16_bf16(kf[3],qr[1],C1,0,0,0),   P0[14],P0[15],P1[0],P1[1],   pw1[2]=PKW(P0,12),pw1[3]=PKW(P0,14), pw1); \
    VRD(2); SBAR(); GAPA(C0=__builtin_amdgcn_mfma_f32_32x32x16_bf16(kf[4],qr[2],C0,0,0,0),   P1[2],P1[3],P1[4],P1[5],     pw2[0]=PKW(P1,0), pw2[1]=PKW(P1,2), pw2); \
    VRD(6); SBAR(); GAPA(C1=__builtin_amdgcn_mfma_f32_32x32x16_bf16(kf[5],qr[2],C1,0,0,0),   P1[6],P1[7],P1[8],P1[9],     pw2[2]=PKW(P1,4), pw2[3]=PKW(P1,6), pw2); \
    VRD(3); SBAR(); GAPA(C0=__builtin_amdgcn_mfma_f32_32x32x16_bf16(kf[6],qr[3],C0,0,0,0),   P1[10],P1[11],P1[12],P1[13], pw3[0]=PKW(P1,8), pw3[1]=PKW(P1,10), pw3); \
    VRD(7); SBAR(); GAPA(C1=__builtin_amdgcn_mfma_f32_32x32x16_bf16(kf[7],qr[3],C1,0,0,0),   P1[14],P1[15],0.f,0.f,       pw3[2]=PKW(P1,12),pw3[3]=PKW(P1,14), pw3); \
    l_reg+=sacc; \
    if(GK){DMA_K((t)+3,sl_cur);} if(GV){DMA_V((t)+1,sl_next);} \
    CMASK(C0,C1,t); \
    { float a=MX3(C0[0],C0[1],C1[0]),b=MX3(C0[2],C0[3],C1[1]); a=MX3(a,C1[2],C1[3]); \
      _Pragma("unroll") for(int r=4;r<16;r+=4){a=MX3(a,C0[r],C0[r+1]);b=MX3(b,C0[r+2],C0[r+3]);a=MX3(a,C1[r],C1[r+1]);b=MX3(b,C1[r+2],C1[r+3]);} \
      float rm=__builtin_fmaxf(a,b); { auto rr=__builtin_amdgcn_permlane32_swap(__float_as_uint(rm),__float_as_uint(rm),false,false); rm=__builtin_fmaxf(__uint_as_float(rr[0]),__uint_as_float(rr[1])); } \
      resc=false; \
      if(__builtin_expect(__any(rm>(float)THRL),0)){ const float dl=__builtin_fmaxf(rm,0.f); mhat+=dl; \
        _Pragma("unroll") for(int r=0;r<16;++r){C0[r]-=dl;C1[r]-=dl;} \
        if constexpr(!BMODE){ _Pragma("unroll") for(int r=0;r<16;++r)negm[r]=-mhat; asm volatile("":"+v"(negm)); } \
        const float f=__builtin_amdgcn_exp2f(-dl); l_reg*=f; if(hi==0)wsf[r32]=f; resc=true; } } \
    SBAR(); \
    GAPB(o[0]=__builtin_amdgcn_mfma_f32_32x32x16_bf16(PAF(0),VFR(0),o[0],0,0,0), C0,0); \
    GAPB(o[1]=__builtin_amdgcn_mfma_f32_32x32x16_bf16(PAF(0),VFR(4),o[1],0,0,0), C0,4); \
    KRD(GL,0); GAPB(o[0]=__builtin_amdgcn_mfma_f32_32x32x16_bf16(PAF(1),VFR(1),o[0],0,0,0), C0,8); \
    KRD(GL,1); GAPB(o[1]=__builtin_amdgcn_mfma_f32_32x32x16_bf16(PAF(1),VFR(5),o[1],0,0,0), C0,12); \
    KRD(GL,2); GAPB(o[0]=__builtin_amdgcn_mfma_f32_32x32x16_bf16(PAF(2),VFR(2),o[0],0,0,0), C1,0); \
    KRD(GL,3); GAPB(o[1]=__builtin_amdgcn_mfma_f32_32x32x16_bf16(PAF(2),VFR(6),o[1],0,0,0), C1,4); \
    GAPB(o[0]=__builtin_amdgcn_mfma_f32_32x32x16_bf16(PAF(3),VFR(3),o[0],0,0,0), C1,8); \
    GAPB(o[1]=__builtin_amdgcn_mfma_f32_32x32x16_bf16(PAF(3),VFR(7),o[1],0,0,0), C1,12); \
    }while(0)
  int t=1;
  for(;t+5<NT;t+=2){
    STEP(pB0,pB1,pA0,pA1,t,true,true,true);     WAIT_BAR(2); RESC(); ROT();
    STEP(pA0,pA1,pB0,pB1,t+1,true,true,true);   WAIT_BAR(2); RESC(); ROT();
  }
  #define ENDW(tt) do{ if((tt)+3<NT){WAIT_BAR(2);} else if((tt)+2<NT){WAIT_BAR(1);} else {WAIT_BAR(0);} }while(0)
  for(;t+1<NT;t+=2){
    STEP(pB0,pB1,pA0,pA1,t,(t+3<NT),(t+1<NT),(t+1<NT));       ENDW(t);   RESC(); ROT();
    STEP(pA0,pA1,pB0,pB1,t+1,(t+4<NT),(t+2<NT),(t+2<NT));     ENDW(t+1); RESC(); ROT();
  }
  STEP(pB0,pB1,pA0,pA1,NT-1,false,false,false); RESC();
  { float sacc=pB0[0]+pB0[1]; _Pragma("unroll") for(int r=2;r<16;++r)sacc+=pB0[r]; _Pragma("unroll") for(int r=0;r<16;++r)sacc+=pB1[r]; l_reg+=sacc;
    pw0=(u32x4){PKW(pB0,0),PKW(pB0,2),PKW(pB0,4),PKW(pB0,6)};pw1=(u32x4){PKW(pB0,8),PKW(pB0,10),PKW(pB0,12),PKW(pB0,14)};pw2=(u32x4){PKW(pB1,0),PKW(pB1,2),PKW(pB1,4),PKW(pB1,6)};pw3=(u32x4){PKW(pB1,8),PKW(pB1,10),PKW(pB1,12),PKW(pB1,14)};
    SBAR(); pv(o,vb0+sl_cur,PAF(0),PAF(1),PAF(2),PAF(3)); }
  #undef PKW
  #undef PAF
  #undef VFR
  #undef PIN
  #undef MX3
  #undef GAPA
  #undef GAPB
  #undef EX
  #undef VRD
  #undef KRD
  #undef STEP
  #undef ENDW
  {auto rr=__builtin_amdgcn_permlane32_swap(__float_as_uint(l_reg),__float_as_uint(l_reg),false,false);l_reg=__uint_as_float(rr[0])+__uint_as_float(rr[1]);}
  if(hi==0)wsf[32+r32]=l_reg;asm volatile("s_waitcnt lgkmcnt(0)":::"memory");
  float rli[16];
  #pragma unroll
  for(int r=0;r<16;++r)rli[r]=__builtin_amdgcn_rcpf(wsf[32+crow(r,hi)]);
  bf16*Ow=Ou+(long)(wid*QBLK)*DM;
  { bf16*stg=(bf16*)(shm+LDS_OST)+wid*2048;
    #pragma unroll
    for(int r=0;r<16;++r){const int orow=crow(r,hi);
      #pragma unroll
      for(int d0=0;d0<2;++d0)stg[orow*64+d0*32+r32]=__float2bfloat16(o[d0][r]*rli[r]);}
    asm volatile("s_waitcnt lgkmcnt(0)":::"memory");
    #pragma unroll
    for(int i=0;i<4;++i){const int row=i*8+(lane>>3),ch=lane&7; const u32x4 v=*(const u32x4*)(stg+row*64+ch*8); ATTN_STORE16(Ow+(long)row*DM+ch*8,v);} }
  asm volatile("s_waitcnt lgkmcnt(0)\n\ts_barrier":::"memory");
  #undef TILE
  #undef DMA_K
  #undef DMA_V
  #undef CMASK
  #undef START
  #undef RESC
  #undef ROT
}
constexpr int ATTN_LDS_BYTES=LDS_BT+15*BT_STRIDE*4;
#undef SBAR
#undef WAIT_BAR
}
#define XB_TMO      128
#define XB_XCNT(j)  (256  + 64 * (j))
#define XB_XSUB(j)  (1280 + 64 * (j))
#define XB_XGEN(j)  (2304 + 64 * (j))
#define XB_TOP      3328
#define XB_TOPGEN   3392
#define XCD_BAR_WORDS 3456
#define XB_SPIN_CAP (1u << 18)

__device__ __forceinline__ unsigned xb_ld(unsigned* p)              { return __hip_atomic_load(p, __ATOMIC_RELAXED, __HIP_MEMORY_SCOPE_AGENT); }
__device__ __forceinline__ unsigned xb_add(unsigned* p, unsigned v) { return __hip_atomic_fetch_add(p, v, __ATOMIC_RELAXED, __HIP_MEMORY_SCOPE_AGENT); }
__device__ __forceinline__ unsigned xb_xcc_id() { return (unsigned)__builtin_amdgcn_s_getreg((3 << 11) | 20) & 0xFu; }
#define XB_SPIN(cond, bar) do { unsigned _sp = 0; while (cond) { __builtin_amdgcn_s_sleep(1); \
    if ((++_sp & 255u) == 0u) { if (xb_ld(&(bar)[XB_TMO])) break; if (_sp > XB_SPIN_CAP) { atomicAdd(&(bar)[XB_TMO], 1u); break; } } } } while (0)

struct XcdBarrier {
    unsigned* bar; unsigned x;
    volatile LAS unsigned* st;
};

__device__ __forceinline__ XcdBarrier xcd_barrier_post(unsigned* bar, volatile LAS unsigned* st) {
    XcdBarrier b; b.bar = bar; b.x = xb_xcc_id(); b.st = st;
    if (threadIdx.x == 0) (void)xb_add(&bar[XB_XCNT(b.x)], 1u);
    return b;
}
__device__ __forceinline__ void xcd_barrier_complete(unsigned* bar, unsigned x, unsigned& nloc, unsigned& nx) {
    const unsigned G = gridDim.x * gridDim.y * gridDim.z;
    unsigned sum, cnt, mine, sp = 0u;
    for (;;) {
        sum = 0u; cnt = 0u; mine = 0u;
#pragma unroll
        for (unsigned j = 0; j < 16; ++j) { const unsigned c = xb_ld(&bar[XB_XCNT(j)]); sum += c; cnt += (c > 0u) ? 1u : 0u; mine = (j == x) ? c : mine; }
        if (sum == G) break;
        __builtin_amdgcn_s_sleep(1);
        if ((++sp & 255u) == 0u) { if (xb_ld(&bar[XB_TMO])) break; if (sp > XB_SPIN_CAP) { atomicAdd(&bar[XB_TMO], 1u); break; } }
    }
    nloc = mine > 0u ? mine : 1u; nx = cnt > 0u ? cnt : 1u;
}

__device__ __forceinline__ void xcd_barrier(const XcdBarrier& b) {
    asm volatile("s_waitcnt vmcnt(0)" ::: "memory");
    __syncthreads();
    if (threadIdx.x == 0) {
        unsigned* bar = b.bar;
        __builtin_amdgcn_s_waitcnt(0);
        unsigned nloc = b.st[0], nx = b.st[1];
        if (nloc == 0u) { xcd_barrier_complete(bar, b.x, nloc, nx); b.st[0] = nloc; b.st[1] = nx; }
        const unsigned old = xb_add(&bar[XB_XSUB(b.x)], 1u);
        const unsigned gen = old / nloc;
        if (old + 1u == (gen + 1u) * nloc) {
            __builtin_amdgcn_fence(__ATOMIC_RELEASE, "agent");
            asm volatile("s_waitcnt vmcnt(0)" ::: "memory");
            const unsigned og = xb_add(&bar[XB_TOP], 1u);
            const unsigned tg = og / nx;
            if (og + 1u == (tg + 1u) * nx) xb_add(&bar[XB_TOPGEN], 1u);
            else XB_SPIN(xb_ld(&bar[XB_TOPGEN]) == tg, bar);
            __builtin_amdgcn_fence(__ATOMIC_ACQUIRE, "agent");
            xb_add(&bar[XB_XGEN(b.x)], 1u);
            asm volatile("s_waitcnt vmcnt(0)" ::: "memory");
        } else {
            XB_SPIN(xb_ld(&bar[XB_XGEN(b.x)]) == gen, bar);
            __builtin_amdgcn_fence(__ATOMIC_ACQUIRE, "agent");
            asm volatile("s_waitcnt vmcnt(0)" ::: "memory");
        }
    }
    __syncthreads();
}

struct Frame {
    LAS unsigned char* lds;
    volatile LAS unsigned* MISC;
    unsigned* ctl;
    int tid, lane, wave, vcu, G;
    float* out; unsigned char* ws;
};
__device__ __forceinline__ const float* inp(const Frame& F, int i) {
    unsigned long long a_ = (unsigned long long)__builtin_amdgcn_kernarg_segment_ptr(); asm volatile("" : "+s"(a_));
    return (const float*)(((const __attribute__((address_space(4))) unsigned long long*)a_)[i]);
}
enum { I_X = 0, I_C, I_CTX, I_CCTX, I_WMOD, I_BMOD, I_WIN, I_GQA, I_GKA, I_GQB, I_GKB, I_RPB, I_CONVW, I_CONVB, I_GOUT, I_WOUT, I_F1, I_F3, I_F2, I_ROUTER, I_ROUTERB, I_M1, I_M3, I_M2 };

struct CvItem { const float* src; unsigned char* dst; int N, K, orow0, k0; };
__device__ __forceinline__ CvItem cv_item(const float* W, int K, int N, void* WT, int il, int half, int item) {
    const int nblk = N / 64, kb = item / nblk, nb = item % nblk, k0 = 64 * kb, n0 = 64 * nb;
    CvItem it; it.src = W + (size_t)k0 * N + n0; it.dst = (unsigned char*)WT; it.N = N; it.K = K; it.k0 = k0; it.orow0 = il ? ((n0 >> 7) * 256 + half * 128 + (n0 & 127)) : n0; return it;
}
__device__ __forceinline__ void cv_load(f32x4 (&v)[16], const CvItem& it, int lane) {
    const float* src = it.src + (size_t)(lane >> 4) * it.N + 4 * (lane & 15);
#pragma unroll
    for (int i = 0; i < 16; ++i) v[i] = __builtin_nontemporal_load((const GAS f32x4*)(src + (size_t)(4 * i) * it.N));
}
__device__ __forceinline__ void cv_to_lds(const f32x4 (&v)[16], LAS float* scr, int lane) {
#pragma unroll
    for (int i = 0; i < 16; ++i) { LAS float* d = scr + (4 * i + (lane >> 4)) * 65 + 4 * (lane & 15); d[0] = v[i].x; d[1] = v[i].y; d[2] = v[i].z; d[3] = v[i].w; }
    LDS_WAIT(); asm volatile("" ::: "memory");
}
template <bool F8> __device__ __forceinline__ void cv_finish(const CvItem& it, LAS float* scr, int lane) {
    const int c = lane & 7;
#pragma unroll
    for (int j = 0; j < 8; ++j) { const int n = (lane >> 3) + 8 * j; const LAS float* s = scr + (8 * c) * 65 + n;
        if constexpr (F8) { v2u o; o.x = pk4_f8(s[0 * 65] * 64.f, s[1 * 65] * 64.f, s[2 * 65] * 64.f, s[3 * 65] * 64.f); o.y = pk4_f8(s[4 * 65] * 64.f, s[5 * 65] * 64.f, s[6 * 65] * 64.f, s[7 * 65] * 64.f);
            __builtin_nontemporal_store(o, (GAS v2u*)(it.dst + (size_t)(it.orow0 + n) * it.K + it.k0 + 8 * c)); }
        else { v4u o; o.x = pk2(s[0 * 65], s[1 * 65]); o.y = pk2(s[2 * 65], s[3 * 65]); o.z = pk2(s[4 * 65], s[5 * 65]); o.w = pk2(s[6 * 65], s[7 * 65]);
            *(GAS v4u*)((bf16*)it.dst + (size_t)(it.orow0 + n) * it.K + it.k0 + 8 * c) = o; } }
    LDS_WAIT(); asm volatile("" ::: "memory");
}
__device__ __forceinline__ float silu_f(float v) { return v / (1.0f + __expf(-v)); }

constexpr int CV_IT_IN = 16 * 36, CV_IT_OUT = 16 * 16, CV_IT_F = 704, CV_DENSE_ITEMS = 2 * CV_IT_IN + 2 * CV_IT_OUT + 3 * CV_IT_F, CV_MOE_ITEMS = 24 * CV_IT_F;
__device__ __forceinline__ CvItem cv_dense_item(Frame& F, int r) {
    if (r < 2 * CV_IT_IN) { const int l = r / CV_IT_IN; return cv_item(inp(F, I_WIN) + (size_t)l * 1024 * INW, 1024, INW, (bf16*)(F.ws + WS_WIN) + (size_t)l * INW * 1024, 0, 0, r % CV_IT_IN); } r -= 2 * CV_IT_IN;
    if (r < 2 * CV_IT_OUT) { const int l = r / CV_IT_OUT; return cv_item(inp(F, I_WOUT) + (size_t)l * 1024 * 1024, 1024, 1024, (bf16*)(F.ws + WS_WOUT) + (size_t)l * 1024 * 1024, 0, 0, r % CV_IT_OUT); } r -= 2 * CV_IT_OUT;
    if (r < CV_IT_F) return cv_item(inp(F, I_F1), 1024, DFF, F.ws + WS_F13, 1, 0, r); r -= CV_IT_F;
    if (r < CV_IT_F) return cv_item(inp(F, I_F3), 1024, DFF, F.ws + WS_F13, 1, 1, r); r -= CV_IT_F;
    return cv_item(inp(F, I_F2), DFF, 1024, F.ws + WS_F2, 0, 0, r);
}
__device__ __forceinline__ void p0_prologue(Frame& F) {
    const int gw = F.vcu * NWAVES + F.wave, NGW = F.G * NWAVES;
    if (blockIdx.x == 0) {
        float* tab = (float*)(F.ws + WS_MISC + MS_ROPE);
        for (int idx = F.tid; idx < 1024; idx += NWAVES * 64) { const int pos = idx >> 4, i = idx & 15;
            const float inv = powf(10000.0f, -(float)(2 * i) / 32.0f); const float ang = (float)pos * inv;
            tab[2 * idx] = cosf(ang); tab[2 * idx + 1] = sinf(ang); }
    }
    {
        LAS float* sv = (LAS float*)F.lds;
        LAS float* red = (LAS float*)(F.lds + 17 * 1024 * 4);
        bool staged = false;
        for (int task = blockIdx.x; task < 192; task += F.G) {
            if (!staged) {
                for (int idx = F.tid; idx < 17 * 1024; idx += NWAVES * 64) { const int r = idx >> 10, k = idx & 1023; const float v = r < 16 ? inp(F, I_C)[r * 1024 + k] : inp(F, I_CCTX)[k]; sv[idx] = silu_f(v); }
                staged = true; __syncthreads();
            }
            const int l = task / 96, cb = task % 96, col = cb * 64 + F.lane;
            const float* W = inp(F, I_WMOD) + (size_t)l * 1024 * 6144 + col;
            float acc[17];
#pragma unroll
            for (int r = 0; r < 17; ++r) acc[r] = 0.f;
            const int kbeg = F.wave * 128;
#pragma unroll 8
            for (int k = kbeg; k < kbeg + 128; ++k) { const float wv = W[(size_t)k * 6144];
#pragma unroll
                for (int r = 0; r < 17; ++r) acc[r] += sv[r * 1024 + k] * wv; }
#pragma unroll
            for (int r = 0; r < 17; ++r) red[(F.wave * 17 + r) * 64 + F.lane] = acc[r];
            __syncthreads();
            for (int idx = F.tid; idx < 17 * 64; idx += NWAVES * 64) { const int r = idx >> 6, ln = idx & 63; float s = 0.f;
#pragma unroll
                for (int w = 0; w < 8; ++w) s += red[(w * 17 + r) * 64 + ln];
                const int n = cb * 64 + ln;
                ((float*)(F.ws + WS_MOD))[((size_t)l * 17 + r) * 6144 + n] = s + inp(F, I_BMOD)[l * 6144 + n]; }
            __syncthreads();
        }
        __syncthreads();
    }
    {
        LAS float* scr = (LAS float*)(F.lds + F.wave * 17408);
        f32x4 v[16]; int it = gw;
        if (it < CV_DENSE_ITEMS) cv_load(v, cv_dense_item(F, it), F.lane);
        while (it < CV_DENSE_ITEMS) {
            const CvItem cur = cv_dense_item(F, it); const bool f8 = it >= 2 * CV_IT_IN + 2 * CV_IT_OUT + 2 * CV_IT_F;
            cv_to_lds(v, scr, F.lane);
            it += NGW; if (it < CV_DENSE_ITEMS) cv_load(v, cv_dense_item(F, it), F.lane);
            if (f8) cv_finish<true>(cur, scr, F.lane); else cv_finish<false>(cur, scr, F.lane);
        }
    }
}
__device__ __forceinline__ CvItem cv_moe_item(Frame& F, int r) {
    constexpr int IT_F = 704;
    const int e = r / (3 * IT_F), q = r % (3 * IT_F), which = q / IT_F, item = q % IT_F;
    if (which == 0) return cv_item(inp(F, I_M1) + (size_t)e * 1024 * DFF, 1024, DFF, F.ws + WS_M13 + (size_t)e * 5632 * 1024, 1, 0, item);
    if (which == 1) return cv_item(inp(F, I_M3) + (size_t)e * 1024 * DFF, 1024, DFF, F.ws + WS_M13 + (size_t)e * 5632 * 1024, 1, 1, item);
    return cv_item(inp(F, I_M2) + (size_t)e * DFF * 1024, DFF, 1024, F.ws + WS_M2 + (size_t)e * 1024 * DFF, 0, 0, item);
}
__device__ __forceinline__ void convert_moe_weights(Frame& F, int first, int end, int step) {
    LAS float* scr = (LAS float*)(F.lds + F.wave * 17408);
    f32x4 v[16]; int it = first;
    if (it < end) cv_load(v, cv_moe_item(F, it), F.lane);
    while (it < end) {
        const CvItem cur = cv_moe_item(F, it);
        cv_to_lds(v, scr, F.lane);
        it += step; if (it < end) cv_load(v, cv_moe_item(F, it), F.lane);
        cv_finish<true>(cur, scr, F.lane);
    }
}

constexpr int SHW_TASKS = 88;
__device__ __forceinline__ void shw_task(Frame& F, int task) {
    LAS float* sv = (LAS float*)F.lds; LAS float* red = (LAS float*)(F.lds + 17 * 1024 * 4);
    const float* src = (const float*)(F.ws + WS_MOD) + 3072;
    __syncthreads();
    for (int idx = F.tid; idx < 17 * 1024; idx += NWAVES * 64) { const int r = idx >> 10, kk = idx & 1023; sv[idx] = src[(size_t)r * 6144 + kk]; }
    __syncthreads();
    const int half = task / 44, n0 = (task % 44) * 64, ip = (n0 >> 7) * 256 + half * 128 + (n0 & 127);
    const float* W = inp(F, half ? I_F3 : I_F1) + n0 + F.lane;
    float acc[17];
#pragma unroll
    for (int r = 0; r < 17; ++r) acc[r] = 0.f;
    const int kbeg = F.wave * 128;
#pragma unroll 8
    for (int kk = kbeg; kk < kbeg + 128; ++kk) { const float wv = W[(size_t)kk * DFF];
#pragma unroll
        for (int r = 0; r < 17; ++r) acc[r] += sv[r * 1024 + kk] * wv; }
#pragma unroll
    for (int r = 0; r < 17; ++r) red[(F.wave * 17 + r) * 64 + F.lane] = acc[r];
    __syncthreads();
    for (int idx = F.tid; idx < 17 * 64; idx += NWAVES * 64) { const int r = idx >> 6, ln = idx & 63; float s = 0.f;
#pragma unroll
        for (int w = 0; w < 8; ++w) s += red[(w * 17 + r) * 64 + ln];
        ((float*)(F.ws + WS_SHW13))[(size_t)r * 5632 + ip + ln] = s; }
    __syncthreads();
}
__device__ __forceinline__ void tail_shw(Frame& F, int nunits) {
    const int rounds = (nunits + F.G - 1) / F.G, full = nunits - (rounds - 1) * F.G, c = (int)blockIdx.x;
    if (full >= F.G || F.G - full < SHW_TASKS) { for (int t = c; t < SHW_TASKS; t += F.G) shw_task(F, t); return; }
    if (c >= full && c - full < SHW_TASKS) shw_task(F, c - full);
}
__device__ __forceinline__ void tail_convert(Frame& F, int nunits, int lo, int hi) {
    const int rounds = (nunits + F.G - 1) / F.G, full = nunits - (rounds - 1) * F.G, c = (int)blockIdx.x;
    if (full >= F.G) { if (MK_N_LAUNCHES != 1) convert_moe_weights(F, lo + F.vcu * NWAVES + F.wave, hi, F.G * NWAVES); else if (c == 0) {   } return; }
    if (c >= full) { __syncthreads(); convert_moe_weights(F, lo + (c - full) * NWAVES + F.wave, hi, (F.G - full) * NWAVES); }
}
constexpr int CV_S1 = 4275, CV_S2 = CV_S1 + 2565, CV_S3 = CV_S2 + 2850;

__device__ __forceinline__ const float* xrow_ptr(const float* lat, const float* ctx, int s) { const int b = s / TPB, j = s % TPB; return j < SEQ ? lat + (size_t)(b * SEQ + j) * DM : ctx + (size_t)(b * CTXL + j - SEQ) * DM; }

template <bool F8 = false> __device__ __forceinline__ void norm_mod_rows(Frame& F, const float* lat, const float* ctx, const float* mod, int shoff, int scoff, bf16* XN, bool with_ctx, bf16* XBo) {
    const int gw = F.vcu * NWAVES + F.wave, NGW = F.G * NWAVES;
    constexpr int R = 6;
    for (int s0 = gw * R; s0 < MROWS; s0 += NGW * R) {
        f32x4 v[R][4];
#pragma unroll
        for (int r = 0; r < R; ++r) { const GAS f32x4* xr = (const GAS f32x4*)xrow_ptr(lat, ctx, s0 + r) + F.lane;
#pragma unroll
            for (int q = 0; q < 4; ++q) v[r][q] = __builtin_nontemporal_load(xr + 64 * q); }
#pragma unroll
        for (int r = 0; r < R; ++r) { const int s = s0 + r, b = s / TPB, j = s % TPB;
            const float* mrow = mod + (size_t)(j < SEQ ? b : 16) * 6144;
            float ss = 0.f;
#pragma unroll
            for (int q = 0; q < 4; ++q) ss += (v[r][q].x * v[r][q].x + v[r][q].y * v[r][q].y) + (v[r][q].z * v[r][q].z + v[r][q].w * v[r][q].w);
            const float rstd = 1.0f / sqrtf(wave_sum(ss, F.lane) * (1.0f / DM) + NORM_EPS);
            GAS v2u* o8 = (GAS v2u*)(XN + (size_t)s * DM) + F.lane;
#pragma unroll
            for (int q = 0; q < 4; ++q) { const f32x4 sh = *(const f32x4*)(mrow + shoff + 4 * F.lane + 256 * q), sc = *(const f32x4*)(mrow + scoff + 4 * F.lane + 256 * q);
                const f32x4 y = v[r][q] * rstd * (sc + 1.0f) + sh;
                if constexpr (F8) ((GAS unsigned*)((unsigned char*)XN + (size_t)s * DM))[F.lane + 64 * q] = pk4_f8(y.x, y.y, y.z, y.w);
                else { v2u w; w.x = pk2(y.x, y.y); w.y = pk2(y.z, y.w); o8[64 * q] = w; }
                { v2u wx; wx.x = pk2(v[r][q].x, v[r][q].y); wx.y = pk2(v[r][q].z, v[r][q].w); ((GAS v2u*)(XBo + (size_t)s * DM) + F.lane)[64 * q] = wx; } } }
    }
}

__device__ __forceinline__ void unpack8(const v4u w, float (&v)[8]);
__device__ __forceinline__ void norm_mod_rows_bf(Frame& F, const bf16* XB, const float* mod, int shoff, int scoff, bf16* XN) {
    const int gw = F.vcu * NWAVES + F.wave, NGW = F.G * NWAVES;
    constexpr int R = 6;
    for (int s0 = gw * R; s0 < MROWS; s0 += NGW * R) {
        v4u w[R][2];
#pragma unroll
        for (int r = 0; r < R; ++r) { const GAS v4u* xr = (const GAS v4u*)(XB + (size_t)(s0 + r) * DM) + F.lane; w[r][0] = __builtin_nontemporal_load(xr); w[r][1] = __builtin_nontemporal_load(xr + 64); }
#pragma unroll
        for (int r = 0; r < R; ++r) { const int s = s0 + r, b = s / TPB, j = s % TPB;
            const float* mrow = mod + (size_t)(j < SEQ ? b : 16) * 6144;
            float v[2][8]; unpack8(w[r][0], v[0]); unpack8(w[r][1], v[1]);
            float ss = 0.f;
#pragma unroll
            for (int h = 0; h < 2; ++h)
#pragma unroll
                for (int i = 0; i < 8; ++i) ss += v[h][i] * v[h][i];
            const float rstd = 1.0f / sqrtf(wave_sum(ss, F.lane) * (1.0f / DM) + NORM_EPS);
#pragma unroll
            for (int h = 0; h < 2; ++h) { const int c0 = 512 * h + 8 * F.lane;
                const f32x4 sh0 = *(const f32x4*)(mrow + shoff + c0), sh1 = *(const f32x4*)(mrow + shoff + c0 + 4), sc0 = *(const f32x4*)(mrow + scoff + c0), sc1 = *(const f32x4*)(mrow + scoff + c0 + 4);
                float y[8];
#pragma unroll
                for (int i = 0; i < 4; ++i) { y[i] = v[h][i] * rstd * (sc0[i] + 1.0f) + sh0[i]; y[4 + i] = v[h][4 + i] * rstd * (sc1[i] + 1.0f) + sh1[i]; }
                v4u o; o.x = pk2(y[0], y[1]); o.y = pk2(y[2], y[3]); o.z = pk2(y[4], y[5]); o.w = pk2(y[6], y[7]);
                *((GAS v4u*)(XN + (size_t)s * DM + c0)) = o; } }
    }
}

__device__ __forceinline__ void headnorm_rows(Frame& F, int l, bool ctx_q) {
    const int gw = F.vcu * NWAVES + F.wave, NGW = F.G * NWAVES; bf16* P = (bf16*)(F.ws + WS_P);
    const float* tab = (const float*)(F.ws + WS_MISC + MS_ROPE);
    const int d = F.lane;
    const float gqa = inp(F, I_GQA)[l * 64 + d], gka = inp(F, I_GKA)[l * 64 + d], gqb = inp(F, I_GQB)[l * 64 + d], gkb = inp(F, I_GKB)[l * 64 + d];
    for (int s = gw; s < MROWS; s += NGW) {
        const int j = s % TPB; const bool lat = j < SEQ; bf16* p = P + (size_t)s * INW;
        float cs = 1.f, sn = 0.f;
        if (lat) { const int pos = (d < 32) ? (j >> 6) : (j & 63); const int i = d & 15; cs = tab[2 * (pos * 16 + i)]; sn = tab[2 * (pos * 16 + i) + 1]; }
        const float sgn = (d & 16) ? 1.f : -1.f;
#pragma unroll 1
        for (int h = 0; h < 18; ++h) {
            int off; float g; bool rope, isq;
            if (h < 8) { off = QA_OFF + 64 * h; g = gqa; rope = true; isq = true; }
            else if (h < 12) { off = QB_OFF + 64 * (h - 8); g = gqb; rope = false; isq = true; }
            else if (h < 14) { off = KA_OFF + 64 * (h - 12); g = gka; rope = true; isq = false; }
            else { off = KB_OFF + 64 * (h - 14); g = gkb; rope = false; isq = false; }
            if (isq && !lat && !ctx_q) continue;
            const float v = bf1(p[off + d]);
            const float ss = wave_sum(v * v, F.lane);
            float y = v * (1.0f / sqrtf(ss * (1.0f / 64.0f) + NORM_EPS)) * g;
            const float pr = xshfl(y, 16, F.lane);
            if (rope && lat) y = y * cs + sgn * pr * sn;
            if (isq) y *= C2;
            p[off + d] = (bf16)f2bf(y);
        }
    }
}

#ifdef ATTN_NAIVE
struct NaiveState { float q[64], o[64], m, l; };
__device__ __forceinline__ void na_load_q(NaiveState& S, const bf16* qp) {
#pragma unroll
    for (int c = 0; c < 8; ++c) { const v4u w = *(const v4u*)(qp + 8 * c);
        S.q[8 * c + 0] = bflo(w.x); S.q[8 * c + 1] = bfhi(w.x); S.q[8 * c + 2] = bflo(w.y); S.q[8 * c + 3] = bfhi(w.y);
        S.q[8 * c + 4] = bflo(w.z); S.q[8 * c + 5] = bfhi(w.z); S.q[8 * c + 6] = bflo(w.w); S.q[8 * c + 7] = bfhi(w.w); }
#pragma unroll
    for (int i = 0; i < 64; ++i) S.o[i] = 0.f;
    S.m = -1e30f; S.l = 0.f;
}
__device__ __forceinline__ float na_dot(const NaiveState& S, const bf16* kp) {
    float s = 0.f;
#pragma unroll
    for (int c = 0; c < 8; ++c) { const v4u w = *(const v4u*)(kp + 8 * c);
        s += S.q[8 * c + 0] * bflo(w.x) + S.q[8 * c + 1] * bfhi(w.x) + S.q[8 * c + 2] * bflo(w.y) + S.q[8 * c + 3] * bfhi(w.y)
           + S.q[8 * c + 4] * bflo(w.z) + S.q[8 * c + 5] * bfhi(w.z) + S.q[8 * c + 6] * bflo(w.w) + S.q[8 * c + 7] * bfhi(w.w); }
    return s;
}
__device__ __forceinline__ void na_acc(NaiveState& S, float p, const bf16* vp) {
#pragma unroll
    for (int c = 0; c < 8; ++c) { const v4u w = *(const v4u*)(vp + 8 * c);
        S.o[8 * c + 0] += p * bflo(w.x); S.o[8 * c + 1] += p * bfhi(w.x); S.o[8 * c + 2] += p * bflo(w.y); S.o[8 * c + 3] += p * bfhi(w.y);
        S.o[8 * c + 4] += p * bflo(w.z); S.o[8 * c + 5] += p * bfhi(w.z); S.o[8 * c + 6] += p * bflo(w.w); S.o[8 * c + 7] += p * bfhi(w.w); }
}
__device__ __forceinline__ void na_step2(NaiveState& S, float s0, float s1, const bf16* v0, const bf16* v1) {
    const float mn = fmaxf(S.m, fmaxf(s0, s1));
    const float sc = __builtin_amdgcn_exp2f(S.m - mn), p0 = __builtin_amdgcn_exp2f(s0 - mn), p1 = __builtin_amdgcn_exp2f(s1 - mn);
    S.l = S.l * sc + p0 + p1; S.m = mn;
#pragma unroll
    for (int i = 0; i < 64; ++i) S.o[i] *= sc;
    na_acc(S, p0, v0); na_acc(S, p1, v1);
}
__device__ __forceinline__ void na_store(const NaiveState& S, bf16* op) {
    const float inv = 1.0f / S.l;
#pragma unroll
    for (int c = 0; c < 8; ++c) { v4u w; w.x = pk2(S.o[8 * c + 0] * inv, S.o[8 * c + 1] * inv); w.y = pk2(S.o[8 * c + 2] * inv, S.o[8 * c + 3] * inv);
        w.z = pk2(S.o[8 * c + 4] * inv, S.o[8 * c + 5] * inv); w.w = pk2(S.o[8 * c + 6] * inv, S.o[8 * c + 7] * inv); *(v4u*)(op + 8 * c) = w; }
}
__device__ __forceinline__ void attn_naive_phase(Frame& F, int l, bool with_ctx) {
    const int gw = F.vcu * NWAVES + F.wave, NGW = F.G * NWAVES; bf16* P = (bf16*)(F.ws + WS_P);
    const float* rpb = inp(F, I_RPB) + (size_t)l * 4 * 15 * 31;
    const int ntask = with_ctx ? 6912 : 6144;
    for (int task = gw; task < ntask; task += NGW) {
        NaiveState S;
        if (task < 4096 || (task >= 6144 && task < 6656)) {
            int b, qh, j0, k0, k1;
            if (task < 4096) { b = task >> 8; qh = (task >> 5) & 7; j0 = (task & 31) * 64; k0 = 0; k1 = TPB; }
            else { const int t = task - 6144; b = t >> 5; qh = (t >> 2) & 7; j0 = SEQ + (t & 3) * 64; k0 = SEQ; k1 = TPB; }
            bf16* qp = P + (size_t)(b * TPB + j0 + F.lane) * INW + QA_OFF + qh * 64;
            na_load_q(S, qp);
            const bf16* Kb = P + (size_t)(b * TPB) * INW + KA_OFF + (qh >> 2) * 64; const bf16* Vb = P + (size_t)(b * TPB) * INW + VA_OFF + (qh >> 2) * 64;
            for (int k = k0; k < k1; k += 2) { const float s0 = na_dot(S, Kb + (size_t)k * INW), s1 = na_dot(S, Kb + (size_t)(k + 1) * INW); na_step2(S, s0, s1, Vb + (size_t)k * INW, Vb + (size_t)(k + 1) * INW); }
            na_store(S, qp);
        } else {
            int b, h, j; bool lat;
            if (task < 6144) { const int t = task - 4096; b = t >> 7; h = (t >> 5) & 3; j = (t & 31) * 64 + F.lane; lat = true; }
            else { const int t = task - 6656; b = t >> 4; h = (t >> 2) & 3; j = SEQ + (t & 3) * 64 + F.lane; lat = false; }
            bf16* qp = P + (size_t)(b * TPB + j) * INW + QB_OFF + h * 64;
            na_load_q(S, qp);
            const bf16* Kb = P + (size_t)(b * TPB) * INW + KB_OFF + h * 64; const bf16* Vb = P + (size_t)(b * TPB) * INW + VB_OFF + h * 64;
            if (lat) {
                const int r = j >> 6, c = j & 63; int rs = r - 4; rs = rs < 0 ? 0 : (rs > 24 ? 24 : rs); int cs = c - 8; cs = cs < 0 ? 0 : (cs > 48 ? 48 : cs);
                for (int i = 0; i < 8; ++i) { const int kr = rs + i; const float* brow = rpb + (h * 15 + (kr - r + 7)) * 31 + (15 - c);
                    for (int jc = 0; jc < 16; jc += 2) { const int kc = cs + jc; const int k = kr * 64 + kc;
                        const float s0 = na_dot(S, Kb + (size_t)k * INW) + brow[kc] * LOG2E, s1 = na_dot(S, Kb + (size_t)(k + 1) * INW) + brow[kc + 1] * LOG2E;
                        na_step2(S, s0, s1, Vb + (size_t)k * INW, Vb + (size_t)(k + 1) * INW); } }
            }
            for (int k = SEQ; k < TPB; k += 2) { const float s0 = na_dot(S, Kb + (size_t)k * INW), s1 = na_dot(S, Kb + (size_t)(k + 1) * INW); na_step2(S, s0, s1, Vb + (size_t)k * INW, Vb + (size_t)(k + 1) * INW); }
            na_store(S, qp);
        }
    }
}


#endif
__device__ __forceinline__ void attn_mfma_phase(Frame& F, int l, bool with_ctx, char* ldsg) {
    typedef attn_body::bf16 abf;
    abf* P = (abf*)(F.ws + WS_P); const int v = F.vcu;
    const int NA = 1024 + (with_ctx ? 192 : 0);
#pragma unroll 1
    for (int u = v; u < NA; u += F.G) {
        int b, qcol, kcol, vcol, qrow, NT, first0;
        if (u < 1024) { b = u >> 6; const int kvh = (u >> 5) & 1, qh = kvh * 4 + ((u >> 3) & 3); qrow = (u & 7) * 256; qcol = QA_OFF + qh * 64; kcol = KA_OFF + kvh * 64; vcol = VA_OFF + kvh * 64; NT = 36; first0 = 0; }
        else if (u < 1024 + 128) { const int t = u - 1024; b = t >> 3; const int qh = t & 7; qrow = SEQ; qcol = QA_OFF + qh * 64; kcol = KA_OFF + (qh >> 2) * 64; vcol = VA_OFF + (qh >> 2) * 64; NT = 4; first0 = 32; }
        else { const int t = u - 1152; b = t >> 2; const int h = t & 3; qrow = SEQ; qcol = QB_OFF + h * 64; kcol = KB_OFF + h * 64; vcol = VB_OFF + h * 64; NT = 4; first0 = 32; }
        abf* Qu = P + (size_t)(b * TPB + qrow) * INW + qcol; const abf* Kh = P + (size_t)(b * TPB) * INW + kcol; const abf* Vh = P + (size_t)(b * TPB) * INW + vcol;
        attn_body::attn_unit<8, false>(Qu, Kh, Vh, Qu, NT, NT, first0, 0, 0, nullptr, ldsg, F.wave);
    }
#ifndef NO_BSITE
    const float* rpbl = inp(F, I_RPB) + (size_t)l * 4 * 15 * 31;
#pragma unroll 1
    for (int u = v; u < 512; u += F.G) {
        const int b = u >> 5, h = (u >> 3) & 3, qb = u & 7, qg = 4 * qb;
        const int n0 = (qb == 0 || qb == 7) ? 8 : 12, s0 = qb == 0 ? 0 : (qb == 7 ? 24 : qg - 4);
        abf* Qu = P + (size_t)(b * TPB + qb * 256) * INW + QB_OFF + h * 64; const abf* Kh = P + (size_t)(b * TPB) * INW + KB_OFF + h * 64; const abf* Vh = P + (size_t)(b * TPB) * INW + VB_OFF + h * 64;
        attn_body::attn_unit<8, true>(Qu, Kh, Vh, Qu, 4 + n0, 4, 32, s0, qg, rpbl + h * 15 * 31, ldsg, F.wave);
    }
#endif
}

__device__ __forceinline__ void unpack8(const v4u w, float (&v)[8]) { v[0] = bflo(w.x); v[1] = bfhi(w.x); v[2] = bflo(w.y); v[3] = bfhi(w.y); v[4] = bflo(w.z); v[5] = bfhi(w.z); v[6] = bflo(w.w); v[7] = bfhi(w.w); }
__device__ __forceinline__ void merge_rows(Frame& F, int l, bool with_ctx) {
    const int gw = F.vcu * NWAVES + F.wave, NGW = F.G * NWAVES; const bf16* P = (const bf16*)(F.ws + WS_P); bf16* CAT = (bf16*)(F.ws + WS_XN);
    const float* gout = inp(F, I_GOUT) + l * 1024; const float* cw = inp(F, I_CONVW) + l * 3 * 256; const float* cb = inp(F, I_CONVB) + l * 256;
    const int lane = F.lane; const bool cl = lane >= 32; const int ch0 = 8 * (lane & 31);
    constexpr int R = 2;
    for (int s0 = gw * R; s0 < MROWS; s0 += NGW * R) {
        if (!with_ctx && (s0 % TPB) >= SEQ) continue;
        v4u la[R], lb[R], lt[R][6]; bool tv[R][3];
#pragma unroll
        for (int r = 0; r < R; ++r) { const int s = s0 + r, j = s % TPB; const bool lat = j < SEQ; const bf16* p = P + (size_t)s * INW;
            la[r] = *(const v4u*)(p + 8 * lane);
            lb[r] = *(const v4u*)(p + (cl ? CPOST_OFF + ch0 : 512 + 8 * lane));
            const int jlo = lat ? 0 : SEQ, jhi = lat ? SEQ : TPB;
#pragma unroll
            for (int tap = 0; tap < 3; ++tap) { const int jj = j + tap - 1; tv[r][tap] = cl && jj >= jlo && jj < jhi;
                if (tv[r][tap]) { const bf16* pp = p + (ptrdiff_t)(tap - 1) * INW; lt[r][2 * tap] = *(const v4u*)(pp + CPRE_OFF + ch0); lt[r][2 * tap + 1] = *(const v4u*)(pp + CVAL_OFF + ch0); }
                else { lt[r][2 * tap] = (v4u){0u, 0u, 0u, 0u}; lt[r][2 * tap + 1] = (v4u){0u, 0u, 0u, 0u}; } } }
#pragma unroll
        for (int r = 0; r < R; ++r) { const int s = s0 + r;
            float va[8], vb[8];
            unpack8(la[r], va); unpack8(lb[r], vb);
            if (cl) { float y[8];
#pragma unroll
                for (int k = 0; k < 8; ++k) y[k] = cb[ch0 + k];
#pragma unroll
                for (int tap = 0; tap < 3; ++tap) { float a[8], c[8]; unpack8(lt[r][2 * tap], a); unpack8(lt[r][2 * tap + 1], c);
#pragma unroll
                    for (int k = 0; k < 8; ++k) y[k] += cw[tap * 256 + ch0 + k] * (a[k] * c[k]); }
#pragma unroll
                for (int k = 0; k < 8; ++k) vb[k] = vb[k] * y[k]; }
            float sa = 0.f, sb = 0.f;
#pragma unroll
            for (int k = 0; k < 8; ++k) { sa += va[k] * va[k]; sb += vb[k] * vb[k]; }
            const float ra = 1.0f / sqrtf(wave_sum(sa, lane) * (1.0f / 512.0f) + NORM_EPS), rb = 1.0f / sqrtf(half_sum(sb, lane) * (1.0f / 256.0f) + NORM_EPS);
            v4u oa, ob; float g[8];
#pragma unroll
            for (int k = 0; k < 8; ++k) g[k] = gout[8 * lane + k];
            oa.x = pk2(va[0] * ra * g[0], va[1] * ra * g[1]); oa.y = pk2(va[2] * ra * g[2], va[3] * ra * g[3]); oa.z = pk2(va[4] * ra * g[4], va[5] * ra * g[5]); oa.w = pk2(va[6] * ra * g[6], va[7] * ra * g[7]);
#pragma unroll
            for (int k = 0; k < 8; ++k) g[k] = gout[512 + 8 * lane + k];
            ob.x = pk2(vb[0] * rb * g[0], vb[1] * rb * g[1]); ob.y = pk2(vb[2] * rb * g[2], vb[3] * rb * g[3]); ob.z = pk2(vb[4] * rb * g[4], vb[5] * rb * g[5]); ob.w = pk2(vb[6] * rb * g[6], vb[7] * rb * g[7]);
            *(v4u*)(CAT + (size_t)s * DM + 8 * lane) = oa; *(v4u*)(CAT + (size_t)s * DM + 512 + 8 * lane) = ob; }
    }
}

__device__ __forceinline__ void moe_route(Frame& F, const float* mod) {
    const bf16* XB = (const bf16*)(F.ws + WS_XB); unsigned char* XT = F.ws + WS_XT8;
    int* tok_e = (int*)(F.ws + WS_MISC + MS_TOKE); float* tok_g = (float*)(F.ws + WS_MISC + MS_TOKG);
    const float* wr = inp(F, I_ROUTER); const float* br = inp(F, I_ROUTERB);
    LAS int* le = (LAS int*)F.lds;
    LAS int* lcnt = le + 256;
    LAS f32x4* wl = (LAS f32x4*)(F.lds + 2048);
    for (int idx = F.tid; idx < 2048; idx += NWAVES * 64) { const int ln = idx & 63, hf = (idx >> 6) & 1, kk = (idx >> 7) & 7, hh = idx >> 10; wl[idx] = *(const f32x4*)(wr + (size_t)(512 * hh + 8 * ln + kk) * 8 + 4 * hf); }
    __syncthreads();
    for (int ch = blockIdx.x; ch < NTOK / 128; ch += F.G) {
#pragma unroll 2
        for (int i = 0; i < 16; ++i) {
            const int tl = F.wave * 16 + i, tok = ch * 128 + tl, b = tok / SEQ, s = b * TPB + (tok - b * SEQ);
            const GAS v4u* xr = (const GAS v4u*)(XB + (size_t)s * DM) + F.lane; const float* mrow = mod + (size_t)b * 6144;
            const v4u w0 = __builtin_nontemporal_load(xr), w1 = __builtin_nontemporal_load(xr + 64);
            float v[2][8]; unpack8(w0, v[0]); unpack8(w1, v[1]);
            float ss = 0.f;
#pragma unroll
            for (int h = 0; h < 2; ++h)
#pragma unroll
                for (int q = 0; q < 8; ++q) ss += v[h][q] * v[h][q];
            const float rstd = 1.0f / sqrtf(wave_sum(ss, F.lane) * (1.0f / DM) + NORM_EPS);
            float lg[8];
#pragma unroll
            for (int e = 0; e < 8; ++e) lg[e] = 0.f;
#pragma unroll
            for (int h = 0; h < 2; ++h) { const int c0 = 512 * h + 8 * F.lane;
                const f32x4 sh0 = *(const f32x4*)(mrow + 3072 + c0), sh1 = *(const f32x4*)(mrow + 3072 + c0 + 4), sc0 = *(const f32x4*)(mrow + 4096 + c0), sc1 = *(const f32x4*)(mrow + 4096 + c0 + 4);
                float y[8];
#pragma unroll
                for (int q = 0; q < 4; ++q) { y[q] = v[h][q] * rstd * (sc0[q] + 1.0f) + sh0[q]; y[4 + q] = v[h][4 + q] * rstd * (sc1[q] + 1.0f) + sh1[q]; }
                v2u o; o.x = pk4_f8(y[0], y[1], y[2], y[3]); o.y = pk4_f8(y[4], y[5], y[6], y[7]);
                *((GAS v2u*)(XT + (size_t)tok * DM + c0)) = o;
#pragma unroll
                for (int q = 0; q < 8; ++q) { const f32x4 wa = wl[((h * 8 + q) * 2 + 0) * 64 + F.lane], wb = wl[((h * 8 + q) * 2 + 1) * 64 + F.lane]; const float yk = y[q];
                    lg[0] += yk * wa.x; lg[1] += yk * wa.y; lg[2] += yk * wa.z; lg[3] += yk * wa.w; lg[4] += yk * wb.x; lg[5] += yk * wb.y; lg[6] += yk * wb.z; lg[7] += yk * wb.w; } }
            { const int ln = F.lane; float t4[4], t2[2], t1;
#pragma unroll
              for (int e = 0; e < 4; ++e) { const float keep = (ln & 32) ? lg[e + 4] : lg[e], give = (ln & 32) ? lg[e] : lg[e + 4]; t4[e] = keep + xshfl(give, 32, ln); }
#pragma unroll
              for (int e = 0; e < 2; ++e) { const float keep = (ln & 16) ? t4[e + 2] : t4[e], give = (ln & 16) ? t4[e] : t4[e + 2]; t2[e] = keep + xshfl(give, 16, ln); }
              { const float keep = (ln & 8) ? t2[1] : t2[0], give = (ln & 8) ? t2[0] : t2[1]; t1 = keep + xshfl(give, 8, ln); }
              t1 += xshfl(t1, 4, ln); t1 += xshfl(t1, 2, ln); t1 += xshfl(t1, 1, ln);
#pragma unroll
              for (int e = 0; e < 8; ++e) lg[e] = __int_as_float(__builtin_amdgcn_readlane(__float_as_int(t1), 8 * e)) + br[e]; }
            int e0 = 0; float v0 = lg[0];
#pragma unroll
            for (int e = 1; e < 8; ++e) if (lg[e] > v0) { v0 = lg[e]; e0 = e; }
            int e1 = -1; float v1 = -3.0e38f;
#pragma unroll
            for (int e = 0; e < 8; ++e) if (e != e0 && lg[e] > v1) { v1 = lg[e]; e1 = e; }
            const float p1 = __expf(v1 - v0), g0 = 1.0f / (1.0f + p1), g1 = p1 / (1.0f + p1);
            if (F.lane == 0) { tok_e[2 * tok] = e0; tok_e[2 * tok + 1] = e1; tok_g[2 * tok] = g0; tok_g[2 * tok + 1] = g1; le[2 * tl] = e0; le[2 * tl + 1] = e1; }
        }
        __syncthreads();
        if (F.tid < 256) { const int e = le[F.tid];
#pragma unroll
            for (int ee = 0; ee < 8; ++ee) { const unsigned long long m = __ballot(e == ee); if (F.lane == 0) lcnt[F.wave * 8 + ee] = __popcll(m); } }
        __syncthreads();
        if (F.tid < 8) F.ctl[CW_CNT + ch * 8 + F.tid] = (unsigned)(lcnt[F.tid] + lcnt[8 + F.tid] + lcnt[16 + F.tid] + lcnt[24 + F.tid]);
        __syncthreads();
    }
}
__device__ __forceinline__ void moe_sort_scatter(Frame& F) {
    const unsigned char* XT = F.ws + WS_XT8; unsigned char* XS = F.ws + WS_XS8;
    const int* tok_e = (const int*)(F.ws + WS_MISC + MS_TOKE); const float* tok_g = (const float*)(F.ws + WS_MISC + MS_TOKG);
    int* tok_s = (int*)(F.ws + WS_MISC + MS_TOKS); float* slot_g = (float*)(F.ws + WS_MISC + MS_SLOTG); int* meta = (int*)(F.ws + WS_MISC + MS_META);
    LAS int* ltot = (LAS int*)F.lds; LAS int* lpre = ltot + 8; LAS int* lps = ltot + 16; LAS int* wcnt = ltot + 32; LAS int* lslot = ltot + 64; LAS int* lacc = ltot + 320;
    for (int ch = blockIdx.x; ch < NTOK / 128; ch += F.G) {
        if (F.tid < 64) lacc[F.tid] = 0;
        __syncthreads();
        int myexp = 0;
        if (F.tid < 256) {
            const v4u c0 = *(const GAS v4u*)(F.ctl + CW_CNT + F.tid * 8), c1 = *(const GAS v4u*)(F.ctl + CW_CNT + F.tid * 8 + 4);
            const unsigned cn[8] = {c0.x, c0.y, c0.z, c0.w, c1.x, c1.y, c1.z, c1.w};
#pragma unroll
            for (int e = 0; e < 8; ++e) { __hip_atomic_fetch_add(lacc + F.wave * 16 + e, (int)cn[e], __ATOMIC_RELAXED, __HIP_MEMORY_SCOPE_WORKGROUP); if (F.tid < ch) __hip_atomic_fetch_add(lacc + F.wave * 16 + 8 + e, (int)cn[e], __ATOMIC_RELAXED, __HIP_MEMORY_SCOPE_WORKGROUP); }
            myexp = tok_e[2 * (ch * 128) + F.tid];
        }
        __syncthreads();
        if (F.tid < 16) ltot[F.tid] = lacc[F.tid] + lacc[16 + F.tid] + lacc[32 + F.tid] + lacc[48 + F.tid];
        __syncthreads();
        if (F.tid == 0) { int p = 0;
#pragma unroll
            for (int e = 0; e < 8; ++e) { lps[e] = p; p += (ltot[e] + 255) & ~255; } lps[8] = p; }
        int myrank = 0;
        if (F.tid < 256) {
#pragma unroll
            for (int ee = 0; ee < 8; ++ee) { const unsigned long long m = __ballot(myexp == ee); if (myexp == ee) myrank = __popcll(m & ((1ull << F.lane) - 1ull)); if (F.lane == 0) wcnt[F.wave * 8 + ee] = __popcll(m); } }
        __syncthreads();
        if (F.tid < 256) { int base = lps[myexp] + lpre[myexp] + myrank;
            for (int w = 0; w < F.wave; ++w) base += wcnt[w * 8 + myexp];
            lslot[F.tid] = base; tok_s[2 * (ch * 128) + F.tid] = base; slot_g[base] = tok_g[2 * (ch * 128) + F.tid]; }
        __syncthreads();
#pragma unroll 1
        for (int a0 = F.wave; a0 < 256; a0 += 8 * NWAVES) {
            v4u r[8];
#pragma unroll
            for (int j = 0; j < 8; ++j) { const int a = a0 + j * NWAVES; r[j] = *((const GAS v4u*)(XT + (size_t)(ch * 128 + (a >> 1)) * DM) + F.lane); }
#pragma unroll
            for (int j = 0; j < 8; ++j) { const int a = a0 + j * NWAVES; *((GAS v4u*)(XS + (size_t)lslot[a] * DM) + F.lane) = r[j]; } }
        if (ch < 8) {
            const int p0 = lps[ch] + ltot[ch], p1 = lps[ch + 1];
            for (int r = p0 + F.wave; r < p1; r += NWAVES) { GAS v4u* dst = (GAS v4u*)(XS + (size_t)r * DM) + F.lane; dst[0] = (v4u){0u, 0u, 0u, 0u}; if (F.lane == 0) slot_g[r] = 0.f; }
        }
        if (ch == 0 && F.tid < 8) meta[F.tid] = lps[F.tid + 1] >> 8;
        __syncthreads();
    }
}
__device__ __forceinline__ void moe_combine(Frame& F, const float* mod, int mode, int slot_lim, int gw, int NGW) { const bf16* Y = (const bf16*)(F.ws + WS_XN); const bf16* XB = (const bf16*)(F.ws + WS_XB); const int* tok_s = (const int*)(F.ws + WS_MISC + MS_TOKS);
    constexpr int R = 4;
    for (int t0 = gw * R; t0 < NTOK; t0 += NGW * R) {
        v4u wx[R][2], wa[R][2], wc[R][2]; bool ok[R]; int sl0[R], sl1[R]; bool any = false;
#pragma unroll
        for (int r = 0; r < R; ++r) { sl0[r] = tok_s[2 * (t0 + r)]; sl1[r] = tok_s[2 * (t0 + r) + 1]; ok[r] = ((sl0[r] < slot_lim && sl1[r] < slot_lim) ? 0 : 1) == mode; any = any || ok[r]; }
        if (!any) continue;
#pragma unroll
        for (int r = 0; r < R; ++r) { const int tok = t0 + r, b = tok / SEQ, s = b * TPB + (tok - b * SEQ), s0 = sl0[r], s1 = sl1[r];
            const GAS v4u* xr = (const GAS v4u*)(XB + (size_t)s * DM) + F.lane; const GAS v4u* y0 = (const GAS v4u*)(Y + (size_t)s0 * DM) + F.lane; const GAS v4u* y1 = (const GAS v4u*)(Y + (size_t)s1 * DM) + F.lane;
#pragma unroll
            for (int h = 0; h < 2; ++h) { wx[r][h] = __builtin_nontemporal_load(xr + 64 * h); wa[r][h] = __builtin_nontemporal_load(y0 + 64 * h); wc[r][h] = __builtin_nontemporal_load(y1 + 64 * h); } }
#pragma unroll
        for (int r = 0; r < R; ++r) { const int tok = t0 + r, b = tok / SEQ; const float* g = mod + (size_t)b * 6144 + 5120; float* orow = F.out + (size_t)tok * DM;
#pragma unroll
            for (int h = 0; h < 2; ++h) { float x[8], a[8], c[8]; unpack8(wx[r][h], x); unpack8(wa[r][h], a); unpack8(wc[r][h], c);
                const int c0 = 512 * h + 8 * F.lane; const f32x4 g0 = *(const f32x4*)(g + c0), g1 = *(const f32x4*)(g + c0 + 4);
                f32x4 o0, o1;
#pragma unroll
                for (int i = 0; i < 4; ++i) { o0[i] = x[i] + g0[i] * (a[i] + c[i]); o1[i] = x[4 + i] + g1[i] * (a[4 + i] + c[4 + i]); }
                if (ok[r]) { __builtin_nontemporal_store(o0, (GAS f32x4*)(orow + c0)); __builtin_nontemporal_store(o1, (GAS f32x4*)(orow + c0 + 4)); } } }
    }
}

struct Args { const float* in[24]; float* out; unsigned char* ws; int ph_lo, ph_hi, li, pad; };
__global__ void __launch_bounds__(NWAVES * 64, 2) mk_fwd(Args args) {
    extern __shared__ __attribute__((aligned(16))) unsigned char lds[];
    Frame F;
    F.lds = (LAS unsigned char*)lds; F.MISC = (volatile LAS unsigned*)(F.lds + MISC_OFF);
    F.tid = threadIdx.x; F.lane = F.tid & 63; F.wave = __builtin_amdgcn_readfirstlane(F.tid >> 6);
    F.G = gridDim.x; { const int bx = blockIdx.x; F.vcu = (F.G % 8 == 0) ? (bx % 8) * (F.G / 8) + bx / 8 : bx; }
    F.out = args.out; F.ws = args.ws; F.ctl = (unsigned*)(args.ws + WS_CTL);
    for (int u = F.tid; u < (LDS_BYTES - LDSCTL_OFF) / 4; u += NWAVES * 64) ((LAS unsigned*)(F.lds + LDSCTL_OFF))[u] = 0u;
    __syncthreads();
    if (F.tid < 24) { const unsigned long long p = (unsigned long long)args.in[F.tid]; LAS unsigned* t = (LAS unsigned*)(F.lds + LDSCTL_OFF + 64) + 2 * F.tid; t[0] = (unsigned)p; t[1] = (unsigned)(p >> 32); }
    __syncthreads();
    XcdBarrier bar; bar.bar = F.ctl + CW_BAR; bar.x = 0; bar.st = nullptr;
    if (MK_N_LAUNCHES == 1) bar = xcd_barrier_post(F.ctl + CW_BAR, F.MISC + 8);
    const int lo = args.ph_lo, hi = args.ph_hi;
#ifndef PHMASK
#define PHMASK 0xFFFFFFFFu
#endif
#define PHON(k) (((PHMASK) >> (k)) & 1u)
#define IN(k) (PHON(k) && lo <= (k) && (k) < hi)
#define INL(x) ((((PHMASK) >> (1 + (x))) & 1u) && lo <= pb + (x) && pb + (x) < hi)
#define INR(k) (lo <= (k) && (k) < hi)
#ifdef PROF_MASK
    if (F.tid == 0) { F.MISC[16] = (unsigned)__builtin_amdgcn_s_memrealtime(); F.MISC[17] = 0u; }
#define STAMP(k) do { if (F.wave == 0 && __builtin_amdgcn_mbcnt_hi(~0u, __builtin_amdgcn_mbcnt_lo(~0u, 0u)) == 0u) { const unsigned now_ = (unsigned)__builtin_amdgcn_s_memrealtime(); if (((unsigned)(PROF_MASK) >> (k)) & 1u) F.MISC[17] = F.MISC[17] + (now_ - F.MISC[16]); F.MISC[16] = now_; } } while (0)
#else
#define STAMP(k) do { } while (0)
#endif
#define SEAM(k) do { if (INR(k) && INR((k) + 1)) xcd_barrier(bar); STAMP(k); } while (0)
    bf16* XB = (bf16*)(F.ws + WS_XB); bf16* XN = (bf16*)(F.ws + WS_XN); bf16* P = (bf16*)(F.ws + WS_P);
    const float* MOD = (const float*)(F.ws + WS_MOD);
    bf16* XN2 = (bf16*)(F.ws + WS_P + 100 * MiB);
#define TABMEM (F.lds + LDSCTL_OFF + 448)
#define PF() do { int ln_ = (int)__builtin_amdgcn_mbcnt_hi(~0u, __builtin_amdgcn_mbcnt_lo(~0u, 0u)); asm volatile("" : "+v"(ln_)); F.lane = ln_; F.tid = F.wave * 64 + ln_; } while (0)

    if (IN(0)) { PF(); p0_prologue(F); } SEAM(0);

#pragma unroll 1
    for (int l = 0; l < 2; ++l) {
        const int pb = 1 + 9 * l; const bool last = (l == 1);
        const float* mod = MOD + (size_t)l * 17 * 6144;
        const float* xlat = inp(F, I_X); const float* xctx = inp(F, I_CTX);
        if (INL(0)) { PF(); if (!last) norm_mod_rows(F, xlat, xctx, mod, 0, 1024, XN, true, XB); else norm_mod_rows_bf(F, XB, mod, 0, 1024, XN); } SEAM(pb + 0);
        if (INL(1)) { PF();
            pg8::Gemm g{XN, (const bf16*)(F.ws + WS_WIN) + (size_t)l * INW * 1024, MROWS, INW, 1024};
            const pg8::TabOrder T = last ? pg8::build_units(TABMEM, 1024, XN, g.Bt, F.G, (int)blockIdx.x, 128, 9, 0, 1, 0, 16, 3, 6, 2, nullptr, 0, F.tid)
                                         : pg8::build_units(TABMEM, 1024, XN, g.Bt, F.G, (int)blockIdx.x, NPAN, 9, 0, 0, 0, 0, 1, 0, 0, nullptr, 0, F.tid);
#ifdef SEPARATE_HN
            pg8::EpiRawBf16 E{P, INW};
            pg8::gemm_phase<pg8::EpiRawBf16, pg8::TabOrder, true, true>(F.lds, g, T, E, F.wave);
#else
            { const float* tg = (const float*)(F.ws + WS_MISC + MS_ROPE); LAS float* tl = (LAS float*)(F.lds + 131072);
              for (int i = F.tid; i < 2048; i += NWAVES * 64) tl[i] = tg[i];
              if (F.tid < 256) { const int w = F.tid >> 6, d = F.tid & 63; const float* gs = w == 0 ? inp(F, I_GQA) : (w == 1 ? inp(F, I_GKA) : (w == 2 ? inp(F, I_GQB) : inp(F, I_GKB))); ((LAS float*)(F.lds + LDSCTL_OFF + 2048))[F.tid] = gs[l * 64 + d]; } }
            pg8::EpiHeads E{P, (const LAS float*)(F.lds + LDSCTL_OFF + 2048), (const LAS float*)(F.lds + 131072)};
            pg8::gemm_phase<pg8::EpiHeads, pg8::TabOrder, true, true>(F.lds, g, T, E, F.wave);
#endif
            if (!last) { tail_shw(F, NPAN * 9); tail_convert(F, NPAN * 9, 0, CV_S1); }
        } SEAM(pb + 1);
#ifdef SEPARATE_HN
        if (INL(2)) { PF(); headnorm_rows(F, l, !last); } SEAM(pb + 2);
#endif
        #ifdef ATTN_NAIVE
        if (INL(3)) { PF(); attn_naive_phase(F, l, !last); } SEAM(pb + 3);
#else
        if (INL(3)) { PF(); attn_mfma_phase(F, l, !last, (char*)lds); } SEAM(pb + 3);
#endif
        if (INL(4)) { PF(); merge_rows(F, l, !last); } SEAM(pb + 4);
        if (INL(5)) { PF();
            pg8::Gemm g{XN, (const bf16*)(F.ws + WS_WOUT) + (size_t)l * 1024 * 1024, MROWS, 1024, 1024};
            const pg8::TabOrder T = pg8::build_units(TABMEM, 1024, XN, g.Bt, F.G, (int)blockIdx.x, last ? 128 : NPAN, 4, 0, last ? 1 : 0, 0, 0, 1, 0, 0, nullptr, 0, F.tid);
            if (!last) { pg8::EpiGateRes<true> E{XB, mod, 2048, 1.0f, XN2, (float*)(F.ws + WS_PART), 4096, (LAS float*)(F.lds + 131072)};
                pg8::gemm_phase<pg8::EpiGateRes<true>, pg8::TabOrder, true, true>(F.lds, g, T, E, F.wave); }
            else { pg8::EpiGateRes<false> E{XB, mod, 2048, 1.0f, nullptr, nullptr, 0, nullptr};
                pg8::gemm_phase<pg8::EpiGateRes<false>, pg8::TabOrder, true, true>(F.lds, g, T, E, F.wave); }
            if (!last) tail_convert(F, NPAN * 4, CV_S1, CV_S2);
        } SEAM(pb + 5);
        if (!last) {
            if (IN(8)) { PF();
                pg8::Gemm g{XN2, (const bf16*)(F.ws + WS_F13), MROWS, 5632, 1024};
                const pg8::TabOrder T = pg8::build_units(TABMEM, 1024, XN2, g.Bt, F.G, (int)blockIdx.x, NPAN, 22, 0, 0, 0, 0, 1, 0, 0, nullptr, 0, F.tid);
                pg8::EpiSwigluF8<true> E{(unsigned char*)P, DFF, 1.0f, (const float*)(F.ws + WS_PART), (const float*)(F.ws + WS_SHW13)};
                pg8::gemm_phase<pg8::EpiSwigluF8<true>, pg8::TabOrder, true, true>(F.lds, g, T, E, F.wave);
                tail_convert(F, NPAN * 22, CV_S2, CV_S3);
            } SEAM(8);
            if (IN(9)) { PF();
                pg8::Gemm g{P, (const bf16*)(F.ws + WS_F2), MROWS, 1024, DFF / 2};
                const pg8::TabOrder T = pg8::build_units(TABMEM, DFF / 2, P, g.Bt, F.G, (int)blockIdx.x, NPAN, 4, 0, 0, 0, 0, 1, 0, 0, nullptr, 0, F.tid);
                pg8::EpiGateRes<false> E{XB, mod, 5120, 1.0f / 64.0f, nullptr, nullptr, 0, nullptr};
                pg8::gemm_phase<pg8::EpiGateRes<false>, pg8::TabOrder, true, true, true>(F.lds, g, T, E, F.wave);
                tail_convert(F, NPAN * 4, CV_S3, CV_MOE_ITEMS);
            } SEAM(9);
        }
    }
    {
        const float* mod = MOD + (size_t)17 * 6144;
        if (IN(16)) { PF(); moe_route(F, mod); } SEAM(16);
        if (IN(17)) { PF(); moe_sort_scatter(F); } SEAM(17);
        const int* meta = (const int*)(F.ws + WS_MISC + MS_META);
        if (IN(18)) { PF();
            const int TP = __builtin_amdgcn_readfirstlane(meta[7]);
            pg8::Gemm g{(const bf16*)(F.ws + WS_XS8), (const bf16*)(F.ws + WS_M13), 0, 5632, 512};
            const pg8::TabOrder T = pg8::build_units(TABMEM, 512, g.A, g.Bt, F.G, (int)blockIdx.x, TP, 22, 0, 0, 0, 0, 1, 0, 0, meta, (size_t)5632 * 1024, F.tid);
            pg8::EpiSwigluF8<false> E{F.ws + WS_H8, DFF, 1.0f / 64.0f, nullptr, nullptr};
            pg8::gemm_phase<pg8::EpiSwigluF8<false>, pg8::TabOrder, true, true, true>(F.lds, g, T, E, F.wave);
        } SEAM(18);
        if (IN(19)) { PF();
            const int TP = __builtin_amdgcn_readfirstlane(meta[7]), npa = TP < 256 ? TP : 256;
            pg8::Gemm g{(const bf16*)(F.ws + WS_H8), (const bf16*)(F.ws + WS_M2), 0, 1024, DFF / 2};
            const pg8::TabOrder T = pg8::build_units(TABMEM, DFF / 2, g.A, g.Bt, F.G, (int)blockIdx.x, npa, 4, 0, 0, 0, 0, 1, 0, 0, meta, (size_t)1024 * DFF, F.tid);
            pg8::EpiMoeOut E{XN, (const float*)(F.ws + WS_MISC + MS_SLOTG), 1.0f / 64.0f};
            pg8::gemm_phase<pg8::EpiMoeOut, pg8::TabOrder, true, true, true>(F.lds, g, T, E, F.wave);
        } SEAM(19);
        if (IN(20)) { PF();
            const int TP = __builtin_amdgcn_readfirstlane(meta[7]), npa = TP < 256 ? TP : 256, npb = TP - npa, n1 = npb * 4;
            if (n1 > 0 && n1 < F.G) {
                pg8::Gemm g{(const bf16*)(F.ws + WS_H8), (const bf16*)(F.ws + WS_M2), 0, 1024, DFF / 2};
                const pg8::TabOrder T = pg8::build_units(TABMEM, DFF / 2, g.A, g.Bt, F.G, (int)blockIdx.x, npb, 4, 0, 0, 256, 0, 1, 0, 0, meta, (size_t)1024 * DFF, F.tid);
                pg8::EpiMoeOut E{XN, (const float*)(F.ws + WS_MISC + MS_SLOTG), 1.0f / 64.0f};
                pg8::gemm_phase<pg8::EpiMoeOut, pg8::TabOrder, true, true, true>(F.lds, g, T, E, F.wave);
                if ((int)blockIdx.x >= n1) moe_combine(F, mod, 0, npa * 256, ((int)blockIdx.x - n1) * NWAVES + F.wave, (F.G - n1) * NWAVES);
            } else if (n1 == 0) moe_combine(F, mod, 0, npa * 256, F.vcu * NWAVES + F.wave, F.G * NWAVES);
            else {
                pg8::Gemm g{(const bf16*)(F.ws + WS_H8), (const bf16*)(F.ws + WS_M2), 0, 1024, DFF / 2};
                const pg8::TabOrder T = pg8::build_units(TABMEM, DFF / 2, g.A, g.Bt, F.G, (int)blockIdx.x, npb, 4, 0, 0, 256, 0, 1, 0, 0, meta, (size_t)1024 * DFF, F.tid);
                pg8::EpiMoeOut E{XN, (const float*)(F.ws + WS_MISC + MS_SLOTG), 1.0f / 64.0f};
                pg8::gemm_phase<pg8::EpiMoeOut, pg8::TabOrder, true, true, true>(F.lds, g, T, E, F.wave);
            }
        } SEAM(20);
        if (IN(22)) { PF();
            const int TP = __builtin_amdgcn_readfirstlane(meta[7]), npa = TP < 256 ? TP : 256, n1 = (TP - npa) * 4;
            if (n1 >= F.G) moe_combine(F, mod, 0, npa * 256, F.vcu * NWAVES + F.wave, F.G * NWAVES);
            moe_combine(F, mod, 1, npa * 256, F.vcu * NWAVES + F.wave, F.G * NWAVES);
        }
        STAMP(22);
    }
#ifdef PROF_MASK
    if (blockIdx.x == 0 && F.wave == 0 && __builtin_amdgcn_mbcnt_hi(~0u, __builtin_amdgcn_mbcnt_lo(~0u, 0u)) == 0u) { const unsigned long long t0_ = __builtin_amdgcn_s_memrealtime(); const unsigned long long w_ = 8ull * F.MISC[17]; while (__builtin_amdgcn_s_memrealtime() - t0_ < w_) __builtin_amdgcn_s_sleep(8); }
#endif
#undef IN
#undef SEAM
}

extern "C" void kernel_launch(void* const* d_in, const int* in_sizes, int n_in, void* d_out, int out_size, void* d_ws, size_t ws_size, hipStream_t stream) {
    static int grid = 0;
    if (grid == 0) {
        if (n_in != 24 || in_sizes[0] != BATCH * SEQ * DM || out_size != BATCH * SEQ * DM || ws_size < WS_END) { fprintf(stderr, "kernel_launch: unexpected shapes / workspace (n_in %d, ws %zu, need %zu); nothing launched\n", n_in, ws_size, (size_t)WS_END); grid = -1; return; }
        int dev = 0, cus = 0, per_cu = 0;
        if (hipGetDevice(&dev) != hipSuccess || hipDeviceGetAttribute(&cus, hipDeviceAttributeMultiprocessorCount, dev) != hipSuccess) { grid = -1; return; }
        if (hipFuncSetAttribute((const void*)mk_fwd, hipFuncAttributeMaxDynamicSharedMemorySize, LDS_BYTES) != hipSuccess) { fprintf(stderr, "kernel_launch: hipFuncSetAttribute failed\n"); grid = -1; return; }
        if (hipOccupancyMaxActiveBlocksPerMultiprocessor(&per_cu, (const void*)mk_fwd, NWAVES * 64, LDS_BYTES) != hipSuccess || per_cu < 1) fprintf(stderr, "kernel_launch: occupancy query reports %d\n", per_cu);
        (void)hipGetLastError();
        grid = cus;
    }
    if (grid < 0) return;
    if (hipMemsetAsync((char*)d_ws + WS_CTL, 0, CTL_ZERO_BYTES, stream) != hipSuccess) return;
    Args a{};
    for (int i = 0; i < 24; ++i) a.in[i] = (const float*)d_in[i];
    a.out = (float*)d_out; a.ws = (unsigned char*)d_ws; a.pad = 0;
    const int nl = MK_N_LAUNCHES == 1 ? 1 : NPH;
    for (int li = 0; li < nl; ++li) {
        a.ph_lo = nl == 1 ? 0 : li; a.ph_hi = nl == 1 ? NPH : li + 1; a.li = 0;
        hipLaunchKernelGGL(mk_fwd, dim3(grid), dim3(NWAVES * 64), LDS_BYTES, stream, a);
        const hipError_t le = hipPeekAtLastError();
        if (le != hipSuccess) { fprintf(stderr, "kernel_launch: launch %d failed: %s\n", li, hipGetErrorName(le)); break; }
    }
}
```

```cpp
#define MK_N_LAUNCHES 1
#include <hip/hip_runtime.h>
#include <cstdio>
#include <cstdint>
#include <cstddef>
#include <cmath>
namespace pg8 {
#define PG8_LAS __attribute__((address_space(3)))
typedef unsigned short bf16_t;
typedef short bf16x8 __attribute__((ext_vector_type(8)));
typedef float f32x4 __attribute__((ext_vector_type(4)));
typedef unsigned u32x4 __attribute__((ext_vector_type(4)));
constexpr int BM = 256, BK = 64, HALF = 128, HTB = HALF * BK * 2  , STAGE_BYTES = 8 * HTB, NXCD = 8, WGM = 8;

__host__ __device__ __forceinline__ int lds_byte(int r, int c) { const int st = (r >> 4) * 2 + (c >> 5), rr = r & 15, cc = c & 31, ob = rr * 64 + cc * 2; return st * 1024 + (ob ^ (((ob >> 9) & 1) << 5)); }
__host__ __device__ __forceinline__ void stage_rc(int b, int& R, int& C) { const int st = b / 1024, sb = b % 1024, swz = sb ^ (((sb >> 9) & 1) << 5); R = (st >> 1) * 16 + swz / 64; C = (st & 1) * 32 + (swz % 64) / 2; }
__host__ __device__ __forceinline__ int perm32(int rho) { const int n = rho >> 4, i = rho & 15; return 8 * (i >> 2) + 4 * n + (i & 3); }

struct Unit { int pm, pn, e; };
struct Gemm { const bf16_t* A; const bf16_t* Bt; int M, N, K; };

struct StaticOrder {
    int nM, nN, nwg, G, c;
    __host__ __device__ void init(int M, int N, int G_, int c_) { nM = M / BM; nN = N / BM; nwg = nM * nN; G = G_; c = c_; }
    __host__ __device__ bool next(int i, Unit& u) const {
        const long L = (long)i * G + c; if (L >= nwg) return false;
        int wgid = (int)L; { const int q = nwg / NXCD, r = nwg % NXCD, xcd = wgid % NXCD, off = wgid / NXCD; wgid = (xcd < r ? xcd * (q + 1) : r * (q + 1) + (xcd - r) * q) + off; }
        const int nig = WGM * nN, gid = wgid / nig, fm = gid * WGM, gsz = (nM - fm) < WGM ? (nM - fm) : WGM;
        u.pm = fm + ((wgid % nig) % gsz); u.pn = (wgid % nig) / gsz; return true;
    }
    __device__ __forceinline__ void a_ready(const Unit&) const {}
    __device__ __forceinline__ void done(const Unit&) const {}
};

__device__ __forceinline__ unsigned cvt_pk_bf16(float lo, float hi) { unsigned r; asm volatile("v_cvt_pk_bf16_f32 %0, %1, %2" : "=v"(r) : "v"(lo), "v"(hi)); return r; }
typedef float f32x2 __attribute__((ext_vector_type(2)));
__device__ __forceinline__ f32x2 gelu_pk(f32x2 v) {
    const f32x2 av = __builtin_elementwise_abs(v), d = av * 0.2316418882f + 1.0f;
    f32x2 t; t.x = __builtin_amdgcn_rcpf(d.x); t.y = __builtin_amdgcn_rcpf(d.y);
    f32x2 q = t * 0.5307027145f + (-0.7265760135f); q = q * t + 0.7107068705f; q = q * t + (-0.142248368f); q = q * t + 0.127414796f; q = q * t;
    const f32x2 s = (v * v) * (-0.72134752044f);
    f32x2 e; e.x = __builtin_amdgcn_exp2f(s.x); e.y = __builtin_amdgcn_exp2f(s.y);
    const f32x2 m = v * (q * e), r = v - m;
    f32x2 o; o.x = v.x < 0.f ? m.x : r.x; o.y = v.y < 0.f ? m.y : r.y; return o;
}

template <int ACT  > struct EpiBf16 {
    static constexpr bool PERM = true, AFTER_DRAIN = false, HEADMAP = false; static_assert(ACT == 0 || ACT == 1, "EpiBf16: ACT is 0 (none) or 1 (gelu_pk)");
    bf16_t* O; int ldc; const float* bias; int split_cols; size_t split_stride; float scale0;
    __device__ __forceinline__ void operator()(const f32x4 (&acc)[2][2][4][2], const Unit& u, int wr, int wc, int fr, int fq) const {
        const int row0 = u.pm * BM + wr * 64 + fr; int colt = u.pn * BM; bf16_t* base = O;
        float sc = 1.f; if (split_cols) { const int t = colt / split_cols; base += (size_t)t * split_stride; colt -= t * split_cols; if (t == 0) sc = scale0; }
        const int col0 = colt + wc * 32 + 8 * fq, bcol0 = u.pn * BM + wc * 32 + 8 * fq;
        f32x4 bv[2][2];
#pragma unroll
        for (int bj = 0; bj < 2; ++bj)
#pragma unroll
            for (int n = 0; n < 2; ++n) bv[bj][n] = bias ? *(const f32x4*)(bias + bcol0 + bj * HALF + 4 * n) : (f32x4){0.f, 0.f, 0.f, 0.f};
#pragma unroll
        for (int ai = 0; ai < 2; ++ai)
#pragma unroll
            for (int m = 0; m < 4; ++m) { bf16_t* rowp = base + (size_t)(row0 + ai * HALF + m * 16) * ldc + col0;
#pragma unroll
                for (int bj = 0; bj < 2; ++bj) { f32x4 v0 = acc[ai][bj][m][0] + bv[bj][0], v1 = acc[ai][bj][m][1] + bv[bj][1];
                    if (ACT == 1) { f32x2 a = gelu_pk((f32x2){v0[0], v0[1]}), b = gelu_pk((f32x2){v0[2], v0[3]}), c = gelu_pk((f32x2){v1[0], v1[1]}), d = gelu_pk((f32x2){v1[2], v1[3]});
                        v0 = (f32x4){a.x, a.y, b.x, b.y}; v1 = (f32x4){c.x, c.y, d.x, d.y}; }
                    v0 = v0 * sc; v1 = v1 * sc; u32x4 w; w.x = cvt_pk_bf16(v0[0], v0[1]); w.y = cvt_pk_bf16(v0[2], v0[3]); w.z = cvt_pk_bf16(v1[0], v1[1]); w.w = cvt_pk_bf16(v1[2], v1[3]);
                    *(u32x4*)(rowp + bj * HALF) = w; } }
    }
};

struct TabOrder {
    const volatile PG8_LAS unsigned* tab;
    __device__ __forceinline__ bool next(int i, Unit& u) const {
        if (i >= 32) return false;
        const volatile PG8_LAS unsigned* r = tab + 8 * i;
        if (__builtin_amdgcn_readfirstlane(r[6]) == 0u) return false;
        u.pm = (int)__builtin_amdgcn_readfirstlane(r[4]); u.pn = (int)__builtin_amdgcn_readfirstlane(r[5]); u.e = i; return true;
    }
    __device__ __forceinline__ const char* abase(const Unit& u, size_t) const { const volatile PG8_LAS unsigned* r = tab + 8 * u.e; const unsigned lo = __builtin_amdgcn_readfirstlane(r[0]), hi = __builtin_amdgcn_readfirstlane(r[1]); return (const char*)(((unsigned long long)hi << 32) | lo); }
    __device__ __forceinline__ const char* bbase(const Unit& u, size_t) const { const volatile PG8_LAS unsigned* r = tab + 8 * u.e; const unsigned lo = __builtin_amdgcn_readfirstlane(r[2]), hi = __builtin_amdgcn_readfirstlane(r[3]); return (const char*)(((unsigned long long)hi << 32) | lo); }
    __device__ __forceinline__ void a_ready(const Unit&) const {}
    __device__ __forceinline__ void done(const Unit&) const {}
};
__device__ __forceinline__ TabOrder build_units(PG8_LAS unsigned char* tabmem, int K, const void* A, const void* B, int G, int c,
                                                int np0, int nn0, int cn0, int mode0, int poff0, int np1, int nn1, int cn1, int mode1, const int* pend, size_t estride, const int tid) {
    __syncthreads();
    if (tid < 32) {
        int i_ = tid; asm volatile("" : "+v"(i_)); const int i = i_;
        const int n0 = np0 * nn0, nwg = n0 + np1 * nn1; const long L = (long)i * G + c; const bool ok = L < nwg;
        int w = ok ? (int)L : 0; { const int q = nwg / NXCD, r = nwg % NXCD, xcd = w % NXCD, off = w / NXCD; w = (xcd < r ? xcd * (q + 1) : r * (q + 1) + (xcd - r) * q) + off; }
        const bool s0 = w < n0; const int ww = s0 ? w : w - n0; const int np = s0 ? np0 : np1, nn = s0 ? nn0 : nn1, cn = s0 ? cn0 : cn1, mode = s0 ? mode0 : mode1;
        const int nig = WGM * nn, gid = ww / nig, fm = gid * WGM, gsz = (np - fm) < WGM ? (np - fm) : WGM;
        const int pv = fm + ((ww % nig) % gsz), pn = cn + (ww % nig) / gsz;
        const int pm0 = pv + poff0, pm1 = pv + (pv >> 3), pm2 = 9 * pv + 8; const int pm = mode == 0 ? pm0 : (mode == 1 ? pm1 : pm2);
        int e = 0;
        if (pend) {
#pragma unroll
            for (int k = 0; k < 8; ++k) e += (pend[k] <= pm) ? 1 : 0;
        }
        const size_t tstep = (size_t)256 * K * 2;
        const unsigned long long a = (unsigned long long)((const char*)A + (size_t)pm * tstep), b = (unsigned long long)((const char*)B + (size_t)e * estride + (size_t)pn * tstep);
        PG8_LAS unsigned* r = (PG8_LAS unsigned*)tabmem + 8 * i;
        r[0] = (unsigned)a; r[1] = (unsigned)(a >> 32); r[2] = (unsigned)b; r[3] = (unsigned)(b >> 32); r[4] = (unsigned)pm; r[5] = (unsigned)pn; r[6] = ok ? 1u : 0u; r[7] = 0u; }
    __syncthreads();
    TabOrder T; T.tab = (const volatile PG8_LAS unsigned*)tabmem; return T;
}

struct EpiRawBf16 {
    static constexpr bool PERM = true, AFTER_DRAIN = false, HEADMAP = false;
    bf16_t* O; int ldc;
    __device__ __forceinline__ void operator()(const f32x4 (&acc)[2][2][4][2], const Unit& u, int wr, int wc, int fr, int fq) const {
        const int row0 = u.pm * BM + wr * 64 + fr, col0 = u.pn * BM + wc * 32 + 8 * fq;
#pragma unroll
        for (int ai = 0; ai < 2; ++ai)
#pragma unroll
            for (int m = 0; m < 4; ++m) { bf16_t* rowp = O + (size_t)(row0 + ai * HALF + m * 16) * ldc + col0;
#pragma unroll
                for (int bj = 0; bj < 2; ++bj) { const f32x4 v0 = acc[ai][bj][m][0], v1 = acc[ai][bj][m][1];
                    u32x4 w; w.x = cvt_pk_bf16(v0[0], v0[1]); w.y = cvt_pk_bf16(v0[2], v0[3]); w.z = cvt_pk_bf16(v1[0], v1[1]); w.w = cvt_pk_bf16(v1[2], v1[3]);
                    *(u32x4*)(rowp + bj * HALF) = w; } }
    }
};

struct EpiHeads {
    static constexpr bool PERM = false, AFTER_DRAIN = false, HEADMAP = true;
    bf16_t* P; const PG8_LAS float* gl; const PG8_LAS float* tab;
    __device__ __forceinline__ void operator()(const f32x4 (&acc)[2][2][4][2], const Unit& u, int wr, int wc, int fr, int fq) const {
        const int pn = u.pn, jpan = u.pm % 9; const bool lat = jpan < 8;
        int mode = 0, gi = 0; float sc = 1.f;
        if (pn < 2) { mode = 2; gi = 0; sc = 0.125f * 1.4426950408889634f; }
        else if (pn == 2) { mode = 1; gi = 2; sc = 0.125f * 1.4426950408889634f; }
        else if (pn == 6) { mode = wc < 2 ? 2 : 0; gi = 1; }
        else if (pn == 7) { mode = 1; gi = 3; }
        if (mode == 2 && !lat) mode = 1;
        const PG8_LAS float* gp = gl + gi * 64 + 4 * fq;
        const int colb = pn * BM + wc * 64 + 4 * fq;
#pragma unroll
        for (int ai = 0; ai < 2; ++ai)
#pragma unroll
            for (int m = 0; m < 4; ++m) {
                const int lr = ai * HALF + wr * 64 + m * 16 + fr, j = jpan * 256 + lr;
                f32x4 v[2][2];
#pragma unroll
                for (int bj = 0; bj < 2; ++bj)
#pragma unroll
                    for (int n = 0; n < 2; ++n) v[bj][n] = acc[ai][bj][m][n];
                if (mode) {
                    float ss = 0.f;
#pragma unroll
                    for (int bj = 0; bj < 2; ++bj)
#pragma unroll
                        for (int n = 0; n < 2; ++n) ss += (v[bj][n][0] * v[bj][n][0] + v[bj][n][1] * v[bj][n][1]) + (v[bj][n][2] * v[bj][n][2] + v[bj][n][3] * v[bj][n][3]);
                    { const int ln_ = fq * 16 + fr; ss += __int_as_float(__builtin_amdgcn_ds_bpermute((ln_ ^ 16) << 2, __float_as_int(ss))); ss += __int_as_float(__builtin_amdgcn_ds_bpermute((ln_ ^ 32) << 2, __float_as_int(ss))); }
                    const float rs = 1.0f / sqrtf(ss * (1.0f / 64.0f) + 1e-6f);
#pragma unroll
                    for (int bj = 0; bj < 2; ++bj)
#pragma unroll
                        for (int n = 0; n < 2; ++n) v[bj][n] = v[bj][n] * (rs * sc) * *(const PG8_LAS f32x4*)(gp + 32 * bj + 16 * n);
                    if (mode == 2) {
#pragma unroll
                        for (int bj = 0; bj < 2; ++bj) { const int pos = bj == 0 ? (j >> 6) : (j & 63);
                            const f32x4 t0 = *(const PG8_LAS f32x4*)(tab + (pos * 16 + 4 * fq) * 2), t1 = *(const PG8_LAS f32x4*)(tab + (pos * 16 + 4 * fq) * 2 + 4);
                            const f32x4 cs = {t0[0], t0[2], t1[0], t1[2]}, sn = {t0[1], t0[3], t1[1], t1[3]};
                            const f32x4 u1 = v[bj][0], u2 = v[bj][1];
                            v[bj][0] = u1 * cs - u2 * sn; v[bj][1] = u2 * cs + u1 * sn; }
                    }
                }
                bf16_t* rowp = P + (size_t)(u.pm * BM + lr) * 2304 + pn * BM + wc * 64 + 4 * (fq & 2) + 16 * (fq & 1);
#pragma unroll
                for (int bj = 0; bj < 2; ++bj) {
                    const unsigned a0 = cvt_pk_bf16(v[bj][0][0], v[bj][0][1]), a1 = cvt_pk_bf16(v[bj][0][2], v[bj][0][3]), b0 = cvt_pk_bf16(v[bj][1][0], v[bj][1][1]), b1 = cvt_pk_bf16(v[bj][1][2], v[bj][1][3]);
                    const bool odd = fq & 1;
                    const unsigned s0 = odd ? a0 : b0, s1 = odd ? a1 : b1;
                    const unsigned r0 = (unsigned)__builtin_amdgcn_ds_swizzle((int)s0, 0x401F), r1 = (unsigned)__builtin_amdgcn_ds_swizzle((int)s1, 0x401F);
                    u32x4 w; if (odd) { w.x = r0; w.y = r1; w.z = b0; w.w = b1; } else { w.x = a0; w.y = a1; w.z = r0; w.w = r1; }
                    *(u32x4*)(rowp + 32 * bj) = w; }
                __builtin_amdgcn_sched_barrier(0);
            }
    }
};
struct EpiGateRes {
    static constexpr bool PERM = true, AFTER_DRAIN = false, HEADMAP = false;
    bf16_t* xb; const float* mod; int goff; float asc;
    __device__ __forceinline__ void operator()(const f32x4 (&acc)[2][2][4][2], const Unit& u, int wr, int wc, int fr, int fq) const {
        const int b = u.pm / 9, j = u.pm % 9; const bool lat = j < 8;
        bf16_t* bo = xb + (size_t)(u.pm * BM) * 1024;
        const float* g = mod + (lat ? b : 16) * 6144 + goff;
        const int col0 = u.pn * BM + wc * 32 + 8 * fq;
        constexpr int GB = 4;
        f32x4 gv[2][2];
#pragma unroll
        for (int bj = 0; bj < 2; ++bj)
#pragma unroll
            for (int n = 0; n < 2; ++n) gv[bj][n] = *(const f32x4*)(g + col0 + bj * HALF + 4 * n) * asc;
#pragma unroll
        for (int g0 = 0; g0 < 8; g0 += GB) { const int ai = g0 >> 2;
            u32x4 xh[4][2];
#pragma unroll
            for (int m = g0 & 3; m < (g0 & 3) + GB; ++m) { const size_t off = (size_t)(ai * HALF + wr * 64 + m * 16 + fr) * 1024 + col0;
#pragma unroll
                for (int bj = 0; bj < 2; ++bj) xh[m][bj] = *(const u32x4*)(bo + off + bj * HALF); }
#pragma unroll
            for (int m = g0 & 3; m < (g0 & 3) + GB; ++m) { const size_t off = (size_t)(ai * HALF + wr * 64 + m * 16 + fr) * 1024 + col0;
#pragma unroll
                for (int bj = 0; bj < 2; ++bj) { const u32x4 w = xh[m][bj];
                    const f32x4 x0 = {__uint_as_float(w.x << 16), __uint_as_float(w.x & 0xffff0000u), __uint_as_float(w.y << 16), __uint_as_float(w.y & 0xffff0000u)};
                    const f32x4 x1 = {__uint_as_float(w.z << 16), __uint_as_float(w.z & 0xffff0000u), __uint_as_float(w.w << 16), __uint_as_float(w.w & 0xffff0000u)};
                    const f32x4 o0 = x0 + gv[bj][0] * acc[ai][bj][m][0], o1 = x1 + gv[bj][1] * acc[ai][bj][m][1];
                    u32x4 wo; wo.x = cvt_pk_bf16(o0[0], o0[1]); wo.y = cvt_pk_bf16(o0[2], o0[3]); wo.z = cvt_pk_bf16(o1[0], o1[1]); wo.w = cvt_pk_bf16(o1[2], o1[3]);
                    *(u32x4*)(bo + off + bj * HALF) = wo; } }
            asm volatile("" ::: "memory"); }
    }
};
struct EpiSwiglu {
    static constexpr bool PERM = true, AFTER_DRAIN = false, HEADMAP = false;
    bf16_t* H; int ldh; int p0;
    __device__ __forceinline__ void operator()(const f32x4 (&acc)[2][2][4][2], const Unit& u, int wr, int wc, int fr, int fq) const {
        const int row0 = (u.pm - p0) * BM + wr * 64 + fr, col0 = u.pn * HALF + wc * 32 + 8 * fq;
#pragma unroll
        for (int ai = 0; ai < 2; ++ai)
#pragma unroll
            for (int m = 0; m < 4; ++m) { bf16_t* rowp = H + (size_t)(row0 + ai * HALF + m * 16) * ldh + col0;
                float h[8];
#pragma unroll
                for (int n = 0; n < 2; ++n)
#pragma unroll
                    for (int k = 0; k < 4; ++k) { const float a = acc[ai][0][m][n][k], b3 = acc[ai][1][m][n][k];
                        const float sg = __builtin_amdgcn_rcpf(1.0f + __builtin_amdgcn_exp2f(-1.4426950408889634f * a)); h[n * 4 + k] = a * sg * b3; }
                u32x4 w; w.x = cvt_pk_bf16(h[0], h[1]); w.y = cvt_pk_bf16(h[2], h[3]); w.z = cvt_pk_bf16(h[4], h[5]); w.w = cvt_pk_bf16(h[6], h[7]);
                *(u32x4*)rowp = w; }
    }
};
struct EpiSwigluF8 {
    static constexpr bool PERM = true, AFTER_DRAIN = false, HEADMAP = false;
    unsigned char* H; int ldh; float isc;
    __device__ __forceinline__ void operator()(const f32x4 (&acc)[2][2][4][2], const Unit& u, int wr, int wc, int fr, int fq) const {
        const int row0 = u.pm * BM + wr * 64 + fr, col0 = u.pn * HALF + wc * 32 + 8 * fq;
        const float c1 = -1.4426950408889634f * isc, c2 = isc * isc;
#pragma unroll
        for (int ai = 0; ai < 2; ++ai)
#pragma unroll
            for (int m = 0; m < 4; ++m) { unsigned char* rowp = H + (size_t)(row0 + ai * HALF + m * 16) * ldh + col0;
                f32x2 h[4];
#pragma unroll
                for (int n = 0; n < 2; ++n)
#pragma unroll
                    for (int k = 0; k < 2; ++k) { const f32x2 a = {acc[ai][0][m][n][2 * k], acc[ai][0][m][n][2 * k + 1]}, b3 = {acc[ai][1][m][n][2 * k], acc[ai][1][m][n][2 * k + 1]};
                        const f32x2 t = a * c1; f32x2 ex; ex.x = __builtin_amdgcn_exp2f(t.x); ex.y = __builtin_amdgcn_exp2f(t.y);
                        const f32x2 d = ex + 1.0f; f32x2 r; r.x = __builtin_amdgcn_rcpf(d.x); r.y = __builtin_amdgcn_rcpf(d.y);
                        h[n * 2 + k] = ((a * b3) * c2) * r; }
                typedef unsigned u32x2 __attribute__((ext_vector_type(2))); u32x2 w;
                { int t = __builtin_amdgcn_cvt_pk_fp8_f32(h[0].x, h[0].y, 0, false); t = __builtin_amdgcn_cvt_pk_fp8_f32(h[1].x, h[1].y, t, true); w.x = (unsigned)t; }
                { int t = __builtin_amdgcn_cvt_pk_fp8_f32(h[2].x, h[2].y, 0, false); t = __builtin_amdgcn_cvt_pk_fp8_f32(h[3].x, h[3].y, t, true); w.y = (unsigned)t; }
                *(u32x2*)rowp = w; }
    }
};
struct EpiMoeOut {
    static constexpr bool PERM = true, AFTER_DRAIN = false, HEADMAP = false;
    bf16_t* Y; const float* sgate; float osc;
    __device__ __forceinline__ void operator()(const f32x4 (&acc)[2][2][4][2], const Unit& u, int wr, int wc, int fr, int fq) const {
        const int row0 = u.pm * BM + wr * 64 + fr, col0 = u.pn * BM + wc * 32 + 8 * fq;
        float gts[8];
#pragma unroll
        for (int i = 0; i < 8; ++i) gts[i] = sgate[row0 + (i >> 2) * HALF + (i & 3) * 16] * osc;
#pragma unroll
        for (int ai = 0; ai < 2; ++ai)
#pragma unroll
            for (int m = 0; m < 4; ++m) { const int row = row0 + ai * HALF + m * 16; const float gt = gts[ai * 4 + m]; bf16_t* rowp = Y + (size_t)row * 1024 + col0;
#pragma unroll
                for (int bj = 0; bj < 2; ++bj) { const f32x4 v0 = acc[ai][bj][m][0] * gt, v1 = acc[ai][bj][m][1] * gt;
                    u32x4 w; w.x = cvt_pk_bf16(v0[0], v0[1]); w.y = cvt_pk_bf16(v0[2], v0[3]); w.z = cvt_pk_bf16(v1[0], v1[1]); w.w = cvt_pk_bf16(v1[2], v1[3]);
                    *(u32x4*)(rowp + bj * HALF) = w; } }
    }
};
template <class Epi, class Sched, bool ALIGN_EPI = false, bool SP2 = false, bool F8 = false>
__device__ __forceinline__ void gemm_phase(PG8_LAS unsigned char* lds, const Gemm g, const Sched& S, const Epi& E, const int wave_sgpr) {
    int ln_ = (int)__builtin_amdgcn_mbcnt_hi(~0u, __builtin_amdgcn_mbcnt_lo(~0u, 0u)); asm volatile("" : "+v"(ln_)); const int tid_ = wave_sgpr * 64 + ln_;
    const int tid = tid_, wid = __builtin_amdgcn_readfirstlane(tid >> 6), lane = tid & 63, wr = wid >> 2, wc = wid & 3, fr = lane & 15, fq = lane >> 4;
    const int K = g.K, nt = K / BK;
    unsigned voffA[2], voffB[2];
#pragma unroll
    for (int i = 0; i < 2; ++i) { int R, C; stage_rc(tid * 16 + i * 8192, R, C); const int Rb = Epi::HEADMAP ? ((R >> 5) * 64 + (R & 31)) : (Epi::PERM ? ((R & ~31) + perm32(R & 31)) : R);
        voffA[i] = (unsigned)(R * K + C) * 2u; voffB[i] = (unsigned)(Rb * K + C) * 2u; }
    const size_t kstep = (size_t)(BK * 2);
    const size_t hstep = (size_t)HALF * K * 2;
    const size_t hstepB = Epi::HEADMAP ? (size_t)32 * K * 2 : hstep;
    const size_t tstep = 2 * hstep;
    const unsigned ldsw = (unsigned)wid * 1024u;
    const int aoff = lds_byte(wr * 64 + fr, fq * 8), boff = lds_byte(wc * 32 + fr, fq * 8);
#define PG8_SA(b, h) (((b) * 2 + (h)) * HTB)
#define PG8_SB(b, h) ((4 + (b) * 2 + (h)) * HTB)
#define PG8_STAGE(bufoff, gbase, voff) do { _Pragma("unroll") for (int _i = 0; _i < 2; ++_i) \
        __builtin_amdgcn_global_load_lds((const unsigned*)((const char*)(gbase) + (voff)[_i]), (PG8_LAS unsigned*)(lds + (bufoff) + ldsw + _i * 8192), 16, 0, 0); } while (0)
#define PG8_LDA(dst, b, h) do { _Pragma("unroll") for (int m = 0; m < 4; ++m) { if constexpr (F8) { dst##8[m].lo = *(const PG8_LAS i32x4_*)(lds + PG8_SA(b, h) + aoff + m * 2048); dst##8[m].hi = *(const PG8_LAS i32x4_*)(lds + PG8_SA(b, h) + aoff + m * 2048 + 1024); } \
        else { _Pragma("unroll") for (int k = 0; k < 2; ++k) dst[m][k] = *(const PG8_LAS bf16x8*)(lds + PG8_SA(b, h) + aoff + m * 2048 + k * 1024); } } } while (0)
#define PG8_LDB(dst, b, h) do { _Pragma("unroll") for (int n = 0; n < 2; ++n) { if constexpr (F8) { dst##8[n].lo = *(const PG8_LAS i32x4_*)(lds + PG8_SB(b, h) + boff + n * 2048); dst##8[n].hi = *(const PG8_LAS i32x4_*)(lds + PG8_SB(b, h) + boff + n * 2048 + 1024); } \
        else { _Pragma("unroll") for (int k = 0; k < 2; ++k) dst[n][k] = *(const PG8_LAS bf16x8*)(lds + PG8_SB(b, h) + boff + n * 2048 + k * 1024); } } } while (0)
#define PG8_MMA(ai, bj, At, Bt) do { __builtin_amdgcn_s_setprio(1); _Pragma("unroll") for (int m = 0; m < 4; ++m) _Pragma("unroll") for (int n = 0; n < 2; ++n) { \
        if constexpr (F8) asm("v_mfma_f32_16x16x128_f8f6f4 %0, %1, %2, %0" : "+v"(acc[ai][bj][m][n]) : "v"(Bt##8[n]), "v"(At##8[m]));     \
        else { _Pragma("unroll") for (int k = 0; k < 2; ++k) acc[ai][bj][m][n] = __builtin_amdgcn_mfma_f32_16x16x32_bf16(Bt[n][k], At[m][k], acc[ai][bj][m][n], 0, 0, 0); } } \
        __builtin_amdgcn_s_setprio(0); } while (0)
#define PG8_WAIT_V(n) asm volatile("s_waitcnt vmcnt(" #n ")" ::: "memory")
#define PG8_WAIT_L(n) asm volatile("s_waitcnt lgkmcnt(" #n ")" ::: "memory")
#define PG8_BAR __builtin_amdgcn_s_barrier()
#define PG8_SCHED __builtin_amdgcn_sched_barrier(0)
    Unit cur, nxt; int ui = 0;
    if (!S.next(0, cur)) return;
    f32x4 acc[2][2][4][2];
#pragma unroll
    for (int a = 0; a < 2; ++a)
#pragma unroll
        for (int b = 0; b < 2; ++b)
#pragma unroll
            for (int m = 0; m < 4; ++m)
#pragma unroll
                for (int n = 0; n < 2; ++n) acc[a][b][m][n] = (f32x4){0.f, 0.f, 0.f, 0.f};
    typedef int i32x4_ __attribute__((ext_vector_type(4))); typedef int i32x8_ __attribute__((ext_vector_type(8)));
    bf16x8 At[4][2], B0[2][2], B1[2][2];
    i32x8_ At8[4], B08[2], B18[2];
    const char* cA = S.abase(cur, tstep); const char* cB = S.bbase(cur, tstep);
    S.a_ready(cur);
    if constexpr (SP2) {
        PG8_STAGE(PG8_SB(0, 0), cB, voffB); PG8_STAGE(PG8_SB(0, 1), cB + hstepB, voffB); PG8_STAGE(PG8_SA(0, 0), cA, voffA); PG8_STAGE(PG8_SA(0, 1), cA + hstep, voffA);
        if (wr == 1) PG8_BAR;
        PG8_WAIT_V(2); PG8_BAR;
        PG8_STAGE(PG8_SB(1, 0), cB + kstep, voffB); PG8_STAGE(PG8_SA(1, 0), cA + kstep, voffA); PG8_STAGE(PG8_SB(1, 1), cB + hstepB + kstep, voffB);
        PG8_WAIT_V(6); PG8_BAR;
    } else {
        PG8_STAGE(PG8_SB(0, 0), cB, voffB); PG8_STAGE(PG8_SA(0, 0), cA, voffA); PG8_STAGE(PG8_SB(0, 1), cB + hstepB, voffB); PG8_STAGE(PG8_SA(0, 1), cA + hstep, voffA);
        if (wr == 1) PG8_BAR;
        PG8_WAIT_V(4); PG8_BAR;
        PG8_STAGE(PG8_SB(1, 0), cB + kstep, voffB); PG8_STAGE(PG8_SA(1, 0), cA + kstep, voffA); PG8_STAGE(PG8_SB(1, 1), cB + hstepB + kstep, voffB);
        PG8_WAIT_V(6); PG8_BAR;
    }
    for (;;) {
        const bool has_next = S.next(ui + 1, nxt);
        const char* nA = has_next ? S.abase(nxt, tstep) : cA; const char* nB = has_next ? S.bbase(nxt, tstep) : cB;
#pragma unroll 1
        for (int t = 0; t < nt; t += 2) {
            const bool last = (t == nt - 2);
            const char* a1 = cA + (size_t)(t + 1) * kstep;
            const char* a2 = last ? nA : cA + (size_t)(t + 2) * kstep; const char* b2 = last ? nB : cB + (size_t)(t + 2) * kstep;
            const char* a3 = a2 + kstep; const char* b3 = b2 + kstep;
            if (last && has_next) S.a_ready(nxt);
            if constexpr (SP2) {
            PG8_LDB(B0, 0, 0); PG8_LDB(B1, 0, 1); PG8_SCHED; PG8_LDA(At, 0, 0); PG8_STAGE(PG8_SA(1, 1), a1 + hstep, voffA);
            PG8_WAIT_V(8); PG8_WAIT_L(0); PG8_BAR; PG8_MMA(0, 0, At, B0); PG8_MMA(0, 1, At, B1); PG8_BAR; PG8_SCHED;
            PG8_LDA(At, 0, 1); PG8_STAGE(PG8_SB(0, 0), b2, voffB); PG8_STAGE(PG8_SB(0, 1), b2 + hstepB, voffB); PG8_STAGE(PG8_SA(0, 0), a2, voffA);
            PG8_WAIT_V(8); PG8_WAIT_L(0); PG8_BAR; PG8_MMA(1, 0, At, B0); PG8_MMA(1, 1, At, B1); PG8_BAR; PG8_SCHED;
            PG8_LDB(B0, 1, 0); PG8_LDB(B1, 1, 1); PG8_SCHED; PG8_LDA(At, 1, 0); PG8_STAGE(PG8_SA(0, 1), a2 + hstep, voffA);
            PG8_WAIT_V(8); PG8_WAIT_L(0); PG8_BAR; PG8_MMA(0, 0, At, B0); PG8_MMA(0, 1, At, B1); PG8_BAR; PG8_SCHED;
            PG8_LDA(At, 1, 1); PG8_STAGE(PG8_SB(1, 0), b3, voffB); PG8_STAGE(PG8_SB(1, 1), b3 + hstepB, voffB); PG8_STAGE(PG8_SA(1, 0), a3, voffA);
            PG8_WAIT_V(8); PG8_WAIT_L(0); PG8_BAR; PG8_MMA(1, 0, At, B0); PG8_MMA(1, 1, At, B1); PG8_BAR; PG8_SCHED;
            } else {
            PG8_LDB(B0, 0, 0); PG8_SCHED; PG8_LDA(At, 0, 0); PG8_STAGE(PG8_SA(1, 1), a1 + hstep, voffA);
            PG8_WAIT_L(8); PG8_BAR; PG8_WAIT_L(0); PG8_MMA(0, 0, At, B0); PG8_BAR; PG8_SCHED;
            PG8_LDB(B1, 0, 1); PG8_STAGE(PG8_SB(0, 0), b2, voffB);
            PG8_BAR; PG8_WAIT_L(0); PG8_MMA(0, 1, At, B1); PG8_BAR;
            PG8_LDA(At, 0, 1); PG8_STAGE(PG8_SA(0, 0), a2, voffA);
            PG8_BAR; PG8_WAIT_L(0); PG8_MMA(1, 0, At, B0); PG8_BAR; PG8_SCHED;
            PG8_STAGE(PG8_SB(0, 1), b2 + hstepB, voffB);
            PG8_WAIT_V(6); PG8_BAR; PG8_MMA(1, 1, At, B1); PG8_BAR;
            PG8_LDB(B0, 1, 0); PG8_SCHED; PG8_LDA(At, 1, 0); PG8_STAGE(PG8_SA(0, 1), a2 + hstep, voffA);
            PG8_WAIT_L(8); PG8_BAR; PG8_WAIT_L(0); PG8_MMA(0, 0, At, B0); PG8_BAR; PG8_SCHED;
            PG8_LDB(B1, 1, 1); PG8_STAGE(PG8_SB(1, 0), b3, voffB);
            PG8_BAR; PG8_WAIT_L(0); PG8_MMA(0, 1, At, B1); PG8_BAR;
            PG8_LDA(At, 1, 1); PG8_STAGE(PG8_SA(1, 0), a3, voffA);
            PG8_BAR; PG8_WAIT_L(0); PG8_MMA(1, 0, At, B0); PG8_BAR; PG8_SCHED;
            PG8_STAGE(PG8_SB(1, 1), b3 + hstepB, voffB);
            PG8_WAIT_V(6); PG8_BAR; PG8_MMA(1, 1, At, B1); PG8_BAR;
            }
        }
        if constexpr (ALIGN_EPI) { if (wr == 0) PG8_BAR; }
        if constexpr (F8) asm volatile("s_nop 15\n\ts_nop 15\n\ts_nop 7" ::: "memory");
        if constexpr (!Epi::AFTER_DRAIN) { E(acc, cur, wr, wc, fr, fq); S.done(cur); }
        if (!has_next) break;
#pragma unroll
        for (int a = 0; a < 2; ++a)
#pragma unroll
            for (int b = 0; b < 2; ++b)
#pragma unroll
                for (int m = 0; m < 4; ++m)
#pragma unroll
                    for (int n = 0; n < 2; ++n) acc[a][b][m][n] = (f32x4){0.f, 0.f, 0.f, 0.f};
        cur = nxt; cA = nA; cB = nB; ++ui;
        if constexpr (ALIGN_EPI) { if (wr == 1) PG8_BAR; }
    }
    PG8_WAIT_V(0);
    if constexpr (!ALIGN_EPI) { if (wr == 0) PG8_BAR; }
    PG8_BAR;
    if constexpr (Epi::AFTER_DRAIN) { E.fused(acc, cur, wr, wc, fr, fq, lds, wid, lane); S.done(cur); }
#undef PG8_SA
#undef PG8_SB
#undef PG8_STAGE
#undef PG8_LDA
#undef PG8_LDB
#undef PG8_MMA
#undef PG8_WAIT_V
#undef PG8_WAIT_L
#undef PG8_BAR
#undef PG8_SCHED
}
}

constexpr int NWAVES = 8;
#ifndef MK_N_LAUNCHES
#define MK_N_LAUNCHES 1
#endif
constexpr int NPH = 23;
constexpr int BATCH = 16, SEQ = 2048, DM = 1024, CTXL = 256, TPB = SEQ + CTXL, MROWS = BATCH * TPB, NPAN = MROWS / 256;
constexpr int INW = 2304, DFF = 2816, NEXP = 8, NTOK = BATCH * SEQ;
constexpr int QA_OFF = 0, QB_OFF = 512, CPOST_OFF = 768, CPRE_OFF = 1024, CVAL_OFF = 1280, KA_OFF = 1536, VA_OFF = 1664, KB_OFF = 1792, VB_OFF = 2048;
constexpr float NORM_EPS = 1e-6f, LOG2E = 1.4426950408889634f, C2 = 0.125f * 1.4426950408889634f;
constexpr int MOE_HCAP = 136;
constexpr int SLOT_CAP = 2 * NTOK + NEXP * 256;

constexpr size_t MiB = 1u << 20;
constexpr size_t WS_CTL = 0, CTL_ZERO_BYTES = 128 * 1024;
constexpr size_t WS_MOD = 1 * MiB;
constexpr size_t WS_MISC = 2 * MiB;
constexpr size_t WS_WIN = 6 * MiB;
constexpr size_t WS_WOUT = 15 * MiB;
constexpr size_t WS_F13 = 19 * MiB;
constexpr size_t WS_F2 = 30 * MiB;
constexpr size_t WS_M13 = 36 * MiB;
constexpr size_t WS_M2 = 80 * MiB;
constexpr size_t WS_XB = 104 * MiB;
constexpr size_t WS_XN = 184 * MiB;
constexpr size_t WS_P = 256 * MiB;
constexpr size_t WS_XT = 316 * MiB;
constexpr size_t WS_END = 504 * MiB;
constexpr size_t WS_XS8 = WS_XN, WS_XT8 = WS_XN + 66 * MiB, WS_H8 = WS_XT;
static_assert(WS_P + (size_t)MROWS * DFF * 2 <= WS_END && WS_H8 + (size_t)SLOT_CAP * DFF <= WS_END && WS_XN + (size_t)SLOT_CAP * DM * 2 <= WS_XT && WS_XT8 + (size_t)NTOK * DM <= WS_XT && (size_t)SLOT_CAP * DM <= 66 * MiB, "ws map");
constexpr size_t MS_TOKE = 0, MS_TOKG = 256 * 1024, MS_TOKS = 512 * 1024, MS_SLOTG = 768 * 1024, MS_META = 1088 * 1024, MS_ROPE = 1152 * 1024;
constexpr int CW_TMO = 0, CW_CODE = 1, CW_BAR = 4096, CW_CNT = 16384;

constexpr int RING_BYTES = 139264, LDSCTL_OFF = RING_BYTES, MISC_OFF = LDSCTL_OFF + 320, LDS_BYTES = 147456;

#define GAS __attribute__((address_space(1)))
#define LAS __attribute__((address_space(3)))
typedef unsigned short bf16;
typedef unsigned v4u __attribute__((ext_vector_type(4)));
typedef unsigned v2u __attribute__((ext_vector_type(2)));
typedef float f32x4 __attribute__((ext_vector_type(4)));
#define LDS_WAIT() asm volatile("s_waitcnt lgkmcnt(0)" ::: "memory")
#define VM_WAIT() asm volatile("s_waitcnt vmcnt(0)" ::: "memory")
__device__ __forceinline__ unsigned f2bf(float f) { unsigned u = __builtin_bit_cast(unsigned, f); return (u + 0x7fffu + ((u >> 16) & 1u)) >> 16; }
__device__ __forceinline__ unsigned pk2(float lo, float hi) { return f2bf(lo) | (f2bf(hi) << 16); }
__device__ __forceinline__ unsigned pk4_f8(float a, float b, float c, float d) { int w = __builtin_amdgcn_cvt_pk_fp8_f32(a, b, 0, false); w = __builtin_amdgcn_cvt_pk_fp8_f32(c, d, w, true); return (unsigned)w; }
__device__ __forceinline__ float bflo(unsigned w) { return __uint_as_float(w << 16); }
__device__ __forceinline__ float bfhi(unsigned w) { return __uint_as_float(w & 0xffff0000u); }
__device__ __forceinline__ float bf1(bf16 h) { return __uint_as_float((unsigned)h << 16); }
__device__ __forceinline__ float xshfl(float v, int mask, int lane) { return __int_as_float(__builtin_amdgcn_ds_bpermute((lane ^ mask) << 2, __float_as_int(v))); }
__device__ __forceinline__ float wave_sum(float v, int lane) {
#pragma unroll
    for (int o = 1; o < 64; o <<= 1) v += xshfl(v, o, lane);
    return v;
}
__device__ __forceinline__ float half_sum(float v, int lane) {
#pragma unroll
    for (int o = 1; o < 32; o <<= 1) v += xshfl(v, o, lane);
    return v;
}
#include <hip/hip_bf16.h>
#include <cmath>
namespace attn_body {
using bf16=__hip_bfloat16;
using bf16x8=__attribute__((ext_vector_type(8)))short;
using s16x4=__attribute__((ext_vector_type(4)))short;
using f32x16=__attribute__((ext_vector_type(16)))float;
using u32x4=__attribute__((ext_vector_type(4)))unsigned;
constexpr int D=64,DM=2304;
constexpr int NW=8,QBLK=32,QB=QBLK*NW,KVBLK=64;
constexpr int LDS_BT=86016, BT_STRIDE=128, BT_PAD=48;
__device__ __forceinline__ int crow(int r,int hi){return (r&3)+8*(r>>2)+4*hi;}
#define SBAR() __builtin_amdgcn_sched_barrier(0)
__device__ __forceinline__ void bias_apply(f32x16&p0,f32x16&p1,const __attribute__((address_space(3))) char*tb,unsigned m0,unsigned m1,float mh){
  const unsigned NEGB=0xf149f2cau;
  #pragma unroll
  for(int g=0;g<4;++g){
    #pragma unroll
    for(int k=0;k<4;++k){ const int r=4*g+k; const int o=((r&3)+8*(r>>2))*4; const float b0=*(const __attribute__((address_space(3))) float*)(tb+o),b1=*(const __attribute__((address_space(3))) float*)(tb+o+128);
      const unsigned s0=(unsigned)__builtin_amdgcn_sbfe((int)m0,r,1), s1=(unsigned)__builtin_amdgcn_sbfe((int)m1,r,1);
      const unsigned x0=__float_as_uint(p0[r]+(b0-mh)), x1=__float_as_uint(p1[r]+(b1-mh));
      float y0=__uint_as_float((x0&s0)|(NEGB&~s0)), y1=__uint_as_float((x1&s1)|(NEGB&~s1)); asm volatile("":"+v"(y0),"+v"(y1)); p0[r]=y0; p1[r]=y1; }
    __builtin_amdgcn_sched_barrier(0); }
}
constexpr int NSLOT=3, SLOTB=8192;
constexpr int LDS_K=0, LDS_V=NSLOT*SLOTB, LDS_WS=2*NSLOT*SLOTB, LDS_OST=LDS_WS+NW*64*4, LDS_BYTES=LDS_OST+NW*4096;
constexpr float C2=0.125f*1.4426950408889634f;
__device__ __forceinline__ void glds16(const void*gsrc,unsigned lds_dst){unsigned keep;
  asm volatile("s_mov_b32 %0, m0\n\ts_mov_b32 m0, %2\n\ts_nop 0\n\tglobal_load_lds_dwordx4 %1, off\n\ts_mov_b32 m0, %0":"=&s"(keep):"v"(gsrc),"s"(lds_dst):"memory");}
__device__ __forceinline__ float max3f(float a,float b,float c){float r;asm("v_max3_f32 %0, %1, %2, %3":"=v"(r):"v"(a),"v"(b),"v"(c));return r;}
__device__ __forceinline__ float max2f(float a,float b){float r;asm("v_max_f32_e32 %0, %1, %2":"=v"(r):"v"(a),"v"(b));return r;}
__device__ __forceinline__ float fadd_s(float a,float b){float r;asm("v_add_f32_e32 %0, %1, %2":"=v"(r):"v"(a),"v"(b));return r;}
__device__ __forceinline__ float fsub_s(float a,float b){float r;asm("v_sub_f32_e32 %0, %1, %2":"=v"(r):"v"(a),"v"(b));return r;}
typedef float f32x2_t __attribute__((ext_vector_type(2))); typedef __bf16 bf16x2_t __attribute__((ext_vector_type(2)));
__device__ __forceinline__ unsigned cvtpk_s(float lo,float hi){f32x2_t v={lo,hi};bf16x2_t b=__builtin_convertvector(v,bf16x2_t);return __builtin_bit_cast(unsigned,b);}
#define WAIT_BAR(N) asm volatile("s_waitcnt vmcnt(" #N ") lgkmcnt(0)\n\ts_barrier":::"memory")

template<bool ZERO> __device__ __forceinline__ f32x16 cinit(const f32x16&negm){ if constexpr(ZERO) return f32x16{}; else return negm; }
__device__ __forceinline__ void qkt(f32x16&p0,f32x16&p1,const char*Kslot,const bf16x8*qr,const f32x16 negm,int r32,int hi){
  const char*kb=Kslot+hi*1024+r32*16;
  #pragma unroll
  for(int d0=0;d0<4;++d0){
    const bf16x8 b0=*reinterpret_cast<const bf16x8*>(kb+d0*2048);
    const bf16x8 b1=*reinterpret_cast<const bf16x8*>(kb+d0*2048+512);
    if(d0==0){p0=__builtin_amdgcn_mfma_f32_32x32x16_bf16(b0,qr[0],negm,0,0,0);p1=__builtin_amdgcn_mfma_f32_32x32x16_bf16(b1,qr[0],negm,0,0,0);}
    else{p0=__builtin_amdgcn_mfma_f32_32x32x16_bf16(b0,qr[d0],p0,0,0,0);p1=__builtin_amdgcn_mfma_f32_32x32x16_bf16(b1,qr[d0],p1,0,0,0);}}
}
typedef __attribute__((address_space(3))) const char* lds_cptr;
typedef short v4i16_t __attribute__((ext_vector_type(4)));
__device__ __forceinline__ void kload8(bf16x8*kf,lds_cptr kp){
  kf[0]=*(const __attribute__((address_space(3))) bf16x8*)(kp);      kf[1]=*(const __attribute__((address_space(3))) bf16x8*)(kp+512);
  kf[2]=*(const __attribute__((address_space(3))) bf16x8*)(kp+2048); kf[3]=*(const __attribute__((address_space(3))) bf16x8*)(kp+2560);
  kf[4]=*(const __attribute__((address_space(3))) bf16x8*)(kp+4096); kf[5]=*(const __attribute__((address_space(3))) bf16x8*)(kp+4608);
  kf[6]=*(const __attribute__((address_space(3))) bf16x8*)(kp+6144); kf[7]=*(const __attribute__((address_space(3))) bf16x8*)(kp+6656);
}
__device__ __forceinline__ void kload2(bf16x8*kf,lds_cptr kp,int j){ kf[2*j]=*(const __attribute__((address_space(3))) bf16x8*)(kp+j*2048); kf[2*j+1]=*(const __attribute__((address_space(3))) bf16x8*)(kp+j*2048+512); }
__device__ __forceinline__ s16x4 vtr(lds_cptr p){ return __builtin_bit_cast(s16x4,__builtin_amdgcn_ds_read_tr16_b64_v4i16((__attribute__((address_space(3))) v4i16_t*)p)); }
__device__ __forceinline__ float rowmax(const f32x16&p0,const f32x16&p1){
  float a=max3f(p0[0],p0[1],p1[0]),b=max3f(p0[2],p0[3],p1[1]);a=max3f(a,p1[2],p1[3]);
  #pragma unroll
  for(int r=4;r<16;r+=4){a=max3f(a,p0[r],p0[r+1]);b=max3f(b,p0[r+2],p0[r+3]);a=max3f(a,p1[r],p1[r+1]);b=max3f(b,p1[r+2],p1[r+3]);}
  const float m=max2f(a,b);
  auto rr=__builtin_amdgcn_permlane32_swap(__float_as_uint(m),__float_as_uint(m),false,false);
  return max2f(__uint_as_float(rr[0]),__uint_as_float(rr[1]));
}
__device__ __forceinline__ void pv(f32x16*o,int vb,bf16x8 pa0,bf16x8 pa1,bf16x8 pa2,bf16x8 pa3){
  #pragma unroll
  for(int d0=0;d0<2;++d0){s16x4 lo[4],hi[4];
    #pragma unroll
    for(int ks=0;ks<4;++ks){
      asm volatile("ds_read_b64_tr_b16 %0,%1 offset:%c2":"=&v"(lo[ks]):"v"(vb),"i"(d0*4096+ks*1024):"memory");
      asm volatile("ds_read_b64_tr_b16 %0,%1 offset:%c2":"=&v"(hi[ks]):"v"(vb),"i"(d0*4096+ks*1024+512):"memory");}
    asm volatile("s_waitcnt lgkmcnt(0)":::"memory");SBAR();
    #define PK(k) (bf16x8){lo[k][0],lo[k][1],lo[k][2],lo[k][3],hi[k][0],hi[k][1],hi[k][2],hi[k][3]}
    o[d0]=__builtin_amdgcn_mfma_f32_32x32x16_bf16(pa0,PK(0),o[d0],0,0,0);
    o[d0]=__builtin_amdgcn_mfma_f32_32x32x16_bf16(pa1,PK(1),o[d0],0,0,0);
    o[d0]=__builtin_amdgcn_mfma_f32_32x32x16_bf16(pa2,PK(2),o[d0],0,0,0);
    o[d0]=__builtin_amdgcn_mfma_f32_32x32x16_bf16(pa3,PK(3),o[d0],0,0,0);
    #undef PK
  }
}

#ifndef ATTN_STORE16
#define ATTN_STORE16(p,v) (*(u32x4*)(p)=(v))
#endif
template<int THRL,bool BMODE> __device__ __forceinline__ void attn_unit(const bf16*Qu,const bf16*__restrict__ Kh,const bf16*__restrict__ Vh,bf16*Ou,const int NT,const int nfirst,const int first0,const int second0,const int qg,const float*rpbh,char*shm,const int wave_sgpr){
  int ln_=(int)__builtin_amdgcn_mbcnt_hi(~0u,__builtin_amdgcn_mbcnt_lo(~0u,0u)); asm volatile("":"+v"(ln_));
  const int wid=wave_sgpr,lane=ln_,tid=wid*64+lane,r32=lane&31,hi=lane>>5;
  const bf16*Qw=Qu+(long)(wid*QBLK)*DM;
  const unsigned lds0=(unsigned)(uintptr_t)shm;
  float*wsf=(float*)(shm+LDS_WS)+wid*64;
  const bf16*ksrc=Kh+(long)lane*DM+wid*8;
  const bf16*vsrc=Vh+(long)(16*(wid&3)+(lane>>2))*DM+(wid>>2)*32+(lane&3)*8;
  const unsigned kdst=lds0+LDS_K+wid*1024, vdst=lds0+LDS_V+wid*1024;
  #define TILE(t) (((t)<nfirst)?(first0+(t)):(second0+(t)-nfirst))
  #define DMA_K(t,slot) glds16(ksrc+(long)TILE(t)*KVBLK*DM,(unsigned)__builtin_amdgcn_readfirstlane(kdst+(slot)))
  #define DMA_V(t,slot) glds16(vsrc+(long)TILE(t)*KVBLK*DM,(unsigned)__builtin_amdgcn_readfirstlane(vdst+(slot)))
  const int vb0=(int)(lds0+LDS_V)+((lane>>4)&1)*32+(lane&3)*8+(4*hi+((lane&15)>>2))*64;
  const char*Kbase=shm+LDS_K; bf16x8 kf[8];
  const lds_cptr shm3=(lds_cptr)shm; const lds_cptr kp0=shm3+LDS_K+hi*1024+r32*16; const lds_cptr vp0=shm3+LDS_V+((lane>>4)&1)*32+(lane&3)*8+(4*hi+((lane&15)>>2))*64;
  unsigned bm0=0u,bm1=0u; int blane=0,bqr=0,brs=0;
  if constexpr(BMODE){ const int qc=(wid&1)*32+r32; int cs=qc-8; cs=cs<0?0:(cs>48?48:cs);
    _Pragma("unroll") for(int r=0;r<16;++r){ const int kc=(r&3)+8*(r>>2)+4*hi; bm0|=(kc>=cs&&kc<cs+16)?(1u<<r):0u; bm1|=(kc+32>=cs&&kc+32<cs+16)?(1u<<r):0u; }
    blane=(BT_PAD+15-qc+4*hi)*4; bqr=qg+(wid>>1); brs=bqr-4; brs=brs<0?0:(brs>24?24:brs);
    __attribute__((address_space(3))) float*bt=(__attribute__((address_space(3))) float*)(shm3+LDS_BT); for(int idx=tid;idx<15*BT_STRIDE;idx+=NW*64){ const int dr=idx/BT_STRIDE,j=idx%BT_STRIDE; bt[idx]=(j>=BT_PAD&&j<=BT_PAD+30)?rpbh[dr*31+j-BT_PAD]*1.4426950408889634f:0.f; } }
  DMA_K(0,0);DMA_V(0,0);DMA_K(1,SLOTB);
  bf16x8 qr[4];
  #pragma unroll
  for(int d0=0;d0<4;++d0)qr[d0]=*reinterpret_cast<const bf16x8*>(&Qw[(long)r32*DM+d0*16+hi*8]);
  float mhat=0.f,l_reg=0.f;f32x16 o[2];o[0]=f32x16{};o[1]=f32x16{};f32x16 negm=f32x16{}; if constexpr(!BMODE){asm volatile("":"+v"(negm));}
  #define CMASK(P0,P1,t) do{ if constexpr(BMODE){ if((t)>=nfirst){ const int kr_=second0+(t)-nfirst; const bool rv_=(kr_>=brs)&&(kr_<brs+8); int dr_=kr_-bqr+7; dr_=dr_<0?0:(dr_>14?14:dr_); \
      bias_apply(P0,P1,shm3+LDS_BT+dr_*(BT_STRIDE*4)+blane,rv_?bm0:0u,rv_?bm1:0u,mhat); } else { _Pragma("unroll") for(int r_=0;r_<16;++r_){P0[r_]-=mhat;P1[r_]-=mhat;} } } }while(0)
  bool resc=false;
  #define START(P0,P1) do{ const float rm=rowmax(P0,P1); resc=false; \
    { const float dl=rm; mhat=fadd_s(mhat,dl); \
      _Pragma("unroll") for(int r=0;r<16;++r){P0[r]=fsub_s(P0[r],dl);P1[r]=fsub_s(P1[r],dl);} \
      if constexpr(!BMODE){ _Pragma("unroll") for(int r=0;r<16;++r)negm[r]=-mhat; asm volatile("":"+v"(negm)); } } \
    _Pragma("unroll") for(int r=0;r<16;++r)P0[r]=__builtin_amdgcn_exp2f(P0[r]); }while(0)
  #define RESC() do{ if(resc){ asm volatile("s_waitcnt lgkmcnt(0)":::"memory"); \
      _Pragma("unroll") for(int d_=0;d_<2;++d_) _Pragma("unroll") for(int r=0;r<16;++r)o[d_][r]*=wsf[crow(r,hi)]; } }while(0)
  f32x16 pA0,pA1,pB0,pB1;
  int sl_prev=0,sl_cur=0,sl_next=SLOTB;
  #define ROT() do{sl_prev=sl_cur;sl_cur=sl_next;sl_next=(sl_next==(NSLOT-1)*SLOTB)?0:sl_next+SLOTB;}while(0)
  DMA_K(2,2*SLOTB);
  WAIT_BAR(3);
  qkt(pA0,pA1,Kbase,qr,cinit<BMODE>(negm),r32,hi);asm volatile("s_nop 15\n\ts_nop 7":"+v"(pA0),"+v"(pA1));CMASK(pA0,pA1,0);
  START(pA0,pA1);
  _Pragma("unroll") for(int r=0;r<16;++r)pA1[r]=__builtin_amdgcn_exp2f(pA1[r]);
  WAIT_BAR(0);
  DMA_K(3,0);DMA_V(1,SLOTB);
  ROT();
  kload8(kf,kp0+sl_cur);
  WAIT_BAR(2);
  s16x4 vlo[8],vhi[8]; u32x4 pw0,pw1,pw2,pw3;
  #define PKW(P,B) cvtpk_s(P[B],P[B+1])
  #define PAF(k) __builtin_bit_cast(bf16x8,pw##k)
  #define VFR(i) (bf16x8){vlo[i][0],vlo[i][1],vlo[i][2],vlo[i][3],vhi[i][0],vhi[i][1],vhi[i][2],vhi[i][3]}
  #define PIN(x) asm volatile("":"+v"(x))
  #define MX3(a,b,c) __builtin_fmaxf(__builtin_fmaxf((a),(b)),(c))
  #define GAPA(MF,A0,A1,A2,A3,W0,W1,PW) do{ MF; sacc+=A0; sacc+=A1; sacc+=A2; sacc+=A3; PIN(sacc); W0; W1; PIN(PW); SBAR(); }while(0)
  #define EX(v) __builtin_amdgcn_exp2f(v)
  #define GAPB(MF,X,B) do{ MF; X[B]=EX(X[B]); X[B+1]=EX(X[B+1]); X[B+2]=EX(X[B+2]); X[B+3]=EX(X[B+3]); PIN(X); SBAR(); }while(0)
  #define VRD(i) do{ vlo[i]=vtr(vp_+(((i)>>2)*4096+((i)&3)*1024)); vhi[i]=vtr(vp_+(((i)>>2)*4096+((i)&3)*1024+512)); }while(0)
  #define KRD(G,j) do{ if(G){ kload2(kf,kp0+sl_next,j); SBAR(); } }while(0)
  #define STEP(C0,C1,P0,P1,t,GK,GV,GL) do{ SBAR(); \
    const lds_cptr vp_=vp0+sl_prev; \
    VRD(0); SBAR(); float sacc=(P0[0]+P0[1]); \
    GAPA(C0=__builtin_amdgcn_mfma_f32_32x32x16_bf16(kf[0],qr[0],cinit<BMODE>(negm),0,0,0), P0[2],P0[3],P0[4],P0[5],     pw0[0]=PKW(P0,0), pw0[1]=PKW(P0,2), pw0); \
    VRD(4); SBAR(); GAPA(C1=__builtin_amdgcn_mfma_f32_32x32x16_bf16(kf[1],qr[0],cinit<BMODE>(negm),0,0,0), P0[6],P0[7],P0[8],P0[9],     pw0[2]=PKW(P0,4), pw0[3]=PKW(P0,6), pw0); \
    VRD(1); SBAR(); GAPA(C0=__builtin_amdgcn_mfma_f32_32x32x16_bf16(kf[2],qr[1],C0,0,0,0),   P0[10],P0[11],P0[12],P0[13], pw1[0]=PKW(P0,8), pw1[1]=PKW(P0,10), pw1); \
    VRD(5); SBAR(); GAPA(C1=__builtin_amdgcn_mfma_f32_32x32x16_bf16(kf[3],qr[1],C1,0,0,0),   P0[14],P0[15],P1[0],P1[1],   pw1[2]=PKW(P0,12),pw1[3]=PKW(P0,14), pw1); \
    VRD(2); SBAR(); GAPA(C0=__builtin_amdgcn_mfma_f32_32x32x16_bf16(kf[4],qr[2],C0,0,0,0),   P1[2],P1[3],P1[4],P1[5],     pw2[0]=PKW(P1,0), pw2[1]=PKW(P1,2), pw2); \
    VRD(6); SBAR(); GAPA(C1=__builtin_amdgcn_mfma_f32_32x32x16_bf16(kf[5],qr[2],C1,0,0,0),   P1[6],P1[7],P1[8],P1[9],     pw2[2]=PKW(P1,4), pw2[3]=PKW(P1,6), pw2); \
    VRD(3); SBAR(); GAPA(C0=__builtin_amdgcn_mfma_f32_32x32x16_bf16(kf[6],qr[3],C0,0,0,0),   P1[10],P1[11],P1[12],P1[13], pw3[0]=PKW(P1,8), pw3[1]=PKW(P1,10), pw3); \
    VRD(7); SBAR(); GAPA(C1=__builtin_amdgcn_mfma_f32_32x32x16_bf16(kf[7],qr[3],C1,0,0,0),   P1[14],P1[15],0.f,0.f,       pw3[2]=PKW(P1,12),pw3[3]=PKW(P1,14), pw3); \
    l_reg+=sacc; \
    if(GK){DMA_K((t)+3,sl_cur);} if(GV){DMA_V((t)+1,sl_next);} \
    CMASK(C0,C1,t); \
    { float a=MX3(C0[0],C0[1],C1[0]),b=MX3(C0[2],C0[3],C1[1]); a=MX3(a,C1[2],C1[3]); \
      _Pragma("unroll") for(int r=4;r<16;r+=4){a=MX3(a,C0[r],C0[r+1]);b=MX3(b,C0[r+2],C0[r+3]);a=MX3(a,C1[r],C1[r+1]);b=MX3(b,C1[r+2],C1[r+3]);} \
      float rm=__builtin_fmaxf(a,b); { auto rr=__builtin_amdgcn_permlane32_swap(__float_as_uint(rm),__float_as_uint(rm),false,false); rm=__builtin_fmaxf(__uint_as_float(rr[0]),__uint_as_float(rr[1])); } \
      resc=false; \
      if(__builtin_expect(__any(rm>(float)THRL),0)){ const float dl=__builtin_fmaxf(rm,0.f); mhat+=dl; \
        _Pragma("unroll") for(int r=0;r<16;++r){C0[r]-=dl;C1[r]-=dl;} \
        if constexpr(!BMODE){ _Pragma("unroll") for(int r=0;r<16;++r)negm[r]=-mhat; asm volatile("":"+v"(negm)); } \
        const float f=__builtin_amdgcn_exp2f(-dl); l_reg*=f; if(hi==0)wsf[r32]=f; resc=true; } } \
    SBAR(); \
    GAPB(o[0]=__builtin_amdgcn_mfma_f32_32x32x16_bf16(PAF(0),VFR(0),o[0],0,0,0), C0,0); \
    GAPB(o[1]=__builtin_amdgcn_mfma_f32_32x32x16_bf16(PAF(0),VFR(4),o[1],0,0,0), C0,4); \
    KRD(GL,0); GAPB(o[0]=__builtin_amdgcn_mfma_f32_32x32x16_bf16(PAF(1),VFR(1),o[0],0,0,0), C0,8); \
    KRD(GL,1); GAPB(o[1]=__builtin_amdgcn_mfma_f32_32x32x16_bf16(PAF(1),VFR(5),o[1],0,0,0), C0,12); \
    KRD(GL,2); GAPB(o[0]=__builtin_amdgcn_mfma_f32_32x32x16_bf16(PAF(2),VFR(2),o[0],0,0,0), C1,0); \
    KRD(GL,3); GAPB(o[1]=__builtin_amdgcn_mfma_f32_32x32x16_bf16(PAF(2),VFR(6),o[1],0,0,0), C1,4); \
    GAPB(o[0]=__builtin_amdgcn_mfma_f32_32x32x16_bf16(PAF(3),VFR(3),o[0],0,0,0), C1,8); \
    GAPB(o[1]=__builtin_amdgcn_mfma_f32_32x32x16_bf16(PAF(3),VFR(7),o[1],0,0,0), C1,12); \
    }while(0)
  int t=1;
  for(;t+5<NT;t+=2){
    STEP(pB0,pB1,pA0,pA1,t,true,true,true);     WAIT_BAR(2); RESC(); ROT();
    STEP(pA0,pA1,pB0,pB1,t+1,true,true,true);   WAIT_BAR(2); RESC(); ROT();
  }
  #define ENDW(tt) do{ if((tt)+3<NT){WAIT_BAR(2);} else if((tt)+2<NT){WAIT_BAR(1);} else {WAIT_BAR(0);} }while(0)
  for(;t+1<NT;t+=2){
    STEP(pB0,pB1,pA0,pA1,t,(t+3<NT),(t+1<NT),(t+1<NT));       ENDW(t);   RESC(); ROT();
    STEP(pA0,pA1,pB0,pB1,t+1,(t+4<NT),(t+2<NT),(t+2<NT));     ENDW(t+1); RESC(); ROT();
  }
  STEP(pB0,pB1,pA0,pA1,NT-1,false,false,false); RESC();
  { float sacc=pB0[0]+pB0[1]; _Pragma("unroll") for(int r=2;r<16;++r)sacc+=pB0[r]; _Pragma("unroll") for(int r=0;r<16;++r)sacc+=pB1[r]; l_reg+=sacc;
    pw0=(u32x4){PKW(pB0,0),PKW(pB0,2),PKW(pB0,4),PKW(pB0,6)};pw1=(u32x4){PKW(pB0,8),PKW(pB0,10),PKW(pB0,12),PKW(pB0,14)};pw2=(u32x4){PKW(pB1,0),PKW(pB1,2),PKW(pB1,4),PKW(pB1,6)};pw3=(u32x4){PKW(pB1,8),PKW(pB1,10),PKW(pB1,12),PKW(pB1,14)};
    SBAR(); pv(o,vb0+sl_cur,PAF(0),PAF(1),PAF(2),PAF(3)); }
  #undef PKW
  #undef PAF
  #undef VFR
  #undef PIN
  #undef MX3
  #undef GAPA
  #undef GAPB
  #undef EX
  #undef VRD
  #undef KRD
  #undef STEP
  #undef ENDW
  {auto rr=__builtin_amdgcn_permlane32_swap(__float_as_uint(l_reg),__float_as_uint(l_reg),false,false);l_reg=__uint_as_float(rr[0])+__uint_as_float(rr[1]);}
  if(hi==0)wsf[32+r32]=l_reg;asm volatile("s_waitcnt lgkmcnt(0)":::"memory");
  float rli[16];
  #pragma unroll
  for(int r=0;r<16;++r)rli[r]=__builtin_amdgcn_rcpf(wsf[32+crow(r,hi)]);
  bf16*Ow=Ou+(long)(wid*QBLK)*DM;
  { bf16*stg=(bf16*)(shm+LDS_OST)+wid*2048;
    #pragma unroll
    for(int r=0;r<16;++r){const int orow=crow(r,hi);
      #pragma unroll
      for(int d0=0;d0<2;++d0)stg[orow*64+d0*32+r32]=__float2bfloat16(o[d0][r]*rli[r]);}
    asm volatile("s_waitcnt lgkmcnt(0)":::"memory");
    #pragma unroll
    for(int i=0;i<4;++i){const int row=i*8+(lane>>3),ch=lane&7; const u32x4 v=*(const u32x4*)(stg+row*64+ch*8); ATTN_STORE16(Ow+(long)row*DM+ch*8,v);} }
  asm volatile("s_waitcnt lgkmcnt(0)\n\ts_barrier":::"memory");
  #undef TILE
  #undef DMA_K
  #undef DMA_V
  #undef CMASK
  #undef START
  #undef RESC
  #undef ROT
}
constexpr int ATTN_LDS_BYTES=LDS_BT+15*BT_STRIDE*4;
#undef SBAR
#undef WAIT_BAR
}
#define XB_TMO      128
#define XB_XCNT(j)  (256  + 64 * (j))
#define XB_XSUB(j)  (1280 + 64 * (j))
#define XB_XGEN(j)  (2304 + 64 * (j))
#define XB_TOP      3328
#define XB_TOPGEN   3392
#define XCD_BAR_WORDS 3456
#define XB_SPIN_CAP (1u << 18)

__device__ __forceinline__ unsigned xb_ld(unsigned* p)              { return __hip_atomic_load(p, __ATOMIC_RELAXED, __HIP_MEMORY_SCOPE_AGENT); }
__device__ __forceinline__ unsigned xb_add(unsigned* p, unsigned v) { return __hip_atomic_fetch_add(p, v, __ATOMIC_RELAXED, __HIP_MEMORY_SCOPE_AGENT); }
__device__ __forceinline__ unsigned xb_xcc_id() { return (unsigned)__builtin_amdgcn_s_getreg((3 << 11) | 20) & 0xFu; }
#define XB_SPIN(cond, bar) do { unsigned _sp = 0; while (cond) { __builtin_amdgcn_s_sleep(1); \
    if ((++_sp & 255u) == 0u) { if (xb_ld(&(bar)[XB_TMO])) break; if (_sp > XB_SPIN_CAP) { atomicAdd(&(bar)[XB_TMO], 1u); break; } } } } while (0)

struct XcdBarrier {
    unsigned* bar; unsigned x;
    volatile LAS unsigned* st;
};

__device__ __forceinline__ XcdBarrier xcd_barrier_post(unsigned* bar, volatile LAS unsigned* st) {
    XcdBarrier b; b.bar = bar; b.x = xb_xcc_id(); b.st = st;
    if (threadIdx.x == 0) (void)xb_add(&bar[XB_XCNT(b.x)], 1u);
    return b;
}
__device__ __forceinline__ void xcd_barrier_complete(unsigned* bar, unsigned x, unsigned& nloc, unsigned& nx) {
    const unsigned G = gridDim.x * gridDim.y * gridDim.z;
    unsigned sum, cnt, mine, sp = 0u;
    for (;;) {
        sum = 0u; cnt = 0u; mine = 0u;
#pragma unroll
        for (unsigned j = 0; j < 16; ++j) { const unsigned c = xb_ld(&bar[XB_XCNT(j)]); sum += c; cnt += (c > 0u) ? 1u : 0u; mine = (j == x) ? c : mine; }
        if (sum == G) break;
        __builtin_amdgcn_s_sleep(1);
        if ((++sp & 255u) == 0u) { if (xb_ld(&bar[XB_TMO])) break; if (sp > XB_SPIN_CAP) { atomicAdd(&bar[XB_TMO], 1u); break; } }
    }
    nloc = mine > 0u ? mine : 1u; nx = cnt > 0u ? cnt : 1u;
}

__device__ __forceinline__ void xcd_barrier(const XcdBarrier& b) {
    asm volatile("s_waitcnt vmcnt(0)" ::: "memory");
    __syncthreads();
    if (threadIdx.x == 0) {
        unsigned* bar = b.bar;
        __builtin_amdgcn_s_waitcnt(0);
        unsigned nloc = b.st[0], nx = b.st[1];
        if (nloc == 0u) { xcd_barrier_complete(bar, b.x, nloc, nx); b.st[0] = nloc; b.st[1] = nx; }
        const unsigned old = xb_add(&bar[XB_XSUB(b.x)], 1u);
        const unsigned gen = old / nloc;
        if (old + 1u == (gen + 1u) * nloc) {
            __builtin_amdgcn_fence(__ATOMIC_RELEASE, "agent");
            asm volatile("s_waitcnt vmcnt(0)" ::: "memory");
            const unsigned og = xb_add(&bar[XB_TOP], 1u);
            const unsigned tg = og / nx;
            if (og + 1u == (tg + 1u) * nx) xb_add(&bar[XB_TOPGEN], 1u);
            else XB_SPIN(xb_ld(&bar[XB_TOPGEN]) == tg, bar);
            __builtin_amdgcn_fence(__ATOMIC_ACQUIRE, "agent");
            xb_add(&bar[XB_XGEN(b.x)], 1u);
            asm volatile("s_waitcnt vmcnt(0)" ::: "memory");
        } else {
            XB_SPIN(xb_ld(&bar[XB_XGEN(b.x)]) == gen, bar);
            __builtin_amdgcn_fence(__ATOMIC_ACQUIRE, "agent");
            asm volatile("s_waitcnt vmcnt(0)" ::: "memory");
        }
    }
    __syncthreads();
}

struct Frame {
    LAS unsigned char* lds;
    volatile LAS unsigned* MISC;
    unsigned* ctl;
    int tid, lane, wave, vcu, G;
    float* out; unsigned char* ws;
};
__device__ __forceinline__ const float* inp(const Frame& F, int i) {
    unsigned long long a_ = (unsigned long long)__builtin_amdgcn_kernarg_segment_ptr(); asm volatile("" : "+s"(a_));
    return (const float*)(((const __attribute__((address_space(4))) unsigned long long*)a_)[i]);
}
enum { I_X = 0, I_C, I_CTX, I_CCTX, I_WMOD, I_BMOD, I_WIN, I_GQA, I_GKA, I_GQB, I_GKB, I_RPB, I_CONVW, I_CONVB, I_GOUT, I_WOUT, I_F1, I_F3, I_F2, I_ROUTER, I_ROUTERB, I_M1, I_M3, I_M2 };

struct CvItem { const float* src; unsigned char* dst; int N, K, orow0, k0; };
__device__ __forceinline__ CvItem cv_item(const float* W, int K, int N, void* WT, int il, int half, int item) {
    const int nblk = N / 64, kb = item / nblk, nb = item % nblk, k0 = 64 * kb, n0 = 64 * nb;
    CvItem it; it.src = W + (size_t)k0 * N + n0; it.dst = (unsigned char*)WT; it.N = N; it.K = K; it.k0 = k0; it.orow0 = il ? ((n0 >> 7) * 256 + half * 128 + (n0 & 127)) : n0; return it;
}
__device__ __forceinline__ void cv_load(f32x4 (&v)[16], const CvItem& it, int lane) {
    const float* src = it.src + (size_t)(lane >> 4) * it.N + 4 * (lane & 15);
#pragma unroll
    for (int i = 0; i < 16; ++i) v[i] = __builtin_nontemporal_load((const GAS f32x4*)(src + (size_t)(4 * i) * it.N));
}
__device__ __forceinline__ void cv_to_lds(const f32x4 (&v)[16], LAS float* scr, int lane) {
#pragma unroll
    for (int i = 0; i < 16; ++i) { LAS float* d = scr + (4 * i + (lane >> 4)) * 65 + 4 * (lane & 15); d[0] = v[i].x; d[1] = v[i].y; d[2] = v[i].z; d[3] = v[i].w; }
    LDS_WAIT(); asm volatile("" ::: "memory");
}
template <bool F8> __device__ __forceinline__ void cv_finish(const CvItem& it, LAS float* scr, int lane) {
    const int c = lane & 7;
#pragma unroll
    for (int j = 0; j < 8; ++j) { const int n = (lane >> 3) + 8 * j; const LAS float* s = scr + (8 * c) * 65 + n;
        if constexpr (F8) { v2u o; o.x = pk4_f8(s[0 * 65] * 64.f, s[1 * 65] * 64.f, s[2 * 65] * 64.f, s[3 * 65] * 64.f); o.y = pk4_f8(s[4 * 65] * 64.f, s[5 * 65] * 64.f, s[6 * 65] * 64.f, s[7 * 65] * 64.f);
            __builtin_nontemporal_store(o, (GAS v2u*)(it.dst + (size_t)(it.orow0 + n) * it.K + it.k0 + 8 * c)); }
        else { v4u o; o.x = pk2(s[0 * 65], s[1 * 65]); o.y = pk2(s[2 * 65], s[3 * 65]); o.z = pk2(s[4 * 65], s[5 * 65]); o.w = pk2(s[6 * 65], s[7 * 65]);
            *(GAS v4u*)((bf16*)it.dst + (size_t)(it.orow0 + n) * it.K + it.k0 + 8 * c) = o; } }
    LDS_WAIT(); asm volatile("" ::: "memory");
}
__device__ __forceinline__ float silu_f(float v) { return v / (1.0f + __expf(-v)); }

constexpr int CV_IT_IN = 16 * 36, CV_IT_OUT = 16 * 16, CV_IT_F = 704, CV_DENSE_ITEMS = 2 * CV_IT_IN + 2 * CV_IT_OUT + 3 * CV_IT_F, CV_MOE_ITEMS = 24 * CV_IT_F;
__device__ __forceinline__ CvItem cv_dense_item(Frame& F, int r) {
    if (r < 2 * CV_IT_IN) { const int l = r / CV_IT_IN; return cv_item(inp(F, I_WIN) + (size_t)l * 1024 * INW, 1024, INW, (bf16*)(F.ws + WS_WIN) + (size_t)l * INW * 1024, 0, 0, r % CV_IT_IN); } r -= 2 * CV_IT_IN;
    if (r < 2 * CV_IT_OUT) { const int l = r / CV_IT_OUT; return cv_item(inp(F, I_WOUT) + (size_t)l * 1024 * 1024, 1024, 1024, (bf16*)(F.ws + WS_WOUT) + (size_t)l * 1024 * 1024, 0, 0, r % CV_IT_OUT); } r -= 2 * CV_IT_OUT;
    if (r < CV_IT_F) return cv_item(inp(F, I_F1), 1024, DFF, F.ws + WS_F13, 1, 0, r); r -= CV_IT_F;
    if (r < CV_IT_F) return cv_item(inp(F, I_F3), 1024, DFF, F.ws + WS_F13, 1, 1, r); r -= CV_IT_F;
    return cv_item(inp(F, I_F2), DFF, 1024, F.ws + WS_F2, 0, 0, r);
}
__device__ __forceinline__ void p0_prologue(Frame& F) {
    const int gw = F.vcu * NWAVES + F.wave, NGW = F.G * NWAVES;
    if (blockIdx.x == 0) {
        float* tab = (float*)(F.ws + WS_MISC + MS_ROPE);
        for (int idx = F.tid; idx < 1024; idx += NWAVES * 64) { const int pos = idx >> 4, i = idx & 15;
            const float inv = powf(10000.0f, -(float)(2 * i) / 32.0f); const float ang = (float)pos * inv;
            tab[2 * idx] = cosf(ang); tab[2 * idx + 1] = sinf(ang); }
    }
    {
        LAS float* sv = (LAS float*)F.lds;
        LAS float* red = (LAS float*)(F.lds + 17 * 1024 * 4);
        bool staged = false;
        for (int task = blockIdx.x; task < 192; task += F.G) {
            if (!staged) {
                for (int idx = F.tid; idx < 17 * 1024; idx += NWAVES * 64) { const int r = idx >> 10, k = idx & 1023; const float v = r < 16 ? inp(F, I_C)[r * 1024 + k] : inp(F, I_CCTX)[k]; sv[idx] = silu_f(v); }
                staged = true; __syncthreads();
            }
            const int l = task / 96, cb = task % 96, col = cb * 64 + F.lane;
            const float* W = inp(F, I_WMOD) + (size_t)l * 1024 * 6144 + col;
            float acc[17];
#pragma unroll
            for (int r = 0; r < 17; ++r) acc[r] = 0.f;
            const int kbeg = F.wave * 128;
#pragma unroll 8
            for (int k = kbeg; k < kbeg + 128; ++k) { const float wv = W[(size_t)k * 6144];
#pragma unroll
                for (int r = 0; r < 17; ++r) acc[r] += sv[r * 1024 + k] * wv; }
#pragma unroll
            for (int r = 0; r < 17; ++r) red[(F.wave * 17 + r) * 64 + F.lane] = acc[r];
            __syncthreads();
            for (int idx = F.tid; idx < 17 * 64; idx += NWAVES * 64) { const int r = idx >> 6, ln = idx & 63; float s = 0.f;
#pragma unroll
                for (int w = 0; w < 8; ++w) s += red[(w * 17 + r) * 64 + ln];
                const int n = cb * 64 + ln;
                ((float*)(F.ws + WS_MOD))[((size_t)l * 17 + r) * 6144 + n] = s + inp(F, I_BMOD)[l * 6144 + n]; }
            __syncthreads();
        }
        __syncthreads();
    }
    {
        LAS float* scr = (LAS float*)(F.lds + F.wave * 17408);
        f32x4 v[16]; int it = gw;
        if (it < CV_DENSE_ITEMS) cv_load(v, cv_dense_item(F, it), F.lane);
        while (it < CV_DENSE_ITEMS) {
            const CvItem cur = cv_dense_item(F, it); const bool f8 = it >= 2 * CV_IT_IN + 2 * CV_IT_OUT + 2 * CV_IT_F;
            cv_to_lds(v, scr, F.lane);
            it += NGW; if (it < CV_DENSE_ITEMS) cv_load(v, cv_dense_item(F, it), F.lane);
            if (f8) cv_finish<true>(cur, scr, F.lane); else cv_finish<false>(cur, scr, F.lane);
        }
    }
}
__device__ __forceinline__ CvItem cv_moe_item(Frame& F, int r) {
    constexpr int IT_F = 704;
    const int e = r / (3 * IT_F), q = r % (3 * IT_F), which = q / IT_F, item = q % IT_F;
    if (which == 0) return cv_item(inp(F, I_M1) + (size_t)e * 1024 * DFF, 1024, DFF, F.ws + WS_M13 + (size_t)e * 5632 * 1024, 1, 0, item);
    if (which == 1) return cv_item(inp(F, I_M3) + (size_t)e * 1024 * DFF, 1024, DFF, F.ws + WS_M13 + (size_t)e * 5632 * 1024, 1, 1, item);
    return cv_item(inp(F, I_M2) + (size_t)e * DFF * 1024, DFF, 1024, F.ws + WS_M2 + (size_t)e * 1024 * DFF, 0, 0, item);
}
__device__ __forceinline__ void convert_moe_weights(Frame& F, int first, int end, int step) {
    LAS float* scr = (LAS float*)(F.lds + F.wave * 17408);
    f32x4 v[16]; int it = first;
    if (it < end) cv_load(v, cv_moe_item(F, it), F.lane);
    while (it < end) {
        const CvItem cur = cv_moe_item(F, it);
        cv_to_lds(v, scr, F.lane);
        it += step; if (it < end) cv_load(v, cv_moe_item(F, it), F.lane);
        cv_finish<true>(cur, scr, F.lane);
    }
}

__device__ __forceinline__ void tail_convert(Frame& F, int nunits, int lo, int hi, int part = 1, int E = 0) {
    const int rounds = (nunits + F.G - 1) / F.G, full = nunits - (rounds - 1) * F.G, c = (int)blockIdx.x;
    if (full >= F.G) { if (part == 0) return; if (MK_N_LAUNCHES != 1) convert_moe_weights(F, lo + F.vcu * NWAVES + F.wave, hi, F.G * NWAVES); else if (c == 0) {   } return; }
    if (c < full) return;
    const int idx = c - full, step = (F.G - full) * NWAVES; const bool early = (E > 0) && (idx & 1);
    int mid = lo + E * step; if (mid > hi) mid = hi;
    if (part == 0) { if (early) { __syncthreads(); convert_moe_weights(F, lo + idx * NWAVES + F.wave, mid, step); __syncthreads(); } return; }
    __syncthreads(); convert_moe_weights(F, (early ? mid : lo) + idx * NWAVES + F.wave, hi, step);
}
constexpr int STAG_G2 = 1, STAG_G4 = 2;
constexpr int CV_S1 = 4275, CV_S2 = CV_S1 + 2565, CV_S3 = CV_S2 + 2850;

__device__ __forceinline__ const float* xrow_ptr(const float* lat, const float* ctx, int s) { const int b = s / TPB, j = s % TPB; return j < SEQ ? lat + (size_t)(b * SEQ + j) * DM : ctx + (size_t)(b * CTXL + j - SEQ) * DM; }

template <bool F8 = false> __device__ __forceinline__ void norm_mod_rows(Frame& F, const float* lat, const float* ctx, const float* mod, int shoff, int scoff, bf16* XN, bool with_ctx, bf16* XBo) {
    const int gw = F.vcu * NWAVES + F.wave, NGW = F.G * NWAVES;
    constexpr int R = 6;
    for (int s0 = gw * R; s0 < MROWS; s0 += NGW * R) {
        f32x4 v[R][4];
#pragma unroll
        for (int r = 0; r < R; ++r) { const GAS f32x4* xr = (const GAS f32x4*)xrow_ptr(lat, ctx, s0 + r) + F.lane;
#pragma unroll
            for (int q = 0; q < 4; ++q) v[r][q] = __builtin_nontemporal_load(xr + 64 * q); }
#pragma unroll
        for (int r = 0; r < R; ++r) { const int s = s0 + r, b = s / TPB, j = s % TPB;
            const float* mrow = mod + (size_t)(j < SEQ ? b : 16) * 6144;
            float ss = 0.f;
#pragma unroll
            for (int q = 0; q < 4; ++q) ss += (v[r][q].x * v[r][q].x + v[r][q].y * v[r][q].y) + (v[r][q].z * v[r][q].z + v[r][q].w * v[r][q].w);
            const float rstd = 1.0f / sqrtf(wave_sum(ss, F.lane) * (1.0f / DM) + NORM_EPS);
            GAS v2u* o8 = (GAS v2u*)(XN + (size_t)s * DM) + F.lane;
#pragma unroll
            for (int q = 0; q < 4; ++q) { const f32x4 sh = *(const f32x4*)(mrow + shoff + 4 * F.lane + 256 * q), sc = *(const f32x4*)(mrow + scoff + 4 * F.lane + 256 * q);
                const f32x4 y = v[r][q] * rstd * (sc + 1.0f) + sh;
                if constexpr (F8) ((GAS unsigned*)((unsigned char*)XN + (size_t)s * DM))[F.lane + 64 * q] = pk4_f8(y.x, y.y, y.z, y.w);
                else { v2u w; w.x = pk2(y.x, y.y); w.y = pk2(y.z, y.w); o8[64 * q] = w; }
                { v2u wx; wx.x = pk2(v[r][q].x, v[r][q].y); wx.y = pk2(v[r][q].z, v[r][q].w); ((GAS v2u*)(XBo + (size_t)s * DM) + F.lane)[64 * q] = wx; } } }
    }
}

__device__ __forceinline__ void unpack8(const v4u w, float (&v)[8]);
__device__ __forceinline__ void norm_mod_rows_bf(Frame& F, const bf16* XB, const float* mod, int shoff, int scoff, bf16* XN) {
    const int gw = F.vcu * NWAVES + F.wave, NGW = F.G * NWAVES;
    constexpr int R = 6;
    for (int s0 = gw * R; s0 < MROWS; s0 += NGW * R) {
        v4u w[R][2];
#pragma unroll
        for (int r = 0; r < R; ++r) { const GAS v4u* xr = (const GAS v4u*)(XB + (size_t)(s0 + r) * DM) + F.lane; w[r][0] = __builtin_nontemporal_load(xr); w[r][1] = __builtin_nontemporal_load(xr + 64); }
#pragma unroll
        for (int r = 0; r < R; ++r) { const int s = s0 + r, b = s / TPB, j = s % TPB;
            const float* mrow = mod + (size_t)(j < SEQ ? b : 16) * 6144;
            float v[2][8]; unpack8(w[r][0], v[0]); unpack8(w[r][1], v[1]);
            float ss = 0.f;
#pragma unroll
            for (int h = 0; h < 2; ++h)
#pragma unroll
                for (int i = 0; i < 8; ++i) ss += v[h][i] * v[h][i];
            const float rstd = 1.0f / sqrtf(wave_sum(ss, F.lane) * (1.0f / DM) + NORM_EPS);
#pragma unroll
            for (int h = 0; h < 2; ++h) { const int c0 = 512 * h + 8 * F.lane;
                const f32x4 sh0 = *(const f32x4*)(mrow + shoff + c0), sh1 = *(const f32x4*)(mrow + shoff + c0 + 4), sc0 = *(const f32x4*)(mrow + scoff + c0), sc1 = *(const f32x4*)(mrow + scoff + c0 + 4);
                float y[8];
#pragma unroll
                for (int i = 0; i < 4; ++i) { y[i] = v[h][i] * rstd * (sc0[i] + 1.0f) + sh0[i]; y[4 + i] = v[h][4 + i] * rstd * (sc1[i] + 1.0f) + sh1[i]; }
                v4u o; o.x = pk2(y[0], y[1]); o.y = pk2(y[2], y[3]); o.z = pk2(y[4], y[5]); o.w = pk2(y[6], y[7]);
                *((GAS v4u*)(XN + (size_t)s * DM + c0)) = o; } }
    }
}

__device__ __forceinline__ void headnorm_rows(Frame& F, int l, bool ctx_q) {
    const int gw = F.vcu * NWAVES + F.wave, NGW = F.G * NWAVES; bf16* P = (bf16*)(F.ws + WS_P);
    const float* tab = (const float*)(F.ws + WS_MISC + MS_ROPE);
    const int d = F.lane;
    const float gqa = inp(F, I_GQA)[l * 64 + d], gka = inp(F, I_GKA)[l * 64 + d], gqb = inp(F, I_GQB)[l * 64 + d], gkb = inp(F, I_GKB)[l * 64 + d];
    for (int s = gw; s < MROWS; s += NGW) {
        const int j = s % TPB; const bool lat = j < SEQ; bf16* p = P + (size_t)s * INW;
        float cs = 1.f, sn = 0.f;
        if (lat) { const int pos = (d < 32) ? (j >> 6) : (j & 63); const int i = d & 15; cs = tab[2 * (pos * 16 + i)]; sn = tab[2 * (pos * 16 + i) + 1]; }
        const float sgn = (d & 16) ? 1.f : -1.f;
#pragma unroll 1
        for (int h = 0; h < 18; ++h) {
            int off; float g; bool rope, isq;
            if (h < 8) { off = QA_OFF + 64 * h; g = gqa; rope = true; isq = true; }
            else if (h < 12) { off = QB_OFF + 64 * (h - 8); g = gqb; rope = false; isq = true; }
            else if (h < 14) { off = KA_OFF + 64 * (h - 12); g = gka; rope = true; isq = false; }
            else { off = KB_OFF + 64 * (h - 14); g = gkb; rope = false; isq = false; }
            if (isq && !lat && !ctx_q) continue;
            const float v = bf1(p[off + d]);
            const float ss = wave_sum(v * v, F.lane);
            float y = v * (1.0f / sqrtf(ss * (1.0f / 64.0f) + NORM_EPS)) * g;
            const float pr = xshfl(y, 16, F.lane);
            if (rope && lat) y = y * cs + sgn * pr * sn;
            if (isq) y *= C2;
            p[off + d] = (bf16)f2bf(y);
        }
    }
}

#ifdef ATTN_NAIVE
struct NaiveState { float q[64], o[64], m, l; };
__device__ __forceinline__ void na_load_q(NaiveState& S, const bf16* qp) {
#pragma unroll
    for (int c = 0; c < 8; ++c) { const v4u w = *(const v4u*)(qp + 8 * c);
        S.q[8 * c + 0] = bflo(w.x); S.q[8 * c + 1] = bfhi(w.x); S.q[8 * c + 2] = bflo(w.y); S.q[8 * c + 3] = bfhi(w.y);
        S.q[8 * c + 4] = bflo(w.z); S.q[8 * c + 5] = bfhi(w.z); S.q[8 * c + 6] = bflo(w.w); S.q[8 * c + 7] = bfhi(w.w); }
#pragma unroll
    for (int i = 0; i < 64; ++i) S.o[i] = 0.f;
    S.m = -1e30f; S.l = 0.f;
}
__device__ __forceinline__ float na_dot(const NaiveState& S, const bf16* kp) {
    float s = 0.f;
#pragma unroll
    for (int c = 0; c < 8; ++c) { const v4u w = *(const v4u*)(kp + 8 * c);
        s += S.q[8 * c + 0] * bflo(w.x) + S.q[8 * c + 1] * bfhi(w.x) + S.q[8 * c + 2] * bflo(w.y) + S.q[8 * c + 3] * bfhi(w.y)
           + S.q[8 * c + 4] * bflo(w.z) + S.q[8 * c + 5] * bfhi(w.z) + S.q[8 * c + 6] * bflo(w.w) + S.q[8 * c + 7] * bfhi(w.w); }
    return s;
}
__device__ __forceinline__ void na_acc(NaiveState& S, float p, const bf16* vp) {
#pragma unroll
    for (int c = 0; c < 8; ++c) { const v4u w = *(const v4u*)(vp + 8 * c);
        S.o[8 * c + 0] += p * bflo(w.x); S.o[8 * c + 1] += p * bfhi(w.x); S.o[8 * c + 2] += p * bflo(w.y); S.o[8 * c + 3] += p * bfhi(w.y);
        S.o[8 * c + 4] += p * bflo(w.z); S.o[8 * c + 5] += p * bfhi(w.z); S.o[8 * c + 6] += p * bflo(w.w); S.o[8 * c + 7] += p * bfhi(w.w); }
}
__device__ __forceinline__ void na_step2(NaiveState& S, float s0, float s1, const bf16* v0, const bf16* v1) {
    const float mn = fmaxf(S.m, fmaxf(s0, s1));
    const float sc = __builtin_amdgcn_exp2f(S.m - mn), p0 = __builtin_amdgcn_exp2f(s0 - mn), p1 = __builtin_amdgcn_exp2f(s1 - mn);
    S.l = S.l * sc + p0 + p1; S.m = mn;
#pragma unroll
    for (int i = 0; i < 64; ++i) S.o[i] *= sc;
    na_acc(S, p0, v0); na_acc(S, p1, v1);
}
__device__ __forceinline__ void na_store(const NaiveState& S, bf16* op) {
    const float inv = 1.0f / S.l;
#pragma unroll
    for (int c = 0; c < 8; ++c) { v4u w; w.x = pk2(S.o[8 * c + 0] * inv, S.o[8 * c + 1] * inv); w.y = pk2(S.o[8 * c + 2] * inv, S.o[8 * c + 3] * inv);
        w.z = pk2(S.o[8 * c + 4] * inv, S.o[8 * c + 5] * inv); w.w = pk2(S.o[8 * c + 6] * inv, S.o[8 * c + 7] * inv); *(v4u*)(op + 8 * c) = w; }
}
__device__ __forceinline__ void attn_naive_phase(Frame& F, int l, bool with_ctx) {
    const int gw = F.vcu * NWAVES + F.wave, NGW = F.G * NWAVES; bf16* P = (bf16*)(F.ws + WS_P);
    const float* rpb = inp(F, I_RPB) + (size_t)l * 4 * 15 * 31;
    const int ntask = with_ctx ? 6912 : 6144;
    for (int task = gw; task < ntask; task += NGW) {
        NaiveState S;
        if (task < 4096 || (task >= 6144 && task < 6656)) {
            int b, qh, j0, k0, k1;
            if (task < 4096) { b = task >> 8; qh = (task >> 5) & 7; j0 = (task & 31) * 64; k0 = 0; k1 = TPB; }
            else { const int t = task - 6144; b = t >> 5; qh = (t >> 2) & 7; j0 = SEQ + (t & 3) * 64; k0 = SEQ; k1 = TPB; }
            bf16* qp = P + (size_t)(b * TPB + j0 + F.lane) * INW + QA_OFF + qh * 64;
            na_load_q(S, qp);
            const bf16* Kb = P + (size_t)(b * TPB) * INW + KA_OFF + (qh >> 2) * 64; const bf16* Vb = P + (size_t)(b * TPB) * INW + VA_OFF + (qh >> 2) * 64;
            for (int k = k0; k < k1; k += 2) { const float s0 = na_dot(S, Kb + (size_t)k * INW), s1 = na_dot(S, Kb + (size_t)(k + 1) * INW); na_step2(S, s0, s1, Vb + (size_t)k * INW, Vb + (size_t)(k + 1) * INW); }
            na_store(S, qp);
        } else {
            int b, h, j; bool lat;
            if (task < 6144) { const int t = task - 4096; b = t >> 7; h = (t >> 5) & 3; j = (t & 31) * 64 + F.lane; lat = true; }
            else { const int t = task - 6656; b = t >> 4; h = (t >> 2) & 3; j = SEQ + (t & 3) * 64 + F.lane; lat = false; }
            bf16* qp = P + (size_t)(b * TPB + j) * INW + QB_OFF + h * 64;
            na_load_q(S, qp);
            const bf16* Kb = P + (size_t)(b * TPB) * INW + KB_OFF + h * 64; const bf16* Vb = P + (size_t)(b * TPB) * INW + VB_OFF + h * 64;
            if (lat) {
                const int r = j >> 6, c = j & 63; int rs = r - 4; rs = rs < 0 ? 0 : (rs > 24 ? 24 : rs); int cs = c - 8; cs = cs < 0 ? 0 : (cs > 48 ? 48 : cs);
                for (int i = 0; i < 8; ++i) { const int kr = rs + i; const float* brow = rpb + (h * 15 + (kr - r + 7)) * 31 + (15 - c);
                    for (int jc = 0; jc < 16; jc += 2) { const int kc = cs + jc; const int k = kr * 64 + kc;
                        const float s0 = na_dot(S, Kb + (size_t)k * INW) + brow[kc] * LOG2E, s1 = na_dot(S, Kb + (size_t)(k + 1) * INW) + brow[kc + 1] * LOG2E;
                        na_step2(S, s0, s1, Vb + (size_t)k * INW, Vb + (size_t)(k + 1) * INW); } }
            }
            for (int k = SEQ; k < TPB; k += 2) { const float s0 = na_dot(S, Kb + (size_t)k * INW), s1 = na_dot(S, Kb + (size_t)(k + 1) * INW); na_step2(S, s0, s1, Vb + (size_t)k * INW, Vb + (size_t)(k + 1) * INW); }
            na_store(S, qp);
        }
    }
}


#endif
__device__ __forceinline__ void attn_mfma_phase(Frame& F, int l, bool with_ctx, char* ldsg) {
    typedef attn_body::bf16 abf;
    abf* P = (abf*)(F.ws + WS_P); const int v = F.vcu;
    const int NA = 1024 + (with_ctx ? 192 : 0);
#pragma unroll 1
    for (int u = v; u < NA; u += F.G) {
        int b, qcol, kcol, vcol, qrow, NT, first0;
        if (u < 1024) { b = u >> 6; const int kvh = (u >> 5) & 1, qh = kvh * 4 + ((u >> 3) & 3); qrow = (u & 7) * 256; qcol = QA_OFF + qh * 64; kcol = KA_OFF + kvh * 64; vcol = VA_OFF + kvh * 64; NT = 36; first0 = 0; }
        else if (u < 1024 + 128) { const int t = u - 1024; b = t >> 3; const int qh = t & 7; qrow = SEQ; qcol = QA_OFF + qh * 64; kcol = KA_OFF + (qh >> 2) * 64; vcol = VA_OFF + (qh >> 2) * 64; NT = 4; first0 = 32; }
        else { const int t = u - 1152; b = t >> 2; const int h = t & 3; qrow = SEQ; qcol = QB_OFF + h * 64; kcol = KB_OFF + h * 64; vcol = VB_OFF + h * 64; NT = 4; first0 = 32; }
        abf* Qu = P + (size_t)(b * TPB + qrow) * INW + qcol; const abf* Kh = P + (size_t)(b * TPB) * INW + kcol; const abf* Vh = P + (size_t)(b * TPB) * INW + vcol;
        attn_body::attn_unit<8, false>(Qu, Kh, Vh, Qu, NT, NT, first0, 0, 0, nullptr, ldsg, F.wave);
    }
#ifndef NO_BSITE
    const float* rpbl = inp(F, I_RPB) + (size_t)l * 4 * 15 * 31;
#pragma unroll 1
    for (int u = v; u < 512; u += F.G) {
        const int b = u >> 5, h = (u >> 3) & 3, qb = u & 7, qg = 4 * qb;
        const int n0 = (qb == 0 || qb == 7) ? 8 : 12, s0 = qb == 0 ? 0 : (qb == 7 ? 24 : qg - 4);
        abf* Qu = P + (size_t)(b * TPB + qb * 256) * INW + QB_OFF + h * 64; const abf* Kh = P + (size_t)(b * TPB) * INW + KB_OFF + h * 64; const abf* Vh = P + (size_t)(b * TPB) * INW + VB_OFF + h * 64;
        attn_body::attn_unit<8, true>(Qu, Kh, Vh, Qu, 4 + n0, 4, 32, s0, qg, rpbl + h * 15 * 31, ldsg, F.wave);
    }
#endif
}

__device__ __forceinline__ void unpack8(const v4u w, float (&v)[8]) { v[0] = bflo(w.x); v[1] = bfhi(w.x); v[2] = bflo(w.y); v[3] = bfhi(w.y); v[4] = bflo(w.z); v[5] = bfhi(w.z); v[6] = bflo(w.w); v[7] = bfhi(w.w); }
__device__ __forceinline__ void merge_rows(Frame& F, int l, bool with_ctx) {
    const int gw = F.vcu * NWAVES + F.wave, NGW = F.G * NWAVES; const bf16* P = (const bf16*)(F.ws + WS_P); bf16* CAT = (bf16*)(F.ws + WS_XN);
    const float* gout = inp(F, I_GOUT) + l * 1024; const float* cw = inp(F, I_CONVW) + l * 3 * 256; const float* cb = inp(F, I_CONVB) + l * 256;
    const int lane = F.lane; const bool cl = lane >= 32; const int ch0 = 8 * (lane & 31);
    constexpr int R = 2;
    for (int s0 = gw * R; s0 < MROWS; s0 += NGW * R) {
        if (!with_ctx && (s0 % TPB) >= SEQ) continue;
        v4u la[R], lb[R], lt[R][6]; bool tv[R][3];
#pragma unroll
        for (int r = 0; r < R; ++r) { const int s = s0 + r, j = s % TPB; const bool lat = j < SEQ; const bf16* p = P + (size_t)s * INW;
            la[r] = *(const v4u*)(p + 8 * lane);
            lb[r] = *(const v4u*)(p + (cl ? CPOST_OFF + ch0 : 512 + 8 * lane));
            const int jlo = lat ? 0 : SEQ, jhi = lat ? SEQ : TPB;
#pragma unroll
            for (int tap = 0; tap < 3; ++tap) { const int jj = j + tap - 1; tv[r][tap] = cl && jj >= jlo && jj < jhi;
                if (tv[r][tap]) { const bf16* pp = p + (ptrdiff_t)(tap - 1) * INW; lt[r][2 * tap] = *(const v4u*)(pp + CPRE_OFF + ch0); lt[r][2 * tap + 1] = *(const v4u*)(pp + CVAL_OFF + ch0); }
                else { lt[r][2 * tap] = (v4u){0u, 0u, 0u, 0u}; lt[r][2 * tap + 1] = (v4u){0u, 0u, 0u, 0u}; } } }
#pragma unroll
        for (int r = 0; r < R; ++r) { const int s = s0 + r;
            float va[8], vb[8];
            unpack8(la[r], va); unpack8(lb[r], vb);
            if (cl) { float y[8];
#pragma unroll
                for (int k = 0; k < 8; ++k) y[k] = cb[ch0 + k];
#pragma unroll
                for (int tap = 0; tap < 3; ++tap) { float a[8], c[8]; unpack8(lt[r][2 * tap], a); unpack8(lt[r][2 * tap + 1], c);
#pragma unroll
                    for (int k = 0; k < 8; ++k) y[k] += cw[tap * 256 + ch0 + k] * (a[k] * c[k]); }
#pragma unroll
                for (int k = 0; k < 8; ++k) vb[k] = vb[k] * y[k]; }
            float sa = 0.f, sb = 0.f;
#pragma unroll
            for (int k = 0; k < 8; ++k) { sa += va[k] * va[k]; sb += vb[k] * vb[k]; }
            const float ra = 1.0f / sqrtf(wave_sum(sa, lane) * (1.0f / 512.0f) + NORM_EPS), rb = 1.0f / sqrtf(half_sum(sb, lane) * (1.0f / 256.0f) + NORM_EPS);
            v4u oa, ob; float g[8];
#pragma unroll
            for (int k = 0; k < 8; ++k) g[k] = gout[8 * lane + k];
            oa.x = pk2(va[0] * ra * g[0], va[1] * ra * g[1]); oa.y = pk2(va[2] * ra * g[2], va[3] * ra * g[3]); oa.z = pk2(va[4] * ra * g[4], va[5] * ra * g[5]); oa.w = pk2(va[6] * ra * g[6], va[7] * ra * g[7]);
#pragma unroll
            for (int k = 0; k < 8; ++k) g[k] = gout[512 + 8 * lane + k];
            ob.x = pk2(vb[0] * rb * g[0], vb[1] * rb * g[1]); ob.y = pk2(vb[2] * rb * g[2], vb[3] * rb * g[3]); ob.z = pk2(vb[4] * rb * g[4], vb[5] * rb * g[5]); ob.w = pk2(vb[6] * rb * g[6], vb[7] * rb * g[7]);
            *(v4u*)(CAT + (size_t)s * DM + 8 * lane) = oa; *(v4u*)(CAT + (size_t)s * DM + 512 + 8 * lane) = ob; }
    }
}

__device__ __forceinline__ void moe_route(Frame& F, const float* mod) {
    const bf16* XB = (const bf16*)(F.ws + WS_XB); unsigned char* XT = F.ws + WS_XT8;
    int* tok_e = (int*)(F.ws + WS_MISC + MS_TOKE); float* tok_g = (float*)(F.ws + WS_MISC + MS_TOKG);
    const float* wr = inp(F, I_ROUTER); const float* br = inp(F, I_ROUTERB);
    LAS int* le = (LAS int*)F.lds;
    LAS int* lcnt = le + 256;
    LAS f32x4* wl = (LAS f32x4*)(F.lds + 2048);
    for (int idx = F.tid; idx < 2048; idx += NWAVES * 64) { const int ln = idx & 63, hf = (idx >> 6) & 1, kk = (idx >> 7) & 7, hh = idx >> 10; wl[idx] = *(const f32x4*)(wr + (size_t)(512 * hh + 8 * ln + kk) * 8 + 4 * hf); }
    __syncthreads();
    for (int ch = blockIdx.x; ch < NTOK / 128; ch += F.G) {
#pragma unroll 2
        for (int i = 0; i < 16; ++i) {
            const int tl = F.wave * 16 + i, tok = ch * 128 + tl, b = tok / SEQ, s = b * TPB + (tok - b * SEQ);
            const GAS v4u* xr = (const GAS v4u*)(XB + (size_t)s * DM) + F.lane; const float* mrow = mod + (size_t)b * 6144;
            const v4u w0 = __builtin_nontemporal_load(xr), w1 = __builtin_nontemporal_load(xr + 64);
            float v[2][8]; unpack8(w0, v[0]); unpack8(w1, v[1]);
            float ss = 0.f;
#pragma unroll
            for (int h = 0; h < 2; ++h)
#pragma unroll
                for (int q = 0; q < 8; ++q) ss += v[h][q] * v[h][q];
            const float rstd = 1.0f / sqrtf(wave_sum(ss, F.lane) * (1.0f / DM) + NORM_EPS);
            float lg[8];
#pragma unroll
            for (int e = 0; e < 8; ++e) lg[e] = 0.f;
#pragma unroll
            for (int h = 0; h < 2; ++h) { const int c0 = 512 * h + 8 * F.lane;
                const f32x4 sh0 = *(const f32x4*)(mrow + 3072 + c0), sh1 = *(const f32x4*)(mrow + 3072 + c0 + 4), sc0 = *(const f32x4*)(mrow + 4096 + c0), sc1 = *(const f32x4*)(mrow + 4096 + c0 + 4);
                float y[8];
#pragma unroll
                for (int q = 0; q < 4; ++q) { y[q] = v[h][q] * rstd * (sc0[q] + 1.0f) + sh0[q]; y[4 + q] = v[h][4 + q] * rstd * (sc1[q] + 1.0f) + sh1[q]; }
                v2u o; o.x = pk4_f8(y[0], y[1], y[2], y[3]); o.y = pk4_f8(y[4], y[5], y[6], y[7]);
                *((GAS v2u*)(XT + (size_t)tok * DM + c0)) = o;
#pragma unroll
                for (int q = 0; q < 8; ++q) { const f32x4 wa = wl[((h * 8 + q) * 2 + 0) * 64 + F.lane], wb = wl[((h * 8 + q) * 2 + 1) * 64 + F.lane]; const float yk = y[q];
                    lg[0] += yk * wa.x; lg[1] += yk * wa.y; lg[2] += yk * wa.z; lg[3] += yk * wa.w; lg[4] += yk * wb.x; lg[5] += yk * wb.y; lg[6] += yk * wb.z; lg[7] += yk * wb.w; } }
            { const int ln = F.lane; float t4[4], t2[2], t1;
#pragma unroll
              for (int e = 0; e < 4; ++e) { const float keep = (ln & 32) ? lg[e + 4] : lg[e], give = (ln & 32) ? lg[e] : lg[e + 4]; t4[e] = keep + xshfl(give, 32, ln); }
#pragma unroll
              for (int e = 0; e < 2; ++e) { const float keep = (ln & 16) ? t4[e + 2] : t4[e], give = (ln & 16) ? t4[e] : t4[e + 2]; t2[e] = keep + xshfl(give, 16, ln); }
              { const float keep = (ln & 8) ? t2[1] : t2[0], give = (ln & 8) ? t2[0] : t2[1]; t1 = keep + xshfl(give, 8, ln); }
              t1 += xshfl(t1, 4, ln); t1 += xshfl(t1, 2, ln); t1 += xshfl(t1, 1, ln);
#pragma unroll
              for (int e = 0; e < 8; ++e) lg[e] = __int_as_float(__builtin_amdgcn_readlane(__float_as_int(t1), 8 * e)) + br[e]; }
            int e0 = 0; float v0 = lg[0];
#pragma unroll
            for (int e = 1; e < 8; ++e) if (lg[e] > v0) { v0 = lg[e]; e0 = e; }
            int e1 = -1; float v1 = -3.0e38f;
#pragma unroll
            for (int e = 0; e < 8; ++e) if (e != e0 && lg[e] > v1) { v1 = lg[e]; e1 = e; }
            const float p1 = __expf(v1 - v0), g0 = 1.0f / (1.0f + p1), g1 = p1 / (1.0f + p1);
            if (F.lane == 0) { tok_e[2 * tok] = e0; tok_e[2 * tok + 1] = e1; tok_g[2 * tok] = g0; tok_g[2 * tok + 1] = g1; le[2 * tl] = e0; le[2 * tl + 1] = e1; }
        }
        __syncthreads();
        if (F.tid < 256) { const int e = le[F.tid];
#pragma unroll
            for (int ee = 0; ee < 8; ++ee) { const unsigned long long m = __ballot(e == ee); if (F.lane == 0) lcnt[F.wave * 8 + ee] = __popcll(m); } }
        __syncthreads();
        if (F.tid < 8) F.ctl[CW_CNT + ch * 8 + F.tid] = (unsigned)(lcnt[F.tid] + lcnt[8 + F.tid] + lcnt[16 + F.tid] + lcnt[24 + F.tid]);
        __syncthreads();
    }
}
__device__ __forceinline__ void moe_sort_scatter(Frame& F) {
    const unsigned char* XT = F.ws + WS_XT8; unsigned char* XS = F.ws + WS_XS8;
    const int* tok_e = (const int*)(F.ws + WS_MISC + MS_TOKE); const float* tok_g = (const float*)(F.ws + WS_MISC + MS_TOKG);
    int* tok_s = (int*)(F.ws + WS_MISC + MS_TOKS); float* slot_g = (float*)(F.ws + WS_MISC + MS_SLOTG); int* meta = (int*)(F.ws + WS_MISC + MS_META);
    LAS int* ltot = (LAS int*)F.lds; LAS int* lpre = ltot + 8; LAS int* lps = ltot + 16; LAS int* wcnt = ltot + 32; LAS int* lslot = ltot + 64; LAS int* lacc = ltot + 320;
    for (int ch = blockIdx.x; ch < NTOK / 128; ch += F.G) {
        if (F.tid < 64) lacc[F.tid] = 0;
        __syncthreads();
        int myexp = 0;
        if (F.tid < 256) {
            const v4u c0 = *(const GAS v4u*)(F.ctl + CW_CNT + F.tid * 8), c1 = *(const GAS v4u*)(F.ctl + CW_CNT + F.tid * 8 + 4);
            const unsigned cn[8] = {c0.x, c0.y, c0.z, c0.w, c1.x, c1.y, c1.z, c1.w};
#pragma unroll
            for (int e = 0; e < 8; ++e) { __hip_atomic_fetch_add(lacc + F.wave * 16 + e, (int)cn[e], __ATOMIC_RELAXED, __HIP_MEMORY_SCOPE_WORKGROUP); if (F.tid < ch) __hip_atomic_fetch_add(lacc + F.wave * 16 + 8 + e, (int)cn[e], __ATOMIC_RELAXED, __HIP_MEMORY_SCOPE_WORKGROUP); }
            myexp = tok_e[2 * (ch * 128) + F.tid];
        }
        __syncthreads();
        if (F.tid < 16) ltot[F.tid] = lacc[F.tid] + lacc[16 + F.tid] + lacc[32 + F.tid] + lacc[48 + F.tid];
        __syncthreads();
        if (F.tid == 0) { int p = 0;
#pragma unroll
            for (int e = 0; e < 8; ++e) { lps[e] = p; p += (ltot[e] + 255) & ~255; } lps[8] = p; }
        int myrank = 0;
        if (F.tid < 256) {
#pragma unroll
            for (int ee = 0; ee < 8; ++ee) { const unsigned long long m = __ballot(myexp == ee); if (myexp == ee) myrank = __popcll(m & ((1ull << F.lane) - 1ull)); if (F.lane == 0) wcnt[F.wave * 8 + ee] = __popcll(m); } }
        __syncthreads();
        if (F.tid < 256) { int base = lps[myexp] + lpre[myexp] + myrank;
            for (int w = 0; w < F.wave; ++w) base += wcnt[w * 8 + myexp];
            lslot[F.tid] = base; tok_s[2 * (ch * 128) + F.tid] = base; slot_g[base] = tok_g[2 * (ch * 128) + F.tid]; }
        __syncthreads();
#pragma unroll 1
        for (int a0 = F.wave; a0 < 256; a0 += 8 * NWAVES) {
            v4u r[8];
#pragma unroll
            for (int j = 0; j < 8; ++j) { const int a = a0 + j * NWAVES; r[j] = *((const GAS v4u*)(XT + (size_t)(ch * 128 + (a >> 1)) * DM) + F.lane); }
#pragma unroll
            for (int j = 0; j < 8; ++j) { const int a = a0 + j * NWAVES; *((GAS v4u*)(XS + (size_t)lslot[a] * DM) + F.lane) = r[j]; } }
        if (ch < 8) {
            const int p0 = lps[ch] + ltot[ch], p1 = lps[ch + 1];
            for (int r = p0 + F.wave; r < p1; r += NWAVES) { GAS v4u* dst = (GAS v4u*)(XS + (size_t)r * DM) + F.lane; dst[0] = (v4u){0u, 0u, 0u, 0u}; if (F.lane == 0) slot_g[r] = 0.f; }
        }
        if (ch == 0 && F.tid < 8) meta[F.tid] = lps[F.tid + 1] >> 8;
        __syncthreads();
    }
}
__device__ __forceinline__ void moe_combine(Frame& F, const float* mod, int mode, int slot_lim, int gw, int NGW) { const bf16* Y = (const bf16*)(F.ws + WS_XN); const bf16* XB = (const bf16*)(F.ws + WS_XB); const int* tok_s = (const int*)(F.ws + WS_MISC + MS_TOKS);
    constexpr int R = 4;
    for (int t0 = gw * R; t0 < NTOK; t0 += NGW * R) {
        v4u wx[R][2], wa[R][2], wc[R][2]; bool ok[R]; int sl0[R], sl1[R]; bool any = false;
#pragma unroll
        for (int r = 0; r < R; ++r) { sl0[r] = tok_s[2 * (t0 + r)]; sl1[r] = tok_s[2 * (t0 + r) + 1]; ok[r] = ((sl0[r] < slot_lim && sl1[r] < slot_lim) ? 0 : 1) == mode; any = any || ok[r]; }
        if (!any) continue;
#pragma unroll
        for (int r = 0; r < R; ++r) { const int tok = t0 + r, b = tok / SEQ, s = b * TPB + (tok - b * SEQ), s0 = sl0[r], s1 = sl1[r];
            const GAS v4u* xr = (const GAS v4u*)(XB + (size_t)s * DM) + F.lane; const GAS v4u* y0 = (const GAS v4u*)(Y + (size_t)s0 * DM) + F.lane; const GAS v4u* y1 = (const GAS v4u*)(Y + (size_t)s1 * DM) + F.lane;
#pragma unroll
            for (int h = 0; h < 2; ++h) { wx[r][h] = __builtin_nontemporal_load(xr + 64 * h); wa[r][h] = __builtin_nontemporal_load(y0 + 64 * h); wc[r][h] = __builtin_nontemporal_load(y1 + 64 * h); } }
#pragma unroll
        for (int r = 0; r < R; ++r) { const int tok = t0 + r, b = tok / SEQ; const float* g = mod + (size_t)b * 6144 + 5120; float* orow = F.out + (size_t)tok * DM;
#pragma unroll
            for (int h = 0; h < 2; ++h) { float x[8], a[8], c[8]; unpack8(wx[r][h], x); unpack8(wa[r][h], a); unpack8(wc[r][h], c);
                const int c0 = 512 * h + 8 * F.lane; const f32x4 g0 = *(const f32x4*)(g + c0), g1 = *(const f32x4*)(g + c0 + 4);
                f32x4 o0, o1;
#pragma unroll
                for (int i = 0; i < 4; ++i) { o0[i] = x[i] + g0[i] * (a[i] + c[i]); o1[i] = x[4 + i] + g1[i] * (a[4 + i] + c[4 + i]); }
                if (ok[r]) { __builtin_nontemporal_store(o0, (GAS f32x4*)(orow + c0)); __builtin_nontemporal_store(o1, (GAS f32x4*)(orow + c0 + 4)); } } }
    }
}

struct Args { const float* in[24]; float* out; unsigned char* ws; int ph_lo, ph_hi, li, pad; };
__global__ void __launch_bounds__(NWAVES * 64, 2) mk_fwd(Args args) {
    extern __shared__ __attribute__((aligned(16))) unsigned char lds[];
    Frame F;
    F.lds = (LAS unsigned char*)lds; F.MISC = (volatile LAS unsigned*)(F.lds + MISC_OFF);
    F.tid = threadIdx.x; F.lane = F.tid & 63; F.wave = __builtin_amdgcn_readfirstlane(F.tid >> 6);
    F.G = gridDim.x; { const int bx = blockIdx.x; F.vcu = (F.G % 8 == 0) ? (bx % 8) * (F.G / 8) + bx / 8 : bx; }
    F.out = args.out; F.ws = args.ws; F.ctl = (unsigned*)(args.ws + WS_CTL);
    for (int u = F.tid; u < (LDS_BYTES - LDSCTL_OFF) / 4; u += NWAVES * 64) ((LAS unsigned*)(F.lds + LDSCTL_OFF))[u] = 0u;
    __syncthreads();
    if (F.tid < 24) { const unsigned long long p = (unsigned long long)args.in[F.tid]; LAS unsigned* t = (LAS unsigned*)(F.lds + LDSCTL_OFF + 64) + 2 * F.tid; t[0] = (unsigned)p; t[1] = (unsigned)(p >> 32); }
    __syncthreads();
    XcdBarrier bar; bar.bar = F.ctl + CW_BAR; bar.x = 0; bar.st = nullptr;
    if (MK_N_LAUNCHES == 1) bar = xcd_barrier_post(F.ctl + CW_BAR, F.MISC + 8);
    const int lo = args.ph_lo, hi = args.ph_hi;
#ifndef PHMASK
#define PHMASK 0xFFFFFFFFu
#endif
#define PHON(k) (((PHMASK) >> (k)) & 1u)
#define IN(k) (PHON(k) && lo <= (k) && (k) < hi)
#define INL(x) ((((PHMASK) >> (1 + (x))) & 1u) && lo <= pb + (x) && pb + (x) < hi)
#define INR(k) (lo <= (k) && (k) < hi)
#ifdef PROF_MASK
    if (F.tid == 0) { F.MISC[16] = (unsigned)__builtin_amdgcn_s_memrealtime(); F.MISC[17] = 0u; }
#define STAMP(k) do { if (F.wave == 0 && __builtin_amdgcn_mbcnt_hi(~0u, __builtin_amdgcn_mbcnt_lo(~0u, 0u)) == 0u) { const unsigned now_ = (unsigned)__builtin_amdgcn_s_memrealtime(); if (((unsigned)(PROF_MASK) >> (k)) & 1u) F.MISC[17] = F.MISC[17] + (now_ - F.MISC[16]); F.MISC[16] = now_; } } while (0)
#else
#define STAMP(k) do { } while (0)
#endif
#define SEAM(k) do { if (INR(k) && INR((k) + 1)) xcd_barrier(bar); STAMP(k); } while (0)
    bf16* XB = (bf16*)(F.ws + WS_XB); bf16* XN = (bf16*)(F.ws + WS_XN); bf16* P = (bf16*)(F.ws + WS_P);
    const float* MOD = (const float*)(F.ws + WS_MOD);
#define TABMEM (F.lds + LDSCTL_OFF + 448)
#define PF() do { int ln_ = (int)__builtin_amdgcn_mbcnt_hi(~0u, __builtin_amdgcn_mbcnt_lo(~0u, 0u)); asm volatile("" : "+v"(ln_)); F.lane = ln_; F.tid = F.wave * 64 + ln_; } while (0)

    if (IN(0)) { PF(); p0_prologue(F); } SEAM(0);

#pragma unroll 1
    for (int l = 0; l < 2; ++l) {
        const int pb = 1 + 9 * l; const bool last = (l == 1);
        const float* mod = MOD + (size_t)l * 17 * 6144;
        const float* xlat = inp(F, I_X); const float* xctx = inp(F, I_CTX);
        if (INL(0)) { PF(); if (!last) norm_mod_rows(F, xlat, xctx, mod, 0, 1024, XN, true, XB); else norm_mod_rows_bf(F, XB, mod, 0, 1024, XN); } SEAM(pb + 0);
        if (INL(1)) { PF();
            pg8::Gemm g{XN, (const bf16*)(F.ws + WS_WIN) + (size_t)l * INW * 1024, MROWS, INW, 1024};
            const pg8::TabOrder T = last ? pg8::build_units(TABMEM, 1024, XN, g.Bt, F.G, (int)blockIdx.x, 128, 9, 0, 1, 0, 16, 3, 6, 2, nullptr, 0, F.tid)
                                         : pg8::build_units(TABMEM, 1024, XN, g.Bt, F.G, (int)blockIdx.x, NPAN, 9, 0, 0, 0, 0, 1, 0, 0, nullptr, 0, F.tid);
#ifdef SEPARATE_HN
            pg8::EpiRawBf16 E{P, INW};
            pg8::gemm_phase<pg8::EpiRawBf16, pg8::TabOrder, true, true>(F.lds, g, T, E, F.wave);
#else
            { const float* tg = (const float*)(F.ws + WS_MISC + MS_ROPE); LAS float* tl = (LAS float*)(F.lds + 131072);
              for (int i = F.tid; i < 2048; i += NWAVES * 64) tl[i] = tg[i];
              if (F.tid < 256) { const int w = F.tid >> 6, d = F.tid & 63; const float* gs = w == 0 ? inp(F, I_GQA) : (w == 1 ? inp(F, I_GKA) : (w == 2 ? inp(F, I_GQB) : inp(F, I_GKB))); ((LAS float*)(F.lds + LDSCTL_OFF + 2048))[F.tid] = gs[l * 64 + d]; } }
            pg8::EpiHeads E{P, (const LAS float*)(F.lds + LDSCTL_OFF + 2048), (const LAS float*)(F.lds + 131072)};
            pg8::gemm_phase<pg8::EpiHeads, pg8::TabOrder, true, true>(F.lds, g, T, E, F.wave);
#endif
            if (!last) tail_convert(F, NPAN * 9, 0, CV_S1);
        } SEAM(pb + 1);
#ifdef SEPARATE_HN
        if (INL(2)) { PF(); headnorm_rows(F, l, !last); } SEAM(pb + 2);
#endif
        #ifdef ATTN_NAIVE
        if (INL(3)) { PF(); attn_naive_phase(F, l, !last); } SEAM(pb + 3);
#else
        if (INL(3)) { PF(); attn_mfma_phase(F, l, !last, (char*)lds); } SEAM(pb + 3);
#endif
        if (INL(4)) { PF(); merge_rows(F, l, !last); } SEAM(pb + 4);
        if (INL(5)) { PF();
            pg8::Gemm g{XN, (const bf16*)(F.ws + WS_WOUT) + (size_t)l * 1024 * 1024, MROWS, 1024, 1024};
            const pg8::TabOrder T = pg8::build_units(TABMEM, 1024, XN, g.Bt, F.G, (int)blockIdx.x, last ? 128 : NPAN, 4, 0, last ? 1 : 0, 0, 0, 1, 0, 0, nullptr, 0, F.tid);
            if (!last) tail_convert(F, NPAN * 4, CV_S1, CV_S2, 0, STAG_G2);
            pg8::EpiGateRes E{XB, mod, 2048, 1.0f};
            pg8::gemm_phase<pg8::EpiGateRes, pg8::TabOrder, true, true>(F.lds, g, T, E, F.wave);
            if (!last) tail_convert(F, NPAN * 4, CV_S1, CV_S2, 1, STAG_G2);
        } SEAM(pb + 5);
        if (!last) {
            if (IN(7)) { PF(); norm_mod_rows_bf(F, XB, mod, 3072, 4096, XN); } SEAM(7);
            if (IN(8)) { PF();
                pg8::Gemm g{XN, (const bf16*)(F.ws + WS_F13), MROWS, 5632, 1024};
                const pg8::TabOrder T = pg8::build_units(TABMEM, 1024, XN, g.Bt, F.G, (int)blockIdx.x, NPAN, 22, 0, 0, 0, 0, 1, 0, 0, nullptr, 0, F.tid);
                pg8::EpiSwigluF8 E{(unsigned char*)P, DFF, 1.0f};
                pg8::gemm_phase<pg8::EpiSwigluF8, pg8::TabOrder, true, true>(F.lds, g, T, E, F.wave);
                tail_convert(F, NPAN * 22, CV_S2, CV_S3);
            } SEAM(8);
            if (IN(9)) { PF();
                pg8::Gemm g{P, (const bf16*)(F.ws + WS_F2), MROWS, 1024, DFF / 2};
                const pg8::TabOrder T = pg8::build_units(TABMEM, DFF / 2, P, g.Bt, F.G, (int)blockIdx.x, NPAN, 4, 0, 0, 0, 0, 1, 0, 0, nullptr, 0, F.tid);
                tail_convert(F, NPAN * 4, CV_S3, CV_MOE_ITEMS, 0, STAG_G4);
                pg8::EpiGateRes E{XB, mod, 5120, 1.0f / 64.0f};
                pg8::gemm_phase<pg8::EpiGateRes, pg8::TabOrder, true, true, true>(F.lds, g, T, E, F.wave);
                tail_convert(F, NPAN * 4, CV_S3, CV_MOE_ITEMS, 1, STAG_G4);
            } SEAM(9);
        }
    }
    {
        const float* mod = MOD + (size_t)17 * 6144;
        if (IN(16)) { PF(); moe_route(F, mod); } SEAM(16);
        if (IN(17)) { PF(); moe_sort_scatter(F); } SEAM(17);
        const int* meta = (const int*)(F.ws + WS_MISC + MS_META);
        if (IN(18)) { PF();
            const int TP = __builtin_amdgcn_readfirstlane(meta[7]);
            pg8::Gemm g{(const bf16*)(F.ws + WS_XS8), (const bf16*)(F.ws + WS_M13), 0, 5632, 512};
            const pg8::TabOrder T = pg8::build_units(TABMEM, 512, g.A, g.Bt, F.G, (int)blockIdx.x, TP, 22, 0, 0, 0, 0, 1, 0, 0, meta, (size_t)5632 * 1024, F.tid);
            pg8::EpiSwigluF8 E{F.ws + WS_H8, DFF, 1.0f / 64.0f};
            pg8::gemm_phase<pg8::EpiSwigluF8, pg8::TabOrder, true, true, true>(F.lds, g, T, E, F.wave);
        } SEAM(18);
        if (IN(19)) { PF();
            const int TP = __builtin_amdgcn_readfirstlane(meta[7]), npa = TP < 256 ? TP : 256;
            pg8::Gemm g{(const bf16*)(F.ws + WS_H8), (const bf16*)(F.ws + WS_M2), 0, 1024, DFF / 2};
            const pg8::TabOrder T = pg8::build_units(TABMEM, DFF / 2, g.A, g.Bt, F.G, (int)blockIdx.x, npa, 4, 0, 0, 0, 0, 1, 0, 0, meta, (size_t)1024 * DFF, F.tid);
            pg8::EpiMoeOut E{XN, (const float*)(F.ws + WS_MISC + MS_SLOTG), 1.0f / 64.0f};
            pg8::gemm_phase<pg8::EpiMoeOut, pg8::TabOrder, true, true, true>(F.lds, g, T, E, F.wave);
        } SEAM(19);
        if (IN(20)) { PF();
            const int TP = __builtin_amdgcn_readfirstlane(meta[7]), npa = TP < 256 ? TP : 256, npb = TP - npa, n1 = npb * 4;
            if (n1 > 0 && n1 < F.G) {
                pg8::Gemm g{(const bf16*)(F.ws + WS_H8), (const bf16*)(F.ws + WS_M2), 0, 1024, DFF / 2};
                const pg8::TabOrder T = pg8::build_units(TABMEM, DFF / 2, g.A, g.Bt, F.G, (int)blockIdx.x, npb, 4, 0, 0, 256, 0, 1, 0, 0, meta, (size_t)1024 * DFF, F.tid);
                pg8::EpiMoeOut E{XN, (const float*)(F.ws + WS_MISC + MS_SLOTG), 1.0f / 64.0f};
                pg8::gemm_phase<pg8::EpiMoeOut, pg8::TabOrder, true, true, true>(F.lds, g, T, E, F.wave);
                if ((int)blockIdx.x >= n1) moe_combine(F, mod, 0, npa * 256, ((int)blockIdx.x - n1) * NWAVES + F.wave, (F.G - n1) * NWAVES);
            } else if (n1 == 0) moe_combine(F, mod, 0, npa * 256, F.vcu * NWAVES + F.wave, F.G * NWAVES);
            else {
                pg8::Gemm g{(const bf16*)(F.ws + WS_H8), (const bf16*)(F.ws + WS_M2), 0, 1024, DFF / 2};
                const pg8::TabOrder T = pg8::build_units(TABMEM, DFF / 2, g.A, g.Bt, F.G, (int)blockIdx.x, npb, 4, 0, 0, 256, 0, 1, 0, 0, meta, (size_t)1024 * DFF, F.tid);
                pg8::EpiMoeOut E{XN, (const float*)(F.ws + WS_MISC + MS_SLOTG), 1.0f / 64.0f};
                pg8::gemm_phase<pg8::EpiMoeOut, pg8::TabOrder, true, true, true>(F.lds, g, T, E, F.wave);
            }
        } SEAM(20);
        if (IN(22)) { PF();
            const int TP = __builtin_amdgcn_readfirstlane(meta[7]), npa = TP < 256 ? TP : 256, n1 = (TP - npa) * 4;
            if (n1 >= F.G) moe_combine(F, mod, 0, npa * 256, F.vcu * NWAVES + F.wave, F.G * NWAVES);
            moe_combine(F, mod, 1, npa * 256, F.vcu * NWAVES + F.wave, F.G * NWAVES);
        }
        STAMP(22);
    }
#ifdef PROF_MASK
    if (blockIdx.x == 0 && F.wave == 0 && __builtin_amdgcn_mbcnt_hi(~0u, __builtin_amdgcn_mbcnt_lo(~0u, 0u)) == 0u) { const unsigned long long t0_ = __builtin_amdgcn_s_memrealtime(); const unsigned long long w_ = 8ull * F.MISC[17]; while (__builtin_amdgcn_s_memrealtime() - t0_ < w_) __builtin_amdgcn_s_sleep(8); }
#endif
#undef IN
#undef SEAM
}

extern "C" void kernel_launch(void* const* d_in, const int* in_sizes, int n_in, void* d_out, int out_size, void* d_ws, size_t ws_size, hipStream_t stream) {
    static int grid = 0;
    if (grid == 0) {
        if (n_in != 24 || in_sizes[0] != BATCH * SEQ * DM || out_size != BATCH * SEQ * DM || ws_size < WS_END) { fprintf(stderr, "kernel_launch: unexpected shapes / workspace (n_in %d, ws %zu, need %zu); nothing launched\n", n_in, ws_size, (size_t)WS_END); grid = -1; return; }
        int dev = 0, cus = 0, per_cu = 0;
        if (hipGetDevice(&dev) != hipSuccess || hipDeviceGetAttribute(&cus, hipDeviceAttributeMultiprocessorCount, dev) != hipSuccess) { grid = -1; return; }
        if (hipFuncSetAttribute((const void*)mk_fwd, hipFuncAttributeMaxDynamicSharedMemorySize, LDS_BYTES) != hipSuccess) { fprintf(stderr, "kernel_launch: hipFuncSetAttribute failed\n"); grid = -1; return; }
        if (hipOccupancyMaxActiveBlocksPerMultiprocessor(&per_cu, (const void*)mk_fwd, NWAVES * 64, LDS_BYTES) != hipSuccess || per_cu < 1) fprintf(stderr, "kernel_launch: occupancy query reports %d\n", per_cu);
        (void)hipGetLastError();
        grid = cus;
    }
    if (grid < 0) return;
    if (hipMemsetAsync((char*)d_ws + WS_CTL, 0, CTL_ZERO_BYTES, stream) != hipSuccess) return;
    Args a{};
    for (int i = 0; i < 24; ++i) a.in[i] = (const float*)d_in[i];
    a.out = (float*)d_out; a.ws = (unsigned char*)d_ws; a.pad = 0;
    const int nl = MK_N_LAUNCHES == 1 ? 1 : NPH;
    for (int li = 0; li < nl; ++li) {
        a.ph_lo = nl == 1 ? 0 : li; a.ph_hi = nl == 1 ? NPH : li + 1; a.li = 0;
        hipLaunchKernelGGL(mk_fwd, dim3(grid), dim3(NWAVES * 64), LDS_BYTES, stream, a);
        const hipError_t le = hipPeekAtLastError();
        if (le != hipSuccess) { fprintf(stderr, "kernel_launch: launch %d failed: %s\n", li, hipGetErrorName(le)); break; }
    }
}
```

```cpp
#define MK_N_LAUNCHES 1
#include <hip/hip_runtime.h>
#include <cstdio>
#include <cstdint>
#include <cstddef>
#include <cmath>
namespace pg8 {
#define PG8_LAS __attribute__((address_space(3)))
typedef unsigned short bf16_t;
typedef short bf16x8 __attribute__((ext_vector_type(8)));
typedef float f32x4 __attribute__((ext_vector_type(4)));
typedef unsigned u32x4 __attribute__((ext_vector_type(4)));
constexpr int BM = 256, BK = 64, HALF = 128, HTB = HALF * BK * 2  , STAGE_BYTES = 8 * HTB, NXCD = 8, WGM = 8;

__host__ __device__ __forceinline__ int lds_byte(int r, int c) { const int st = (r >> 4) * 2 + (c >> 5), rr = r & 15, cc = c & 31, ob = rr * 64 + cc * 2; return st * 1024 + (ob ^ (((ob >> 9) & 1) << 5)); }
__host__ __device__ __forceinline__ void stage_rc(int b, int& R, int& C) { const int st = b / 1024, sb = b % 1024, swz = sb ^ (((sb >> 9) & 1) << 5); R = (st >> 1) * 16 + swz / 64; C = (st & 1) * 32 + (swz % 64) / 2; }
__host__ __device__ __forceinline__ int perm32(int rho) { const int n = rho >> 4, i = rho & 15; return 8 * (i >> 2) + 4 * n + (i & 3); }

struct Unit { int pm, pn, e; };
struct Gemm { const bf16_t* A; const bf16_t* Bt; int M, N, K; };

struct StaticOrder {
    int nM, nN, nwg, G, c;
    __host__ __device__ void init(int M, int N, int G_, int c_) { nM = M / BM; nN = N / BM; nwg = nM * nN; G = G_; c = c_; }
    __host__ __device__ bool next(int i, Unit& u) const {
        const long L = (long)i * G + c; if (L >= nwg) return false;
        int wgid = (int)L; { const int q = nwg / NXCD, r = nwg % NXCD, xcd = wgid % NXCD, off = wgid / NXCD; wgid = (xcd < r ? xcd * (q + 1) : r * (q + 1) + (xcd - r) * q) + off; }
        const int nig = WGM * nN, gid = wgid / nig, fm = gid * WGM, gsz = (nM - fm) < WGM ? (nM - fm) : WGM;
        u.pm = fm + ((wgid % nig) % gsz); u.pn = (wgid % nig) / gsz; return true;
    }
    __device__ __forceinline__ void a_ready(const Unit&) const {}
    __device__ __forceinline__ void done(const Unit&) const {}
};

__device__ __forceinline__ unsigned cvt_pk_bf16(float lo, float hi) { unsigned r; asm volatile("v_cvt_pk_bf16_f32 %0, %1, %2" : "=v"(r) : "v"(lo), "v"(hi)); return r; }
typedef float f32x2 __attribute__((ext_vector_type(2)));
__device__ __forceinline__ f32x2 gelu_pk(f32x2 v) {
    const f32x2 av = __builtin_elementwise_abs(v), d = av * 0.2316418882f + 1.0f;
    f32x2 t; t.x = __builtin_amdgcn_rcpf(d.x); t.y = __builtin_amdgcn_rcpf(d.y);
    f32x2 q = t * 0.5307027145f + (-0.7265760135f); q = q * t + 0.7107068705f; q = q * t + (-0.142248368f); q = q * t + 0.127414796f; q = q * t;
    const f32x2 s = (v * v) * (-0.72134752044f);
    f32x2 e; e.x = __builtin_amdgcn_exp2f(s.x); e.y = __builtin_amdgcn_exp2f(s.y);
    const f32x2 m = v * (q * e), r = v - m;
    f32x2 o; o.x = v.x < 0.f ? m.x : r.x; o.y = v.y < 0.f ? m.y : r.y; return o;
}

template <int ACT  > struct EpiBf16 {
    static constexpr bool PERM = true, AFTER_DRAIN = false, HEADMAP = false; static_assert(ACT == 0 || ACT == 1, "EpiBf16: ACT is 0 (none) or 1 (gelu_pk)");
    bf16_t* O; int ldc; const float* bias; int split_cols; size_t split_stride; float scale0;
    __device__ __forceinline__ void operator()(const f32x4 (&acc)[2][2][4][2], const Unit& u, int wr, int wc, int fr, int fq) const {
        const int row0 = u.pm * BM + wr * 64 + fr; int colt = u.pn * BM; bf16_t* base = O;
        float sc = 1.f; if (split_cols) { const int t = colt / split_cols; base += (size_t)t * split_stride; colt -= t * split_cols; if (t == 0) sc = scale0; }
        const int col0 = colt + wc * 32 + 8 * fq, bcol0 = u.pn * BM + wc * 32 + 8 * fq;
        f32x4 bv[2][2];
#pragma unroll
        for (int bj = 0; bj < 2; ++bj)
#pragma unroll
            for (int n = 0; n < 2; ++n) bv[bj][n] = bias ? *(const f32x4*)(bias + bcol0 + bj * HALF + 4 * n) : (f32x4){0.f, 0.f, 0.f, 0.f};
#pragma unroll
        for (int ai = 0; ai < 2; ++ai)
#pragma unroll
            for (int m = 0; m < 4; ++m) { bf16_t* rowp = base + (size_t)(row0 + ai * HALF + m * 16) * ldc + col0;
#pragma unroll
                for (int bj = 0; bj < 2; ++bj) { f32x4 v0 = acc[ai][bj][m][0] + bv[bj][0], v1 = acc[ai][bj][m][1] + bv[bj][1];
                    if (ACT == 1) { f32x2 a = gelu_pk((f32x2){v0[0], v0[1]}), b = gelu_pk((f32x2){v0[2], v0[3]}), c = gelu_pk((f32x2){v1[0], v1[1]}), d = gelu_pk((f32x2){v1[2], v1[3]});
                        v0 = (f32x4){a.x, a.y, b.x, b.y}; v1 = (f32x4){c.x, c.y, d.x, d.y}; }
                    v0 = v0 * sc; v1 = v1 * sc; u32x4 w; w.x = cvt_pk_bf16(v0[0], v0[1]); w.y = cvt_pk_bf16(v0[2], v0[3]); w.z = cvt_pk_bf16(v1[0], v1[1]); w.w = cvt_pk_bf16(v1[2], v1[3]);
                    *(u32x4*)(rowp + bj * HALF) = w; } }
    }
};

struct TabOrder {
    const volatile PG8_LAS unsigned* tab;
    __device__ __forceinline__ bool next(int i, Unit& u) const {
        if (i >= 32) return false;
        const volatile PG8_LAS unsigned* r = tab + 8 * i;
        if (__builtin_amdgcn_readfirstlane(r[6]) == 0u) return false;
        u.pm = (int)__builtin_amdgcn_readfirstlane(r[4]); u.pn = (int)__builtin_amdgcn_readfirstlane(r[5]); u.e = i; return true;
    }
    __device__ __forceinline__ const char* abase(const Unit& u, size_t) const { const volatile PG8_LAS unsigned* r = tab + 8 * u.e; const unsigned lo = __builtin_amdgcn_readfirstlane(r[0]), hi = __builtin_amdgcn_readfirstlane(r[1]); return (const char*)(((unsigned long long)hi << 32) | lo); }
    __device__ __forceinline__ const char* bbase(const Unit& u, size_t) const { const volatile PG8_LAS unsigned* r = tab + 8 * u.e; const unsigned lo = __builtin_amdgcn_readfirstlane(r[2]), hi = __builtin_amdgcn_readfirstlane(r[3]); return (const char*)(((unsigned long long)hi << 32) | lo); }
    __device__ __forceinline__ void a_ready(const Unit&) const {}
    __device__ __forceinline__ void done(const Unit&) const {}
};
__device__ __forceinline__ TabOrder build_units(PG8_LAS unsigned char* tabmem, int K, const void* A, const void* B, int G, int c,
                                                int np0, int nn0, int cn0, int mode0, int poff0, int np1, int nn1, int cn1, int mode1, const int* pend, size_t estride, const int tid) {
    __syncthreads();
    if (tid < 32) {
        int i_ = tid; asm volatile("" : "+v"(i_)); const int i = i_;
        const int n0 = np0 * nn0, nwg = n0 + np1 * nn1; const long L = (long)i * G + c; const bool ok = L < nwg;
        int w = ok ? (int)L : 0; { const int q = nwg / NXCD, r = nwg % NXCD, xcd = w % NXCD, off = w / NXCD; w = (xcd < r ? xcd * (q + 1) : r * (q + 1) + (xcd - r) * q) + off; }
        const bool s0 = w < n0; const int ww = s0 ? w : w - n0; const int np = s0 ? np0 : np1, nn = s0 ? nn0 : nn1, cn = s0 ? cn0 : cn1, mode = s0 ? mode0 : mode1;
        const int nig = WGM * nn, gid = ww / nig, fm = gid * WGM, gsz = (np - fm) < WGM ? (np - fm) : WGM;
        const int pv = fm + ((ww % nig) % gsz), pn = cn + (ww % nig) / gsz;
        const int pm0 = pv + poff0, pm1 = pv + (pv >> 3), pm2 = 9 * pv + 8; const int pm = mode == 0 ? pm0 : (mode == 1 ? pm1 : pm2);
        int e = 0;
        if (pend) {
#pragma unroll
            for (int k = 0; k < 8; ++k) e += (pend[k] <= pm) ? 1 : 0;
        }
        const size_t tstep = (size_t)256 * K * 2;
        const unsigned long long a = (unsigned long long)((const char*)A + (size_t)pm * tstep), b = (unsigned long long)((const char*)B + (size_t)e * estride + (size_t)pn * tstep);
        PG8_LAS unsigned* r = (PG8_LAS unsigned*)tabmem + 8 * i;
        r[0] = (unsigned)a; r[1] = (unsigned)(a >> 32); r[2] = (unsigned)b; r[3] = (unsigned)(b >> 32); r[4] = (unsigned)pm; r[5] = (unsigned)pn; r[6] = ok ? 1u : 0u; r[7] = 0u; }
    __syncthreads();
    TabOrder T; T.tab = (const volatile PG8_LAS unsigned*)tabmem; return T;
}

struct EpiRawBf16 {
    static constexpr bool PERM = true, AFTER_DRAIN = false, HEADMAP = false;
    bf16_t* O; int ldc;
    __device__ __forceinline__ void operator()(const f32x4 (&acc)[2][2][4][2], const Unit& u, int wr, int wc, int fr, int fq) const {
        const int row0 = u.pm * BM + wr * 64 + fr, col0 = u.pn * BM + wc * 32 + 8 * fq;
#pragma unroll
        for (int ai = 0; ai < 2; ++ai)
#pragma unroll
            for (int m = 0; m < 4; ++m) { bf16_t* rowp = O + (size_t)(row0 + ai * HALF + m * 16) * ldc + col0;
#pragma unroll
                for (int bj = 0; bj < 2; ++bj) { const f32x4 v0 = acc[ai][bj][m][0], v1 = acc[ai][bj][m][1];
                    u32x4 w; w.x = cvt_pk_bf16(v0[0], v0[1]); w.y = cvt_pk_bf16(v0[2], v0[3]); w.z = cvt_pk_bf16(v1[0], v1[1]); w.w = cvt_pk_bf16(v1[2], v1[3]);
                    *(u32x4*)(rowp + bj * HALF) = w; } }
    }
};

struct EpiHeads {
    static constexpr bool PERM = false, AFTER_DRAIN = false, HEADMAP = true;
    bf16_t* P; const PG8_LAS float* gl; const PG8_LAS float* tab;
    __device__ __forceinline__ void operator()(const f32x4 (&acc)[2][2][4][2], const Unit& u, int wr, int wc, int fr, int fq) const {
        const int pn = u.pn, jpan = u.pm % 9; const bool lat = jpan < 8;
        int mode = 0, gi = 0; float sc = 1.f;
        if (pn < 2) { mode = 2; gi = 0; sc = 0.125f * 1.4426950408889634f; }
        else if (pn == 2) { mode = 1; gi = 2; sc = 0.125f * 1.4426950408889634f; }
        else if (pn == 6) { mode = wc < 2 ? 2 : 0; gi = 1; }
        else if (pn == 7) { mode = 1; gi = 3; }
        if (mode == 2 && !lat) mode = 1;
        const PG8_LAS float* gp = gl + gi * 64 + 4 * fq;
        const int colb = pn * BM + wc * 64 + 4 * fq;
#pragma unroll
        for (int ai = 0; ai < 2; ++ai)
#pragma unroll
            for (int m = 0; m < 4; ++m) {
                const int lr = ai * HALF + wr * 64 + m * 16 + fr, j = jpan * 256 + lr;
                f32x4 v[2][2];
#pragma unroll
                for (int bj = 0; bj < 2; ++bj)
#pragma unroll
                    for (int n = 0; n < 2; ++n) v[bj][n] = acc[ai][bj][m][n];
                if (mode) {
                    float ss = 0.f;
#pragma unroll
                    for (int bj = 0; bj < 2; ++bj)
#pragma unroll
                        for (int n = 0; n < 2; ++n) ss += (v[bj][n][0] * v[bj][n][0] + v[bj][n][1] * v[bj][n][1]) + (v[bj][n][2] * v[bj][n][2] + v[bj][n][3] * v[bj][n][3]);
                    { const int ln_ = fq * 16 + fr; ss += __int_as_float(__builtin_amdgcn_ds_bpermute((ln_ ^ 16) << 2, __float_as_int(ss))); ss += __int_as_float(__builtin_amdgcn_ds_bpermute((ln_ ^ 32) << 2, __float_as_int(ss))); }
                    const float rs = 1.0f / sqrtf(ss * (1.0f / 64.0f) + 1e-6f);
#pragma unroll
                    for (int bj = 0; bj < 2; ++bj)
#pragma unroll
                        for (int n = 0; n < 2; ++n) v[bj][n] = v[bj][n] * (rs * sc) * *(const PG8_LAS f32x4*)(gp + 32 * bj + 16 * n);
                    if (mode == 2) {
#pragma unroll
                        for (int bj = 0; bj < 2; ++bj) { const int pos = bj == 0 ? (j >> 6) : (j & 63);
                            const f32x4 t0 = *(const PG8_LAS f32x4*)(tab + (pos * 16 + 4 * fq) * 2), t1 = *(const PG8_LAS f32x4*)(tab + (pos * 16 + 4 * fq) * 2 + 4);
                            const f32x4 cs = {t0[0], t0[2], t1[0], t1[2]}, sn = {t0[1], t0[3], t1[1], t1[3]};
                            const f32x4 u1 = v[bj][0], u2 = v[bj][1];
                            v[bj][0] = u1 * cs - u2 * sn; v[bj][1] = u2 * cs + u1 * sn; }
                    }
                }
                bf16_t* rowp = P + (size_t)(u.pm * BM + lr) * 2304 + pn * BM + wc * 64 + 4 * (fq & 2) + 16 * (fq & 1);
#pragma unroll
                for (int bj = 0; bj < 2; ++bj) {
                    const unsigned a0 = cvt_pk_bf16(v[bj][0][0], v[bj][0][1]), a1 = cvt_pk_bf16(v[bj][0][2], v[bj][0][3]), b0 = cvt_pk_bf16(v[bj][1][0], v[bj][1][1]), b1 = cvt_pk_bf16(v[bj][1][2], v[bj][1][3]);
                    const bool odd = fq & 1;
                    const unsigned s0 = odd ? a0 : b0, s1 = odd ? a1 : b1;
                    const unsigned r0 = (unsigned)__builtin_amdgcn_ds_swizzle((int)s0, 0x401F), r1 = (unsigned)__builtin_amdgcn_ds_swizzle((int)s1, 0x401F);
                    u32x4 w; if (odd) { w.x = r0; w.y = r1; w.z = b0; w.w = b1; } else { w.x = a0; w.y = a1; w.z = r0; w.w = r1; }
                    *(u32x4*)(rowp + 32 * bj) = w; }
                __builtin_amdgcn_sched_barrier(0);
            }
    }
};
struct EpiGateRes {
    static constexpr bool PERM = true, AFTER_DRAIN = false, HEADMAP = false;
    bf16_t* xb; const float* mod; int goff; float asc;
    __device__ __forceinline__ void operator()(const f32x4 (&acc)[2][2][4][2], const Unit& u, int wr, int wc, int fr, int fq) const {
        const int b = u.pm / 9, j = u.pm % 9; const bool lat = j < 8;
        bf16_t* bo = xb + (size_t)(u.pm * BM) * 1024;
        const float* g = mod + (lat ? b : 16) * 6144 + goff;
        const int col0 = u.pn * BM + wc * 32 + 8 * fq;
        constexpr int GB = 4;
        f32x4 gv[2][2];
#pragma unroll
        for (int bj = 0; bj < 2; ++bj)
#pragma unroll
            for (int n = 0; n < 2; ++n) gv[bj][n] = *(const f32x4*)(g + col0 + bj * HALF + 4 * n) * asc;
#pragma unroll
        for (int g0 = 0; g0 < 8; g0 += GB) { const int ai = g0 >> 2;
            u32x4 xh[4][2];
#pragma unroll
            for (int m = g0 & 3; m < (g0 & 3) + GB; ++m) { const size_t off = (size_t)(ai * HALF + wr * 64 + m * 16 + fr) * 1024 + col0;
#pragma unroll
                for (int bj = 0; bj < 2; ++bj) xh[m][bj] = *(const u32x4*)(bo + off + bj * HALF); }
#pragma unroll
            for (int m = g0 & 3; m < (g0 & 3) + GB; ++m) { const size_t off = (size_t)(ai * HALF + wr * 64 + m * 16 + fr) * 1024 + col0;
#pragma unroll
                for (int bj = 0; bj < 2; ++bj) { const u32x4 w = xh[m][bj];
                    const f32x4 x0 = {__uint_as_float(w.x << 16), __uint_as_float(w.x & 0xffff0000u), __uint_as_float(w.y << 16), __uint_as_float(w.y & 0xffff0000u)};
                    const f32x4 x1 = {__uint_as_float(w.z << 16), __uint_as_float(w.z & 0xffff0000u), __uint_as_float(w.w << 16), __uint_as_float(w.w & 0xffff0000u)};
                    const f32x4 o0 = x0 + gv[bj][0] * acc[ai][bj][m][0], o1 = x1 + gv[bj][1] * acc[ai][bj][m][1];
                    u32x4 wo; wo.x = cvt_pk_bf16(o0[0], o0[1]); wo.y = cvt_pk_bf16(o0[2], o0[3]); wo.z = cvt_pk_bf16(o1[0], o1[1]); wo.w = cvt_pk_bf16(o1[2], o1[3]);
                    *(u32x4*)(bo + off + bj * HALF) = wo; } }
            asm volatile("" ::: "memory"); }
    }
};
struct EpiSwiglu {
    static constexpr bool PERM = true, AFTER_DRAIN = false, HEADMAP = false;
    bf16_t* H; int ldh; int p0;
    __device__ __forceinline__ void operator()(const f32x4 (&acc)[2][2][4][2], const Unit& u, int wr, int wc, int fr, int fq) const {
        const int row0 = (u.pm - p0) * BM + wr * 64 + fr, col0 = u.pn * HALF + wc * 32 + 8 * fq;
#pragma unroll
        for (int ai = 0; ai < 2; ++ai)
#pragma unroll
            for (int m = 0; m < 4; ++m) { bf16_t* rowp = H + (size_t)(row0 + ai * HALF + m * 16) * ldh + col0;
                float h[8];
#pragma unroll
                for (int n = 0; n < 2; ++n)
#pragma unroll
                    for (int k = 0; k < 4; ++k) { const float a = acc[ai][0][m][n][k], b3 = acc[ai][1][m][n][k];
                        const float sg = __builtin_amdgcn_rcpf(1.0f + __builtin_amdgcn_exp2f(-1.4426950408889634f * a)); h[n * 4 + k] = a * sg * b3; }
                u32x4 w; w.x = cvt_pk_bf16(h[0], h[1]); w.y = cvt_pk_bf16(h[2], h[3]); w.z = cvt_pk_bf16(h[4], h[5]); w.w = cvt_pk_bf16(h[6], h[7]);
                *(u32x4*)rowp = w; }
    }
};
struct EpiSwigluF8 {
    static constexpr bool PERM = true, AFTER_DRAIN = false, HEADMAP = false;
    unsigned char* H; int ldh; float isc;
    __device__ __forceinline__ void operator()(const f32x4 (&acc)[2][2][4][2], const Unit& u, int wr, int wc, int fr, int fq) const {
        const int row0 = u.pm * BM + wr * 64 + fr, col0 = u.pn * HALF + wc * 32 + 8 * fq;
        const float c1 = -1.4426950408889634f * isc, c2 = isc * isc;
#pragma unroll
        for (int ai = 0; ai < 2; ++ai)
#pragma unroll
            for (int m = 0; m < 4; ++m) { unsigned char* rowp = H + (size_t)(row0 + ai * HALF + m * 16) * ldh + col0;
                f32x2 h[4];
#pragma unroll
                for (int n = 0; n < 2; ++n)
#pragma unroll
                    for (int k = 0; k < 2; ++k) { const f32x2 a = {acc[ai][0][m][n][2 * k], acc[ai][0][m][n][2 * k + 1]}, b3 = {acc[ai][1][m][n][2 * k], acc[ai][1][m][n][2 * k + 1]};
                        const f32x2 t = a * c1; f32x2 ex; ex.x = __builtin_amdgcn_exp2f(t.x); ex.y = __builtin_amdgcn_exp2f(t.y);
                        const f32x2 d = ex + 1.0f; f32x2 r; r.x = __builtin_amdgcn_rcpf(d.x); r.y = __builtin_amdgcn_rcpf(d.y);
                        h[n * 2 + k] = ((a * b3) * c2) * r; }
                typedef unsigned u32x2 __attribute__((ext_vector_type(2))); u32x2 w;
                { int t = __builtin_amdgcn_cvt_pk_fp8_f32(h[0].x, h[0].y, 0, false); t = __builtin_amdgcn_cvt_pk_fp8_f32(h[1].x, h[1].y, t, true); w.x = (unsigned)t; }
                { int t = __builtin_amdgcn_cvt_pk_fp8_f32(h[2].x, h[2].y, 0, false); t = __builtin_amdgcn_cvt_pk_fp8_f32(h[3].x, h[3].y, t, true); w.y = (unsigned)t; }
                *(u32x2*)rowp = w; }
    }
};
struct EpiMoeOut {
    static constexpr bool PERM = true, AFTER_DRAIN = false, HEADMAP = false;
    bf16_t* Y; const float* sgate; float osc;
    __device__ __forceinline__ void operator()(const f32x4 (&acc)[2][2][4][2], const Unit& u, int wr, int wc, int fr, int fq) const {
        const int row0 = u.pm * BM + wr * 64 + fr, col0 = u.pn * BM + wc * 32 + 8 * fq;
        float gts[8];
#pragma unroll
        for (int i = 0; i < 8; ++i) gts[i] = sgate[row0 + (i >> 2) * HALF + (i & 3) * 16] * osc;
#pragma unroll
        for (int ai = 0; ai < 2; ++ai)
#pragma unroll
            for (int m = 0; m < 4; ++m) { const int row = row0 + ai * HALF + m * 16; const float gt = gts[ai * 4 + m]; bf16_t* rowp = Y + (size_t)row * 1024 + col0;
#pragma unroll
                for (int bj = 0; bj < 2; ++bj) { const f32x4 v0 = acc[ai][bj][m][0] * gt, v1 = acc[ai][bj][m][1] * gt;
                    u32x4 w; w.x = cvt_pk_bf16(v0[0], v0[1]); w.y = cvt_pk_bf16(v0[2], v0[3]); w.z = cvt_pk_bf16(v1[0], v1[1]); w.w = cvt_pk_bf16(v1[2], v1[3]);
                    *(u32x4*)(rowp + bj * HALF) = w; } }
    }
};
template <class Epi, class Sched, bool ALIGN_EPI = false, bool SP2 = false, bool F8 = false>
__device__ __forceinline__ void gemm_phase(PG8_LAS unsigned char* lds, const Gemm g, const Sched& S, const Epi& E, const int wave_sgpr) {
    int ln_ = (int)__builtin_amdgcn_mbcnt_hi(~0u, __builtin_amdgcn_mbcnt_lo(~0u, 0u)); asm volatile("" : "+v"(ln_)); const int tid_ = wave_sgpr * 64 + ln_;
    const int tid = tid_, wid = __builtin_amdgcn_readfirstlane(tid >> 6), lane = tid & 63, wr = wid >> 2, wc = wid & 3, fr = lane & 15, fq = lane >> 4;
    const int K = g.K, nt = K / BK;
    unsigned voffA[2], voffB[2];
#pragma unroll
    for (int i = 0; i < 2; ++i) { int R, C; stage_rc(tid * 16 + i * 8192, R, C); const int Rb = Epi::HEADMAP ? ((R >> 5) * 64 + (R & 31)) : (Epi::PERM ? ((R & ~31) + perm32(R & 31)) : R);
        voffA[i] = (unsigned)(R * K + C) * 2u; voffB[i] = (unsigned)(Rb * K + C) * 2u; }
    const size_t kstep = (size_t)(BK * 2);
    const size_t hstep = (size_t)HALF * K * 2;
    const size_t hstepB = Epi::HEADMAP ? (size_t)32 * K * 2 : hstep;
    const size_t tstep = 2 * hstep;
    const unsigned ldsw = (unsigned)wid * 1024u;
    const int aoff = lds_byte(wr * 64 + fr, fq * 8), boff = lds_byte(wc * 32 + fr, fq * 8);
#define PG8_SA(b, h) (((b) * 2 + (h)) * HTB)
#define PG8_SB(b, h) ((4 + (b) * 2 + (h)) * HTB)
#define PG8_STAGE(bufoff, gbase, voff) do { _Pragma("unroll") for (int _i = 0; _i < 2; ++_i) \
        __builtin_amdgcn_global_load_lds((const unsigned*)((const char*)(gbase) + (voff)[_i]), (PG8_LAS unsigned*)(lds + (bufoff) + ldsw + _i * 8192), 16, 0, 0); } while (0)
#define PG8_LDA(dst, b, h) do { _Pragma("unroll") for (int m = 0; m < 4; ++m) { if constexpr (F8) { dst##8[m].lo = *(const PG8_LAS i32x4_*)(lds + PG8_SA(b, h) + aoff + m * 2048); dst##8[m].hi = *(const PG8_LAS i32x4_*)(lds + PG8_SA(b, h) + aoff + m * 2048 + 1024); } \
        else { _Pragma("unroll") for (int k = 0; k < 2; ++k) dst[m][k] = *(const PG8_LAS bf16x8*)(lds + PG8_SA(b, h) + aoff + m * 2048 + k * 1024); } } } while (0)
#define PG8_LDB(dst, b, h) do { _Pragma("unroll") for (int n = 0; n < 2; ++n) { if constexpr (F8) { dst##8[n].lo = *(const PG8_LAS i32x4_*)(lds + PG8_SB(b, h) + boff + n * 2048); dst##8[n].hi = *(const PG8_LAS i32x4_*)(lds + PG8_SB(b, h) + boff + n * 2048 + 1024); } \
        else { _Pragma("unroll") for (int k = 0; k < 2; ++k) dst[n][k] = *(const PG8_LAS bf16x8*)(lds + PG8_SB(b, h) + boff + n * 2048 + k * 1024); } } } while (0)
#define PG8_MMA(ai, bj, At, Bt) do { __builtin_amdgcn_s_setprio(1); _Pragma("unroll") for (int m = 0; m < 4; ++m) _Pragma("unroll") for (int n = 0; n < 2; ++n) { \
        if constexpr (F8) asm("v_mfma_f32_16x16x128_f8f6f4 %0, %1, %2, %0" : "+v"(acc[ai][bj][m][n]) : "v"(Bt##8[n]), "v"(At##8[m]));     \
        else { _Pragma("unroll") for (int k = 0; k < 2; ++k) acc[ai][bj][m][n] = __builtin_amdgcn_mfma_f32_16x16x32_bf16(Bt[n][k], At[m][k], acc[ai][bj][m][n], 0, 0, 0); } } \
        __builtin_amdgcn_s_setprio(0); } while (0)
#define PG8_WAIT_V(n) asm volatile("s_waitcnt vmcnt(" #n ")" ::: "memory")
#define PG8_WAIT_L(n) asm volatile("s_waitcnt lgkmcnt(" #n ")" ::: "memory")
#define PG8_BAR __builtin_amdgcn_s_barrier()
#define PG8_SCHED __builtin_amdgcn_sched_barrier(0)
    Unit cur, nxt; int ui = 0;
    if (!S.next(0, cur)) return;
    f32x4 acc[2][2][4][2];
#pragma unroll
    for (int a = 0; a < 2; ++a)
#pragma unroll
        for (int b = 0; b < 2; ++b)
#pragma unroll
            for (int m = 0; m < 4; ++m)
#pragma unroll
                for (int n = 0; n < 2; ++n) acc[a][b][m][n] = (f32x4){0.f, 0.f, 0.f, 0.f};
    typedef int i32x4_ __attribute__((ext_vector_type(4))); typedef int i32x8_ __attribute__((ext_vector_type(8)));
    bf16x8 At[4][2], B0[2][2], B1[2][2];
    i32x8_ At8[4], B08[2], B18[2];
    const char* cA = S.abase(cur, tstep); const char* cB = S.bbase(cur, tstep);
    S.a_ready(cur);
    if constexpr (SP2) {
        PG8_STAGE(PG8_SB(0, 0), cB, voffB); PG8_STAGE(PG8_SB(0, 1), cB + hstepB, voffB); PG8_STAGE(PG8_SA(0, 0), cA, voffA); PG8_STAGE(PG8_SA(0, 1), cA + hstep, voffA);
        if (wr == 1) PG8_BAR;
        PG8_WAIT_V(2); PG8_BAR;
        PG8_STAGE(PG8_SB(1, 0), cB + kstep, voffB); PG8_STAGE(PG8_SA(1, 0), cA + kstep, voffA); PG8_STAGE(PG8_SB(1, 1), cB + hstepB + kstep, voffB);
        PG8_WAIT_V(6); PG8_BAR;
    } else {
        PG8_STAGE(PG8_SB(0, 0), cB, voffB); PG8_STAGE(PG8_SA(0, 0), cA, voffA); PG8_STAGE(PG8_SB(0, 1), cB + hstepB, voffB); PG8_STAGE(PG8_SA(0, 1), cA + hstep, voffA);
        if (wr == 1) PG8_BAR;
        PG8_WAIT_V(4); PG8_BAR;
        PG8_STAGE(PG8_SB(1, 0), cB + kstep, voffB); PG8_STAGE(PG8_SA(1, 0), cA + kstep, voffA); PG8_STAGE(PG8_SB(1, 1), cB + hstepB + kstep, voffB);
        PG8_WAIT_V(6); PG8_BAR;
    }
    for (;;) {
        const bool has_next = S.next(ui + 1, nxt);
        const char* nA = has_next ? S.abase(nxt, tstep) : cA; const char* nB = has_next ? S.bbase(nxt, tstep) : cB;
#pragma unroll 1
        for (int t = 0; t < nt; t += 2) {
            const bool last = (t == nt - 2);
            const char* a1 = cA + (size_t)(t + 1) * kstep;
            const char* a2 = last ? nA : cA + (size_t)(t + 2) * kstep; const char* b2 = last ? nB : cB + (size_t)(t + 2) * kstep;
            const char* a3 = a2 + kstep; const char* b3 = b2 + kstep;
            if (last && has_next) S.a_ready(nxt);
            if constexpr (SP2) {
            PG8_LDB(B0, 0, 0); PG8_LDB(B1, 0, 1); PG8_SCHED; PG8_LDA(At, 0, 0); PG8_STAGE(PG8_SA(1, 1), a1 + hstep, voffA);
            PG8_WAIT_V(8); PG8_WAIT_L(0); PG8_BAR; PG8_MMA(0, 0, At, B0); PG8_MMA(0, 1, At, B1); PG8_BAR; PG8_SCHED;
            PG8_LDA(At, 0, 1); PG8_STAGE(PG8_SB(0, 0), b2, voffB); PG8_STAGE(PG8_SB(0, 1), b2 + hstepB, voffB); PG8_STAGE(PG8_SA(0, 0), a2, voffA);
            PG8_WAIT_V(8); PG8_WAIT_L(0); PG8_BAR; PG8_MMA(1, 0, At, B0); PG8_MMA(1, 1, At, B1); PG8_BAR; PG8_SCHED;
            PG8_LDB(B0, 1, 0); PG8_LDB(B1, 1, 1); PG8_SCHED; PG8_LDA(At, 1, 0); PG8_STAGE(PG8_SA(0, 1), a2 + hstep, voffA);
            PG8_WAIT_V(8); PG8_WAIT_L(0); PG8_BAR; PG8_MMA(0, 0, At, B0); PG8_MMA(0, 1, At, B1); PG8_BAR; PG8_SCHED;
            PG8_LDA(At, 1, 1); PG8_STAGE(PG8_SB(1, 0), b3, voffB); PG8_STAGE(PG8_SB(1, 1), b3 + hstepB, voffB); PG8_STAGE(PG8_SA(1, 0), a3, voffA);
            PG8_WAIT_V(8); PG8_WAIT_L(0); PG8_BAR; PG8_MMA(1, 0, At, B0); PG8_MMA(1, 1, At, B1); PG8_BAR; PG8_SCHED;
            } else {
            PG8_LDB(B0, 0, 0); PG8_SCHED; PG8_LDA(At, 0, 0); PG8_STAGE(PG8_SA(1, 1), a1 + hstep, voffA);
            PG8_WAIT_L(8); PG8_BAR; PG8_WAIT_L(0); PG8_MMA(0, 0, At, B0); PG8_BAR; PG8_SCHED;
            PG8_LDB(B1, 0, 1); PG8_STAGE(PG8_SB(0, 0), b2, voffB);
            PG8_BAR; PG8_WAIT_L(0); PG8_MMA(0, 1, At, B1); PG8_BAR;
            PG8_LDA(At, 0, 1); PG8_STAGE(PG8_SA(0, 0), a2, voffA);
            PG8_BAR; PG8_WAIT_L(0); PG8_MMA(1, 0, At, B0); PG8_BAR; PG8_SCHED;
            PG8_STAGE(PG8_SB(0, 1), b2 + hstepB, voffB);
            PG8_WAIT_V(6); PG8_BAR; PG8_MMA(1, 1, At, B1); PG8_BAR;
            PG8_LDB(B0, 1, 0); PG8_SCHED; PG8_LDA(At, 1, 0); PG8_STAGE(PG8_SA(0, 1), a2 + hstep, voffA);
            PG8_WAIT_L(8); PG8_BAR; PG8_WAIT_L(0); PG8_MMA(0, 0, At, B0); PG8_BAR; PG8_SCHED;
            PG8_LDB(B1, 1, 1); PG8_STAGE(PG8_SB(1, 0), b3, voffB);
            PG8_BAR; PG8_WAIT_L(0); PG8_MMA(0, 1, At, B1); PG8_BAR;
            PG8_LDA(At, 1, 1); PG8_STAGE(PG8_SA(1, 0), a3, voffA);
            PG8_BAR; PG8_WAIT_L(0); PG8_MMA(1, 0, At, B0); PG8_BAR; PG8_SCHED;
            PG8_STAGE(PG8_SB(1, 1), b3 + hstepB, voffB);
            PG8_WAIT_V(6); PG8_BAR; PG8_MMA(1, 1, At, B1); PG8_BAR;
            }
        }
        if constexpr (ALIGN_EPI) { if (wr == 0) PG8_BAR; }
        if constexpr (F8) asm volatile("s_nop 15\n\ts_nop 15\n\ts_nop 7" ::: "memory");
        if constexpr (!Epi::AFTER_DRAIN) { E(acc, cur, wr, wc, fr, fq); S.done(cur); }
        if (!has_next) break;
#pragma unroll
        for (int a = 0; a < 2; ++a)
#pragma unroll
            for (int b = 0; b < 2; ++b)
#pragma unroll
                for (int m = 0; m < 4; ++m)
#pragma unroll
                    for (int n = 0; n < 2; ++n) acc[a][b][m][n] = (f32x4){0.f, 0.f, 0.f, 0.f};
        cur = nxt; cA = nA; cB = nB; ++ui;
        if constexpr (ALIGN_EPI) { if (wr == 1) PG8_BAR; }
    }
    PG8_WAIT_V(0);
    if constexpr (!ALIGN_EPI) { if (wr == 0) PG8_BAR; }
    PG8_BAR;
    if constexpr (Epi::AFTER_DRAIN) { E.fused(acc, cur, wr, wc, fr, fq, lds, wid, lane); S.done(cur); }
#undef PG8_SA
#undef PG8_SB
#undef PG8_STAGE
#undef PG8_LDA
#undef PG8_LDB
#undef PG8_MMA
#undef PG8_WAIT_V
#undef PG8_WAIT_L
#undef PG8_BAR
#undef PG8_SCHED
}
}

constexpr int NWAVES = 8;
#ifndef MK_N_LAUNCHES
#define MK_N_LAUNCHES 1
#endif
constexpr int NPH = 23;
constexpr int BATCH = 16, SEQ = 2048, DM = 1024, CTXL = 256, TPB = SEQ + CTXL, MROWS = BATCH * TPB, NPAN = MROWS / 256;
constexpr int INW = 2304, DFF = 2816, NEXP = 8, NTOK = BATCH * SEQ;
constexpr int QA_OFF = 0, QB_OFF = 512, CPOST_OFF = 768, CPRE_OFF = 1024, CVAL_OFF = 1280, KA_OFF = 1536, VA_OFF = 1664, KB_OFF = 1792, VB_OFF = 2048;
constexpr float NORM_EPS = 1e-6f, LOG2E = 1.4426950408889634f, C2 = 0.125f * 1.4426950408889634f;
constexpr int MOE_HCAP = 136;
constexpr int SLOT_CAP = 2 * NTOK + NEXP * 256;

constexpr size_t MiB = 1u << 20;
constexpr size_t WS_CTL = 0, CTL_ZERO_BYTES = 128 * 1024;
constexpr size_t WS_MOD = 1 * MiB;
constexpr size_t WS_MISC = 2 * MiB;
constexpr size_t WS_WIN = 6 * MiB;
constexpr size_t WS_WOUT = 15 * MiB;
constexpr size_t WS_F13 = 19 * MiB;
constexpr size_t WS_F2 = 30 * MiB;
constexpr size_t WS_M13 = 36 * MiB;
constexpr size_t WS_M2 = 80 * MiB;
constexpr size_t WS_XB = 104 * MiB;
constexpr size_t WS_XN = 184 * MiB;
constexpr size_t WS_P = 256 * MiB;
constexpr size_t WS_XT = 316 * MiB;
constexpr size_t WS_END = 504 * MiB;
constexpr size_t WS_XS8 = WS_XN, WS_XT8 = WS_XN + 66 * MiB, WS_H8 = WS_XT;
static_assert(WS_P + (size_t)MROWS * DFF * 2 <= WS_END && WS_H8 + (size_t)SLOT_CAP * DFF <= WS_END && WS_XN + (size_t)SLOT_CAP * DM * 2 <= WS_XT && WS_XT8 + (size_t)NTOK * DM <= WS_XT && (size_t)SLOT_CAP * DM <= 66 * MiB, "ws map");
constexpr size_t MS_TOKE = 0, MS_TOKG = 256 * 1024, MS_TOKS = 512 * 1024, MS_SLOTG = 768 * 1024, MS_META = 1088 * 1024, MS_ROPE = 1152 * 1024;
constexpr int CW_TMO = 0, CW_CODE = 1, CW_BAR = 4096, CW_CNT = 16384;

constexpr int RING_BYTES = 139264, LDSCTL_OFF = RING_BYTES, MISC_OFF = LDSCTL_OFF + 320, LDS_BYTES = 147456;

#define GAS __attribute__((address_space(1)))
#define LAS __attribute__((address_space(3)))
typedef unsigned short bf16;
typedef unsigned v4u __attribute__((ext_vector_type(4)));
typedef unsigned v2u __attribute__((ext_vector_type(2)));
typedef float f32x4 __attribute__((ext_vector_type(4)));
#define LDS_WAIT() asm volatile("s_waitcnt lgkmcnt(0)" ::: "memory")
#define VM_WAIT() asm volatile("s_waitcnt vmcnt(0)" ::: "memory")
__device__ __forceinline__ unsigned f2bf(float f) { unsigned u = __builtin_bit_cast(unsigned, f); return (u + 0x7fffu + ((u >> 16) & 1u)) >> 16; }
__device__ __forceinline__ unsigned pk2(float lo, float hi) { return f2bf(lo) | (f2bf(hi) << 16); }
__device__ __forceinline__ unsigned pk4_f8(float a, float b, float c, float d) { int w = __builtin_amdgcn_cvt_pk_fp8_f32(a, b, 0, false); w = __builtin_amdgcn_cvt_pk_fp8_f32(c, d, w, true); return (unsigned)w; }
__device__ __forceinline__ float bflo(unsigned w) { return __uint_as_float(w << 16); }
__device__ __forceinline__ float bfhi(unsigned w) { return __uint_as_float(w & 0xffff0000u); }
__device__ __forceinline__ float bf1(bf16 h) { return __uint_as_float((unsigned)h << 16); }
__device__ __forceinline__ float xshfl(float v, int mask, int lane) { return __int_as_float(__builtin_amdgcn_ds_bpermute((lane ^ mask) << 2, __float_as_int(v))); }
__device__ __forceinline__ float wave_sum(float v, int lane) {
#pragma unroll
    for (int o = 1; o < 64; o <<= 1) v += xshfl(v, o, lane);
    return v;
}
__device__ __forceinline__ float half_sum(float v, int lane) {
#pragma unroll
    for (int o = 1; o < 32; o <<= 1) v += xshfl(v, o, lane);
    return v;
}
#include <hip/hip_bf16.h>
#include <cmath>
namespace attn_body {
using bf16=__hip_bfloat16;
using bf16x8=__attribute__((ext_vector_type(8)))short;
using s16x4=__attribute__((ext_vector_type(4)))short;
using f32x16=__attribute__((ext_vector_type(16)))float;
using u32x4=__attribute__((ext_vector_type(4)))unsigned;
constexpr int D=64,DM=2304;
constexpr int NW=8,QBLK=32,QB=QBLK*NW,KVBLK=64;
constexpr int LDS_BT=86016, BT_STRIDE=128, BT_PAD=48;
__device__ __forceinline__ int crow(int r,int hi){return (r&3)+8*(r>>2)+4*hi;}
#define SBAR() __builtin_amdgcn_sched_barrier(0)
__device__ __forceinline__ void bias_apply(f32x16&p0,f32x16&p1,const __attribute__((address_space(3))) char*tb,unsigned m0,unsigned m1,float mh){
  const unsigned NEGB=0xf149f2cau;
  #pragma unroll
  for(int g=0;g<4;++g){
    #pragma unroll
    for(int k=0;k<4;++k){ const int r=4*g+k; const int o=((r&3)+8*(r>>2))*4; const float b0=*(const __attribute__((address_space(3))) float*)(tb+o),b1=*(const __attribute__((address_space(3))) float*)(tb+o+128);
      const unsigned s0=(unsigned)__builtin_amdgcn_sbfe((int)m0,r,1), s1=(unsigned)__builtin_amdgcn_sbfe((int)m1,r,1);
      const unsigned x0=__float_as_uint(p0[r]+(b0-mh)), x1=__float_as_uint(p1[r]+(b1-mh));
      float y0=__uint_as_float((x0&s0)|(NEGB&~s0)), y1=__uint_as_float((x1&s1)|(NEGB&~s1)); asm volatile("":"+v"(y0),"+v"(y1)); p0[r]=y0; p1[r]=y1; }
    __builtin_amdgcn_sched_barrier(0); }
}
constexpr int NSLOT=3, SLOTB=8192;
constexpr int LDS_K=0, LDS_V=NSLOT*SLOTB, LDS_WS=2*NSLOT*SLOTB, LDS_OST=LDS_WS+NW*64*4, LDS_BYTES=LDS_OST+NW*4096;
constexpr float C2=0.125f*1.4426950408889634f;
__device__ __forceinline__ void glds16(const void*gsrc,unsigned lds_dst){unsigned keep;
  asm volatile("s_mov_b32 %0, m0\n\ts_mov_b32 m0, %2\n\ts_nop 0\n\tglobal_load_lds_dwordx4 %1, off\n\ts_mov_b32 m0, %0":"=&s"(keep):"v"(gsrc),"s"(lds_dst):"memory");}
__device__ __forceinline__ float max3f(float a,float b,float c){float r;asm("v_max3_f32 %0, %1, %2, %3":"=v"(r):"v"(a),"v"(b),"v"(c));return r;}
__device__ __forceinline__ float max2f(float a,float b){float r;asm("v_max_f32_e32 %0, %1, %2":"=v"(r):"v"(a),"v"(b));return r;}
__device__ __forceinline__ float fadd_s(float a,float b){float r;asm("v_add_f32_e32 %0, %1, %2":"=v"(r):"v"(a),"v"(b));return r;}
__device__ __forceinline__ float fsub_s(float a,float b){float r;asm("v_sub_f32_e32 %0, %1, %2":"=v"(r):"v"(a),"v"(b));return r;}
typedef float f32x2_t __attribute__((ext_vector_type(2))); typedef __bf16 bf16x2_t __attribute__((ext_vector_type(2)));
__device__ __forceinline__ unsigned cvtpk_s(float lo,float hi){f32x2_t v={lo,hi};bf16x2_t b=__builtin_convertvector(v,bf16x2_t);return __builtin_bit_cast(unsigned,b);}
#define WAIT_BAR(N) asm volatile("s_waitcnt vmcnt(" #N ") lgkmcnt(0)\n\ts_barrier":::"memory")

template<bool ZERO> __device__ __forceinline__ f32x16 cinit(const f32x16&negm){ if constexpr(ZERO) return f32x16{}; else return negm; }
__device__ __forceinline__ void qkt(f32x16&p0,f32x16&p1,const char*Kslot,const bf16x8*qr,const f32x16 negm,int r32,int hi){
  const char*kb=Kslot+hi*1024+r32*16;
  #pragma unroll
  for(int d0=0;d0<4;++d0){
    const bf16x8 b0=*reinterpret_cast<const bf16x8*>(kb+d0*2048);
    const bf16x8 b1=*reinterpret_cast<const bf16x8*>(kb+d0*2048+512);
    if(d0==0){p0=__builtin_amdgcn_mfma_f32_32x32x16_bf16(b0,qr[0],negm,0,0,0);p1=__builtin_amdgcn_mfma_f32_32x32x16_bf16(b1,qr[0],negm,0,0,0);}
    else{p0=__builtin_amdgcn_mfma_f32_32x32x16_bf16(b0,qr[d0],p0,0,0,0);p1=__builtin_amdgcn_mfma_f32_32x32x16_bf16(b1,qr[d0],p1,0,0,0);}}
}
typedef __attribute__((address_space(3))) const char* lds_cptr;
typedef short v4i16_t __attribute__((ext_vector_type(4)));
__device__ __forceinline__ void kload8(bf16x8*kf,lds_cptr kp){
  kf[0]=*(const __attribute__((address_space(3))) bf16x8*)(kp);      kf[1]=*(const __attribute__((address_space(3))) bf16x8*)(kp+512);
  kf[2]=*(const __attribute__((address_space(3))) bf16x8*)(kp+2048); kf[3]=*(const __attribute__((address_space(3))) bf16x8*)(kp+2560);
  kf[4]=*(const __attribute__((address_space(3))) bf16x8*)(kp+4096); kf[5]=*(const __attribute__((address_space(3))) bf16x8*)(kp+4608);
  kf[6]=*(const __attribute__((address_space(3))) bf16x8*)(kp+6144); kf[7]=*(const __attribute__((address_space(3))) bf16x8*)(kp+6656);
}
__device__ __forceinline__ void kload2(bf16x8*kf,lds_cptr kp,int j){ kf[2*j]=*(const __attribute__((address_space(3))) bf16x8*)(kp+j*2048); kf[2*j+1]=*(const __attribute__((address_space(3))) bf16x8*)(kp+j*2048+512); }
__device__ __forceinline__ s16x4 vtr(lds_cptr p){ return __builtin_bit_cast(s16x4,__builtin_amdgcn_ds_read_tr16_b64_v4i16((__attribute__((address_space(3))) v4i16_t*)p)); }
__device__ __forceinline__ float rowmax(const f32x16&p0,const f32x16&p1){
  float a=max3f(p0[0],p0[1],p1[0]),b=max3f(p0[2],p0[3],p1[1]);a=max3f(a,p1[2],p1[3]);
  #pragma unroll
  for(int r=4;r<16;r+=4){a=max3f(a,p0[r],p0[r+1]);b=max3f(b,p0[r+2],p0[r+3]);a=max3f(a,p1[r],p1[r+1]);b=max3f(b,p1[r+2],p1[r+3]);}
  const float m=max2f(a,b);
  auto rr=__builtin_amdgcn_permlane32_swap(__float_as_uint(m),__float_as_uint(m),false,false);
  return max2f(__uint_as_float(rr[0]),__uint_as_float(rr[1]));
}
__device__ __forceinline__ void pv(f32x16*o,int vb,bf16x8 pa0,bf16x8 pa1,bf16x8 pa2,bf16x8 pa3){
  #pragma unroll
  for(int d0=0;d0<2;++d0){s16x4 lo[4],hi[4];
    #pragma unroll
    for(int ks=0;ks<4;++ks){
      asm volatile("ds_read_b64_tr_b16 %0,%1 offset:%c2":"=&v"(lo[ks]):"v"(vb),"i"(d0*4096+ks*1024):"memory");
      asm volatile("ds_read_b64_tr_b16 %0,%1 offset:%c2":"=&v"(hi[ks]):"v"(vb),"i"(d0*4096+ks*1024+512):"memory");}
    asm volatile("s_waitcnt lgkmcnt(0)":::"memory");SBAR();
    #define PK(k) (bf16x8){lo[k][0],lo[k][1],lo[k][2],lo[k][3],hi[k][0],hi[k][1],hi[k][2],hi[k][3]}
    o[d0]=__builtin_amdgcn_mfma_f32_32x32x16_bf16(pa0,PK(0),o[d0],0,0,0);
    o[d0]=__builtin_amdgcn_mfma_f32_32x32x16_bf16(pa1,PK(1),o[d0],0,0,0);
    o[d0]=__builtin_amdgcn_mfma_f32_32x32x16_bf16(pa2,PK(2),o[d0],0,0,0);
    o[d0]=__builtin_amdgcn_mfma_f32_32x32x16_bf16(pa3,PK(3),o[d0],0,0,0);
    #undef PK
  }
}

#ifndef ATTN_STORE16
#define ATTN_STORE16(p,v) (*(u32x4*)(p)=(v))
#endif
template<int THRL,bool BMODE> __device__ __forceinline__ void attn_unit(const bf16*Qu,const bf16*__restrict__ Kh,const bf16*__restrict__ Vh,bf16*Ou,const int NT,const int nfirst,const int first0,const int second0,const int qg,const float*rpbh,char*shm,const int wave_sgpr){
  int ln_=(int)__builtin_amdgcn_mbcnt_hi(~0u,__builtin_amdgcn_mbcnt_lo(~0u,0u)); asm volatile("":"+v"(ln_));
  const int wid=wave_sgpr,lane=ln_,tid=wid*64+lane,r32=lane&31,hi=lane>>5;
  const bf16*Qw=Qu+(long)(wid*QBLK)*DM;
  const unsigned lds0=(unsigned)(uintptr_t)shm;
  float*wsf=(float*)(shm+LDS_WS)+wid*64;
  const bf16*ksrc=Kh+(long)lane*DM+wid*8;
  const bf16*vsrc=Vh+(long)(16*(wid&3)+(lane>>2))*DM+(wid>>2)*32+(lane&3)*8;
  const unsigned kdst=lds0+LDS_K+wid*1024, vdst=lds0+LDS_V+wid*1024;
  #define TILE(t) (((t)<nfirst)?(first0+(t)):(second0+(t)-nfirst))
  #define DMA_K(t,slot) glds16(ksrc+(long)TILE(t)*KVBLK*DM,(unsigned)__builtin_amdgcn_readfirstlane(kdst+(slot)))
  #define DMA_V(t,slot) glds16(vsrc+(long)TILE(t)*KVBLK*DM,(unsigned)__builtin_amdgcn_readfirstlane(vdst+(slot)))
  const int vb0=(int)(lds0+LDS_V)+((lane>>4)&1)*32+(lane&3)*8+(4*hi+((lane&15)>>2))*64;
  const char*Kbase=shm+LDS_K; bf16x8 kf[8];
  const lds_cptr shm3=(lds_cptr)shm; const lds_cptr kp0=shm3+LDS_K+hi*1024+r32*16; const lds_cptr vp0=shm3+LDS_V+((lane>>4)&1)*32+(lane&3)*8+(4*hi+((lane&15)>>2))*64;
  unsigned bm0=0u,bm1=0u; int blane=0,bqr=0,brs=0;
  if constexpr(BMODE){ const int qc=(wid&1)*32+r32; int cs=qc-8; cs=cs<0?0:(cs>48?48:cs);
    _Pragma("unroll") for(int r=0;r<16;++r){ const int kc=(r&3)+8*(r>>2)+4*hi; bm0|=(kc>=cs&&kc<cs+16)?(1u<<r):0u; bm1|=(kc+32>=cs&&kc+32<cs+16)?(1u<<r):0u; }
    blane=(BT_PAD+15-qc+4*hi)*4; bqr=qg+(wid>>1); brs=bqr-4; brs=brs<0?0:(brs>24?24:brs);
    __attribute__((address_space(3))) float*bt=(__attribute__((address_space(3))) float*)(shm3+LDS_BT); for(int idx=tid;idx<15*BT_STRIDE;idx+=NW*64){ const int dr=idx/BT_STRIDE,j=idx%BT_STRIDE; bt[idx]=(j>=BT_PAD&&j<=BT_PAD+30)?rpbh[dr*31+j-BT_PAD]*1.4426950408889634f:0.f; } }
  DMA_K(0,0);DMA_V(0,0);DMA_K(1,SLOTB);
  bf16x8 qr[4];
  #pragma unroll
  for(int d0=0;d0<4;++d0)qr[d0]=*reinterpret_cast<const bf16x8*>(&Qw[(long)r32*DM+d0*16+hi*8]);
  float mhat=0.f,l_reg=0.f;f32x16 o[2];o[0]=f32x16{};o[1]=f32x16{};f32x16 negm=f32x16{}; if constexpr(!BMODE){asm volatile("":"+v"(negm));}
  #define CMASK(P0,P1,t) do{ if constexpr(BMODE){ if((t)>=nfirst){ const int kr_=second0+(t)-nfirst; const bool rv_=(kr_>=brs)&&(kr_<brs+8); int dr_=kr_-bqr+7; dr_=dr_<0?0:(dr_>14?14:dr_); \
      bias_apply(P0,P1,shm3+LDS_BT+dr_*(BT_STRIDE*4)+blane,rv_?bm0:0u,rv_?bm1:0u,mhat); } else { _Pragma("unroll") for(int r_=0;r_<16;++r_){P0[r_]-=mhat;P1[r_]-=mhat;} } } }while(0)
  bool resc=false;
  #define START(P0,P1) do{ const float rm=rowmax(P0,P1); resc=false; \
    { const float dl=rm; mhat=fadd_s(mhat,dl); \
      _Pragma("unroll") for(int r=0;r<16;++r){P0[r]=fsub_s(P0[r],dl);P1[r]=fsub_s(P1[r],dl);} \
      if constexpr(!BMODE){ _Pragma("unroll") for(int r=0;r<16;++r)negm[r]=-mhat; asm volatile("":"+v"(negm)); } } \
    _Pragma("unroll") for(int r=0;r<16;++r)P0[r]=__builtin_amdgcn_exp2f(P0[r]); }while(0)
  #define RESC() do{ if(resc){ asm volatile("s_waitcnt lgkmcnt(0)":::"memory"); \
      _Pragma("unroll") for(int d_=0;d_<2;++d_) _Pragma("unroll") for(int r=0;r<16;++r)o[d_][r]*=wsf[crow(r,hi)]; } }while(0)
  f32x16 pA0,pA1,pB0,pB1;
  int sl_prev=0,sl_cur=0,sl_next=SLOTB;
  #define ROT() do{sl_prev=sl_cur;sl_cur=sl_next;sl_next=(sl_next==(NSLOT-1)*SLOTB)?0:sl_next+SLOTB;}while(0)
  DMA_K(2,2*SLOTB);
  WAIT_BAR(3);
  qkt(pA0,pA1,Kbase,qr,cinit<BMODE>(negm),r32,hi);asm volatile("s_nop 15\n\ts_nop 7":"+v"(pA0),"+v"(pA1));CMASK(pA0,pA1,0);
  START(pA0,pA1);
  _Pragma("unroll") for(int r=0;r<16;++r)pA1[r]=__builtin_amdgcn_exp2f(pA1[r]);
  WAIT_BAR(0);
  DMA_K(3,0);DMA_V(1,SLOTB);
  ROT();
  kload8(kf,kp0+sl_cur);
  WAIT_BAR(2);
  s16x4 vlo[8],vhi[8]; u32x4 pw0,pw1,pw2,pw3;
  #define PKW(P,B) cvtpk_s(P[B],P[B+1])
  #define PAF(k) __builtin_bit_cast(bf16x8,pw##k)
  #define VFR(i) (bf16x8){vlo[i][0],vlo[i][1],vlo[i][2],vlo[i][3],vhi[i][0],vhi[i][1],vhi[i][2],vhi[i][3]}
  #define PIN(x) asm volatile("":"+v"(x))
  #define MX3(a,b,c) __builtin_fmaxf(__builtin_fmaxf((a),(b)),(c))
  #define GAPA(MF,A0,A1,A2,A3,W0,W1,PW) do{ MF; sacc+=A0; sacc+=A1; sacc+=A2; sacc+=A3; PIN(sacc); W0; W1; PIN(PW); SBAR(); }while(0)
  #define EX(v) __builtin_amdgcn_exp2f(v)
  #define GAPB(MF,X,B) do{ MF; X[B]=EX(X[B]); X[B+1]=EX(X[B+1]); X[B+2]=EX(X[B+2]); X[B+3]=EX(X[B+3]); PIN(X); SBAR(); }while(0)
  #define VRD(i) do{ vlo[i]=vtr(vp_+(((i)>>2)*4096+((i)&3)*1024)); vhi[i]=vtr(vp_+(((i)>>2)*4096+((i)&3)*1024+512)); }while(0)
  #define KRD(G,j) do{ if(G){ kload2(kf,kp0+sl_next,j); SBAR(); } }while(0)
  #define STEP(C0,C1,P0,P1,t,GK,GV,GL) do{ SBAR(); \
    const lds_cptr vp_=vp0+sl_prev; \
    VRD(0); SBAR(); float sacc=(P0[0]+P0[1]); \
    GAPA(C0=__builtin_amdgcn_mfma_f32_32x32x16_bf16(kf[0],qr[0],cinit<BMODE>(negm),0,0,0), P0[2],P0[3],P0[4],P0[5],     pw0[0]=PKW(P0,0), pw0[1]=PKW(P0,2), pw0); \
    VRD(4); SBAR(); GAPA(C1=__builtin_amdgcn_mfma_f32_32x32x16_bf16(kf[1],qr[0],cinit<BMODE>(negm),0,0,0), P0[6],P0[7],P0[8],P0[9],     pw0[2]=PKW(P0,4), pw0[3]=PKW(P0,6), pw0); \
    VRD(1); SBAR(); GAPA(C0=__builtin_amdgcn_mfma_f32_32x32x16_bf16(kf[2],qr[1],C0,0,0,0),   P0[10],P0[11],P0[12],P0[13], pw1[0]=PKW(P0,8), pw1[1]=PKW(P0,10), pw1); \
    VRD(5); SBAR(); GAPA(C1=__builtin_amdgcn_mfma_f32_32x32x16_bf16(kf[3],qr[1],C1,0,0,0),   P0[14],P0[15],P1[0],P1[1],   pw1[2]=PKW(P0,12),pw1[3]=PKW(P0,14), pw1); \
    VRD(2); SBAR(); GAPA(C0=__builtin_amdgcn_mfma_f32_32x32x16_bf16(kf[4],qr[2],C0,0,0,0),   P1[2],P1[3],P1[4],P1[5],     pw2[0]=PKW(P1,0), pw2[1]=PKW(P1,2), pw2); \
    VRD(6); SBAR(); GAPA(C1=__builtin_amdgcn_mfma_f32_32x32x16_bf16(kf[5],qr[2],C1,0,0,0),   P1[6],P1[7],P1[8],P1[9],     pw2[2]=PKW(P1,4), pw2[3]=PKW(P1,6), pw2); \
    VRD(3); SBAR(); GAPA(C0=__builtin_amdgcn_mfma_f32_32x32x16_bf16(kf[6],qr[3],C0,0,0,0),   P1[10],P1[11],P1[12],P1[13], pw3[0]=PKW(P1,8), pw3[1]=PKW(P1,10), pw3); \
    VRD(7); SBAR(); GAPA(C1=__builtin_amdgcn_mfma_f32_32x32x16_bf16(kf[7],qr[3],C1,0,0,0),   P1[14],P1[15],0.f,0.f,       pw3[2]=PKW(P1,12),pw3[3]=PKW(P1,14), pw3); \
    l_reg+=sacc; \
    if(GK){DMA_K((t)+3,sl_cur);} if(GV){DMA_V((t)+1,sl_next);} \
    CMASK(C0,C1,t); \
    { float a=MX3(C0[0],C0[1],C1[0]),b=MX3(C0[2],C0[3],C1[1]); a=MX3(a,C1[2],C1[3]); \
      _Pragma("unroll") for(int r=4;r<16;r+=4){a=MX3(a,C0[r],C0[r+1]);b=MX3(b,C0[r+2],C0[r+3]);a=MX3(a,C1[r],C1[r+1]);b=MX3(b,C1[r+2],C1[r+3]);} \
      float rm=__builtin_fmaxf(a,b); { auto rr=__builtin_amdgcn_permlane32_swap(__float_as_uint(rm),__float_as_uint(rm),false,false); rm=__builtin_fmaxf(__uint_as_float(rr[0]),__uint_as_float(rr[1])); } \
      resc=false; \
      if(__builtin_expect(__any(rm>(float)THRL),0)){ const float dl=__builtin_fmaxf(rm,0.f); mhat+=dl; \
        _Pragma("unroll") for(int r=0;r<16;++r){C0[r]-=dl;C1[r]-=dl;} \
        if constexpr(!BMODE){ _Pragma("unroll") for(int r=0;r<16;++r)negm[r]=-mhat; asm volatile("":"+v"(negm)); } \
        const float f=__builtin_amdgcn_exp2f(-dl); l_reg*=f; if(hi==0)wsf[r32]=f; resc=true; } } \
    SBAR(); \
    GAPB(o[0]=__builtin_amdgcn_mfma_f32_32x32x16_bf16(PAF(0),VFR(0),o[0],0,0,0), C0,0); \
    GAPB(o[1]=__builtin_amdgcn_mfma_f32_32x32x16_bf16(PAF(0),VFR(4),o[1],0,0,0), C0,4); \
    KRD(GL,0); GAPB(o[0]=__builtin_amdgcn_mfma_f32_32x32x16_bf16(PAF(1),VFR(1),o[0],0,0,0), C0,8); \
    KRD(GL,1); GAPB(o[1]=__builtin_amdgcn_mfma_f32_32x32x16_bf16(PAF(1),VFR(5),o[1],0,0,0), C0,12); \
    KRD(GL,2); GAPB(o[0]=__builtin_amdgcn_mfma_f32_32x32x16_bf16(PAF(2),VFR(2),o[0],0,0,0), C1,0); \
    KRD(GL,3); GAPB(o[1]=__builtin_amdgcn_mfma_f32_32x32x16_bf16(PAF(2),VFR(6),o[1],0,0,0), C1,4); \
    GAPB(o[0]=__builtin_amdgcn_mfma_f32_32x32x16_bf16(PAF(3),VFR(3),o[0],0,0,0), C1,8); \
    GAPB(o[1]=__builtin_amdgcn_mfma_f32_32x32x16_bf16(PAF(3),VFR(7),o[1],0,0,0), C1,12); \
    }while(0)
  int t=1;
  for(;t+5<NT;t+=2){
    STEP(pB0,pB1,pA0,pA1,t,true,true,true);     WAIT_BAR(2); RESC(); ROT();
    STEP(pA0,pA1,pB0,pB1,t+1,true,true,true);   WAIT_BAR(2); RESC(); ROT();
  }
  #define ENDW(tt) do{ if((tt)+3<NT){WAIT_BAR(2);} else if((tt)+2<NT){WAIT_BAR(1);} else {WAIT_BAR(0);} }while(0)
  for(;t+1<NT;t+=2){
    STEP(pB0,pB1,pA0,pA1,t,(t+3<NT),(t+1<NT),(t+1<NT));       ENDW(t);   RESC(); ROT();
    STEP(pA0,pA1,pB0,pB1,t+1,(t+4<NT),(t+2<NT),(t+2<NT));     ENDW(t+1); RESC(); ROT();
  }
  STEP(pB0,pB1,pA0,pA1,NT-1,false,false,false); RESC();
  { float sacc=pB0[0]+pB0[1]; _Pragma("unroll") for(int r=2;r<16;++r)sacc+=pB0[r]; _Pragma("unroll") for(int r=0;r<16;++r)sacc+=pB1[r]; l_reg+=sacc;
    pw0=(u32x4){PKW(pB0,0),PKW(pB0,2),PKW(pB0,4),PKW(pB0,6)};pw1=(u32x4){PKW(pB0,8),PKW(pB0,10),PKW(pB0,12),PKW(pB0,14)};pw2=(u32x4){PKW(pB1,0),PKW(pB1,2),PKW(pB1,4),PKW(pB1,6)};pw3=(u32x4){PKW(pB1,8),PKW(pB1,10),PKW(pB1,12),PKW(pB1,14)};
    SBAR(); pv(o,vb0+sl_cur,PAF(0),PAF(1),PAF(2),PAF(3)); }
  #undef PKW
  #undef PAF
  #undef VFR
  #undef PIN
  #undef MX3
  #undef GAPA
  #undef GAPB
  #undef EX
  #undef VRD
  #undef KRD
  #undef STEP
  #undef ENDW
  {auto rr=__builtin_amdgcn_permlane32_swap(__float_as_uint(l_reg),__float_as_uint(l_reg),false,false);l_reg=__uint_as_float(rr[0])+__uint_as_float(rr[1]);}
  if(hi==0)wsf[32+r32]=l_reg;asm volatile("s_waitcnt lgkmcnt(0)":::"memory");
  float rli[16];
  #pragma unroll
  for(int r=0;r<16;++r)rli[r]=__builtin_amdgcn_rcpf(wsf[32+crow(r,hi)]);
  bf16*Ow=Ou+(long)(wid*QBLK)*DM;
  { bf16*stg=(bf16*)(shm+LDS_OST)+wid*2048;
    #pragma unroll
    for(int r=0;r<16;++r){const int orow=crow(r,hi);
      #pragma unroll
      for(int d0=0;d0<2;++d0)stg[orow*64+d0*32+r32]=__float2bfloat16(o[d0][r]*rli[r]);}
    asm volatile("s_waitcnt lgkmcnt(0)":::"memory");
    #pragma unroll
    for(int i=0;i<4;++i){const int row=i*8+(lane>>3),ch=lane&7; const u32x4 v=*(const u32x4*)(stg+row*64+ch*8); ATTN_STORE16(Ow+(long)row*DM+ch*8,v);} }
  asm volatile("s_waitcnt lgkmcnt(0)\n\ts_barrier":::"memory");
  #undef TILE
  #undef DMA_K
  #undef DMA_V
  #undef CMASK
  #undef START
  #undef RESC
  #undef ROT
}
constexpr int ATTN_LDS_BYTES=LDS_BT+15*BT_STRIDE*4;
#undef SBAR
#undef WAIT_BAR
}
#define XB_TMO      128
#define XB_XCNT(j)  (256  + 64 * (j))
#define XB_XSUB(j)  (1280 + 64 * (j))
#define XB_XGEN(j)  (2304 + 64 * (j))
#define XB_TOP      3328
#define XB_TOPGEN   3392
#define XCD_BAR_WORDS 3456
#define XB_SPIN_CAP (1u << 18)

__device__ __forceinline__ unsigned xb_ld(unsigned* p)              { return __hip_atomic_load(p, __ATOMIC_RELAXED, __HIP_MEMORY_SCOPE_AGENT); }
__device__ __forceinline__ unsigned xb_add(unsigned* p, unsigned v) { return __hip_atomic_fetch_add(p, v, __ATOMIC_RELAXED, __HIP_MEMORY_SCOPE_AGENT); }
__device__ __forceinline__ unsigned xb_xcc_id() { return (unsigned)__builtin_amdgcn_s_getreg((3 << 11) | 20) & 0xFu; }
#define XB_SPIN(cond, bar) do { unsigned _sp = 0; while (cond) { __builtin_amdgcn_s_sleep(1); \
    if ((++_sp & 255u) == 0u) { if (xb_ld(&(bar)[XB_TMO])) break; if (_sp > XB_SPIN_CAP) { atomicAdd(&(bar)[XB_TMO], 1u); break; } } } } while (0)

struct XcdBarrier {
    unsigned* bar; unsigned x;
    volatile LAS unsigned* st;
};

__device__ __forceinline__ XcdBarrier xcd_barrier_post(unsigned* bar, volatile LAS unsigned* st) {
    XcdBarrier b; b.bar = bar; b.x = xb_xcc_id(); b.st = st;
    if (threadIdx.x == 0) (void)xb_add(&bar[XB_XCNT(b.x)], 1u);
    return b;
}
__device__ __forceinline__ void xcd_barrier_complete(unsigned* bar, unsigned x, unsigned& nloc, unsigned& nx) {
    const unsigned G = gridDim.x * gridDim.y * gridDim.z;
    unsigned sum, cnt, mine, sp = 0u;
    for (;;) {
        sum = 0u; cnt = 0u; mine = 0u;
#pragma unroll
        for (unsigned j = 0; j < 16; ++j) { const unsigned c = xb_ld(&bar[XB_XCNT(j)]); sum += c; cnt += (c > 0u) ? 1u : 0u; mine = (j == x) ? c : mine; }
        if (sum == G) break;
        __builtin_amdgcn_s_sleep(1);
        if ((++sp & 255u) == 0u) { if (xb_ld(&bar[XB_TMO])) break; if (sp > XB_SPIN_CAP) { atomicAdd(&bar[XB_TMO], 1u); break; } }
    }
    nloc = mine > 0u ? mine : 1u; nx = cnt > 0u ? cnt : 1u;
}

__device__ __forceinline__ void xcd_barrier(const XcdBarrier& b) {
    asm volatile("s_waitcnt vmcnt(0)" ::: "memory");
    __syncthreads();
    if (threadIdx.x == 0) {
        unsigned* bar = b.bar;
        __builtin_amdgcn_s_waitcnt(0);
        unsigned nloc = b.st[0], nx = b.st[1];
        if (nloc == 0u) { xcd_barrier_complete(bar, b.x, nloc, nx); b.st[0] = nloc; b.st[1] = nx; }
        const unsigned old = xb_add(&bar[XB_XSUB(b.x)], 1u);
        const unsigned gen = old / nloc;
        if (old + 1u == (gen + 1u) * nloc) {
            __builtin_amdgcn_fence(__ATOMIC_RELEASE, "agent");
            asm volatile("s_waitcnt vmcnt(0)" ::: "memory");
            const unsigned og = xb_add(&bar[XB_TOP], 1u);
            const unsigned tg = og / nx;
            if (og + 1u == (tg + 1u) * nx) xb_add(&bar[XB_TOPGEN], 1u);
            else XB_SPIN(xb_ld(&bar[XB_TOPGEN]) == tg, bar);
            __builtin_amdgcn_fence(__ATOMIC_ACQUIRE, "agent");
            xb_add(&bar[XB_XGEN(b.x)], 1u);
            asm volatile("s_waitcnt vmcnt(0)" ::: "memory");
        } else {
            XB_SPIN(xb_ld(&bar[XB_XGEN(b.x)]) == gen, bar);
            __builtin_amdgcn_fence(__ATOMIC_ACQUIRE, "agent");
            asm volatile("s_waitcnt vmcnt(0)" ::: "memory");
        }
    }
    __syncthreads();
}

struct Frame {
    LAS unsigned char* lds;
    volatile LAS unsigned* MISC;
    unsigned* ctl;
    int tid, lane, wave, vcu, G;
    float* out; unsigned char* ws;
};
__device__ __forceinline__ const float* inp(const Frame& F, int i) {
    unsigned long long a_ = (unsigned long long)__builtin_amdgcn_kernarg_segment_ptr(); asm volatile("" : "+s"(a_));
    return (const float*)(((const __attribute__((address_space(4))) unsigned long long*)a_)[i]);
}
enum { I_X = 0, I_C, I_CTX, I_CCTX, I_WMOD, I_BMOD, I_WIN, I_GQA, I_GKA, I_GQB, I_GKB, I_RPB, I_CONVW, I_CONVB, I_GOUT, I_WOUT, I_F1, I_F3, I_F2, I_ROUTER, I_ROUTERB, I_M1, I_M3, I_M2 };

struct CvItem { const float* src; unsigned char* dst; int N, K, orow0, k0; };
__device__ __forceinline__ CvItem cv_item(const float* W, int K, int N, void* WT, int il, int half, int item) {
    const int nblk = N / 64, kb = item / nblk, nb = item % nblk, k0 = 64 * kb, n0 = 64 * nb;
    CvItem it; it.src = W + (size_t)k0 * N + n0; it.dst = (unsigned char*)WT; it.N = N; it.K = K; it.k0 = k0; it.orow0 = il ? ((n0 >> 7) * 256 + half * 128 + (n0 & 127)) : n0; return it;
}
__device__ __forceinline__ void cv_load(f32x4 (&v)[16], const CvItem& it, int lane) {
    const float* src = it.src + (size_t)(lane >> 4) * it.N + 4 * (lane & 15);
#pragma unroll
    for (int i = 0; i < 16; ++i) v[i] = __builtin_nontemporal_load((const GAS f32x4*)(src + (size_t)(4 * i) * it.N));
}
__device__ __forceinline__ void cv_to_lds(const f32x4 (&v)[16], LAS float* scr, int lane) {
#pragma unroll
    for (int i = 0; i < 16; ++i) { LAS float* d = scr + (4 * i + (lane >> 4)) * 65 + 4 * (lane & 15); d[0] = v[i].x; d[1] = v[i].y; d[2] = v[i].z; d[3] = v[i].w; }
    LDS_WAIT(); asm volatile("" ::: "memory");
}
template <bool F8> __device__ __forceinline__ void cv_finish(const CvItem& it, LAS float* scr, int lane) {
    const int c = lane & 7;
#pragma unroll
    for (int j = 0; j < 8; ++j) { const int n = (lane >> 3) + 8 * j; const LAS float* s = scr + (8 * c) * 65 + n;
        if constexpr (F8) { v2u o; o.x = pk4_f8(s[0 * 65] * 64.f, s[1 * 65] * 64.f, s[2 * 65] * 64.f, s[3 * 65] * 64.f); o.y = pk4_f8(s[4 * 65] * 64.f, s[5 * 65] * 64.f, s[6 * 65] * 64.f, s[7 * 65] * 64.f);
            __builtin_nontemporal_store(o, (GAS v2u*)(it.dst + (size_t)(it.orow0 + n) * it.K + it.k0 + 8 * c)); }
        else { v4u o; o.x = pk2(s[0 * 65], s[1 * 65]); o.y = pk2(s[2 * 65], s[3 * 65]); o.z = pk2(s[4 * 65], s[5 * 65]); o.w = pk2(s[6 * 65], s[7 * 65]);
            *(GAS v4u*)((bf16*)it.dst + (size_t)(it.orow0 + n) * it.K + it.k0 + 8 * c) = o; } }
    LDS_WAIT(); asm volatile("" ::: "memory");
}
__device__ __forceinline__ float silu_f(float v) { return v / (1.0f + __expf(-v)); }

constexpr int CV_IT_IN = 16 * 36, CV_IT_OUT = 16 * 16, CV_IT_F = 704, CV_DENSE_ITEMS = 2 * CV_IT_IN + 2 * CV_IT_OUT + 3 * CV_IT_F, CV_MOE_ITEMS = 24 * CV_IT_F;
__device__ __forceinline__ CvItem cv_dense_item(Frame& F, int r) {
    if (r < 2 * CV_IT_IN) { const int l = r / CV_IT_IN; return cv_item(inp(F, I_WIN) + (size_t)l * 1024 * INW, 1024, INW, (bf16*)(F.ws + WS_WIN) + (size_t)l * INW * 1024, 0, 0, r % CV_IT_IN); } r -= 2 * CV_IT_IN;
    if (r < 2 * CV_IT_OUT) { const int l = r / CV_IT_OUT; return cv_item(inp(F, I_WOUT) + (size_t)l * 1024 * 1024, 1024, 1024, (bf16*)(F.ws + WS_WOUT) + (size_t)l * 1024 * 1024, 0, 0, r % CV_IT_OUT); } r -= 2 * CV_IT_OUT;
    if (r < CV_IT_F) return cv_item(inp(F, I_F1), 1024, DFF, F.ws + WS_F13, 1, 0, r); r -= CV_IT_F;
    if (r < CV_IT_F) return cv_item(inp(F, I_F3), 1024, DFF, F.ws + WS_F13, 1, 1, r); r -= CV_IT_F;
    return cv_item(inp(F, I_F2), DFF, 1024, F.ws + WS_F2, 0, 0, r);
}
__device__ __forceinline__ void p0_prologue(Frame& F) {
    const int gw = F.vcu * NWAVES + F.wave, NGW = F.G * NWAVES;
    if (blockIdx.x == 0) {
        float* tab = (float*)(F.ws + WS_MISC + MS_ROPE);
        for (int idx = F.tid; idx < 1024; idx += NWAVES * 64) { const int pos = idx >> 4, i = idx & 15;
            const float inv = powf(10000.0f, -(float)(2 * i) / 32.0f); const float ang = (float)pos * inv;
            tab[2 * idx] = cosf(ang); tab[2 * idx + 1] = sinf(ang); }
    }
    {
        LAS float* sv = (LAS float*)F.lds;
        LAS float* red = (LAS float*)(F.lds + 17 * 1024 * 4);
        bool staged = false;
        for (int task = blockIdx.x; task < 192; task += F.G) {
            if (!staged) {
                for (int idx = F.tid; idx < 17 * 1024; idx += NWAVES * 64) { const int r = idx >> 10, k = idx & 1023; const float v = r < 16 ? inp(F, I_C)[r * 1024 + k] : inp(F, I_CCTX)[k]; sv[idx] = silu_f(v); }
                staged = true; __syncthreads();
            }
            const int l = task / 96, cb = task % 96, col = cb * 64 + F.lane;
            const float* W = inp(F, I_WMOD) + (size_t)l * 1024 * 6144 + col;
            float acc[17];
#pragma unroll
            for (int r = 0; r < 17; ++r) acc[r] = 0.f;
            const int kbeg = F.wave * 128;
#pragma unroll 8
            for (int k = kbeg; k < kbeg + 128; ++k) { const float wv = W[(size_t)k * 6144];
#pragma unroll
                for (int r = 0; r < 17; ++r) acc[r] += sv[r * 1024 + k] * wv; }
#pragma unroll
            for (int r = 0; r < 17; ++r) red[(F.wave * 17 + r) * 64 + F.lane] = acc[r];
            __syncthreads();
            for (int idx = F.tid; idx < 17 * 64; idx += NWAVES * 64) { const int r = idx >> 6, ln = idx & 63; float s = 0.f;
#pragma unroll
                for (int w = 0; w < 8; ++w) s += red[(w * 17 + r) * 64 + ln];
                const int n = cb * 64 + ln;
                ((float*)(F.ws + WS_MOD))[((size_t)l * 17 + r) * 6144 + n] = s + inp(F, I_BMOD)[l * 6144 + n]; }
            __syncthreads();
        }
        __syncthreads();
    }
    {
        LAS float* scr = (LAS float*)(F.lds + F.wave * 17408);
        f32x4 v[16]; int it = gw;
        if (it < CV_DENSE_ITEMS) cv_load(v, cv_dense_item(F, it), F.lane);
        while (it < CV_DENSE_ITEMS) {
            const CvItem cur = cv_dense_item(F, it); const bool f8 = it >= 2 * CV_IT_IN + 2 * CV_IT_OUT + 2 * CV_IT_F;
            cv_to_lds(v, scr, F.lane);
            it += NGW; if (it < CV_DENSE_ITEMS) cv_load(v, cv_dense_item(F, it), F.lane);
            if (f8) cv_finish<true>(cur, scr, F.lane); else cv_finish<false>(cur, scr, F.lane);
        }
    }
}
__device__ __forceinline__ CvItem cv_moe_item(Frame& F, int r) {
    constexpr int IT_F = 704;
    const int e = r / (3 * IT_F), q = r % (3 * IT_F), which = q / IT_F, item = q % IT_F;
    if (which == 0) return cv_item(inp(F, I_M1) + (size_t)e * 1024 * DFF, 1024, DFF, F.ws + WS_M13 + (size_t)e * 5632 * 1024, 1, 0, item);
    if (which == 1) return cv_item(inp(F, I_M3) + (size_t)e * 1024 * DFF, 1024, DFF, F.ws + WS_M13 + (size_t)e * 5632 * 1024, 1, 1, item);
    return cv_item(inp(F, I_M2) + (size_t)e * DFF * 1024, DFF, 1024, F.ws + WS_M2 + (size_t)e * 1024 * DFF, 0, 0, item);
}
__device__ __forceinline__ void convert_moe_weights(Frame& F, int first, int end, int step) {
    LAS float* scr = (LAS float*)(F.lds + F.wave * 17408);
    f32x4 v[16]; int it = first;
    if (it < end) cv_load(v, cv_moe_item(F, it), F.lane);
    while (it < end) {
        const CvItem cur = cv_moe_item(F, it);
        cv_to_lds(v, scr, F.lane);
        it += step; if (it < end) cv_load(v, cv_moe_item(F, it), F.lane);
        cv_finish<true>(cur, scr, F.lane);
    }
}

__device__ __forceinline__ void tail_convert(Frame& F, int nunits, int lo, int hi) {
    const int rounds = (nunits + F.G - 1) / F.G, full = nunits - (rounds - 1) * F.G, c = (int)blockIdx.x;
    if (full >= F.G) { if (MK_N_LAUNCHES != 1) convert_moe_weights(F, lo + F.vcu * NWAVES + F.wave, hi, F.G * NWAVES); else if (c == 0) {   } return; }
    if (c >= full) { __syncthreads(); convert_moe_weights(F, lo + (c - full) * NWAVES + F.wave, hi, (F.G - full) * NWAVES); }
}
constexpr int CV_S1 = 4275, CV_S2 = CV_S1 + 2565, CV_S3 = CV_S2 + 2850;

__device__ __forceinline__ const float* xrow_ptr(const float* lat, const float* ctx, int s) { const int b = s / TPB, j = s % TPB; return j < SEQ ? lat + (size_t)(b * SEQ + j) * DM : ctx + (size_t)(b * CTXL + j - SEQ) * DM; }

template <bool F8 = false> __device__ __forceinline__ void norm_mod_rows(Frame& F, const float* lat, const float* ctx, const float* mod, int shoff, int scoff, bf16* XN, bool with_ctx, bf16* XBo) {
    const int gw = F.vcu * NWAVES + F.wave, NGW = F.G * NWAVES;
    constexpr int R = 6;
    for (int s0 = gw * R; s0 < MROWS; s0 += NGW * R) {
        f32x4 v[R][4];
#pragma unroll
        for (int r = 0; r < R; ++r) { const GAS f32x4* xr = (const GAS f32x4*)xrow_ptr(lat, ctx, s0 + r) + F.lane;
#pragma unroll
            for (int q = 0; q < 4; ++q) v[r][q] = __builtin_nontemporal_load(xr + 64 * q); }
#pragma unroll
        for (int r = 0; r < R; ++r) { const int s = s0 + r, b = s / TPB, j = s % TPB;
            const float* mrow = mod + (size_t)(j < SEQ ? b : 16) * 6144;
            float ss = 0.f;
#pragma unroll
            for (int q = 0; q < 4; ++q) ss += (v[r][q].x * v[r][q].x + v[r][q].y * v[r][q].y) + (v[r][q].z * v[r][q].z + v[r][q].w * v[r][q].w);
            const float rstd = 1.0f / sqrtf(wave_sum(ss, F.lane) * (1.0f / DM) + NORM_EPS);
            GAS v2u* o8 = (GAS v2u*)(XN + (size_t)s * DM) + F.lane;
#pragma unroll
            for (int q = 0; q < 4; ++q) { const f32x4 sh = *(const f32x4*)(mrow + shoff + 4 * F.lane + 256 * q), sc = *(const f32x4*)(mrow + scoff + 4 * F.lane + 256 * q);
                const f32x4 y = v[r][q] * rstd * (sc + 1.0f) + sh;
                if constexpr (F8) ((GAS unsigned*)((unsigned char*)XN + (size_t)s * DM))[F.lane + 64 * q] = pk4_f8(y.x, y.y, y.z, y.w);
                else { v2u w; w.x = pk2(y.x, y.y); w.y = pk2(y.z, y.w); o8[64 * q] = w; }
                { v2u wx; wx.x = pk2(v[r][q].x, v[r][q].y); wx.y = pk2(v[r][q].z, v[r][q].w); ((GAS v2u*)(XBo + (size_t)s * DM) + F.lane)[64 * q] = wx; } } }
    }
}

__device__ __forceinline__ void unpack8(const v4u w, float (&v)[8]);
__device__ __forceinline__ void norm_mod_rows_bf(Frame& F, const bf16* XB, const float* mod, int shoff, int scoff, bf16* XN) {
    const int gw = F.vcu * NWAVES + F.wave, NGW = F.G * NWAVES;
    constexpr int R = 6;
    for (int s0 = gw * R; s0 < MROWS; s0 += NGW * R) {
        v4u w[R][2];
#pragma unroll
        for (int r = 0; r < R; ++r) { const GAS v4u* xr = (const GAS v4u*)(XB + (size_t)(s0 + r) * DM) + F.lane; w[r][0] = __builtin_nontemporal_load(xr); w[r][1] = __builtin_nontemporal_load(xr + 64); }
#pragma unroll
        for (int r = 0; r < R; ++r) { const int s = s0 + r, b = s / TPB, j = s % TPB;
            const float* mrow = mod + (size_t)(j < SEQ ? b : 16) * 6144;
            float v[2][8]; unpack8(w[r][0], v[0]); unpack8(w[r][1], v[1]);
            float ss = 0.f;
#pragma unroll
            for (int h = 0; h < 2; ++h)
#pragma unroll
                for (int i = 0; i < 8; ++i) ss += v[h][i] * v[h][i];
            const float rstd = 1.0f / sqrtf(wave_sum(ss, F.lane) * (1.0f / DM) + NORM_EPS);
#pragma unroll
            for (int h = 0; h < 2; ++h) { const int c0 = 512 * h + 8 * F.lane;
                const f32x4 sh0 = *(const f32x4*)(mrow + shoff + c0), sh1 = *(const f32x4*)(mrow + shoff + c0 + 4), sc0 = *(const f32x4*)(mrow + scoff + c0), sc1 = *(const f32x4*)(mrow + scoff + c0 + 4);
                float y[8];
#pragma unroll
                for (int i = 0; i < 4; ++i) { y[i] = v[h][i] * rstd * (sc0[i] + 1.0f) + sh0[i]; y[4 + i] = v[h][4 + i] * rstd * (sc1[i] + 1.0f) + sh1[i]; }
                v4u o; o.x = pk2(y[0], y[1]); o.y = pk2(y[2], y[3]); o.z = pk2(y[4], y[5]); o.w = pk2(y[6], y[7]);
                *((GAS v4u*)(XN + (size_t)s * DM + c0)) = o; } }
    }
}

__device__ __forceinline__ void headnorm_rows(Frame& F, int l, bool ctx_q) {
    const int gw = F.vcu * NWAVES + F.wave, NGW = F.G * NWAVES; bf16* P = (bf16*)(F.ws + WS_P);
    const float* tab = (const float*)(F.ws + WS_MISC + MS_ROPE);
    const int d = F.lane;
    const float gqa = inp(F, I_GQA)[l * 64 + d], gka = inp(F, I_GKA)[l * 64 + d], gqb = inp(F, I_GQB)[l * 64 + d], gkb = inp(F, I_GKB)[l * 64 + d];
    for (int s = gw; s < MROWS; s += NGW) {
        const int j = s % TPB; const bool lat = j < SEQ; bf16* p = P + (size_t)s * INW;
        float cs = 1.f, sn = 0.f;
        if (lat) { const int pos = (d < 32) ? (j >> 6) : (j & 63); const int i = d & 15; cs = tab[2 * (pos * 16 + i)]; sn = tab[2 * (pos * 16 + i) + 1]; }
        const float sgn = (d & 16) ? 1.f : -1.f;
#pragma unroll 1
        for (int h = 0; h < 18; ++h) {
            int off; float g; bool rope, isq;
            if (h < 8) { off = QA_OFF + 64 * h; g = gqa; rope = true; isq = true; }
            else if (h < 12) { off = QB_OFF + 64 * (h - 8); g = gqb; rope = false; isq = true; }
            else if (h < 14) { off = KA_OFF + 64 * (h - 12); g = gka; rope = true; isq = false; }
            else { off = KB_OFF + 64 * (h - 14); g = gkb; rope = false; isq = false; }
            if (isq && !lat && !ctx_q) continue;
            const float v = bf1(p[off + d]);
            const float ss = wave_sum(v * v, F.lane);
            float y = v * (1.0f / sqrtf(ss * (1.0f / 64.0f) + NORM_EPS)) * g;
            const float pr = xshfl(y, 16, F.lane);
            if (rope && lat) y = y * cs + sgn * pr * sn;
            if (isq) y *= C2;
            p[off + d] = (bf16)f2bf(y);
        }
    }
}

#ifdef ATTN_NAIVE
struct NaiveState { float q[64], o[64], m, l; };
__device__ __forceinline__ void na_load_q(NaiveState& S, const bf16* qp) {
#pragma unroll
    for (int c = 0; c < 8; ++c) { const v4u w = *(const v4u*)(qp + 8 * c);
        S.q[8 * c + 0] = bflo(w.x); S.q[8 * c + 1] = bfhi(w.x); S.q[8 * c + 2] = bflo(w.y); S.q[8 * c + 3] = bfhi(w.y);
        S.q[8 * c + 4] = bflo(w.z); S.q[8 * c + 5] = bfhi(w.z); S.q[8 * c + 6] = bflo(w.w); S.q[8 * c + 7] = bfhi(w.w); }
#pragma unroll
    for (int i = 0; i < 64; ++i) S.o[i] = 0.f;
    S.m = -1e30f; S.l = 0.f;
}
__device__ __forceinline__ float na_dot(const NaiveState& S, const bf16* kp) {
    float s = 0.f;
#pragma unroll
    for (int c = 0; c < 8; ++c) { const v4u w = *(const v4u*)(kp + 8 * c);
        s += S.q[8 * c + 0] * bflo(w.x) + S.q[8 * c + 1] * bfhi(w.x) + S.q[8 * c + 2] * bflo(w.y) + S.q[8 * c + 3] * bfhi(w.y)
           + S.q[8 * c + 4] * bflo(w.z) + S.q[8 * c + 5] * bfhi(w.z) + S.q[8 * c + 6] * bflo(w.w) + S.q[8 * c + 7] * bfhi(w.w); }
    return s;
}
__device__ __forceinline__ void na_acc(NaiveState& S, float p, const bf16* vp) {
#pragma unroll
    for (int c = 0; c < 8; ++c) { const v4u w = *(const v4u*)(vp + 8 * c);
        S.o[8 * c + 0] += p * bflo(w.x); S.o[8 * c + 1] += p * bfhi(w.x); S.o[8 * c + 2] += p * bflo(w.y); S.o[8 * c + 3] += p * bfhi(w.y);
        S.o[8 * c + 4] += p * bflo(w.z); S.o[8 * c + 5] += p * bfhi(w.z); S.o[8 * c + 6] += p * bflo(w.w); S.o[8 * c + 7] += p * bfhi(w.w); }
}
__device__ __forceinline__ void na_step2(NaiveState& S, float s0, float s1, const bf16* v0, const bf16* v1) {
    const float mn = fmaxf(S.m, fmaxf(s0, s1));
    const float sc = __builtin_amdgcn_exp2f(S.m - mn), p0 = __builtin_amdgcn_exp2f(s0 - mn), p1 = __builtin_amdgcn_exp2f(s1 - mn);
    S.l = S.l * sc + p0 + p1; S.m = mn;
#pragma unroll
    for (int i = 0; i < 64; ++i) S.o[i] *= sc;
    na_acc(S, p0, v0); na_acc(S, p1, v1);
}
__device__ __forceinline__ void na_store(const NaiveState& S, bf16* op) {
    const float inv = 1.0f / S.l;
#pragma unroll
    for (int c = 0; c < 8; ++c) { v4u w; w.x = pk2(S.o[8 * c + 0] * inv, S.o[8 * c + 1] * inv); w.y = pk2(S.o[8 * c + 2] * inv, S.o[8 * c + 3] * inv);
        w.z = pk2(S.o[8 * c + 4] * inv, S.o[8 * c + 5] * inv); w.w = pk2(S.o[8 * c + 6] * inv, S.o[8 * c + 7] * inv); *(v4u*)(op + 8 * c) = w; }
}
__device__ __forceinline__ void attn_naive_phase(Frame& F, int l, bool with_ctx) {
    const int gw = F.vcu * NWAVES + F.wave, NGW = F.G * NWAVES; bf16* P = (bf16*)(F.ws + WS_P);
    const float* rpb = inp(F, I_RPB) + (size_t)l * 4 * 15 * 31;
    const int ntask = with_ctx ? 6912 : 6144;
    for (int task = gw; task < ntask; task += NGW) {
        NaiveState S;
        if (task < 4096 || (task >= 6144 && task < 6656)) {
            int b, qh, j0, k0, k1;
            if (task < 4096) { b = task >> 8; qh = (task >> 5) & 7; j0 = (task & 31) * 64; k0 = 0; k1 = TPB; }
            else { const int t = task - 6144; b = t >> 5; qh = (t >> 2) & 7; j0 = SEQ + (t & 3) * 64; k0 = SEQ; k1 = TPB; }
            bf16* qp = P + (size_t)(b * TPB + j0 + F.lane) * INW + QA_OFF + qh * 64;
            na_load_q(S, qp);
            const bf16* Kb = P + (size_t)(b * TPB) * INW + KA_OFF + (qh >> 2) * 64; const bf16* Vb = P + (size_t)(b * TPB) * INW + VA_OFF + (qh >> 2) * 64;
            for (int k = k0; k < k1; k += 2) { const float s0 = na_dot(S, Kb + (size_t)k * INW), s1 = na_dot(S, Kb + (size_t)(k + 1) * INW); na_step2(S, s0, s1, Vb + (size_t)k * INW, Vb + (size_t)(k + 1) * INW); }
            na_store(S, qp);
        } else {
            int b, h, j; bool lat;
            if (task < 6144) { const int t = task - 4096; b = t >> 7; h = (t >> 5) & 3; j = (t & 31) * 64 + F.lane; lat = true; }
            else { const int t = task - 6656; b = t >> 4; h = (t >> 2) & 3; j = SEQ + (t & 3) * 64 + F.lane; lat = false; }
            bf16* qp = P + (size_t)(b * TPB + j) * INW + QB_OFF + h * 64;
            na_load_q(S, qp);
            const bf16* Kb = P + (size_t)(b * TPB) * INW + KB_OFF + h * 64; const bf16* Vb = P + (size_t)(b * TPB) * INW + VB_OFF + h * 64;
            if (lat) {
                const int r = j >> 6, c = j & 63; int rs = r - 4; rs = rs < 0 ? 0 : (rs > 24 ? 24 : rs); int cs = c - 8; cs = cs < 0 ? 0 : (cs > 48 ? 48 : cs);
                for (int i = 0; i < 8; ++i) { const int kr = rs + i; const float* brow = rpb + (h * 15 + (kr - r + 7)) * 31 + (15 - c);
                    for (int jc = 0; jc < 16; jc += 2) { const int kc = cs + jc; const int k = kr * 64 + kc;
                        const float s0 = na_dot(S, Kb + (size_t)k * INW) + brow[kc] * LOG2E, s1 = na_dot(S, Kb + (size_t)(k + 1) * INW) + brow[kc + 1] * LOG2E;
                        na_step2(S, s0, s1, Vb + (size_t)k * INW, Vb + (size_t)(k + 1) * INW); } }
            }
            for (int k = SEQ; k < TPB; k += 2) { const float s0 = na_dot(S, Kb + (size_t)k * INW), s1 = na_dot(S, Kb + (size_t)(k + 1) * INW); na_step2(S, s0, s1, Vb + (size_t)k * INW, Vb + (size_t)(k + 1) * INW); }
            na_store(S, qp);
        }
    }
}


#endif
__device__ __forceinline__ void attn_mfma_phase(Frame& F, int l, bool with_ctx, char* ldsg) {
    typedef attn_body::bf16 abf;
    abf* P = (abf*)(F.ws + WS_P); const int v = F.vcu;
    const int NA = 1024 + (with_ctx ? 192 : 0);
#pragma unroll 1
    for (int u = v; u < NA; u += F.G) {
        int b, qcol, kcol, vcol, qrow, NT, first0;
        if (u < 1024) { b = u >> 6; const int kvh = (u >> 5) & 1, qh = kvh * 4 + ((u >> 3) & 3); qrow = (u & 7) * 256; qcol = QA_OFF + qh * 64; kcol = KA_OFF + kvh * 64; vcol = VA_OFF + kvh * 64; NT = 36; first0 = 0; }
        else if (u < 1024 + 128) { const int t = u - 1024; b = t >> 3; const int qh = t & 7; qrow = SEQ; qcol = QA_OFF + qh * 64; kcol = KA_OFF + (qh >> 2) * 64; vcol = VA_OFF + (qh >> 2) * 64; NT = 4; first0 = 32; }
        else { const int t = u - 1152; b = t >> 2; const int h = t & 3; qrow = SEQ; qcol = QB_OFF + h * 64; kcol = KB_OFF + h * 64; vcol = VB_OFF + h * 64; NT = 4; first0 = 32; }
        abf* Qu = P + (size_t)(b * TPB + qrow) * INW + qcol; const abf* Kh = P + (size_t)(b * TPB) * INW + kcol; const abf* Vh = P + (size_t)(b * TPB) * INW + vcol;
        attn_body::attn_unit<8, false>(Qu, Kh, Vh, Qu, NT, NT, first0, 0, 0, nullptr, ldsg, F.wave);
    }
#ifndef NO_BSITE
    const float* rpbl = inp(F, I_RPB) + (size_t)l * 4 * 15 * 31;
#pragma unroll 1
    for (int u = v; u < 512; u += F.G) {
        const int b = u >> 5, h = (u >> 3) & 3, qb = u & 7, qg = 4 * qb;
        const int n0 = (qb == 0 || qb == 7) ? 8 : 12, s0 = qb == 0 ? 0 : (qb == 7 ? 24 : qg - 4);
        abf* Qu = P + (size_t)(b * TPB + qb * 256) * INW + QB_OFF + h * 64; const abf* Kh = P + (size_t)(b * TPB) * INW + KB_OFF + h * 64; const abf* Vh = P + (size_t)(b * TPB) * INW + VB_OFF + h * 64;
        attn_body::attn_unit<8, true>(Qu, Kh, Vh, Qu, 4 + n0, 4, 32, s0, qg, rpbl + h * 15 * 31, ldsg, F.wave);
    }
#endif
}

__device__ __forceinline__ void unpack8(const v4u w, float (&v)[8]) { v[0] = bflo(w.x); v[1] = bfhi(w.x); v[2] = bflo(w.y); v[3] = bfhi(w.y); v[4] = bflo(w.z); v[5] = bfhi(w.z); v[6] = bflo(w.w); v[7] = bfhi(w.w); }
__device__ __forceinline__ void merge_rows(Frame& F, int l, bool with_ctx) {
    const int gw = F.vcu * NWAVES + F.wave, NGW = F.G * NWAVES; const bf16* P = (const bf16*)(F.ws + WS_P); bf16* CAT = (bf16*)(F.ws + WS_XN);
    const float* gout = inp(F, I_GOUT) + l * 1024; const float* cw = inp(F, I_CONVW) + l * 3 * 256; const float* cb = inp(F, I_CONVB) + l * 256;
    const int lane = F.lane; const bool cl = lane >= 32; const int ch0 = 8 * (lane & 31);
    constexpr int R = 2;
    for (int s0 = gw * R; s0 < MROWS; s0 += NGW * R) {
        if (!with_ctx && (s0 % TPB) >= SEQ) continue;
        v4u la[R], lb[R], lt[R][6]; bool tv[R][3];
#pragma unroll
        for (int r = 0; r < R; ++r) { const int s = s0 + r, j = s % TPB; const bool lat = j < SEQ; const bf16* p = P + (size_t)s * INW;
            la[r] = *(const v4u*)(p + 8 * lane);
            lb[r] = *(const v4u*)(p + (cl ? CPOST_OFF + ch0 : 512 + 8 * lane));
            const int jlo = lat ? 0 : SEQ, jhi = lat ? SEQ : TPB;
#pragma unroll
            for (int tap = 0; tap < 3; ++tap) { const int jj = j + tap - 1; tv[r][tap] = cl && jj >= jlo && jj < jhi;
                if (tv[r][tap]) { const bf16* pp = p + (ptrdiff_t)(tap - 1) * INW; lt[r][2 * tap] = *(const v4u*)(pp + CPRE_OFF + ch0); lt[r][2 * tap + 1] = *(const v4u*)(pp + CVAL_OFF + ch0); }
                else { lt[r][2 * tap] = (v4u){0u, 0u, 0u, 0u}; lt[r][2 * tap + 1] = (v4u){0u, 0u, 0u, 0u}; } } }
#pragma unroll
        for (int r = 0; r < R; ++r) { const int s = s0 + r;
            float va[8], vb[8];
            unpack8(la[r], va); unpack8(lb[r], vb);
            if (cl) { float y[8];
#pragma unroll
                for (int k = 0; k < 8; ++k) y[k] = cb[ch0 + k];
#pragma unroll
                for (int tap = 0; tap < 3; ++tap) { float a[8], c[8]; unpack8(lt[r][2 * tap], a); unpack8(lt[r][2 * tap + 1], c);
#pragma unroll
                    for (int k = 0; k < 8; ++k) y[k] += cw[tap * 256 + ch0 + k] * (a[k] * c[k]); }
#pragma unroll
                for (int k = 0; k < 8; ++k) vb[k] = vb[k] * y[k]; }
            float sa = 0.f, sb = 0.f;
#pragma unroll
            for (int k = 0; k < 8; ++k) { sa += va[k] * va[k]; sb += vb[k] * vb[k]; }
            const float ra = 1.0f / sqrtf(wave_sum(sa, lane) * (1.0f / 512.0f) + NORM_EPS), rb = 1.0f / sqrtf(half_sum(sb, lane) * (1.0f / 256.0f) + NORM_EPS);
            v4u oa, ob; float g[8];
#pragma unroll
            for (int k = 0; k < 8; ++k) g[k] = gout[8 * lane + k];
            oa.x = pk2(va[0] * ra * g[0], va[1] * ra * g[1]); oa.y = pk2(va[2] * ra * g[2], va[3] * ra * g[3]); oa.z = pk2(va[4] * ra * g[4], va[5] * ra * g[5]); oa.w = pk2(va[6] * ra * g[6], va[7] * ra * g[7]);
#pragma unroll
            for (int k = 0; k < 8; ++k) g[k] = gout[512 + 8 * lane + k];
            ob.x = pk2(vb[0] * rb * g[0], vb[1] * rb * g[1]); ob.y = pk2(vb[2] * rb * g[2], vb[3] * rb * g[3]); ob.z = pk2(vb[4] * rb * g[4], vb[5] * rb * g[5]); ob.w = pk2(vb[6] * rb * g[6], vb[7] * rb * g[7]);
            *(v4u*)(CAT + (size_t)s * DM + 8 * lane) = oa; *(v4u*)(CAT + (size_t)s * DM + 512 + 8 * lane) = ob; }
    }
}

__device__ __forceinline__ void moe_route(Frame& F, const float* mod) {
    const bf16* XB = (const bf16*)(F.ws + WS_XB); unsigned char* XT = F.ws + WS_XT8;
    int* tok_e = (int*)(F.ws + WS_MISC + MS_TOKE); float* tok_g = (float*)(F.ws + WS_MISC + MS_TOKG);
    const float* wr = inp(F, I_ROUTER); const float* br = inp(F, I_ROUTERB);
    LAS int* le = (LAS int*)F.lds;
    LAS int* lcnt = le + 256;
    LAS f32x4* wl = (LAS f32x4*)(F.lds + 2048);
    for (int idx = F.tid; idx < 2048; idx += NWAVES * 64) { const int ln = idx & 63, hf = (idx >> 6) & 1, kk = (idx >> 7) & 7, hh = idx >> 10; wl[idx] = *(const f32x4*)(wr + (size_t)(512 * hh + 8 * ln + kk) * 8 + 4 * hf); }
    __syncthreads();
    for (int ch = blockIdx.x; ch < NTOK / 128; ch += F.G) {
        const int bch = (ch * 128) / SEQ; const float* mrow = mod + (size_t)bch * 6144;
        f32x4 shv[2][2], scv[2][2];
#pragma unroll
        for (int h = 0; h < 2; ++h)
#pragma unroll
            for (int q = 0; q < 2; ++q) { shv[h][q] = *(const f32x4*)(mrow + 3072 + 512 * h + 8 * F.lane + 4 * q); scv[h][q] = *(const f32x4*)(mrow + 4096 + 512 * h + 8 * F.lane + 4 * q) + 1.0f; }
        const int tok0 = ch * 128 + F.wave * 16; const GAS v4u* xr0 = (const GAS v4u*)(XB + (size_t)(bch * TPB + (tok0 - bch * SEQ)) * DM) + F.lane;
        v4u nw[2][2];
#pragma unroll
        for (int r = 0; r < 2; ++r) { nw[r][0] = __builtin_nontemporal_load(xr0 + 128 * r); nw[r][1] = __builtin_nontemporal_load(xr0 + 128 * r + 64); }
#pragma unroll 1
        for (int i = 0; i < 16; i += 2) {
            float v[2][2][8];
#pragma unroll
            for (int r = 0; r < 2; ++r) { unpack8(nw[r][0], v[r][0]); unpack8(nw[r][1], v[r][1]); }
            if (i + 2 < 16) {
#pragma unroll
                for (int r = 0; r < 2; ++r) { nw[r][0] = __builtin_nontemporal_load(xr0 + 128 * (i + 2 + r)); nw[r][1] = __builtin_nontemporal_load(xr0 + 128 * (i + 2 + r) + 64); } }
            float ss[2] = {0.f, 0.f};
#pragma unroll
            for (int r = 0; r < 2; ++r)
#pragma unroll
                for (int h = 0; h < 2; ++h)
#pragma unroll
                    for (int q = 0; q < 8; ++q) ss[r] += v[r][h][q] * v[r][h][q];
            { const int ln = F.lane;
#pragma unroll
              for (int o = 1; o < 64; o <<= 1) { const float a0 = xshfl(ss[0], o, ln), a1 = xshfl(ss[1], o, ln); ss[0] += a0; ss[1] += a1; } }
            float rstd[2];
#pragma unroll
            for (int r = 0; r < 2; ++r) rstd[r] = 1.0f / sqrtf(ss[r] * (1.0f / DM) + NORM_EPS);
            float lg[2][8]; v2u ow[2][2];
#pragma unroll
            for (int r = 0; r < 2; ++r)
#pragma unroll
                for (int e = 0; e < 8; ++e) lg[r][e] = 0.f;
#pragma unroll
            for (int h = 0; h < 2; ++h) {
                float y[2][8];
#pragma unroll
                for (int r = 0; r < 2; ++r) {
#pragma unroll
                    for (int q = 0; q < 4; ++q) { y[r][q] = v[r][h][q] * rstd[r] * scv[h][0][q] + shv[h][0][q]; y[r][4 + q] = v[r][h][4 + q] * rstd[r] * scv[h][1][q] + shv[h][1][q]; }
                    ow[r][h].x = pk4_f8(y[r][0], y[r][1], y[r][2], y[r][3]); ow[r][h].y = pk4_f8(y[r][4], y[r][5], y[r][6], y[r][7]); }
#pragma unroll
                for (int q = 0; q < 8; ++q) { const f32x4 wa = wl[((h * 8 + q) * 2 + 0) * 64 + F.lane], wb = wl[((h * 8 + q) * 2 + 1) * 64 + F.lane];
#pragma unroll
                    for (int r = 0; r < 2; ++r) { const float yk = y[r][q];
                        lg[r][0] += yk * wa.x; lg[r][1] += yk * wa.y; lg[r][2] += yk * wa.z; lg[r][3] += yk * wa.w; lg[r][4] += yk * wb.x; lg[r][5] += yk * wb.y; lg[r][6] += yk * wb.z; lg[r][7] += yk * wb.w; } } }
            { const int ln = F.lane; float t4[2][4], t2[2][2], t1[2];
#pragma unroll
              for (int e = 0; e < 4; ++e)
#pragma unroll
                  for (int r = 0; r < 2; ++r) { const float keep = (ln & 32) ? lg[r][e + 4] : lg[r][e], give = (ln & 32) ? lg[r][e] : lg[r][e + 4]; t4[r][e] = keep + xshfl(give, 32, ln); }
#pragma unroll
              for (int e = 0; e < 2; ++e)
#pragma unroll
                  for (int r = 0; r < 2; ++r) { const float keep = (ln & 16) ? t4[r][e + 2] : t4[r][e], give = (ln & 16) ? t4[r][e] : t4[r][e + 2]; t2[r][e] = keep + xshfl(give, 16, ln); }
#pragma unroll
              for (int r = 0; r < 2; ++r) { const float keep = (ln & 8) ? t2[r][1] : t2[r][0], give = (ln & 8) ? t2[r][0] : t2[r][1]; t1[r] = keep + xshfl(give, 8, ln); }
#pragma unroll
              for (int o = 4; o >= 1; o >>= 1) { const float a0 = xshfl(t1[0], o, ln), a1 = xshfl(t1[1], o, ln); t1[0] += a0; t1[1] += a1; }
#pragma unroll
              for (int r = 0; r < 2; ++r)
#pragma unroll
                  for (int e = 0; e < 8; ++e) lg[r][e] = __int_as_float(__builtin_amdgcn_readlane(__float_as_int(t1[r]), 8 * e)) + br[e]; }
#pragma unroll
            for (int r = 0; r < 2; ++r) { const int tl = F.wave * 16 + i + r, tok = ch * 128 + tl;
                int e0 = 0; float v0 = lg[r][0];
#pragma unroll
                for (int e = 1; e < 8; ++e) if (lg[r][e] > v0) { v0 = lg[r][e]; e0 = e; }
                int e1 = -1; float v1 = -3.0e38f;
#pragma unroll
                for (int e = 0; e < 8; ++e) if (e != e0 && lg[r][e] > v1) { v1 = lg[r][e]; e1 = e; }
                const float p1 = __expf(v1 - v0), g0 = 1.0f / (1.0f + p1), g1 = p1 / (1.0f + p1);
#pragma unroll
                for (int h = 0; h < 2; ++h) *((GAS v2u*)(XT + (size_t)tok * DM + 512 * h + 8 * F.lane)) = ow[r][h];
                if (F.lane == 0) { tok_e[2 * tok] = e0; tok_e[2 * tok + 1] = e1; tok_g[2 * tok] = g0; tok_g[2 * tok + 1] = g1; le[2 * tl] = e0; le[2 * tl + 1] = e1; } }
        }
        __syncthreads();
        if (F.tid < 256) { const int e = le[F.tid];
#pragma unroll
            for (int ee = 0; ee < 8; ++ee) { const unsigned long long m = __ballot(e == ee); if (F.lane == 0) lcnt[F.wave * 8 + ee] = __popcll(m); } }
        __syncthreads();
        if (F.tid < 8) F.ctl[CW_CNT + ch * 8 + F.tid] = (unsigned)(lcnt[F.tid] + lcnt[8 + F.tid] + lcnt[16 + F.tid] + lcnt[24 + F.tid]);
        __syncthreads();
    }
}
__device__ __forceinline__ void moe_sort_scatter(Frame& F) {
    const unsigned char* XT = F.ws + WS_XT8; unsigned char* XS = F.ws + WS_XS8;
    const int* tok_e = (const int*)(F.ws + WS_MISC + MS_TOKE); const float* tok_g = (const float*)(F.ws + WS_MISC + MS_TOKG);
    int* tok_s = (int*)(F.ws + WS_MISC + MS_TOKS); float* slot_g = (float*)(F.ws + WS_MISC + MS_SLOTG); int* meta = (int*)(F.ws + WS_MISC + MS_META);
    LAS int* ltot = (LAS int*)F.lds; LAS int* lpre = ltot + 8; LAS int* lps = ltot + 16; LAS int* wcnt = ltot + 32; LAS int* lslot = ltot + 64; LAS int* lacc = ltot + 320;
    for (int ch = blockIdx.x; ch < NTOK / 128; ch += F.G) {
        if (F.tid < 64) lacc[F.tid] = 0;
        __syncthreads();
        int myexp = 0;
        if (F.tid < 256) {
            const v4u c0 = *(const GAS v4u*)(F.ctl + CW_CNT + F.tid * 8), c1 = *(const GAS v4u*)(F.ctl + CW_CNT + F.tid * 8 + 4);
            const unsigned cn[8] = {c0.x, c0.y, c0.z, c0.w, c1.x, c1.y, c1.z, c1.w};
#pragma unroll
            for (int e = 0; e < 8; ++e) { __hip_atomic_fetch_add(lacc + F.wave * 16 + e, (int)cn[e], __ATOMIC_RELAXED, __HIP_MEMORY_SCOPE_WORKGROUP); if (F.tid < ch) __hip_atomic_fetch_add(lacc + F.wave * 16 + 8 + e, (int)cn[e], __ATOMIC_RELAXED, __HIP_MEMORY_SCOPE_WORKGROUP); }
            myexp = tok_e[2 * (ch * 128) + F.tid];
        }
        __syncthreads();
        if (F.tid < 16) ltot[F.tid] = lacc[F.tid] + lacc[16 + F.tid] + lacc[32 + F.tid] + lacc[48 + F.tid];
        __syncthreads();
        if (F.tid == 0) { int p = 0;
#pragma unroll
            for (int e = 0; e < 8; ++e) { lps[e] = p; p += (ltot[e] + 255) & ~255; } lps[8] = p; }
        int myrank = 0;
        if (F.tid < 256) {
#pragma unroll
            for (int ee = 0; ee < 8; ++ee) { const unsigned long long m = __ballot(myexp == ee); if (myexp == ee) myrank = __popcll(m & ((1ull << F.lane) - 1ull)); if (F.lane == 0) wcnt[F.wave * 8 + ee] = __popcll(m); } }
        __syncthreads();
        if (F.tid < 256) { int base = lps[myexp] + lpre[myexp] + myrank;
            for (int w = 0; w < F.wave; ++w) base += wcnt[w * 8 + myexp];
            lslot[F.tid] = base; tok_s[2 * (ch * 128) + F.tid] = base; slot_g[base] = tok_g[2 * (ch * 128) + F.tid]; }
        __syncthreads();
#pragma unroll 1
        for (int a0 = F.wave; a0 < 256; a0 += 8 * NWAVES) {
            v4u r[8];
#pragma unroll
            for (int j = 0; j < 8; ++j) { const int a = a0 + j * NWAVES; r[j] = *((const GAS v4u*)(XT + (size_t)(ch * 128 + (a >> 1)) * DM) + F.lane); }
#pragma unroll
            for (int j = 0; j < 8; ++j) { const int a = a0 + j * NWAVES; *((GAS v4u*)(XS + (size_t)lslot[a] * DM) + F.lane) = r[j]; } }
        if (ch < 8) {
            const int p0 = lps[ch] + ltot[ch], p1 = lps[ch + 1];
            for (int r = p0 + F.wave; r < p1; r += NWAVES) { GAS v4u* dst = (GAS v4u*)(XS + (size_t)r * DM) + F.lane; dst[0] = (v4u){0u, 0u, 0u, 0u}; if (F.lane == 0) slot_g[r] = 0.f; }
        }
        if (ch == 0 && F.tid < 8) meta[F.tid] = lps[F.tid + 1] >> 8;
        __syncthreads();
    }
}
__device__ __forceinline__ void moe_combine(Frame& F, const float* mod, int mode, int slot_lim, int gw, int NGW) { const bf16* Y = (const bf16*)(F.ws + WS_XN); const bf16* XB = (const bf16*)(F.ws + WS_XB); const int* tok_s = (const int*)(F.ws + WS_MISC + MS_TOKS);
    constexpr int R = 4;
    for (int t0 = gw * R; t0 < NTOK; t0 += NGW * R) {
        v4u wx[R][2], wa[R][2], wc[R][2]; bool ok[R]; int sl0[R], sl1[R]; bool any = false;
#pragma unroll
        for (int r = 0; r < R; ++r) { sl0[r] = tok_s[2 * (t0 + r)]; sl1[r] = tok_s[2 * (t0 + r) + 1]; ok[r] = ((sl0[r] < slot_lim && sl1[r] < slot_lim) ? 0 : 1) == mode; any = any || ok[r]; }
        if (!any) continue;
#pragma unroll
        for (int r = 0; r < R; ++r) { const int tok = t0 + r, b = tok / SEQ, s = b * TPB + (tok - b * SEQ), s0 = sl0[r], s1 = sl1[r];
            const GAS v4u* xr = (const GAS v4u*)(XB + (size_t)s * DM) + F.lane; const GAS v4u* y0 = (const GAS v4u*)(Y + (size_t)s0 * DM) + F.lane; const GAS v4u* y1 = (const GAS v4u*)(Y + (size_t)s1 * DM) + F.lane;
#pragma unroll
            for (int h = 0; h < 2; ++h) { wx[r][h] = __builtin_nontemporal_load(xr + 64 * h); wa[r][h] = __builtin_nontemporal_load(y0 + 64 * h); wc[r][h] = __builtin_nontemporal_load(y1 + 64 * h); } }
#pragma unroll
        for (int r = 0; r < R; ++r) { const int tok = t0 + r, b = tok / SEQ; const float* g = mod + (size_t)b * 6144 + 5120; float* orow = F.out + (size_t)tok * DM;
#pragma unroll
            for (int h = 0; h < 2; ++h) { float x[8], a[8], c[8]; unpack8(wx[r][h], x); unpack8(wa[r][h], a); unpack8(wc[r][h], c);
                const int c0 = 512 * h + 8 * F.lane; const f32x4 g0 = *(const f32x4*)(g + c0), g1 = *(const f32x4*)(g + c0 + 4);
                f32x4 o0, o1;
#pragma unroll
                for (int i = 0; i < 4; ++i) { o0[i] = x[i] + g0[i] * (a[i] + c[i]); o1[i] = x[4 + i] + g1[i] * (a[4 + i] + c[4 + i]); }
                if (ok[r]) { __builtin_nontemporal_store(o0, (GAS f32x4*)(orow + c0)); __builtin_nontemporal_store(o1, (GAS f32x4*)(orow + c0 + 4)); } } }
    }
}

struct Args { const float* in[24]; float* out; unsigned char* ws; int ph_lo, ph_hi, li, pad; };
__global__ void __launch_bounds__(NWAVES * 64, 2) mk_fwd(Args args) {
    extern __shared__ __attribute__((aligned(16))) unsigned char lds[];
    Frame F;
    F.lds = (LAS unsigned char*)lds; F.MISC = (volatile LAS unsigned*)(F.lds + MISC_OFF);
    F.tid = threadIdx.x; F.lane = F.tid & 63; F.wave = __builtin_amdgcn_readfirstlane(F.tid >> 6);
    F.G = gridDim.x; { const int bx = blockIdx.x; F.vcu = (F.G % 8 == 0) ? (bx % 8) * (F.G / 8) + bx / 8 : bx; }
    F.out = args.out; F.ws = args.ws; F.ctl = (unsigned*)(args.ws + WS_CTL);
    for (int u = F.tid; u < (LDS_BYTES - LDSCTL_OFF) / 4; u += NWAVES * 64) ((LAS unsigned*)(F.lds + LDSCTL_OFF))[u] = 0u;
    __syncthreads();
    if (F.tid < 24) { const unsigned long long p = (unsigned long long)args.in[F.tid]; LAS unsigned* t = (LAS unsigned*)(F.lds + LDSCTL_OFF + 64) + 2 * F.tid; t[0] = (unsigned)p; t[1] = (unsigned)(p >> 32); }
    __syncthreads();
    XcdBarrier bar; bar.bar = F.ctl + CW_BAR; bar.x = 0; bar.st = nullptr;
    if (MK_N_LAUNCHES == 1) bar = xcd_barrier_post(F.ctl + CW_BAR, F.MISC + 8);
    const int lo = args.ph_lo, hi = args.ph_hi;
#ifndef PHMASK
#define PHMASK 0xFFFFFFFFu
#endif
#define PHON(k) (((PHMASK) >> (k)) & 1u)
#define IN(k) (PHON(k) && lo <= (k) && (k) < hi)
#define INL(x) ((((PHMASK) >> (1 + (x))) & 1u) && lo <= pb + (x) && pb + (x) < hi)
#define INR(k) (lo <= (k) && (k) < hi)
#ifdef PROF_MASK
    if (F.tid == 0) { F.MISC[16] = (unsigned)__builtin_amdgcn_s_memrealtime(); F.MISC[17] = 0u; }
#define STAMP(k) do { if (F.wave == 0 && __builtin_amdgcn_mbcnt_hi(~0u, __builtin_amdgcn_mbcnt_lo(~0u, 0u)) == 0u) { const unsigned now_ = (unsigned)__builtin_amdgcn_s_memrealtime(); if (((unsigned)(PROF_MASK) >> (k)) & 1u) F.MISC[17] = F.MISC[17] + (now_ - F.MISC[16]); F.MISC[16] = now_; } } while (0)
#else
#define STAMP(k) do { } while (0)
#endif
#define SEAM(k) do { if (INR(k) && INR((k) + 1)) xcd_barrier(bar); STAMP(k); } while (0)
    bf16* XB = (bf16*)(F.ws + WS_XB); bf16* XN = (bf16*)(F.ws + WS_XN); bf16* P = (bf16*)(F.ws + WS_P);
    const float* MOD = (const float*)(F.ws + WS_MOD);
#define TABMEM (F.lds + LDSCTL_OFF + 448)
#define PF() do { int ln_ = (int)__builtin_amdgcn_mbcnt_hi(~0u, __builtin_amdgcn_mbcnt_lo(~0u, 0u)); asm volatile("" : "+v"(ln_)); F.lane = ln_; F.tid = F.wave * 64 + ln_; } while (0)

    if (IN(0)) { PF(); p0_prologue(F); } SEAM(0);

#pragma unroll 1
    for (int l = 0; l < 2; ++l) {
        const int pb = 1 + 9 * l; const bool last = (l == 1);
        const float* mod = MOD + (size_t)l * 17 * 6144;
        const float* xlat = inp(F, I_X); const float* xctx = inp(F, I_CTX);
        if (INL(0)) { PF(); if (!last) norm_mod_rows(F, xlat, xctx, mod, 0, 1024, XN, true, XB); else norm_mod_rows_bf(F, XB, mod, 0, 1024, XN); } SEAM(pb + 0);
        if (INL(1)) { PF();
            pg8::Gemm g{XN, (const bf16*)(F.ws + WS_WIN) + (size_t)l * INW * 1024, MROWS, INW, 1024};
            const pg8::TabOrder T = last ? pg8::build_units(TABMEM, 1024, XN, g.Bt, F.G, (int)blockIdx.x, 128, 9, 0, 1, 0, 16, 3, 6, 2, nullptr, 0, F.tid)
                                         : pg8::build_units(TABMEM, 1024, XN, g.Bt, F.G, (int)blockIdx.x, NPAN, 9, 0, 0, 0, 0, 1, 0, 0, nullptr, 0, F.tid);
#ifdef SEPARATE_HN
            pg8::EpiRawBf16 E{P, INW};
            pg8::gemm_phase<pg8::EpiRawBf16, pg8::TabOrder, true, true>(F.lds, g, T, E, F.wave);
#else
            { const float* tg = (const float*)(F.ws + WS_MISC + MS_ROPE); LAS float* tl = (LAS float*)(F.lds + 131072);
              for (int i = F.tid; i < 2048; i += NWAVES * 64) tl[i] = tg[i];
              if (F.tid < 256) { const int w = F.tid >> 6, d = F.tid & 63; const float* gs = w == 0 ? inp(F, I_GQA) : (w == 1 ? inp(F, I_GKA) : (w == 2 ? inp(F, I_GQB) : inp(F, I_GKB))); ((LAS float*)(F.lds + LDSCTL_OFF + 2048))[F.tid] = gs[l * 64 + d]; } }
            pg8::EpiHeads E{P, (const LAS float*)(F.lds + LDSCTL_OFF + 2048), (const LAS float*)(F.lds + 131072)};
            pg8::gemm_phase<pg8::EpiHeads, pg8::TabOrder, true, true>(F.lds, g, T, E, F.wave);
#endif
            if (!last) tail_convert(F, NPAN * 9, 0, CV_S1);
        } SEAM(pb + 1);
#ifdef SEPARATE_HN
        if (INL(2)) { PF(); headnorm_rows(F, l, !last); } SEAM(pb + 2);
#endif
        #ifdef ATTN_NAIVE
        if (INL(3)) { PF(); attn_naive_phase(F, l, !last); } SEAM(pb + 3);
#else
        if (INL(3)) { PF(); attn_mfma_phase(F, l, !last, (char*)lds); } SEAM(pb + 3);
#endif
        if (INL(4)) { PF(); merge_rows(F, l, !last); } SEAM(pb + 4);
        if (INL(5)) { PF();
            pg8::Gemm g{XN, (const bf16*)(F.ws + WS_WOUT) + (size_t)l * 1024 * 1024, MROWS, 1024, 1024};
            const pg8::TabOrder T = pg8::build_units(TABMEM, 1024, XN, g.Bt, F.G, (int)blockIdx.x, last ? 128 : NPAN, 4, 0, last ? 1 : 0, 0, 0, 1, 0, 0, nullptr, 0, F.tid);
            pg8::EpiGateRes E{XB, mod, 2048, 1.0f};
            pg8::gemm_phase<pg8::EpiGateRes, pg8::TabOrder, true, true>(F.lds, g, T, E, F.wave);
            if (!last) tail_convert(F, NPAN * 4, CV_S1, CV_S2);
        } SEAM(pb + 5);
        if (!last) {
            if (IN(7)) { PF(); norm_mod_rows_bf(F, XB, mod, 3072, 4096, XN); } SEAM(7);
            if (IN(8)) { PF();
                pg8::Gemm g{XN, (const bf16*)(F.ws + WS_F13), MROWS, 5632, 1024};
                const pg8::TabOrder T = pg8::build_units(TABMEM, 1024, XN, g.Bt, F.G, (int)blockIdx.x, NPAN, 22, 0, 0, 0, 0, 1, 0, 0, nullptr, 0, F.tid);
                pg8::EpiSwigluF8 E{(unsigned char*)P, DFF, 1.0f};
                pg8::gemm_phase<pg8::EpiSwigluF8, pg8::TabOrder, true, true>(F.lds, g, T, E, F.wave);
                tail_convert(F, NPAN * 22, CV_S2, CV_S3);
            } SEAM(8);
            if (IN(9)) { PF();
                pg8::Gemm g{P, (const bf16*)(F.ws + WS_F2), MROWS, 1024, DFF / 2};
                const pg8::TabOrder T = pg8::build_units(TABMEM, DFF / 2, P, g.Bt, F.G, (int)blockIdx.x, NPAN, 4, 0, 0, 0, 0, 1, 0, 0, nullptr, 0, F.tid);
                pg8::EpiGateRes E{XB, mod, 5120, 1.0f / 64.0f};
                pg8::gemm_phase<pg8::EpiGateRes, pg8::TabOrder, true, true, true>(F.lds, g, T, E, F.wave);
                tail_convert(F, NPAN * 4, CV_S3, CV_MOE_ITEMS);
            } SEAM(9);
        }
    }
    {
        const float* mod = MOD + (size_t)17 * 6144;
        if (IN(16)) { PF(); moe_route(F, mod); } SEAM(16);
        if (IN(17)) { PF(); moe_sort_scatter(F); } SEAM(17);
        const int* meta = (const int*)(F.ws + WS_MISC + MS_META);
        if (IN(18)) { PF();
            const int TP = __builtin_amdgcn_readfirstlane(meta[7]);
            pg8::Gemm g{(const bf16*)(F.ws + WS_XS8), (const bf16*)(F.ws + WS_M13), 0, 5632, 512};
            const pg8::TabOrder T = pg8::build_units(TABMEM, 512, g.A, g.Bt, F.G, (int)blockIdx.x, TP, 22, 0, 0, 0, 0, 1, 0, 0, meta, (size_t)5632 * 1024, F.tid);
            pg8::EpiSwigluF8 E{F.ws + WS_H8, DFF, 1.0f / 64.0f};
            pg8::gemm_phase<pg8::EpiSwigluF8, pg8::TabOrder, true, true, true>(F.lds, g, T, E, F.wave);
        } SEAM(18);
        if (IN(19)) { PF();
            const int TP = __builtin_amdgcn_readfirstlane(meta[7]), npa = TP < 256 ? TP : 256;
            pg8::Gemm g{(const bf16*)(F.ws + WS_H8), (const bf16*)(F.ws + WS_M2), 0, 1024, DFF / 2};
            const pg8::TabOrder T = pg8::build_units(TABMEM, DFF / 2, g.A, g.Bt, F.G, (int)blockIdx.x, npa, 4, 0, 0, 0, 0, 1, 0, 0, meta, (size_t)1024 * DFF, F.tid);
            pg8::EpiMoeOut E{XN, (const float*)(F.ws + WS_MISC + MS_SLOTG), 1.0f / 64.0f};
            pg8::gemm_phase<pg8::EpiMoeOut, pg8::TabOrder, true, true, true>(F.lds, g, T, E, F.wave);
        } SEAM(19);
        if (IN(20)) { PF();
            const int TP = __builtin_amdgcn_readfirstlane(meta[7]), npa = TP < 256 ? TP : 256, npb = TP - npa, n1 = npb * 4;
            if (n1 > 0 && n1 < F.G) {
                pg8::Gemm g{(const bf16*)(F.ws + WS_H8), (const bf16*)(F.ws + WS_M2), 0, 1024, DFF / 2};
                const pg8::TabOrder T = pg8::build_units(TABMEM, DFF / 2, g.A, g.Bt, F.G, (int)blockIdx.x, npb, 4, 0, 0, 256, 0, 1, 0, 0, meta, (size_t)1024 * DFF, F.tid);
                pg8::EpiMoeOut E{XN, (const float*)(F.ws + WS_MISC + MS_SLOTG), 1.0f / 64.0f};
                pg8::gemm_phase<pg8::EpiMoeOut, pg8::TabOrder, true, true, true>(F.lds, g, T, E, F.wave);
                if ((int)blockIdx.x >= n1) moe_combine(F, mod, 0, npa * 256, ((int)blockIdx.x - n1) * NWAVES + F.wave, (F.G - n1) * NWAVES);
            } else if (n1 == 0) moe_combine(F, mod, 0, npa * 256, F.vcu * NWAVES + F.wave, F.G * NWAVES);
            else {
                pg8::Gemm g{(const bf16*)(F.ws + WS_H8), (const bf16*)(F.ws + WS_M2), 0, 1024, DFF / 2};
                const pg8::TabOrder T = pg8::build_units(TABMEM, DFF / 2, g.A, g.Bt, F.G, (int)blockIdx.x, npb, 4, 0, 0, 256, 0, 1, 0, 0, meta, (size_t)1024 * DFF, F.tid);
                pg8::EpiMoeOut E{XN, (const float*)(F.ws + WS_MISC + MS_SLOTG), 1.0f / 64.0f};
                pg8::gemm_phase<pg8::EpiMoeOut, pg8::TabOrder, true, true, true>(F.lds, g, T, E, F.wave);
            }
        } SEAM(20);
        if (IN(22)) { PF();
            const int TP = __builtin_amdgcn_readfirstlane(meta[7]), npa = TP < 256 ? TP : 256, n1 = (TP - npa) * 4;
            if (n1 >= F.G) moe_combine(F, mod, 0, npa * 256, F.vcu * NWAVES + F.wave, F.G * NWAVES);
            moe_combine(F, mod, 1, npa * 256, F.vcu * NWAVES + F.wave, F.G * NWAVES);
        }
        STAMP(22);
    }
#ifdef PROF_MASK
    if (blockIdx.x == 0 && F.wave == 0 && __builtin_amdgcn_mbcnt_hi(~0u, __builtin_amdgcn_mbcnt_lo(~0u, 0u)) == 0u) { const unsigned long long t0_ = __builtin_amdgcn_s_memrealtime(); const unsigned long long w_ = 8ull * F.MISC[17]; while (__builtin_amdgcn_s_memrealtime() - t0_ < w_) __builtin_amdgcn_s_sleep(8); }
#endif
#undef IN
#undef SEAM
}

extern "C" void kernel_launch(void* const* d_in, const int* in_sizes, int n_in, void* d_out, int out_size, void* d_ws, size_t ws_size, hipStream_t stream) {
    static int grid = 0;
    if (grid == 0) {
        if (n_in != 24 || in_sizes[0] != BATCH * SEQ * DM || out_size != BATCH * SEQ * DM || ws_size < WS_END) { fprintf(stderr, "kernel_launch: unexpected shapes / workspace (n_in %d, ws %zu, need %zu); nothing launched\n", n_in, ws_size, (size_t)WS_END); grid = -1; return; }
        int dev = 0, cus = 0, per_cu = 0;
        if (hipGetDevice(&dev) != hipSuccess || hipDeviceGetAttribute(&cus, hipDeviceAttributeMultiprocessorCount, dev) != hipSuccess) { grid = -1; return; }
        if (hipFuncSetAttribute((const void*)mk_fwd, hipFuncAttributeMaxDynamicSharedMemorySize, LDS_BYTES) != hipSuccess) { fprintf(stderr, "kernel_launch: hipFuncSetAttribute failed\n"); grid = -1; return; }
        if (hipOccupancyMaxActiveBlocksPerMultiprocessor(&per_cu, (const void*)mk_fwd, NWAVES * 64, LDS_BYTES) != hipSuccess || per_cu < 1) fprintf(stderr, "kernel_launch: occupancy query reports %d\n", per_cu);
        (void)hipGetLastError();
        grid = cus;
    }
    if (grid < 0) return;
    if (hipMemsetAsync((char*)d_ws + WS_CTL, 0, CTL_ZERO_BYTES, stream) != hipSuccess) return;
    Args a{};
    for (int i = 0; i < 24; ++i) a.in[i] = (const float*)d_in[i];
    a.out = (float*)d_out; a.ws = (unsigned char*)d_ws; a.pad = 0;
    const int nl = MK_N_LAUNCHES == 1 ? 1 : NPH;
    for (int li = 0; li < nl; ++li) {
        a.ph_lo = nl == 1 ? 0 : li; a.ph_hi = nl == 1 ? NPH : li + 1; a.li = 0;
        hipLaunchKernelGGL(mk_fwd, dim3(grid), dim3(NWAVES * 64), LDS_BYTES, stream, a);
        const hipError_t le = hipPeekAtLastError();
        if (le != hipSuccess) { fprintf(stderr, "kernel_launch: launch %d failed: %s\n", li, hipGetErrorName(le)); break; }
    }
}
```

```cpp
#define MK_N_LAUNCHES 1
#include <hip/hip_runtime.h>
#include <cstdio>
#include <cstdint>
#include <cstddef>
#include <cmath>
namespace pg8 {
#define PG8_LAS __attribute__((address_space(3)))
typedef unsigned short bf16_t;
typedef short bf16x8 __attribute__((ext_vector_type(8)));
typedef float f32x4 __attribute__((ext_vector_type(4)));
typedef unsigned u32x4 __attribute__((ext_vector_type(4)));
constexpr int BM = 256, BK = 64, HALF = 128, HTB = HALF * BK * 2  , STAGE_BYTES = 8 * HTB, NXCD = 8, WGM = 8;

__host__ __device__ __forceinline__ int lds_byte(int r, int c) { const int st = (r >> 4) * 2 + (c >> 5), rr = r & 15, cc = c & 31, ob = rr * 64 + cc * 2; return st * 1024 + (ob ^ (((ob >> 9) & 1) << 5)); }
__host__ __device__ __forceinline__ void stage_rc(int b, int& R, int& C) { const int st = b / 1024, sb = b % 1024, swz = sb ^ (((sb >> 9) & 1) << 5); R = (st >> 1) * 16 + swz / 64; C = (st & 1) * 32 + (swz % 64) / 2; }
__host__ __device__ __forceinline__ int perm32(int rho) { const int n = rho >> 4, i = rho & 15; return 8 * (i >> 2) + 4 * n + (i & 3); }

struct Unit { int pm, pn, e; };
struct Gemm { const bf16_t* A; const bf16_t* Bt; int M, N, K; };

struct StaticOrder {
    int nM, nN, nwg, G, c;
    __host__ __device__ void init(int M, int N, int G_, int c_) { nM = M / BM; nN = N / BM; nwg = nM * nN; G = G_; c = c_; }
    __host__ __device__ bool next(int i, Unit& u) const {
        const long L = (long)i * G + c; if (L >= nwg) return false;
        int wgid = (int)L; { const int q = nwg / NXCD, r = nwg % NXCD, xcd = wgid % NXCD, off = wgid / NXCD; wgid = (xcd < r ? xcd * (q + 1) : r * (q + 1) + (xcd - r) * q) + off; }
        const int nig = WGM * nN, gid = wgid / nig, fm = gid * WGM, gsz = (nM - fm) < WGM ? (nM - fm) : WGM;
        u.pm = fm + ((wgid % nig) % gsz); u.pn = (wgid % nig) / gsz; return true;
    }
    __device__ __forceinline__ void a_ready(const Unit&) const {}
    __device__ __forceinline__ void done(const Unit&) const {}
};

__device__ __forceinline__ unsigned cvt_pk_bf16(float lo, float hi) { unsigned r; asm volatile("v_cvt_pk_bf16_f32 %0, %1, %2" : "=v"(r) : "v"(lo), "v"(hi)); return r; }
typedef float f32x2 __attribute__((ext_vector_type(2)));
__device__ __forceinline__ f32x2 gelu_pk(f32x2 v) {
    const f32x2 av = __builtin_elementwise_abs(v), d = av * 0.2316418882f + 1.0f;
    f32x2 t; t.x = __builtin_amdgcn_rcpf(d.x); t.y = __builtin_amdgcn_rcpf(d.y);
    f32x2 q = t * 0.5307027145f + (-0.7265760135f); q = q * t + 0.7107068705f; q = q * t + (-0.142248368f); q = q * t + 0.127414796f; q = q * t;
    const f32x2 s = (v * v) * (-0.72134752044f);
    f32x2 e; e.x = __builtin_amdgcn_exp2f(s.x); e.y = __builtin_amdgcn_exp2f(s.y);
    const f32x2 m = v * (q * e), r = v - m;
    f32x2 o; o.x = v.x < 0.f ? m.x : r.x; o.y = v.y < 0.f ? m.y : r.y; return o;
}

template <int ACT  > struct EpiBf16 {
    static constexpr bool PERM = true, AFTER_DRAIN = false, HEADMAP = false; static_assert(ACT == 0 || ACT == 1, "EpiBf16: ACT is 0 (none) or 1 (gelu_pk)");
    bf16_t* O; int ldc; const float* bias; int split_cols; size_t split_stride; float scale0;
    __device__ __forceinline__ void operator()(const f32x4 (&acc)[2][2][4][2], const Unit& u, int wr, int wc, int fr, int fq) const {
        const int row0 = u.pm * BM + wr * 64 + fr; int colt = u.pn * BM; bf16_t* base = O;
        float sc = 1.f; if (split_cols) { const int t = colt / split_cols; base += (size_t)t * split_stride; colt -= t * split_cols; if (t == 0) sc = scale0; }
        const int col0 = colt + wc * 32 + 8 * fq, bcol0 = u.pn * BM + wc * 32 + 8 * fq;
        f32x4 bv[2][2];
#pragma unroll
        for (int bj = 0; bj < 2; ++bj)
#pragma unroll
            for (int n = 0; n < 2; ++n) bv[bj][n] = bias ? *(const f32x4*)(bias + bcol0 + bj * HALF + 4 * n) : (f32x4){0.f, 0.f, 0.f, 0.f};
#pragma unroll
        for (int ai = 0; ai < 2; ++ai)
#pragma unroll
            for (int m = 0; m < 4; ++m) { bf16_t* rowp = base + (size_t)(row0 + ai * HALF + m * 16) * ldc + col0;
#pragma unroll
                for (int bj = 0; bj < 2; ++bj) { f32x4 v0 = acc[ai][bj][m][0] + bv[bj][0], v1 = acc[ai][bj][m][1] + bv[bj][1];
                    if (ACT == 1) { f32x2 a = gelu_pk((f32x2){v0[0], v0[1]}), b = gelu_pk((f32x2){v0[2], v0[3]}), c = gelu_pk((f32x2){v1[0], v1[1]}), d = gelu_pk((f32x2){v1[2], v1[3]});
                        v0 = (f32x4){a.x, a.y, b.x, b.y}; v1 = (f32x4){c.x, c.y, d.x, d.y}; }
                    v0 = v0 * sc; v1 = v1 * sc; u32x4 w; w.x = cvt_pk_bf16(v0[0], v0[1]); w.y = cvt_pk_bf16(v0[2], v0[3]); w.z = cvt_pk_bf16(v1[0], v1[1]); w.w = cvt_pk_bf16(v1[2], v1[3]);
                    *(u32x4*)(rowp + bj * HALF) = w; } }
    }
};

struct TabOrder {
    const volatile PG8_LAS unsigned* tab;
    __device__ __forceinline__ bool next(int i, Unit& u) const {
        if (i >= 32) return false;
        const volatile PG8_LAS unsigned* r = tab + 8 * i;
        if (__builtin_amdgcn_readfirstlane(r[6]) == 0u) return false;
        u.pm = (int)__builtin_amdgcn_readfirstlane(r[4]); u.pn = (int)__builtin_amdgcn_readfirstlane(r[5]); u.e = i; return true;
    }
    __device__ __forceinline__ const char* abase(const Unit& u, size_t) const { const volatile PG8_LAS unsigned* r = tab + 8 * u.e; const unsigned lo = __builtin_amdgcn_readfirstlane(r[0]), hi = __builtin_amdgcn_readfirstlane(r[1]); return (const char*)(((unsigned long long)hi << 32) | lo); }
    __device__ __forceinline__ const char* bbase(const Unit& u, size_t) const { const volatile PG8_LAS unsigned* r = tab + 8 * u.e; const unsigned lo = __builtin_amdgcn_readfirstlane(r[2]), hi = __builtin_amdgcn_readfirstlane(r[3]); return (const char*)(((unsigned long long)hi << 32) | lo); }
    __device__ __forceinline__ void a_ready(const Unit&) const {}
    __device__ __forceinline__ void done(const Unit&) const {}
};
__device__ __forceinline__ TabOrder build_units(PG8_LAS unsigned char* tabmem, int K, const void* A, const void* B, int G, int c,
                                                int np0, int nn0, int cn0, int mode0, int poff0, int np1, int nn1, int cn1, int mode1, const int* pend, size_t estride, const int tid) {
    __syncthreads();
    if (tid < 32) {
        int i_ = tid; asm volatile("" : "+v"(i_)); const int i = i_;
        const int n0 = np0 * nn0, nwg = n0 + np1 * nn1; const long L = (long)i * G + c; const bool ok = L < nwg;
        int w = ok ? (int)L : 0; { const int q = nwg / NXCD, r = nwg % NXCD, xcd = w % NXCD, off = w / NXCD; w = (xcd < r ? xcd * (q + 1) : r * (q + 1) + (xcd - r) * q) + off; }
        const bool s0 = w < n0; const int ww = s0 ? w : w - n0; const int np = s0 ? np0 : np1, nn = s0 ? nn0 : nn1, cn = s0 ? cn0 : cn1, mode = s0 ? mode0 : mode1;
        const int nig = WGM * nn, gid = ww / nig, fm = gid * WGM, gsz = (np - fm) < WGM ? (np - fm) : WGM;
        const int pv = fm + ((ww % nig) % gsz), pn = cn + (ww % nig) / gsz;
        const int pm0 = pv + poff0, pm1 = pv + (pv >> 3), pm2 = 9 * pv + 8; const int pm = mode == 0 ? pm0 : (mode == 1 ? pm1 : pm2);
        int e = 0;
        if (pend) {
#pragma unroll
            for (int k = 0; k < 8; ++k) e += (pend[k] <= pm) ? 1 : 0;
        }
        const size_t tstep = (size_t)256 * K * 2;
        const unsigned long long a = (unsigned long long)((const char*)A + (size_t)pm * tstep), b = (unsigned long long)((const char*)B + (size_t)e * estride + (size_t)pn * tstep);
        PG8_LAS unsigned* r = (PG8_LAS unsigned*)tabmem + 8 * i;
        r[0] = (unsigned)a; r[1] = (unsigned)(a >> 32); r[2] = (unsigned)b; r[3] = (unsigned)(b >> 32); r[4] = (unsigned)pm; r[5] = (unsigned)pn; r[6] = ok ? 1u : 0u; r[7] = 0u; }
    __syncthreads();
    TabOrder T; T.tab = (const volatile PG8_LAS unsigned*)tabmem; return T;
}

struct EpiRawBf16 {
    static constexpr bool PERM = true, AFTER_DRAIN = false, HEADMAP = false;
    bf16_t* O; int ldc;
    __device__ __forceinline__ void operator()(const f32x4 (&acc)[2][2][4][2], const Unit& u, int wr, int wc, int fr, int fq) const {
        const int row0 = u.pm * BM + wr * 64 + fr, col0 = u.pn * BM + wc * 32 + 8 * fq;
#pragma unroll
        for (int ai = 0; ai < 2; ++ai)
#pragma unroll
            for (int m = 0; m < 4; ++m) { bf16_t* rowp = O + (size_t)(row0 + ai * HALF + m * 16) * ldc + col0;
#pragma unroll
                for (int bj = 0; bj < 2; ++bj) { const f32x4 v0 = acc[ai][bj][m][0], v1 = acc[ai][bj][m][1];
                    u32x4 w; w.x = cvt_pk_bf16(v0[0], v0[1]); w.y = cvt_pk_bf16(v0[2], v0[3]); w.z = cvt_pk_bf16(v1[0], v1[1]); w.w = cvt_pk_bf16(v1[2], v1[3]);
                    *(u32x4*)(rowp + bj * HALF) = w; } }
    }
};

struct EpiHeads {
    static constexpr bool PERM = false, AFTER_DRAIN = false, HEADMAP = true;
    bf16_t* P; const PG8_LAS float* gl; const PG8_LAS float* tab;
    __device__ __forceinline__ void operator()(const f32x4 (&acc)[2][2][4][2], const Unit& u, int wr, int wc, int fr, int fq) const {
        const int pn = u.pn, jpan = u.pm % 9; const bool lat = jpan < 8;
        int mode = 0, gi = 0; float sc = 1.f;
        if (pn < 2) { mode = 2; gi = 0; sc = 0.125f * 1.4426950408889634f; }
        else if (pn == 2) { mode = 1; gi = 2; sc = 0.125f * 1.4426950408889634f; }
        else if (pn == 6) { mode = wc < 2 ? 2 : 0; gi = 1; }
        else if (pn == 7) { mode = 1; gi = 3; }
        if (mode == 2 && !lat) mode = 1;
        const PG8_LAS float* gp = gl + gi * 64 + 4 * fq;
        const int colb = pn * BM + wc * 64 + 4 * fq;
#pragma unroll
        for (int ai = 0; ai < 2; ++ai)
#pragma unroll
            for (int m = 0; m < 4; ++m) {
                const int lr = ai * HALF + wr * 64 + m * 16 + fr, j = jpan * 256 + lr;
                f32x4 v[2][2];
#pragma unroll
                for (int bj = 0; bj < 2; ++bj)
#pragma unroll
                    for (int n = 0; n < 2; ++n) v[bj][n] = acc[ai][bj][m][n];
                if (mode) {
                    float ss = 0.f;
#pragma unroll
                    for (int bj = 0; bj < 2; ++bj)
#pragma unroll
                        for (int n = 0; n < 2; ++n) ss += (v[bj][n][0] * v[bj][n][0] + v[bj][n][1] * v[bj][n][1]) + (v[bj][n][2] * v[bj][n][2] + v[bj][n][3] * v[bj][n][3]);
                    { const int ln_ = fq * 16 + fr; ss += __int_as_float(__builtin_amdgcn_ds_bpermute((ln_ ^ 16) << 2, __float_as_int(ss))); ss += __int_as_float(__builtin_amdgcn_ds_bpermute((ln_ ^ 32) << 2, __float_as_int(ss))); }
                    const float rs = 1.0f / sqrtf(ss * (1.0f / 64.0f) + 1e-6f);
#pragma unroll
                    for (int bj = 0; bj < 2; ++bj)
#pragma unroll
                        for (int n = 0; n < 2; ++n) v[bj][n] = v[bj][n] * (rs * sc) * *(const PG8_LAS f32x4*)(gp + 32 * bj + 16 * n);
                    if (mode == 2) {
#pragma unroll
                        for (int bj = 0; bj < 2; ++bj) { const int pos = bj == 0 ? (j >> 6) : (j & 63);
                            const f32x4 t0 = *(const PG8_LAS f32x4*)(tab + (pos * 16 + 4 * fq) * 2), t1 = *(const PG8_LAS f32x4*)(tab + (pos * 16 + 4 * fq) * 2 + 4);
                            const f32x4 cs = {t0[0], t0[2], t1[0], t1[2]}, sn = {t0[1], t0[3], t1[1], t1[3]};
                            const f32x4 u1 = v[bj][0], u2 = v[bj][1];
                            v[bj][0] = u1 * cs - u2 * sn; v[bj][1] = u2 * cs + u1 * sn; }
                    }
                }
                bf16_t* rowp = P + (size_t)(u.pm * BM + lr) * 2304 + pn * BM + wc * 64 + 4 * (fq & 2) + 16 * (fq & 1);
#pragma unroll
                for (int bj = 0; bj < 2; ++bj) {
                    const unsigned a0 = cvt_pk_bf16(v[bj][0][0], v[bj][0][1]), a1 = cvt_pk_bf16(v[bj][0][2], v[bj][0][3]), b0 = cvt_pk_bf16(v[bj][1][0], v[bj][1][1]), b1 = cvt_pk_bf16(v[bj][1][2], v[bj][1][3]);
                    const bool odd = fq & 1;
                    const unsigned s0 = odd ? a0 : b0, s1 = odd ? a1 : b1;
                    const unsigned r0 = (unsigned)__builtin_amdgcn_ds_swizzle((int)s0, 0x401F), r1 = (unsigned)__builtin_amdgcn_ds_swizzle((int)s1, 0x401F);
                    u32x4 w; if (odd) { w.x = r0; w.y = r1; w.z = b0; w.w = b1; } else { w.x = a0; w.y = a1; w.z = r0; w.w = r1; }
                    *(u32x4*)(rowp + 32 * bj) = w; }
                __builtin_amdgcn_sched_barrier(0);
            }
    }
};
template <int GB> struct EpiGateRes {
    static constexpr bool PERM = true, AFTER_DRAIN = false, HEADMAP = false;
    bf16_t* xb; const float* mod; int goff; float asc;
    __device__ __forceinline__ void operator()(const f32x4 (&acc)[2][2][4][2], const Unit& u, int wr, int wc, int fr_in, int fq) const {
        int fr = fr_in; asm volatile("" : "+v"(fr));
        const int b = u.pm / 9, j = u.pm % 9; const bool lat = j < 8;
        bf16_t* bo = xb + (size_t)(u.pm * BM) * 1024;
        const float* g = mod + (lat ? b : 16) * 6144 + goff;
        const int col0 = u.pn * BM + wc * 32 + 8 * fq;
        f32x4 gv[2][2];
#pragma unroll
        for (int bj = 0; bj < 2; ++bj)
#pragma unroll
            for (int n = 0; n < 2; ++n) gv[bj][n] = *(const f32x4*)(g + col0 + bj * HALF + 4 * n) * asc;
#pragma unroll
        for (int g0 = 0; g0 < 8; g0 += GB) {
            u32x4 xh[GB][2];
#pragma unroll
            for (int q = 0; q < GB; ++q) { const int ai = (g0 + q) >> 2, m = (g0 + q) & 3; const unsigned off = (unsigned)(ai * HALF + wr * 64 + m * 16 + fr) * 1024u + (unsigned)col0;
#pragma unroll
                for (int bj = 0; bj < 2; ++bj) xh[q][bj] = *(const u32x4*)(bo + off + bj * HALF); }
#pragma unroll
            for (int q = 0; q < GB; ++q) { const int ai = (g0 + q) >> 2, m = (g0 + q) & 3; const unsigned off = (unsigned)(ai * HALF + wr * 64 + m * 16 + fr) * 1024u + (unsigned)col0;
#pragma unroll
                for (int bj = 0; bj < 2; ++bj) { const u32x4 w = xh[q][bj];
                    const f32x4 x0 = {__uint_as_float(w.x << 16), __uint_as_float(w.x & 0xffff0000u), __uint_as_float(w.y << 16), __uint_as_float(w.y & 0xffff0000u)};
                    const f32x4 x1 = {__uint_as_float(w.z << 16), __uint_as_float(w.z & 0xffff0000u), __uint_as_float(w.w << 16), __uint_as_float(w.w & 0xffff0000u)};
                    const f32x4 o0 = x0 + gv[bj][0] * acc[ai][bj][m][0], o1 = x1 + gv[bj][1] * acc[ai][bj][m][1];
                    u32x4 wo; wo.x = cvt_pk_bf16(o0[0], o0[1]); wo.y = cvt_pk_bf16(o0[2], o0[3]); wo.z = cvt_pk_bf16(o1[0], o1[1]); wo.w = cvt_pk_bf16(o1[2], o1[3]);
                    *(u32x4*)(bo + off + bj * HALF) = wo; } }
            asm volatile("" ::: "memory"); }
    }
};
struct EpiSwiglu {
    static constexpr bool PERM = true, AFTER_DRAIN = false, HEADMAP = false;
    bf16_t* H; int ldh; int p0;
    __device__ __forceinline__ void operator()(const f32x4 (&acc)[2][2][4][2], const Unit& u, int wr, int wc, int fr, int fq) const {
        const int row0 = (u.pm - p0) * BM + wr * 64 + fr, col0 = u.pn * HALF + wc * 32 + 8 * fq;
#pragma unroll
        for (int ai = 0; ai < 2; ++ai)
#pragma unroll
            for (int m = 0; m < 4; ++m) { bf16_t* rowp = H + (size_t)(row0 + ai * HALF + m * 16) * ldh + col0;
                float h[8];
#pragma unroll
                for (int n = 0; n < 2; ++n)
#pragma unroll
                    for (int k = 0; k < 4; ++k) { const float a = acc[ai][0][m][n][k], b3 = acc[ai][1][m][n][k];
                        const float sg = __builtin_amdgcn_rcpf(1.0f + __builtin_amdgcn_exp2f(-1.4426950408889634f * a)); h[n * 4 + k] = a * sg * b3; }
                u32x4 w; w.x = cvt_pk_bf16(h[0], h[1]); w.y = cvt_pk_bf16(h[2], h[3]); w.z = cvt_pk_bf16(h[4], h[5]); w.w = cvt_pk_bf16(h[6], h[7]);
                *(u32x4*)rowp = w; }
    }
};
struct EpiSwigluF8 {
    static constexpr bool PERM = true, AFTER_DRAIN = false, HEADMAP = false;
    unsigned char* H; int ldh; float isc;
    __device__ __forceinline__ void operator()(const f32x4 (&acc)[2][2][4][2], const Unit& u, int wr, int wc, int fr, int fq) const {
        const int row0 = u.pm * BM + wr * 64 + fr, col0 = u.pn * HALF + wc * 32 + 8 * fq;
        const float c1 = -1.4426950408889634f * isc, c2 = isc * isc;
#pragma unroll
        for (int ai = 0; ai < 2; ++ai)
#pragma unroll
            for (int m = 0; m < 4; ++m) { unsigned char* rowp = H + (size_t)(row0 + ai * HALF + m * 16) * ldh + col0;
                f32x2 h[4];
#pragma unroll
                for (int n = 0; n < 2; ++n)
#pragma unroll
                    for (int k = 0; k < 2; ++k) { const f32x2 a = {acc[ai][0][m][n][2 * k], acc[ai][0][m][n][2 * k + 1]}, b3 = {acc[ai][1][m][n][2 * k], acc[ai][1][m][n][2 * k + 1]};
                        const f32x2 t = a * c1; f32x2 ex; ex.x = __builtin_amdgcn_exp2f(t.x); ex.y = __builtin_amdgcn_exp2f(t.y);
                        const f32x2 d = ex + 1.0f; f32x2 r; r.x = __builtin_amdgcn_rcpf(d.x); r.y = __builtin_amdgcn_rcpf(d.y);
                        h[n * 2 + k] = ((a * b3) * c2) * r; }
                typedef unsigned u32x2 __attribute__((ext_vector_type(2))); u32x2 w;
                { int t = __builtin_amdgcn_cvt_pk_fp8_f32(h[0].x, h[0].y, 0, false); t = __builtin_amdgcn_cvt_pk_fp8_f32(h[1].x, h[1].y, t, true); w.x = (unsigned)t; }
                { int t = __builtin_amdgcn_cvt_pk_fp8_f32(h[2].x, h[2].y, 0, false); t = __builtin_amdgcn_cvt_pk_fp8_f32(h[3].x, h[3].y, t, true); w.y = (unsigned)t; }
                *(u32x2*)rowp = w; }
    }
};
struct EpiMoeOut {
    static constexpr bool PERM = true, AFTER_DRAIN = false, HEADMAP = false;
    bf16_t* Y; const float* sgate; float osc;
    __device__ __forceinline__ void operator()(const f32x4 (&acc)[2][2][4][2], const Unit& u, int wr, int wc, int fr, int fq) const {
        const int row0 = u.pm * BM + wr * 64 + fr, col0 = u.pn * BM + wc * 32 + 8 * fq;
        float gts[8];
#pragma unroll
        for (int i = 0; i < 8; ++i) gts[i] = sgate[row0 + (i >> 2) * HALF + (i & 3) * 16] * osc;
#pragma unroll
        for (int ai = 0; ai < 2; ++ai)
#pragma unroll
            for (int m = 0; m < 4; ++m) { const int row = row0 + ai * HALF + m * 16; const float gt = gts[ai * 4 + m]; bf16_t* rowp = Y + (size_t)row * 1024 + col0;
#pragma unroll
                for (int bj = 0; bj < 2; ++bj) { const f32x4 v0 = acc[ai][bj][m][0] * gt, v1 = acc[ai][bj][m][1] * gt;
                    u32x4 w; w.x = cvt_pk_bf16(v0[0], v0[1]); w.y = cvt_pk_bf16(v0[2], v0[3]); w.z = cvt_pk_bf16(v1[0], v1[1]); w.w = cvt_pk_bf16(v1[2], v1[3]);
                    *(u32x4*)(rowp + bj * HALF) = w; } }
    }
};
template <class Epi, class Sched, bool ALIGN_EPI = false, bool SP2 = false, bool F8 = false, bool GATHER = false>
__device__ __forceinline__ void gemm_phase(PG8_LAS unsigned char* lds, const Gemm g, const Sched& S, const Epi& E, const int wave_sgpr) {
    int ln_ = (int)__builtin_amdgcn_mbcnt_hi(~0u, __builtin_amdgcn_mbcnt_lo(~0u, 0u)); asm volatile("" : "+v"(ln_)); const int tid_ = wave_sgpr * 64 + ln_;
    const int tid = tid_, wid = __builtin_amdgcn_readfirstlane(tid >> 6), lane = tid & 63, wr = wid >> 2, wc = wid & 3, fr = lane & 15, fq = lane >> 4;
    const int K = g.K, nt = K / BK;
    unsigned voffA[2], voffB[2];
#pragma unroll
    for (int i = 0; i < 2; ++i) { int R, C; stage_rc(tid * 16 + i * 8192, R, C); const int Rb = Epi::HEADMAP ? ((R >> 5) * 64 + (R & 31)) : (Epi::PERM ? ((R & ~31) + perm32(R & 31)) : R);
        voffA[i] = GATHER ? (unsigned)(((R * 2) << 16) | (C * 2)) : (unsigned)(R * K + C) * 2u; voffB[i] = (unsigned)(Rb * K + C) * 2u; }
    static_assert(!GATHER || SP2, "GATHER is written for the SP2 loop");
    unsigned gC[2][2], gN[2][2], gS[2][2];
#define PG8_GLOAD(o, ui_) do { _Pragma("unroll") for (int h_ = 0; h_ < 2; ++h_) _Pragma("unroll") for (int i_ = 0; i_ < 2; ++i_) \
        o[h_][i_] = (unsigned)*(const PG8_LAS unsigned short*)(lds + 147456 + (ui_) * 512 + h_ * 256 + (voffA[i_] >> 16)) * (unsigned)(K * 2) + (voffA[i_] & 0xffffu); } while (0)
#define PG8_STAGE_A(bufoff, kptr, h, OFFS) do { if constexpr (GATHER) PG8_STAGE(bufoff, kptr, OFFS[h]); else PG8_STAGE(bufoff, (kptr) + (h) * hstep, voffA); } while (0)
    const size_t kstep = (size_t)(BK * 2);
    const size_t hstep = (size_t)HALF * K * 2;
    const size_t hstepB = Epi::HEADMAP ? (size_t)32 * K * 2 : hstep;
    const size_t tstep = 2 * hstep;
    const unsigned ldsw = (unsigned)wid * 1024u;
    const int aoff = lds_byte(wr * 64 + fr, fq * 8), boff = lds_byte(wc * 32 + fr, fq * 8);
#define PG8_SA(b, h) (((b) * 2 + (h)) * HTB)
#define PG8_SB(b, h) ((4 + (b) * 2 + (h)) * HTB)
#define PG8_STAGE(bufoff, gbase, voff) do { _Pragma("unroll") for (int _i = 0; _i < 2; ++_i) \
        __builtin_amdgcn_global_load_lds((const unsigned*)((const char*)(gbase) + (voff)[_i]), (PG8_LAS unsigned*)(lds + (bufoff) + ldsw + _i * 8192), 16, 0, 0); } while (0)
#define PG8_LDA(dst, b, h) do { _Pragma("unroll") for (int m = 0; m < 4; ++m) { if constexpr (F8) { dst##8[m].lo = *(const PG8_LAS i32x4_*)(lds + PG8_SA(b, h) + aoff + m * 2048); dst##8[m].hi = *(const PG8_LAS i32x4_*)(lds + PG8_SA(b, h) + aoff + m * 2048 + 1024); } \
        else { _Pragma("unroll") for (int k = 0; k < 2; ++k) dst[m][k] = *(const PG8_LAS bf16x8*)(lds + PG8_SA(b, h) + aoff + m * 2048 + k * 1024); } } } while (0)
#define PG8_LDB(dst, b, h) do { _Pragma("unroll") for (int n = 0; n < 2; ++n) { if constexpr (F8) { dst##8[n].lo = *(const PG8_LAS i32x4_*)(lds + PG8_SB(b, h) + boff + n * 2048); dst##8[n].hi = *(const PG8_LAS i32x4_*)(lds + PG8_SB(b, h) + boff + n * 2048 + 1024); } \
        else { _Pragma("unroll") for (int k = 0; k < 2; ++k) dst[n][k] = *(const PG8_LAS bf16x8*)(lds + PG8_SB(b, h) + boff + n * 2048 + k * 1024); } } } while (0)
#define PG8_MMA(ai, bj, At, Bt) do { __builtin_amdgcn_s_setprio(1); _Pragma("unroll") for (int m = 0; m < 4; ++m) _Pragma("unroll") for (int n = 0; n < 2; ++n) { \
        if constexpr (F8) asm("v_mfma_f32_16x16x128_f8f6f4 %0, %1, %2, %0" : "+v"(acc[ai][bj][m][n]) : "v"(Bt##8[n]), "v"(At##8[m]));     \
        else { _Pragma("unroll") for (int k = 0; k < 2; ++k) acc[ai][bj][m][n] = __builtin_amdgcn_mfma_f32_16x16x32_bf16(Bt[n][k], At[m][k], acc[ai][bj][m][n], 0, 0, 0); } } \
        __builtin_amdgcn_s_setprio(0); } while (0)
#define PG8_WAIT_V(n) asm volatile("s_waitcnt vmcnt(" #n ")" ::: "memory")
#define PG8_WAIT_L(n) asm volatile("s_waitcnt lgkmcnt(" #n ")" ::: "memory")
#define PG8_BAR __builtin_amdgcn_s_barrier()
#define PG8_SCHED __builtin_amdgcn_sched_barrier(0)
    Unit cur, nxt; int ui = 0;
    if (!S.next(0, cur)) return;
    f32x4 acc[2][2][4][2];
#pragma unroll
    for (int a = 0; a < 2; ++a)
#pragma unroll
        for (int b = 0; b < 2; ++b)
#pragma unroll
            for (int m = 0; m < 4; ++m)
#pragma unroll
                for (int n = 0; n < 2; ++n) acc[a][b][m][n] = (f32x4){0.f, 0.f, 0.f, 0.f};
    typedef int i32x4_ __attribute__((ext_vector_type(4))); typedef int i32x8_ __attribute__((ext_vector_type(8)));
    bf16x8 At[4][2], B0[2][2], B1[2][2];
    i32x8_ At8[4], B08[2], B18[2];
    const char* cA = GATHER ? (const char*)g.A : S.abase(cur, tstep); const char* cB = S.bbase(cur, tstep);
    if constexpr (GATHER) PG8_GLOAD(gC, cur.e);
    S.a_ready(cur);
    if constexpr (SP2) {
        PG8_STAGE(PG8_SB(0, 0), cB, voffB); PG8_STAGE(PG8_SB(0, 1), cB + hstepB, voffB); PG8_STAGE_A(PG8_SA(0, 0), cA, 0, gC); PG8_STAGE_A(PG8_SA(0, 1), cA, 1, gC);
        if (wr == 1) PG8_BAR;
        PG8_WAIT_V(2); PG8_BAR;
        PG8_STAGE(PG8_SB(1, 0), cB + kstep, voffB); PG8_STAGE_A(PG8_SA(1, 0), cA + kstep, 0, gC); PG8_STAGE(PG8_SB(1, 1), cB + hstepB + kstep, voffB);
        PG8_WAIT_V(6); PG8_BAR;
    } else {
        PG8_STAGE(PG8_SB(0, 0), cB, voffB); PG8_STAGE(PG8_SA(0, 0), cA, voffA); PG8_STAGE(PG8_SB(0, 1), cB + hstepB, voffB); PG8_STAGE(PG8_SA(0, 1), cA + hstep, voffA);
        if (wr == 1) PG8_BAR;
        PG8_WAIT_V(4); PG8_BAR;
        PG8_STAGE(PG8_SB(1, 0), cB + kstep, voffB); PG8_STAGE(PG8_SA(1, 0), cA + kstep, voffA); PG8_STAGE(PG8_SB(1, 1), cB + hstepB + kstep, voffB);
        PG8_WAIT_V(6); PG8_BAR;
    }
    for (;;) {
        const bool has_next = S.next(ui + 1, nxt);
        const char* nA = GATHER ? cA : (has_next ? S.abase(nxt, tstep) : cA); const char* nB = has_next ? S.bbase(nxt, tstep) : cB;
        if constexpr (GATHER) { if (has_next) PG8_GLOAD(gN, nxt.e); else { _Pragma("unroll") for (int h_ = 0; h_ < 2; ++h_) _Pragma("unroll") for (int i_ = 0; i_ < 2; ++i_) gN[h_][i_] = gC[h_][i_]; } }
#pragma unroll 1
        for (int t = 0; t < nt; t += 2) {
            const bool last = (t == nt - 2);
            const char* a1 = cA + (size_t)(t + 1) * kstep;
            const char* a2 = last ? nA : cA + (size_t)(t + 2) * kstep; const char* b2 = last ? nB : cB + (size_t)(t + 2) * kstep;
            const char* a3 = a2 + kstep; const char* b3 = b2 + kstep;
            if (last && has_next) S.a_ready(nxt);
            if constexpr (GATHER) { _Pragma("unroll") for (int h_ = 0; h_ < 2; ++h_) _Pragma("unroll") for (int i_ = 0; i_ < 2; ++i_) gS[h_][i_] = last ? gN[h_][i_] : gC[h_][i_]; }
            if constexpr (SP2) {
            PG8_LDB(B0, 0, 0); PG8_LDB(B1, 0, 1); PG8_SCHED; PG8_LDA(At, 0, 0); PG8_STAGE_A(PG8_SA(1, 1), a1, 1, gC);
            PG8_WAIT_V(8); PG8_WAIT_L(0); PG8_BAR; PG8_MMA(0, 0, At, B0); PG8_MMA(0, 1, At, B1); PG8_BAR; PG8_SCHED;
            PG8_LDA(At, 0, 1); PG8_STAGE(PG8_SB(0, 0), b2, voffB); PG8_STAGE(PG8_SB(0, 1), b2 + hstepB, voffB); PG8_STAGE_A(PG8_SA(0, 0), a2, 0, gS);
            PG8_WAIT_V(8); PG8_WAIT_L(0); PG8_BAR; PG8_MMA(1, 0, At, B0); PG8_MMA(1, 1, At, B1); PG8_BAR; PG8_SCHED;
            PG8_LDB(B0, 1, 0); PG8_LDB(B1, 1, 1); PG8_SCHED; PG8_LDA(At, 1, 0); PG8_STAGE_A(PG8_SA(0, 1), a2, 1, gS);
            PG8_WAIT_V(8); PG8_WAIT_L(0); PG8_BAR; PG8_MMA(0, 0, At, B0); PG8_MMA(0, 1, At, B1); PG8_BAR; PG8_SCHED;
            PG8_LDA(At, 1, 1); PG8_STAGE(PG8_SB(1, 0), b3, voffB); PG8_STAGE(PG8_SB(1, 1), b3 + hstepB, voffB); PG8_STAGE_A(PG8_SA(1, 0), a3, 0, gS);
            PG8_WAIT_V(8); PG8_WAIT_L(0); PG8_BAR; PG8_MMA(1, 0, At, B0); PG8_MMA(1, 1, At, B1); PG8_BAR; PG8_SCHED;
            } else {
            PG8_LDB(B0, 0, 0); PG8_SCHED; PG8_LDA(At, 0, 0); PG8_STAGE(PG8_SA(1, 1), a1 + hstep, voffA);
            PG8_WAIT_L(8); PG8_BAR; PG8_WAIT_L(0); PG8_MMA(0, 0, At, B0); PG8_BAR; PG8_SCHED;
            PG8_LDB(B1, 0, 1); PG8_STAGE(PG8_SB(0, 0), b2, voffB);
            PG8_BAR; PG8_WAIT_L(0); PG8_MMA(0, 1, At, B1); PG8_BAR;
            PG8_LDA(At, 0, 1); PG8_STAGE(PG8_SA(0, 0), a2, voffA);
            PG8_BAR; PG8_WAIT_L(0); PG8_MMA(1, 0, At, B0); PG8_BAR; PG8_SCHED;
            PG8_STAGE(PG8_SB(0, 1), b2 + hstepB, voffB);
            PG8_WAIT_V(6); PG8_BAR; PG8_MMA(1, 1, At, B1); PG8_BAR;
            PG8_LDB(B0, 1, 0); PG8_SCHED; PG8_LDA(At, 1, 0); PG8_STAGE(PG8_SA(0, 1), a2 + hstep, voffA);
            PG8_WAIT_L(8); PG8_BAR; PG8_WAIT_L(0); PG8_MMA(0, 0, At, B0); PG8_BAR; PG8_SCHED;
            PG8_LDB(B1, 1, 1); PG8_STAGE(PG8_SB(1, 0), b3, voffB);
            PG8_BAR; PG8_WAIT_L(0); PG8_MMA(0, 1, At, B1); PG8_BAR;
            PG8_LDA(At, 1, 1); PG8_STAGE(PG8_SA(1, 0), a3, voffA);
            PG8_BAR; PG8_WAIT_L(0); PG8_MMA(1, 0, At, B0); PG8_BAR; PG8_SCHED;
            PG8_STAGE(PG8_SB(1, 1), b3 + hstepB, voffB);
            PG8_WAIT_V(6); PG8_BAR; PG8_MMA(1, 1, At, B1); PG8_BAR;
            }
        }
        if constexpr (ALIGN_EPI) { if (wr == 0) PG8_BAR; }
        if constexpr (F8) asm volatile("s_nop 15\n\ts_nop 15\n\ts_nop 7" ::: "memory");
        if constexpr (!Epi::AFTER_DRAIN) { E(acc, cur, wr, wc, fr, fq); S.done(cur); }
        if (!has_next) break;
#pragma unroll
        for (int a = 0; a < 2; ++a)
#pragma unroll
            for (int b = 0; b < 2; ++b)
#pragma unroll
                for (int m = 0; m < 4; ++m)
#pragma unroll
                    for (int n = 0; n < 2; ++n) acc[a][b][m][n] = (f32x4){0.f, 0.f, 0.f, 0.f};
        cur = nxt; cA = nA; cB = nB; ++ui;
        if constexpr (GATHER) { _Pragma("unroll") for (int h_ = 0; h_ < 2; ++h_) _Pragma("unroll") for (int i_ = 0; i_ < 2; ++i_) gC[h_][i_] = gN[h_][i_]; }
        if constexpr (ALIGN_EPI) { if (wr == 1) PG8_BAR; }
    }
    PG8_WAIT_V(0);
    if constexpr (!ALIGN_EPI) { if (wr == 0) PG8_BAR; }
    PG8_BAR;
    if constexpr (Epi::AFTER_DRAIN) { E.fused(acc, cur, wr, wc, fr, fq, lds, wid, lane); S.done(cur); }
#undef PG8_SA
#undef PG8_SB
#undef PG8_STAGE
#undef PG8_STAGE_A
#undef PG8_GLOAD
#undef PG8_LDA
#undef PG8_LDB
#undef PG8_MMA
#undef PG8_WAIT_V
#undef PG8_WAIT_L
#undef PG8_BAR
#undef PG8_SCHED
}
}

constexpr int NWAVES = 8;
#ifndef MK_N_LAUNCHES
#define MK_N_LAUNCHES 1
#endif
constexpr int NPH = 23;
constexpr int BATCH = 16, SEQ = 2048, DM = 1024, CTXL = 256, TPB = SEQ + CTXL, MROWS = BATCH * TPB, NPAN = MROWS / 256;
constexpr int INW = 2304, DFF = 2816, NEXP = 8, NTOK = BATCH * SEQ;
constexpr int QA_OFF = 0, QB_OFF = 512, CPOST_OFF = 768, CPRE_OFF = 1024, CVAL_OFF = 1280, KA_OFF = 1536, VA_OFF = 1664, KB_OFF = 1792, VB_OFF = 2048;
constexpr float NORM_EPS = 1e-6f, LOG2E = 1.4426950408889634f, C2 = 0.125f * 1.4426950408889634f;
constexpr int MOE_HCAP = 136;
constexpr int SLOT_CAP = 2 * NTOK + NEXP * 256;

constexpr size_t MiB = 1u << 20;
constexpr size_t WS_CTL = 0, CTL_ZERO_BYTES = 128 * 1024;
constexpr size_t WS_MOD = 1 * MiB;
constexpr size_t WS_MISC = 2 * MiB;
constexpr size_t WS_WIN = 6 * MiB;
constexpr size_t WS_WOUT = 15 * MiB;
constexpr size_t WS_F13 = 19 * MiB;
constexpr size_t WS_F2 = 30 * MiB;
constexpr size_t WS_M13 = 36 * MiB;
constexpr size_t WS_M2 = 80 * MiB;
constexpr size_t WS_XB = 104 * MiB;
constexpr size_t WS_XN = 184 * MiB;
constexpr size_t WS_P = 256 * MiB;
constexpr size_t WS_XT = 316 * MiB;
constexpr size_t WS_END = 504 * MiB;
constexpr size_t WS_XS8 = WS_XN, WS_XT8 = WS_XN + 66 * MiB, WS_H8 = WS_XT;
static_assert(WS_P + (size_t)MROWS * DFF * 2 <= WS_END && WS_H8 + (size_t)SLOT_CAP * DFF <= WS_END && WS_XN + (size_t)SLOT_CAP * DM * 2 <= WS_XT && WS_XT8 + (size_t)NTOK * DM <= WS_XT && (size_t)SLOT_CAP * DM <= 66 * MiB, "ws map");
constexpr size_t MS_TOKE = 0, MS_TOKG = 256 * 1024, MS_TOKS = 512 * 1024, MS_SLOTG = 768 * 1024, MS_META = 1088 * 1024, MS_ROPE = 1152 * 1024, MS_SLOTT = 1280 * 1024;
constexpr int CW_TMO = 0, CW_CODE = 1, CW_BAR = 4096, CW_CNT = 16384;

constexpr int RING_BYTES = 139264, LDSCTL_OFF = RING_BYTES, MISC_OFF = LDSCTL_OFF + 320, LDS_IDS_OFF = 147456, LDS_BYTES = 163840;

#define GAS __attribute__((address_space(1)))
#define LAS __attribute__((address_space(3)))
typedef unsigned short bf16;
typedef unsigned v4u __attribute__((ext_vector_type(4)));
typedef unsigned v2u __attribute__((ext_vector_type(2)));
typedef float f32x4 __attribute__((ext_vector_type(4)));
#define LDS_WAIT() asm volatile("s_waitcnt lgkmcnt(0)" ::: "memory")
#define VM_WAIT() asm volatile("s_waitcnt vmcnt(0)" ::: "memory")
__device__ __forceinline__ unsigned f2bf(float f) { unsigned u = __builtin_bit_cast(unsigned, f); return (u + 0x7fffu + ((u >> 16) & 1u)) >> 16; }
__device__ __forceinline__ unsigned pk2(float lo, float hi) { return f2bf(lo) | (f2bf(hi) << 16); }
__device__ __forceinline__ unsigned pk4_f8(float a, float b, float c, float d) { int w = __builtin_amdgcn_cvt_pk_fp8_f32(a, b, 0, false); w = __builtin_amdgcn_cvt_pk_fp8_f32(c, d, w, true); return (unsigned)w; }
__device__ __forceinline__ float bflo(unsigned w) { return __uint_as_float(w << 16); }
__device__ __forceinline__ float bfhi(unsigned w) { return __uint_as_float(w & 0xffff0000u); }
__device__ __forceinline__ float bf1(bf16 h) { return __uint_as_float((unsigned)h << 16); }
__device__ __forceinline__ float xshfl(float v, int mask, int lane) { return __int_as_float(__builtin_amdgcn_ds_bpermute((lane ^ mask) << 2, __float_as_int(v))); }
template <int CTRL> __device__ __forceinline__ float dpp_mov(float v) { return __int_as_float(__builtin_amdgcn_update_dpp(0, __float_as_int(v), CTRL, 0xF, 0xF, true)); }
__device__ __forceinline__ float row_sum16(float v) { v += dpp_mov<0xB1>(v); v += dpp_mov<0x4E>(v); v += dpp_mov<0x141>(v); v += dpp_mov<0x140>(v); return v; }
__device__ __forceinline__ float half_sum(float v, int) {
    v = row_sum16(v); const auto a = __builtin_amdgcn_permlane16_swap(__float_as_uint(v), __float_as_uint(v), false, false); return __uint_as_float(a[0]) + __uint_as_float(a[1]);
}
__device__ __forceinline__ float wave_sum(float v, int lane) {
    v = half_sum(v, lane); const auto b = __builtin_amdgcn_permlane32_swap(__float_as_uint(v), __float_as_uint(v), false, false); return __uint_as_float(b[0]) + __uint_as_float(b[1]);
}
#include <hip/hip_bf16.h>
#include <cmath>
namespace attn_body {
using bf16=__hip_bfloat16;
using bf16x8=__attribute__((ext_vector_type(8)))short;
using s16x4=__attribute__((ext_vector_type(4)))short;
using f32x16=__attribute__((ext_vector_type(16)))float;
using u32x4=__attribute__((ext_vector_type(4)))unsigned;
constexpr int D=64,DM=2304;
constexpr int NW=8,QBLK=32,QB=QBLK*NW,KVBLK=64;
constexpr int LDS_BT=86016, BT_STRIDE=128, BT_PAD=48;
__device__ __forceinline__ int crow(int r,int hi){return (r&3)+8*(r>>2)+4*hi;}
#define SBAR() __builtin_amdgcn_sched_barrier(0)
__device__ __forceinline__ void bias_apply(f32x16&p0,f32x16&p1,const __attribute__((address_space(3))) char*tb,unsigned m0,unsigned m1,float mh){
  const unsigned NEGB=0xf149f2cau;
  #pragma unroll
  for(int g=0;g<4;++g){
    #pragma unroll
    for(int k=0;k<4;++k){ const int r=4*g+k; const int o=((r&3)+8*(r>>2))*4; const float b0=*(const __attribute__((address_space(3))) float*)(tb+o),b1=*(const __attribute__((address_space(3))) float*)(tb+o+128);
      const unsigned s0=(unsigned)__builtin_amdgcn_sbfe((int)m0,r,1), s1=(unsigned)__builtin_amdgcn_sbfe((int)m1,r,1);
      const unsigned x0=__float_as_uint(p0[r]+(b0-mh)), x1=__float_as_uint(p1[r]+(b1-mh));
      float y0=__uint_as_float((x0&s0)|(NEGB&~s0)), y1=__uint_as_float((x1&s1)|(NEGB&~s1)); asm volatile("":"+v"(y0),"+v"(y1)); p0[r]=y0; p1[r]=y1; }
    __builtin_amdgcn_sched_barrier(0); }
}
constexpr int NSLOT=3, SLOTB=8192;
constexpr int LDS_K=0, LDS_V=NSLOT*SLOTB, LDS_WS=2*NSLOT*SLOTB, LDS_OST=LDS_WS+NW*64*4, LDS_BYTES=LDS_OST+NW*4096;
constexpr float C2=0.125f*1.4426950408889634f;
__device__ __forceinline__ void glds16(const void*gsrc,unsigned lds_dst){unsigned keep;
  asm volatile("s_mov_b32 %0, m0\n\ts_mov_b32 m0, %2\n\ts_nop 0\n\tglobal_load_lds_dwordx4 %1, off\n\ts_mov_b32 m0, %0":"=&s"(keep):"v"(gsrc),"s"(lds_dst):"memory");}
__device__ __forceinline__ float max3f(float a,float b,float c){float r;asm("v_max3_f32 %0, %1, %2, %3":"=v"(r):"v"(a),"v"(b),"v"(c));return r;}
__device__ __forceinline__ float max2f(float a,float b){float r;asm("v_max_f32_e32 %0, %1, %2":"=v"(r):"v"(a),"v"(b));return r;}
__device__ __forceinline__ float fadd_s(float a,float b){float r;asm("v_add_f32_e32 %0, %1, %2":"=v"(r):"v"(a),"v"(b));return r;}
__device__ __forceinline__ float fsub_s(float a,float b){float r;asm("v_sub_f32_e32 %0, %1, %2":"=v"(r):"v"(a),"v"(b));return r;}
typedef float f32x2_t __attribute__((ext_vector_type(2))); typedef __bf16 bf16x2_t __attribute__((ext_vector_type(2)));
__device__ __forceinline__ unsigned cvtpk_s(float lo,float hi){f32x2_t v={lo,hi};bf16x2_t b=__builtin_convertvector(v,bf16x2_t);return __builtin_bit_cast(unsigned,b);}
#define WAIT_BAR(N) asm volatile("s_waitcnt vmcnt(" #N ") lgkmcnt(0)\n\ts_barrier":::"memory")

template<bool ZERO> __device__ __forceinline__ f32x16 cinit(const f32x16&negm){ if constexpr(ZERO) return f32x16{}; else return negm; }
__device__ __forceinline__ void qkt(f32x16&p0,f32x16&p1,const char*Kslot,const bf16x8*qr,const f32x16 negm,int r32,int hi){
  const char*kb=Kslot+hi*1024+r32*16;
  #pragma unroll
  for(int d0=0;d0<4;++d0){
    const bf16x8 b0=*reinterpret_cast<const bf16x8*>(kb+d0*2048);
    const bf16x8 b1=*reinterpret_cast<const bf16x8*>(kb+d0*2048+512);
    if(d0==0){p0=__builtin_amdgcn_mfma_f32_32x32x16_bf16(b0,qr[0],negm,0,0,0);p1=__builtin_amdgcn_mfma_f32_32x32x16_bf16(b1,qr[0],negm,0,0,0);}
    else{p0=__builtin_amdgcn_mfma_f32_32x32x16_bf16(b0,qr[d0],p0,0,0,0);p1=__builtin_amdgcn_mfma_f32_32x32x16_bf16(b1,qr[d0],p1,0,0,0);}}
}
typedef __attribute__((address_space(3))) const char* lds_cptr;
typedef short v4i16_t __attribute__((ext_vector_type(4)));
__device__ __forceinline__ void kload8(bf16x8*kf,lds_cptr kp){
  kf[0]=*(const __attribute__((address_space(3))) bf16x8*)(kp);      kf[1]=*(const __attribute__((address_space(3))) bf16x8*)(kp+512);
  kf[2]=*(const __attribute__((address_space(3))) bf16x8*)(kp+2048); kf[3]=*(const __attribute__((address_space(3))) bf16x8*)(kp+2560);
  kf[4]=*(const __attribute__((address_space(3))) bf16x8*)(kp+4096); kf[5]=*(const __attribute__((address_space(3))) bf16x8*)(kp+4608);
  kf[6]=*(const __attribute__((address_space(3))) bf16x8*)(kp+6144); kf[7]=*(const __attribute__((address_space(3))) bf16x8*)(kp+6656);
}
__device__ __forceinline__ void kload2(bf16x8*kf,lds_cptr kp,int j){ kf[2*j]=*(const __attribute__((address_space(3))) bf16x8*)(kp+j*2048); kf[2*j+1]=*(const __attribute__((address_space(3))) bf16x8*)(kp+j*2048+512); }
__device__ __forceinline__ s16x4 vtr(lds_cptr p){ return __builtin_bit_cast(s16x4,__builtin_amdgcn_ds_read_tr16_b64_v4i16((__attribute__((address_space(3))) v4i16_t*)p)); }
__device__ __forceinline__ float rowmax(const f32x16&p0,const f32x16&p1){
  float a=max3f(p0[0],p0[1],p1[0]),b=max3f(p0[2],p0[3],p1[1]);a=max3f(a,p1[2],p1[3]);
  #pragma unroll
  for(int r=4;r<16;r+=4){a=max3f(a,p0[r],p0[r+1]);b=max3f(b,p0[r+2],p0[r+3]);a=max3f(a,p1[r],p1[r+1]);b=max3f(b,p1[r+2],p1[r+3]);}
  const float m=max2f(a,b);
  auto rr=__builtin_amdgcn_permlane32_swap(__float_as_uint(m),__float_as_uint(m),false,false);
  return max2f(__uint_as_float(rr[0]),__uint_as_float(rr[1]));
}
__device__ __forceinline__ void pv(f32x16*o,int vb,bf16x8 pa0,bf16x8 pa1,bf16x8 pa2,bf16x8 pa3){
  #pragma unroll
  for(int d0=0;d0<2;++d0){s16x4 lo[4],hi[4];
    #pragma unroll
    for(int ks=0;ks<4;++ks){
      asm volatile("ds_read_b64_tr_b16 %0,%1 offset:%c2":"=&v"(lo[ks]):"v"(vb),"i"(d0*4096+ks*1024):"memory");
      asm volatile("ds_read_b64_tr_b16 %0,%1 offset:%c2":"=&v"(hi[ks]):"v"(vb),"i"(d0*4096+ks*1024+512):"memory");}
    asm volatile("s_waitcnt lgkmcnt(0)":::"memory");SBAR();
    #define PK(k) (bf16x8){lo[k][0],lo[k][1],lo[k][2],lo[k][3],hi[k][0],hi[k][1],hi[k][2],hi[k][3]}
    o[d0]=__builtin_amdgcn_mfma_f32_32x32x16_bf16(pa0,PK(0),o[d0],0,0,0);
    o[d0]=__builtin_amdgcn_mfma_f32_32x32x16_bf16(pa1,PK(1),o[d0],0,0,0);
    o[d0]=__builtin_amdgcn_mfma_f32_32x32x16_bf16(pa2,PK(2),o[d0],0,0,0);
    o[d0]=__builtin_amdgcn_mfma_f32_32x32x16_bf16(pa3,PK(3),o[d0],0,0,0);
    #undef PK
  }
}

#ifndef ATTN_STORE16
#define ATTN_STORE16(p,v) (*(u32x4*)(p)=(v))
#endif
template<int THRL,bool BMODE> __device__ __forceinline__ void attn_unit(const bf16*Qu,const bf16*__restrict__ Kh,const bf16*__restrict__ Vh,bf16*Ou,const int NT,const int nfirst,const int first0,const int second0,const int qg,const float*rpbh,char*shm,const int wave_sgpr,
    const bool kpre,const bf16*__restrict__ Kh_next,const int nx_nfirst,const int nx_first0,const int nx_second0){
  int ln_=(int)__builtin_amdgcn_mbcnt_hi(~0u,__builtin_amdgcn_mbcnt_lo(~0u,0u)); asm volatile("":"+v"(ln_));
  const int wid=wave_sgpr,lane=ln_,tid=wid*64+lane,r32=lane&31,hi=lane>>5;
  const bf16*Qw=Qu+(long)(wid*QBLK)*DM;
  const unsigned lds0=(unsigned)(uintptr_t)shm;
  float*wsf=(float*)(shm+LDS_WS)+wid*64;
  const bf16*ksrc=Kh+(long)lane*DM+wid*8;
  const bf16*vsrc=Vh+(long)(16*(wid&3)+(lane>>2))*DM+(wid>>2)*32+(lane&3)*8;
  const unsigned kdst=lds0+LDS_K+wid*1024, vdst=lds0+LDS_V+wid*1024;
  #define TILE(t) (((t)<nfirst)?(first0+(t)):(second0+(t)-nfirst))
  #define DMA_K(t,slot) glds16(ksrc+(long)TILE(t)*KVBLK*DM,(unsigned)__builtin_amdgcn_readfirstlane(kdst+(slot)))
  #define DMA_V(t,slot) glds16(vsrc+(long)TILE(t)*KVBLK*DM,(unsigned)__builtin_amdgcn_readfirstlane(vdst+(slot)))
  const int vb0=(int)(lds0+LDS_V)+((lane>>4)&1)*32+(lane&3)*8+(4*hi+((lane&15)>>2))*64;
  const char*Kbase=shm+LDS_K; bf16x8 kf[8];
  const lds_cptr shm3=(lds_cptr)shm; const lds_cptr kp0=shm3+LDS_K+hi*1024+r32*16; const lds_cptr vp0=shm3+LDS_V+((lane>>4)&1)*32+(lane&3)*8+(4*hi+((lane&15)>>2))*64;
  unsigned bm0=0u,bm1=0u; int blane=0,bqr=0,brs=0;
  if constexpr(BMODE){ const int qc=(wid&1)*32+r32; int cs=qc-8; cs=cs<0?0:(cs>48?48:cs);
    _Pragma("unroll") for(int r=0;r<16;++r){ const int kc=(r&3)+8*(r>>2)+4*hi; bm0|=(kc>=cs&&kc<cs+16)?(1u<<r):0u; bm1|=(kc+32>=cs&&kc+32<cs+16)?(1u<<r):0u; }
    blane=(BT_PAD+15-qc+4*hi)*4; bqr=qg+(wid>>1); brs=bqr-4; brs=brs<0?0:(brs>24?24:brs);
    __attribute__((address_space(3))) float*bt=(__attribute__((address_space(3))) float*)(shm3+LDS_BT); for(int idx=tid;idx<15*BT_STRIDE;idx+=NW*64){ const int dr=idx/BT_STRIDE,j=idx%BT_STRIDE; bt[idx]=(j>=BT_PAD&&j<=BT_PAD+30)?rpbh[dr*31+j-BT_PAD]*1.4426950408889634f:0.f; } }
  if(!kpre){ DMA_K(0,0);DMA_V(0,0);DMA_K(1,SLOTB); }
  bf16x8 qr[4];
  #pragma unroll
  for(int d0=0;d0<4;++d0)qr[d0]=*reinterpret_cast<const bf16x8*>(&Qw[(long)r32*DM+d0*16+hi*8]);
  float mhat=0.f,l_reg=0.f;f32x16 o[2];o[0]=f32x16{};o[1]=f32x16{};f32x16 negm=f32x16{}; if constexpr(!BMODE){asm volatile("":"+v"(negm));}
  #define CMASK(P0,P1,t) do{ if constexpr(BMODE){ if((t)>=nfirst){ const int kr_=second0+(t)-nfirst; const bool rv_=(kr_>=brs)&&(kr_<brs+8); int dr_=kr_-bqr+7; dr_=dr_<0?0:(dr_>14?14:dr_); \
      bias_apply(P0,P1,shm3+LDS_BT+dr_*(BT_STRIDE*4)+blane,rv_?bm0:0u,rv_?bm1:0u,mhat); } else { _Pragma("unroll") for(int r_=0;r_<16;++r_){P0[r_]-=mhat;P1[r_]-=mhat;} } } }while(0)
  bool resc=false;
  #define START(P0,P1) do{ const float rm=rowmax(P0,P1); resc=false; \
    { const float dl=rm; mhat=fadd_s(mhat,dl); \
      _Pragma("unroll") for(int r=0;r<16;++r){P0[r]=fsub_s(P0[r],dl);P1[r]=fsub_s(P1[r],dl);} \
      if constexpr(!BMODE){ _Pragma("unroll") for(int r=0;r<16;++r)negm[r]=-mhat; asm volatile("":"+v"(negm)); } } \
    _Pragma("unroll") for(int r=0;r<16;++r)P0[r]=__builtin_amdgcn_exp2f(P0[r]); }while(0)
  #define RESC() do{ if(resc){ asm volatile("s_waitcnt lgkmcnt(0)":::"memory"); \
      _Pragma("unroll") for(int d_=0;d_<2;++d_) _Pragma("unroll") for(int r=0;r<16;++r)o[d_][r]*=wsf[crow(r,hi)]; } }while(0)
  f32x16 pA0,pA1,pB0,pB1;
  int sl_prev=0,sl_cur=0,sl_next=SLOTB;
  #define ROT() do{sl_prev=sl_cur;sl_cur=sl_next;sl_next=(sl_next==(NSLOT-1)*SLOTB)?0:sl_next+SLOTB;}while(0)
  if(!kpre){ DMA_K(2,2*SLOTB);
    WAIT_BAR(3); }
  else { DMA_V(0,0); WAIT_BAR(1); }
  qkt(pA0,pA1,Kbase,qr,cinit<BMODE>(negm),r32,hi);asm volatile("s_nop 15\n\ts_nop 7":"+v"(pA0),"+v"(pA1));CMASK(pA0,pA1,0);
  START(pA0,pA1);
  _Pragma("unroll") for(int r=0;r<16;++r)pA1[r]=__builtin_amdgcn_exp2f(pA1[r]);
  WAIT_BAR(0);
  DMA_K(3,0);DMA_V(1,SLOTB);
  ROT();
  kload8(kf,kp0+sl_cur);
  WAIT_BAR(2);
  s16x4 vlo[8],vhi[8]; u32x4 pw0,pw1,pw2,pw3;
  #define PKW(P,B) cvtpk_s(P[B],P[B+1])
  #define PAF(k) __builtin_bit_cast(bf16x8,pw##k)
  #define VFR(i) (bf16x8){vlo[i][0],vlo[i][1],vlo[i][2],vlo[i][3],vhi[i][0],vhi[i][1],vhi[i][2],vhi[i][3]}
  #define PIN(x) asm volatile("":"+v"(x))
  #define MX3(a,b,c) __builtin_fmaxf(__builtin_fmaxf((a),(b)),(c))
  #define GAPA(MF,A0,A1,A2,A3,W0,W1,PW) do{ MF; sacc+=A0; sacc+=A1; sacc+=A2; sacc+=A3; PIN(sacc); W0; W1; PIN(PW); SBAR(); }while(0)
  #define EX(v) __builtin_amdgcn_exp2f(v)
  #define GAPB(MF,X,B) do{ MF; X[B]=EX(X[B]); X[B+1]=EX(X[B+1]); X[B+2]=EX(X[B+2]); X[B+3]=EX(X[B+3]); PIN(X); SBAR(); }while(0)
  #define VRD(i) do{ vlo[i]=vtr(vp_+(((i)>>2)*4096+((i)&3)*1024)); vhi[i]=vtr(vp_+(((i)>>2)*4096+((i)&3)*1024+512)); }while(0)
  #define KRD(G,j) do{ if(G){ kload2(kf,kp0+sl_next,j); SBAR(); } }while(0)
  #define STEP(C0,C1,P0,P1,t,GK,GV,GL) do{ SBAR(); \
    const lds_cptr vp_=vp0+sl_prev; \
    VRD(0); SBAR(); float sacc=(P0[0]+P0[1]); \
    GAPA(C0=__builtin_amdgcn_mfma_f32_32x32x16_bf16(kf[0],qr[0],cinit<BMODE>(negm),0,0,0), P0[2],P0[3],P0[4],P0[5],     pw0[0]=PKW(P0,0), pw0[1]=PKW(P0,2), pw0); \
    VRD(4); SBAR(); GAPA(C1=__builtin_amdgcn_mfma_f32_32x32x16_bf16(kf[1],qr[0],cinit<BMODE>(negm),0,0,0), P0[6],P0[7],P0[8],P0[9],     pw0[2]=PKW(P0,4), pw0[3]=PKW(P0,6), pw0); \
    VRD(1); SBAR(); GAPA(C0=__builtin_amdgcn_mfma_f32_32x32x16_bf16(kf[2],qr[1],C0,0,0,0),   P0[10],P0[11],P0[12],P0[13], pw1[0]=PKW(P0,8), pw1[1]=PKW(P0,10), pw1); \
    VRD(5); SBAR(); GAPA(C1=__builtin_amdgcn_mfma_f32_32x32x16_bf16(kf[3],qr[1],C1,0,0,0),   P0[14],P0[15],P1[0],P1[1],   pw1[2]=PKW(P0,12),pw1[3]=PKW(P0,14), pw1); \
    VRD(2); SBAR(); GAPA(C0=__builtin_amdgcn_mfma_f32_32x32x16_bf16(kf[4],qr[2],C0,0,0,0),   P1[2],P1[3],P1[4],P1[5],     pw2[0]=PKW(P1,0), pw2[1]=PKW(P1,2), pw2); \
    VRD(6); SBAR(); GAPA(C1=__builtin_amdgcn_mfma_f32_32x32x16_bf16(kf[5],qr[2],C1,0,0,0),   P1[6],P1[7],P1[8],P1[9],     pw2[2]=PKW(P1,4), pw2[3]=PKW(P1,6), pw2); \
    VRD(3); SBAR(); GAPA(C0=__builtin_amdgcn_mfma_f32_32x32x16_bf16(kf[6],qr[3],C0,0,0,0),   P1[10],P1[11],P1[12],P1[13], pw3[0]=PKW(P1,8), pw3[1]=PKW(P1,10), pw3); \
    VRD(7); SBAR(); GAPA(C1=__builtin_amdgcn_mfma_f32_32x32x16_bf16(kf[7],qr[3],C1,0,0,0),   P1[14],P1[15],0.f,0.f,       pw3[2]=PKW(P1,12),pw3[3]=PKW(P1,14), pw3); \
    l_reg+=sacc; \
    if(GK){DMA_K((t)+3,sl_cur);} if(GV){DMA_V((t)+1,sl_next);} \
    CMASK(C0,C1,t); \
    { float a=MX3(C0[0],C0[1],C1[0]),b=MX3(C0[2],C0[3],C1[1]); a=MX3(a,C1[2],C1[3]); \
      _Pragma("unroll") for(int r=4;r<16;r+=4){a=MX3(a,C0[r],C0[r+1]);b=MX3(b,C0[r+2],C0[r+3]);a=MX3(a,C1[r],C1[r+1]);b=MX3(b,C1[r+2],C1[r+3]);} \
      float rm=__builtin_fmaxf(a,b); { auto rr=__builtin_amdgcn_permlane32_swap(__float_as_uint(rm),__float_as_uint(rm),false,false); rm=__builtin_fmaxf(__uint_as_float(rr[0]),__uint_as_float(rr[1])); } \
      resc=false; \
      if(__builtin_expect(__any(rm>(float)THRL),0)){ const float dl=__builtin_fmaxf(rm,0.f); mhat+=dl; \
        _Pragma("unroll") for(int r=0;r<16;++r){C0[r]-=dl;C1[r]-=dl;} \
        if constexpr(!BMODE){ _Pragma("unroll") for(int r=0;r<16;++r)negm[r]=-mhat; asm volatile("":"+v"(negm)); } \
        const float f=__builtin_amdgcn_exp2f(-dl); l_reg*=f; if(hi==0)wsf[r32]=f; resc=true; } } \
    SBAR(); \
    GAPB(o[0]=__builtin_amdgcn_mfma_f32_32x32x16_bf16(PAF(0),VFR(0),o[0],0,0,0), C0,0); \
    GAPB(o[1]=__builtin_amdgcn_mfma_f32_32x32x16_bf16(PAF(0),VFR(4),o[1],0,0,0), C0,4); \
    KRD(GL,0); GAPB(o[0]=__builtin_amdgcn_mfma_f32_32x32x16_bf16(PAF(1),VFR(1),o[0],0,0,0), C0,8); \
    KRD(GL,1); GAPB(o[1]=__builtin_amdgcn_mfma_f32_32x32x16_bf16(PAF(1),VFR(5),o[1],0,0,0), C0,12); \
    KRD(GL,2); GAPB(o[0]=__builtin_amdgcn_mfma_f32_32x32x16_bf16(PAF(2),VFR(2),o[0],0,0,0), C1,0); \
    KRD(GL,3); GAPB(o[1]=__builtin_amdgcn_mfma_f32_32x32x16_bf16(PAF(2),VFR(6),o[1],0,0,0), C1,4); \
    GAPB(o[0]=__builtin_amdgcn_mfma_f32_32x32x16_bf16(PAF(3),VFR(3),o[0],0,0,0), C1,8); \
    GAPB(o[1]=__builtin_amdgcn_mfma_f32_32x32x16_bf16(PAF(3),VFR(7),o[1],0,0,0), C1,12); \
    }while(0)
  int t=1;
  for(;t+5<NT;t+=2){
    STEP(pB0,pB1,pA0,pA1,t,true,true,true);     WAIT_BAR(2); RESC(); ROT();
    STEP(pA0,pA1,pB0,pB1,t+1,true,true,true);   WAIT_BAR(2); RESC(); ROT();
  }
  #define ENDW(tt) do{ if((tt)+3<NT){WAIT_BAR(2);} else if((tt)+2<NT){WAIT_BAR(1);} else {WAIT_BAR(0);} }while(0)
  for(;t+1<NT;t+=2){
    STEP(pB0,pB1,pA0,pA1,t,(t+3<NT),(t+1<NT),(t+1<NT));       ENDW(t);   RESC(); ROT();
    STEP(pA0,pA1,pB0,pB1,t+1,(t+4<NT),(t+2<NT),(t+2<NT));     ENDW(t+1); RESC(); ROT();
  }
  STEP(pB0,pB1,pA0,pA1,NT-1,false,false,false); RESC();
  if(Kh_next){ const bf16*kn=Kh_next+(long)lane*DM+wid*8;
    _Pragma("unroll") for(int t_=0;t_<3;++t_){ const int tl_=(t_<nx_nfirst)?(nx_first0+t_):(nx_second0+t_-nx_nfirst); glds16(kn+(long)tl_*KVBLK*DM,(unsigned)__builtin_amdgcn_readfirstlane(kdst+t_*SLOTB)); } }
  { float sacc=pB0[0]+pB0[1]; _Pragma("unroll") for(int r=2;r<16;++r)sacc+=pB0[r]; _Pragma("unroll") for(int r=0;r<16;++r)sacc+=pB1[r]; l_reg+=sacc;
    pw0=(u32x4){PKW(pB0,0),PKW(pB0,2),PKW(pB0,4),PKW(pB0,6)};pw1=(u32x4){PKW(pB0,8),PKW(pB0,10),PKW(pB0,12),PKW(pB0,14)};pw2=(u32x4){PKW(pB1,0),PKW(pB1,2),PKW(pB1,4),PKW(pB1,6)};pw3=(u32x4){PKW(pB1,8),PKW(pB1,10),PKW(pB1,12),PKW(pB1,14)};
    SBAR(); pv(o,vb0+sl_cur,PAF(0),PAF(1),PAF(2),PAF(3)); }
  #undef PKW
  #undef PAF
  #undef VFR
  #undef PIN
  #undef MX3
  #undef GAPA
  #undef GAPB
  #undef EX
  #undef VRD
  #undef KRD
  #undef STEP
  #undef ENDW
  {auto rr=__builtin_amdgcn_permlane32_swap(__float_as_uint(l_reg),__float_as_uint(l_reg),false,false);l_reg=__uint_as_float(rr[0])+__uint_as_float(rr[1]);}
  if(hi==0)wsf[32+r32]=l_reg;asm volatile("s_waitcnt lgkmcnt(0)":::"memory");
  float rli[16];
  #pragma unroll
  for(int r=0;r<16;++r)rli[r]=__builtin_amdgcn_rcpf(wsf[32+crow(r,hi)]);
  bf16*Ow=Ou+(long)(wid*QBLK)*DM;
  { bf16*stg=(bf16*)(shm+LDS_OST)+wid*2048;
    #pragma unroll
    for(int r=0;r<16;++r){const int orow=crow(r,hi);
      #pragma unroll
      for(int d0=0;d0<2;++d0)stg[orow*64+d0*32+r32]=__float2bfloat16(o[d0][r]*rli[r]);}
    asm volatile("s_waitcnt lgkmcnt(0)":::"memory");
    #pragma unroll
    for(int i=0;i<4;++i){const int row=i*8+(lane>>3),ch=lane&7; const u32x4 v=*(const u32x4*)(stg+row*64+ch*8); ATTN_STORE16(Ow+(long)row*DM+ch*8,v);} }
  asm volatile("s_waitcnt lgkmcnt(0)\n\ts_barrier":::"memory");
  #undef TILE
  #undef DMA_K
  #undef DMA_V
  #undef CMASK
  #undef START
  #undef RESC
  #undef ROT
}
constexpr int ATTN_LDS_BYTES=LDS_BT+15*BT_STRIDE*4;
#undef SBAR
#undef WAIT_BAR
}
#define XB_TMO      128
#define XB_XCNT(j)  (256  + 64 * (j))
#define XB_XSUB(j)  (1280 + 64 * (j))
#define XB_XGEN(j)  (2304 + 64 * (j))
#define XB_TOP      3328
#define XB_TOPGEN   3392
#define XCD_BAR_WORDS 3456
#define XB_SPIN_CAP (1u << 18)

__device__ __forceinline__ unsigned xb_ld(unsigned* p)              { return __hip_atomic_load(p, __ATOMIC_RELAXED, __HIP_MEMORY_SCOPE_AGENT); }
__device__ __forceinline__ unsigned xb_add(unsigned* p, unsigned v) { return __hip_atomic_fetch_add(p, v, __ATOMIC_RELAXED, __HIP_MEMORY_SCOPE_AGENT); }
__device__ __forceinline__ unsigned xb_xcc_id() { return (unsigned)__builtin_amdgcn_s_getreg((3 << 11) | 20) & 0xFu; }
#define XB_SPIN(cond, bar) do { unsigned _sp = 0; while (cond) { __builtin_amdgcn_s_sleep(1); \
    if ((++_sp & 255u) == 0u) { if (xb_ld(&(bar)[XB_TMO])) break; if (_sp > XB_SPIN_CAP) { atomicAdd(&(bar)[XB_TMO], 1u); break; } } } } while (0)

struct XcdBarrier {
    unsigned* bar; unsigned x;
    volatile LAS unsigned* st;
};

__device__ __forceinline__ XcdBarrier xcd_barrier_post(unsigned* bar, volatile LAS unsigned* st) {
    XcdBarrier b; b.bar = bar; b.x = xb_xcc_id(); b.st = st;
    if (threadIdx.x == 0) (void)xb_add(&bar[XB_XCNT(b.x)], 1u);
    return b;
}
__device__ __forceinline__ void xcd_barrier_complete(unsigned* bar, unsigned x, unsigned& nloc, unsigned& nx) {
    const unsigned G = gridDim.x * gridDim.y * gridDim.z;
    unsigned sum, cnt, mine, sp = 0u;
    for (;;) {
        sum = 0u; cnt = 0u; mine = 0u;
#pragma unroll
        for (unsigned j = 0; j < 16; ++j) { const unsigned c = xb_ld(&bar[XB_XCNT(j)]); sum += c; cnt += (c > 0u) ? 1u : 0u; mine = (j == x) ? c : mine; }
        if (sum == G) break;
        __builtin_amdgcn_s_sleep(1);
        if ((++sp & 255u) == 0u) { if (xb_ld(&bar[XB_TMO])) break; if (sp > XB_SPIN_CAP) { atomicAdd(&bar[XB_TMO], 1u); break; } }
    }
    nloc = mine > 0u ? mine : 1u; nx = cnt > 0u ? cnt : 1u;
}

__device__ __forceinline__ void xcd_barrier(const XcdBarrier& b) {
    asm volatile("s_waitcnt vmcnt(0)" ::: "memory");
    __syncthreads();
    if (threadIdx.x == 0) {
        unsigned* bar = b.bar;
        __builtin_amdgcn_s_waitcnt(0);
        unsigned nloc = b.st[0], nx = b.st[1];
        if (nloc == 0u) { xcd_barrier_complete(bar, b.x, nloc, nx); b.st[0] = nloc; b.st[1] = nx; }
        const unsigned old = xb_add(&bar[XB_XSUB(b.x)], 1u);
        const unsigned gen = old / nloc;
        if (old + 1u == (gen + 1u) * nloc) {
            __builtin_amdgcn_fence(__ATOMIC_RELEASE, "agent");
            asm volatile("s_waitcnt vmcnt(0)" ::: "memory");
            const unsigned og = xb_add(&bar[XB_TOP], 1u);
            const unsigned tg = og / nx;
            if (og + 1u == (tg + 1u) * nx) xb_add(&bar[XB_TOPGEN], 1u);
            else XB_SPIN(xb_ld(&bar[XB_TOPGEN]) == tg, bar);
            __builtin_amdgcn_fence(__ATOMIC_ACQUIRE, "agent");
            xb_add(&bar[XB_XGEN(b.x)], 1u);
            asm volatile("s_waitcnt vmcnt(0)" ::: "memory");
        } else {
            XB_SPIN(xb_ld(&bar[XB_XGEN(b.x)]) == gen, bar);
            __builtin_amdgcn_fence(__ATOMIC_ACQUIRE, "agent");
            asm volatile("s_waitcnt vmcnt(0)" ::: "memory");
        }
    }
    __syncthreads();
}

struct Frame {
    LAS unsigned char* lds;
    volatile LAS unsigned* MISC;
    unsigned* ctl;
    int tid, lane, wave, vcu, G;
    float* out; unsigned char* ws;
};
__device__ __forceinline__ const float* inp(const Frame& F, int i) {
    unsigned long long a_ = (unsigned long long)__builtin_amdgcn_kernarg_segment_ptr(); asm volatile("" : "+s"(a_));
    return (const float*)(((const __attribute__((address_space(4))) unsigned long long*)a_)[i]);
}
enum { I_X = 0, I_C, I_CTX, I_CCTX, I_WMOD, I_BMOD, I_WIN, I_GQA, I_GKA, I_GQB, I_GKB, I_RPB, I_CONVW, I_CONVB, I_GOUT, I_WOUT, I_F1, I_F3, I_F2, I_ROUTER, I_ROUTERB, I_M1, I_M3, I_M2 };

struct CvItem { const float* src; unsigned char* dst; int N, K, orow0, k0; };
__device__ __forceinline__ CvItem cv_item(const float* W, int K, int N, void* WT, int il, int half, int item) {
    const int nblk = N / 64, kb = item / nblk, nb = item % nblk, k0 = 64 * kb, n0 = 64 * nb;
    CvItem it; it.src = W + (size_t)k0 * N + n0; it.dst = (unsigned char*)WT; it.N = N; it.K = K; it.k0 = k0; it.orow0 = il ? ((n0 >> 7) * 256 + half * 128 + (n0 & 127)) : n0; return it;
}
__device__ __forceinline__ void cv_load(f32x4 (&v)[16], const CvItem& it, int lane) {
    const float* src = it.src + (size_t)(lane >> 4) * it.N + 4 * (lane & 15);
#pragma unroll
    for (int i = 0; i < 16; ++i) v[i] = __builtin_nontemporal_load((const GAS f32x4*)(src + (size_t)(4 * i) * it.N));
}
__device__ __forceinline__ void cv_to_lds(const f32x4 (&v)[16], LAS float* scr, int lane) {
#pragma unroll
    for (int i = 0; i < 16; ++i) { LAS float* d = scr + (4 * i + (lane >> 4)) * 65 + 4 * (lane & 15); d[0] = v[i].x; d[1] = v[i].y; d[2] = v[i].z; d[3] = v[i].w; }
    LDS_WAIT(); asm volatile("" ::: "memory");
}
template <bool F8> __device__ __forceinline__ void cv_finish(const CvItem& it, LAS float* scr, int lane) {
    const int c = lane & 7;
#pragma unroll
    for (int j = 0; j < 8; ++j) { const int n = (lane >> 3) + 8 * j; const LAS float* s = scr + (8 * c) * 65 + n;
        if constexpr (F8) { v2u o; o.x = pk4_f8(s[0 * 65] * 64.f, s[1 * 65] * 64.f, s[2 * 65] * 64.f, s[3 * 65] * 64.f); o.y = pk4_f8(s[4 * 65] * 64.f, s[5 * 65] * 64.f, s[6 * 65] * 64.f, s[7 * 65] * 64.f);
            __builtin_nontemporal_store(o, (GAS v2u*)(it.dst + (size_t)(it.orow0 + n) * it.K + it.k0 + 8 * c)); }
        else { v4u o; o.x = pk2(s[0 * 65], s[1 * 65]); o.y = pk2(s[2 * 65], s[3 * 65]); o.z = pk2(s[4 * 65], s[5 * 65]); o.w = pk2(s[6 * 65], s[7 * 65]);
            *(GAS v4u*)((bf16*)it.dst + (size_t)(it.orow0 + n) * it.K + it.k0 + 8 * c) = o; } }
    LDS_WAIT(); asm volatile("" ::: "memory");
}
__device__ __forceinline__ float silu_f(float v) { return v / (1.0f + __expf(-v)); }

constexpr int CV_IT_IN = 16 * 36, CV_IT_OUT = 16 * 16, CV_IT_F = 704, CV_DENSE_ITEMS = 2 * CV_IT_IN + 2 * CV_IT_OUT + 3 * CV_IT_F, CV_MOE_ITEMS = 24 * CV_IT_F;
__device__ __forceinline__ CvItem cv_dense_item(Frame& F, int r) {
    if (r < 2 * CV_IT_IN) { const int l = r / CV_IT_IN; return cv_item(inp(F, I_WIN) + (size_t)l * 1024 * INW, 1024, INW, (bf16*)(F.ws + WS_WIN) + (size_t)l * INW * 1024, 0, 0, r % CV_IT_IN); } r -= 2 * CV_IT_IN;
    if (r < 2 * CV_IT_OUT) { const int l = r / CV_IT_OUT; return cv_item(inp(F, I_WOUT) + (size_t)l * 1024 * 1024, 1024, 1024, (bf16*)(F.ws + WS_WOUT) + (size_t)l * 1024 * 1024, 0, 0, r % CV_IT_OUT); } r -= 2 * CV_IT_OUT;
    if (r < CV_IT_F) return cv_item(inp(F, I_F1), 1024, DFF, F.ws + WS_F13, 1, 0, r); r -= CV_IT_F;
    if (r < CV_IT_F) return cv_item(inp(F, I_F3), 1024, DFF, F.ws + WS_F13, 1, 1, r); r -= CV_IT_F;
    return cv_item(inp(F, I_F2), DFF, 1024, F.ws + WS_F2, 0, 0, r);
}
__device__ __forceinline__ void p0_prologue(Frame& F) {
    const int gw = F.vcu * NWAVES + F.wave, NGW = F.G * NWAVES;
    if ((int)blockIdx.x == (F.G > 192 ? F.G - 1 : 0)) {
        float* tab = (float*)(F.ws + WS_MISC + MS_ROPE);
        for (int idx = F.tid; idx < 1024; idx += NWAVES * 64) { const int pos = idx >> 4, i = idx & 15;
            const float inv = powf(10000.0f, -(float)(2 * i) / 32.0f); const float ang = (float)pos * inv;
            tab[2 * idx] = cosf(ang); tab[2 * idx + 1] = sinf(ang); }
    }
    {
        LAS float* sv = (LAS float*)F.lds;
        LAS float* red = (LAS float*)(F.lds + 17 * 1024 * 4);
        bool staged = false;
        for (int task = blockIdx.x; task < 192; task += F.G) {
            if (!staged) {
                { const float* cp_ = inp(F, I_C); const float* ccp_ = inp(F, I_CCTX); float tv_[34];
#pragma unroll
                  for (int q = 0; q < 34; ++q) { const int k = F.tid + 512 * (q & 1); tv_[q] = q < 32 ? cp_[(q >> 1) * 1024 + k] : ccp_[k]; }
#pragma unroll
                  for (int q = 0; q < 34; ++q) { const float v = tv_[q]; sv[F.tid + 512 * q] = v * __builtin_amdgcn_rcpf(1.0f + __builtin_amdgcn_exp2f(-1.4426950408889634f * v)); } }
                staged = true; __syncthreads();
            }
            const int l = task / 96, cb = task % 96, col = cb * 64 + F.lane;
            const float* W = inp(F, I_WMOD) + (size_t)l * 1024 * 6144 + col;
            float acc[17];
#pragma unroll
            for (int r = 0; r < 17; ++r) acc[r] = 0.f;
            const int kbeg = F.wave * 128;
#pragma unroll 8
            for (int k = kbeg; k < kbeg + 128; ++k) { const float wv = W[(size_t)k * 6144];
#pragma unroll
                for (int r = 0; r < 17; ++r) acc[r] += sv[r * 1024 + k] * wv; }
#pragma unroll
            for (int r = 0; r < 17; ++r) red[(F.wave * 17 + r) * 64 + F.lane] = acc[r];
            __syncthreads();
            for (int idx = F.tid; idx < 17 * 64; idx += NWAVES * 64) { const int r = idx >> 6, ln = idx & 63; float s = 0.f;
#pragma unroll
                for (int w = 0; w < 8; ++w) s += red[(w * 17 + r) * 64 + ln];
                const int n = cb * 64 + ln;
                ((float*)(F.ws + WS_MOD))[((size_t)l * 17 + r) * 6144 + n] = s + inp(F, I_BMOD)[l * 6144 + n]; }
            __syncthreads();
        }
        __syncthreads();
    }
    {
        LAS float* scr = (LAS float*)(F.lds + F.wave * 17408);
        constexpr int CV_PRO = 2 * CV_IT_IN + 2 * CV_IT_OUT;
        const int nfree = F.G > 192 ? F.G - 192 : 0; int NA = nfree >= 32 ? nfree * NWAVES * 5 : 0; NA = NA < CV_PRO ? NA : CV_PRO;
        int it, end, step; bool second;
        if (NA > 0 && (int)blockIdx.x >= 192) { it = ((int)blockIdx.x - 192) * NWAVES + F.wave; end = NA; step = nfree * NWAVES; second = false; }
        else { it = NA + gw; end = CV_PRO; step = NGW; second = true; }
        if (it >= end && !second) { it = NA + gw; end = CV_PRO; step = NGW; second = true; }
        f32x4 v[16];
        if (it < end) cv_load(v, cv_dense_item(F, it), F.lane);
        while (it < end) {
            const CvItem cur = cv_dense_item(F, it); const bool f8 = it >= 2 * CV_IT_IN + 2 * CV_IT_OUT;
            cv_to_lds(v, scr, F.lane);
            it += step;
            if (it >= end && !second) { it = NA + gw; end = CV_PRO; step = NGW; second = true; }
            if (it < end) cv_load(v, cv_dense_item(F, it), F.lane);
            if (f8) cv_finish<true>(cur, scr, F.lane); else cv_finish<false>(cur, scr, F.lane);
        }
    }
}
__device__ __forceinline__ CvItem cv_moe_item(Frame& F, int r) {
    constexpr int IT_F = 704;
    const int e = r / (3 * IT_F), q = r % (3 * IT_F), which = q / IT_F, item = q % IT_F;
    if (which == 0) return cv_item(inp(F, I_M1) + (size_t)e * 1024 * DFF, 1024, DFF, F.ws + WS_M13 + (size_t)e * 5632 * 1024, 1, 0, item);
    if (which == 1) return cv_item(inp(F, I_M3) + (size_t)e * 1024 * DFF, 1024, DFF, F.ws + WS_M13 + (size_t)e * 5632 * 1024, 1, 1, item);
    return cv_item(inp(F, I_M2) + (size_t)e * DFF * 1024, DFF, 1024, F.ws + WS_M2 + (size_t)e * 1024 * DFF, 0, 0, item);
}
__device__ __forceinline__ void convert_moe_weights(Frame& F, int first, int end, int step) {
    LAS float* scr = (LAS float*)(F.lds + F.wave * 17408);
    f32x4 v[16]; int it = first;
    if (it < end) cv_load(v, cv_moe_item(F, it), F.lane);
    while (it < end) {
        const CvItem cur = cv_moe_item(F, it);
        cv_to_lds(v, scr, F.lane);
        it += step; if (it < end) cv_load(v, cv_moe_item(F, it), F.lane);
        cv_finish<true>(cur, scr, F.lane);
    }
}

__device__ __forceinline__ void convert_dense_ffn(Frame& F, int first, int end, int step) {
    LAS float* scr = (LAS float*)(F.lds + F.wave * 17408);
    f32x4 v[16]; int it = first;
    if (it < end) cv_load(v, cv_dense_item(F, it), F.lane);
    while (it < end) {
        const CvItem cur = cv_dense_item(F, it);
        cv_to_lds(v, scr, F.lane);
        it += step; if (it < end) cv_load(v, cv_dense_item(F, it), F.lane);
        cv_finish<true>(cur, scr, F.lane);
    }
}
__device__ __forceinline__ void tail_convert(Frame& F, int nunits, int lo, int hi, int dlo = 0, int dhi = 0) {
    const int rounds = (nunits + F.G - 1) / F.G, full = nunits - (rounds - 1) * F.G, c = (int)blockIdx.x;
    if (full >= F.G) { if (MK_N_LAUNCHES != 1) convert_moe_weights(F, lo + F.vcu * NWAVES + F.wave, hi, F.G * NWAVES); else if (c == 0) {   } return; }
    if (c >= full) { __syncthreads(); if (dhi > dlo) convert_dense_ffn(F, 2 * CV_IT_IN + 2 * CV_IT_OUT + dlo + (c - full) * NWAVES + F.wave, 2 * CV_IT_IN + 2 * CV_IT_OUT + dhi, (F.G - full) * NWAVES); convert_moe_weights(F, lo + (c - full) * NWAVES + F.wave, hi, (F.G - full) * NWAVES); }
}
constexpr int CV_S1 = 4275, CV_S2 = CV_S1 + 2565, CV_S3 = CV_S2 + 1550, CV_S4 = CV_MOE_ITEMS - 3000;

__device__ __forceinline__ const float* xrow_ptr(const float* lat, const float* ctx, int s) { const int b = s / TPB, j = s % TPB; return j < SEQ ? lat + (size_t)(b * SEQ + j) * DM : ctx + (size_t)(b * CTXL + j - SEQ) * DM; }

template <bool F8 = false> __device__ __forceinline__ void norm_mod_rows(Frame& F, const float* lat, const float* ctx, const float* mod, int shoff, int scoff, bf16* XN, bool with_ctx, bf16* XBo) {
    const int gw = F.vcu * NWAVES + F.wave, NGW = F.G * NWAVES;
    constexpr int R = 6;
    for (int s0 = gw * R; s0 < MROWS; s0 += NGW * R) {
        f32x4 v[R][4];
#pragma unroll
        for (int r = 0; r < R; ++r) { const GAS f32x4* xr = (const GAS f32x4*)xrow_ptr(lat, ctx, s0 + r) + F.lane;
#pragma unroll
            for (int q = 0; q < 4; ++q) v[r][q] = __builtin_nontemporal_load(xr + 64 * q); }
#pragma unroll
        for (int r = 0; r < R; ++r) { const int s = s0 + r, b = s / TPB, j = s % TPB;
            const float* mrow = mod + (size_t)(j < SEQ ? b : 16) * 6144;
            float ss = 0.f;
#pragma unroll
            for (int q = 0; q < 4; ++q) ss += (v[r][q].x * v[r][q].x + v[r][q].y * v[r][q].y) + (v[r][q].z * v[r][q].z + v[r][q].w * v[r][q].w);
            const float rstd = 1.0f / sqrtf(wave_sum(ss, F.lane) * (1.0f / DM) + NORM_EPS);
            GAS v2u* o8 = (GAS v2u*)(XN + (size_t)s * DM) + F.lane;
#pragma unroll
            for (int q = 0; q < 4; ++q) { const f32x4 sh = *(const f32x4*)(mrow + shoff + 4 * F.lane + 256 * q), sc = *(const f32x4*)(mrow + scoff + 4 * F.lane + 256 * q);
                const f32x4 y = v[r][q] * rstd * (sc + 1.0f) + sh;
                if constexpr (F8) ((GAS unsigned*)((unsigned char*)XN + (size_t)s * DM))[F.lane + 64 * q] = pk4_f8(y.x, y.y, y.z, y.w);
                else { v2u w; w.x = pk2(y.x, y.y); w.y = pk2(y.z, y.w); o8[64 * q] = w; }
                { v2u wx; wx.x = pk2(v[r][q].x, v[r][q].y); wx.y = pk2(v[r][q].z, v[r][q].w); ((GAS v2u*)(XBo + (size_t)s * DM) + F.lane)[64 * q] = wx; } } }
    }
}

__device__ __forceinline__ void unpack8(const v4u w, float (&v)[8]);
template <bool F8 = false> __device__ __forceinline__ void norm_mod_rows_bf(Frame& F, const bf16* XB, const float* mod, int shoff, int scoff, bf16* XN) {
    const int gw = F.vcu * NWAVES + F.wave, NGW = F.G * NWAVES;
    constexpr int R = 6;
    for (int s0 = gw * R; s0 < MROWS; s0 += NGW * R) {
        v4u w[R][2];
#pragma unroll
        for (int r = 0; r < R; ++r) { const GAS v4u* xr = (const GAS v4u*)(XB + (size_t)(s0 + r) * DM) + F.lane; w[r][0] = __builtin_nontemporal_load(xr); w[r][1] = __builtin_nontemporal_load(xr + 64); }
#pragma unroll
        for (int r = 0; r < R; ++r) { const int s = s0 + r, b = s / TPB, j = s % TPB;
            const float* mrow = mod + (size_t)(j < SEQ ? b : 16) * 6144;
            float v[2][8]; unpack8(w[r][0], v[0]); unpack8(w[r][1], v[1]);
            float ss = 0.f;
#pragma unroll
            for (int h = 0; h < 2; ++h)
#pragma unroll
                for (int i = 0; i < 8; ++i) ss += v[h][i] * v[h][i];
            const float rstd = 1.0f / sqrtf(wave_sum(ss, F.lane) * (1.0f / DM) + NORM_EPS);
#pragma unroll
            for (int h = 0; h < 2; ++h) { const int c0 = 512 * h + 8 * F.lane;
                const f32x4 sh0 = *(const f32x4*)(mrow + shoff + c0), sh1 = *(const f32x4*)(mrow + shoff + c0 + 4), sc0 = *(const f32x4*)(mrow + scoff + c0), sc1 = *(const f32x4*)(mrow + scoff + c0 + 4);
                float y[8];
#pragma unroll
                for (int i = 0; i < 4; ++i) { y[i] = v[h][i] * rstd * (sc0[i] + 1.0f) + sh0[i]; y[4 + i] = v[h][4 + i] * rstd * (sc1[i] + 1.0f) + sh1[i]; }
                if constexpr (F8) { v2u o; o.x = pk4_f8(y[0], y[1], y[2], y[3]); o.y = pk4_f8(y[4], y[5], y[6], y[7]); *((GAS v2u*)((unsigned char*)XN + (size_t)s * DM + c0)) = o; }
                else { v4u o; o.x = pk2(y[0], y[1]); o.y = pk2(y[2], y[3]); o.z = pk2(y[4], y[5]); o.w = pk2(y[6], y[7]);
                    *((GAS v4u*)(XN + (size_t)s * DM + c0)) = o; } } }
    }
}

__device__ __forceinline__ void headnorm_rows(Frame& F, int l, bool ctx_q) {
    const int gw = F.vcu * NWAVES + F.wave, NGW = F.G * NWAVES; bf16* P = (bf16*)(F.ws + WS_P);
    const float* tab = (const float*)(F.ws + WS_MISC + MS_ROPE);
    const int d = F.lane;
    const float gqa = inp(F, I_GQA)[l * 64 + d], gka = inp(F, I_GKA)[l * 64 + d], gqb = inp(F, I_GQB)[l * 64 + d], gkb = inp(F, I_GKB)[l * 64 + d];
    for (int s = gw; s < MROWS; s += NGW) {
        const int j = s % TPB; const bool lat = j < SEQ; bf16* p = P + (size_t)s * INW;
        float cs = 1.f, sn = 0.f;
        if (lat) { const int pos = (d < 32) ? (j >> 6) : (j & 63); const int i = d & 15; cs = tab[2 * (pos * 16 + i)]; sn = tab[2 * (pos * 16 + i) + 1]; }
        const float sgn = (d & 16) ? 1.f : -1.f;
#pragma unroll 1
        for (int h = 0; h < 18; ++h) {
            int off; float g; bool rope, isq;
            if (h < 8) { off = QA_OFF + 64 * h; g = gqa; rope = true; isq = true; }
            else if (h < 12) { off = QB_OFF + 64 * (h - 8); g = gqb; rope = false; isq = true; }
            else if (h < 14) { off = KA_OFF + 64 * (h - 12); g = gka; rope = true; isq = false; }
            else { off = KB_OFF + 64 * (h - 14); g = gkb; rope = false; isq = false; }
            if (isq && !lat && !ctx_q) continue;
            const float v = bf1(p[off + d]);
            const float ss = wave_sum(v * v, F.lane);
            float y = v * (1.0f / sqrtf(ss * (1.0f / 64.0f) + NORM_EPS)) * g;
            const float pr = xshfl(y, 16, F.lane);
            if (rope && lat) y = y * cs + sgn * pr * sn;
            if (isq) y *= C2;
            p[off + d] = (bf16)f2bf(y);
        }
    }
}

#ifdef ATTN_NAIVE
struct NaiveState { float q[64], o[64], m, l; };
__device__ __forceinline__ void na_load_q(NaiveState& S, const bf16* qp) {
#pragma unroll
    for (int c = 0; c < 8; ++c) { const v4u w = *(const v4u*)(qp + 8 * c);
        S.q[8 * c + 0] = bflo(w.x); S.q[8 * c + 1] = bfhi(w.x); S.q[8 * c + 2] = bflo(w.y); S.q[8 * c + 3] = bfhi(w.y);
        S.q[8 * c + 4] = bflo(w.z); S.q[8 * c + 5] = bfhi(w.z); S.q[8 * c + 6] = bflo(w.w); S.q[8 * c + 7] = bfhi(w.w); }
#pragma unroll
    for (int i = 0; i < 64; ++i) S.o[i] = 0.f;
    S.m = -1e30f; S.l = 0.f;
}
__device__ __forceinline__ float na_dot(const NaiveState& S, const bf16* kp) {
    float s = 0.f;
#pragma unroll
    for (int c = 0; c < 8; ++c) { const v4u w = *(const v4u*)(kp + 8 * c);
        s += S.q[8 * c + 0] * bflo(w.x) + S.q[8 * c + 1] * bfhi(w.x) + S.q[8 * c + 2] * bflo(w.y) + S.q[8 * c + 3] * bfhi(w.y)
           + S.q[8 * c + 4] * bflo(w.z) + S.q[8 * c + 5] * bfhi(w.z) + S.q[8 * c + 6] * bflo(w.w) + S.q[8 * c + 7] * bfhi(w.w); }
    return s;
}
__device__ __forceinline__ void na_acc(NaiveState& S, float p, const bf16* vp) {
#pragma unroll
    for (int c = 0; c < 8; ++c) { const v4u w = *(const v4u*)(vp + 8 * c);
        S.o[8 * c + 0] += p * bflo(w.x); S.o[8 * c + 1] += p * bfhi(w.x); S.o[8 * c + 2] += p * bflo(w.y); S.o[8 * c + 3] += p * bfhi(w.y);
        S.o[8 * c + 4] += p * bflo(w.z); S.o[8 * c + 5] += p * bfhi(w.z); S.o[8 * c + 6] += p * bflo(w.w); S.o[8 * c + 7] += p * bfhi(w.w); }
}
__device__ __forceinline__ void na_step2(NaiveState& S, float s0, float s1, const bf16* v0, const bf16* v1) {
    const float mn = fmaxf(S.m, fmaxf(s0, s1));
    const float sc = __builtin_amdgcn_exp2f(S.m - mn), p0 = __builtin_amdgcn_exp2f(s0 - mn), p1 = __builtin_amdgcn_exp2f(s1 - mn);
    S.l = S.l * sc + p0 + p1; S.m = mn;
#pragma unroll
    for (int i = 0; i < 64; ++i) S.o[i] *= sc;
    na_acc(S, p0, v0); na_acc(S, p1, v1);
}
__device__ __forceinline__ void na_store(const NaiveState& S, bf16* op) {
    const float inv = 1.0f / S.l;
#pragma unroll
    for (int c = 0; c < 8; ++c) { v4u w; w.x = pk2(S.o[8 * c + 0] * inv, S.o[8 * c + 1] * inv); w.y = pk2(S.o[8 * c + 2] * inv, S.o[8 * c + 3] * inv);
        w.z = pk2(S.o[8 * c + 4] * inv, S.o[8 * c + 5] * inv); w.w = pk2(S.o[8 * c + 6] * inv, S.o[8 * c + 7] * inv); *(v4u*)(op + 8 * c) = w; }
}
__device__ __forceinline__ void attn_naive_phase(Frame& F, int l, bool with_ctx) {
    const int gw = F.vcu * NWAVES + F.wave, NGW = F.G * NWAVES; bf16* P = (bf16*)(F.ws + WS_P);
    const float* rpb = inp(F, I_RPB) + (size_t)l * 4 * 15 * 31;
    const int ntask = with_ctx ? 6912 : 6144;
    for (int task = gw; task < ntask; task += NGW) {
        NaiveState S;
        if (task < 4096 || (task >= 6144 && task < 6656)) {
            int b, qh, j0, k0, k1;
            if (task < 4096) { b = task >> 8; qh = (task >> 5) & 7; j0 = (task & 31) * 64; k0 = 0; k1 = TPB; }
            else { const int t = task - 6144; b = t >> 5; qh = (t >> 2) & 7; j0 = SEQ + (t & 3) * 64; k0 = SEQ; k1 = TPB; }
            bf16* qp = P + (size_t)(b * TPB + j0 + F.lane) * INW + QA_OFF + qh * 64;
            na_load_q(S, qp);
            const bf16* Kb = P + (size_t)(b * TPB) * INW + KA_OFF + (qh >> 2) * 64; const bf16* Vb = P + (size_t)(b * TPB) * INW + VA_OFF + (qh >> 2) * 64;
            for (int k = k0; k < k1; k += 2) { const float s0 = na_dot(S, Kb + (size_t)k * INW), s1 = na_dot(S, Kb + (size_t)(k + 1) * INW); na_step2(S, s0, s1, Vb + (size_t)k * INW, Vb + (size_t)(k + 1) * INW); }
            na_store(S, qp);
        } else {
            int b, h, j; bool lat;
            if (task < 6144) { const int t = task - 4096; b = t >> 7; h = (t >> 5) & 3; j = (t & 31) * 64 + F.lane; lat = true; }
            else { const int t = task - 6656; b = t >> 4; h = (t >> 2) & 3; j = SEQ + (t & 3) * 64 + F.lane; lat = false; }
            bf16* qp = P + (size_t)(b * TPB + j) * INW + QB_OFF + h * 64;
            na_load_q(S, qp);
            const bf16* Kb = P + (size_t)(b * TPB) * INW + KB_OFF + h * 64; const bf16* Vb = P + (size_t)(b * TPB) * INW + VB_OFF + h * 64;
            if (lat) {
                const int r = j >> 6, c = j & 63; int rs = r - 4; rs = rs < 0 ? 0 : (rs > 24 ? 24 : rs); int cs = c - 8; cs = cs < 0 ? 0 : (cs > 48 ? 48 : cs);
                for (int i = 0; i < 8; ++i) { const int kr = rs + i; const float* brow = rpb + (h * 15 + (kr - r + 7)) * 31 + (15 - c);
                    for (int jc = 0; jc < 16; jc += 2) { const int kc = cs + jc; const int k = kr * 64 + kc;
                        const float s0 = na_dot(S, Kb + (size_t)k * INW) + brow[kc] * LOG2E, s1 = na_dot(S, Kb + (size_t)(k + 1) * INW) + brow[kc + 1] * LOG2E;
                        na_step2(S, s0, s1, Vb + (size_t)k * INW, Vb + (size_t)(k + 1) * INW); } }
            }
            for (int k = SEQ; k < TPB; k += 2) { const float s0 = na_dot(S, Kb + (size_t)k * INW), s1 = na_dot(S, Kb + (size_t)(k + 1) * INW); na_step2(S, s0, s1, Vb + (size_t)k * INW, Vb + (size_t)(k + 1) * INW); }
            na_store(S, qp);
        }
    }
}


#endif
__device__ __forceinline__ void attn_mfma_phase(Frame& F, int l, bool with_ctx, char* ldsg) {
    typedef attn_body::bf16 abf;
    abf* P = (abf*)(F.ws + WS_P); const int v = F.vcu;
    const int NA = 1024 + (with_ctx ? 192 : 0);
#define ATT_A_PARAMS(u, b, qcol, kcol, vcol, qrow, NT, first0) do { \
        if ((u) < 1024) { b = (u) >> 6; const int kvh_ = ((u) >> 5) & 1, qh_ = kvh_ * 4 + (((u) >> 3) & 3); qrow = ((u) & 7) * 256; qcol = QA_OFF + qh_ * 64; kcol = KA_OFF + kvh_ * 64; vcol = VA_OFF + kvh_ * 64; NT = 36; first0 = 0; } \
        else if ((u) < 1024 + 128) { const int t_ = (u) - 1024; b = t_ >> 3; const int qh_ = t_ & 7; qrow = SEQ; qcol = QA_OFF + qh_ * 64; kcol = KA_OFF + (qh_ >> 2) * 64; vcol = VA_OFF + (qh_ >> 2) * 64; NT = 4; first0 = 32; } \
        else { const int t_ = (u) - 1152; b = t_ >> 2; const int h_ = t_ & 3; qrow = SEQ; qcol = QB_OFF + h_ * 64; kcol = KB_OFF + h_ * 64; vcol = VB_OFF + h_ * 64; NT = 4; first0 = 32; } } while (0)
    bool kpre = false;
#pragma unroll 1
    for (int u = v; u < NA; u += F.G) {
        int b, qcol, kcol, vcol, qrow, NT, first0;
        ATT_A_PARAMS(u, b, qcol, kcol, vcol, qrow, NT, first0);
        abf* Qu = P + (size_t)(b * TPB + qrow) * INW + qcol; const abf* Kh = P + (size_t)(b * TPB) * INW + kcol; const abf* Vh = P + (size_t)(b * TPB) * INW + vcol;
        const int un = u + F.G; const abf* Kn = nullptr; int nNT = 4, nfirst0 = 0;
        if (un < NA) { int b2, qcol2, kcol2, vcol2, qrow2; ATT_A_PARAMS(un, b2, qcol2, kcol2, vcol2, qrow2, nNT, nfirst0); Kn = P + (size_t)(b2 * TPB) * INW + kcol2; }
        attn_body::attn_unit<8, false>(Qu, Kh, Vh, Qu, NT, NT, first0, 0, 0, nullptr, ldsg, F.wave, kpre, Kn, nNT, nfirst0, 0);
        kpre = Kn != nullptr;
    }
#undef ATT_A_PARAMS
#ifndef NO_BSITE
    const float* rpbl = inp(F, I_RPB) + (size_t)l * 4 * 15 * 31;
    kpre = false;
#pragma unroll 1
    for (int u = v; u < 512; u += F.G) {
        const int b = u >> 5, h = (u >> 3) & 3, qb = u & 7, qg = 4 * qb;
        const int n0 = (qb == 0 || qb == 7) ? 8 : 12, s0 = qb == 0 ? 0 : (qb == 7 ? 24 : qg - 4);
        abf* Qu = P + (size_t)(b * TPB + qb * 256) * INW + QB_OFF + h * 64; const abf* Kh = P + (size_t)(b * TPB) * INW + KB_OFF + h * 64; const abf* Vh = P + (size_t)(b * TPB) * INW + VB_OFF + h * 64;
        const int un = u + F.G; const abf* Kn = nullptr; int ns0 = 0;
        if (un < 512) { const int b2 = un >> 5, h2 = (un >> 3) & 3, qb2 = un & 7; ns0 = qb2 == 0 ? 0 : (qb2 == 7 ? 24 : 4 * qb2 - 4); Kn = P + (size_t)(b2 * TPB) * INW + KB_OFF + h2 * 64; }
        attn_body::attn_unit<8, true>(Qu, Kh, Vh, Qu, 4 + n0, 4, 32, s0, qg, rpbl + h * 15 * 31, ldsg, F.wave, kpre, Kn, 4, 32, ns0);
        kpre = Kn != nullptr;
    }
#endif
}

__device__ __forceinline__ void unpack8(const v4u w, float (&v)[8]) { v[0] = bflo(w.x); v[1] = bfhi(w.x); v[2] = bflo(w.y); v[3] = bfhi(w.y); v[4] = bflo(w.z); v[5] = bfhi(w.z); v[6] = bflo(w.w); v[7] = bfhi(w.w); }
__device__ __forceinline__ void merge_rows(Frame& F, int l, bool with_ctx) {
    const int gw = F.vcu * NWAVES + F.wave, NGW = F.G * NWAVES; const bf16* P = (const bf16*)(F.ws + WS_P); bf16* CAT = (bf16*)(F.ws + WS_XN);
    const float* gout = inp(F, I_GOUT) + l * 1024; const float* cw = inp(F, I_CONVW) + l * 3 * 256; const float* cb = inp(F, I_CONVB) + l * 256;
    const int lane = F.lane; const bool cl = lane >= 32; const int ch0 = 8 * (lane & 31);
    constexpr int R = 3;
    float gA[8], gB[8], cbv[8], cwv[3][8];
#pragma unroll
    for (int k = 0; k < 8; ++k) { gA[k] = gout[8 * lane + k]; gB[k] = gout[512 + 8 * lane + k]; cbv[k] = cb[ch0 + k];
#pragma unroll
        for (int tap = 0; tap < 3; ++tap) cwv[tap][k] = cw[tap * 256 + ch0 + k]; }
    for (int s0 = gw * R; s0 < MROWS; s0 += NGW * R) {
        if (!with_ctx && (s0 % TPB) >= SEQ) continue;
        v4u la[R], lb[R], lt[R][6]; bool tv[R][3];
#pragma unroll
        for (int r = 0; r < R; ++r) { const int s = s0 + r, j = s % TPB; const bool lat = j < SEQ; const bf16* p = P + (size_t)s * INW;
            la[r] = *(const v4u*)(p + 8 * lane);
            lb[r] = *(const v4u*)(p + (cl ? CPOST_OFF + ch0 : 512 + 8 * lane));
            const int jlo = lat ? 0 : SEQ, jhi = lat ? SEQ : TPB;
#pragma unroll
            for (int tap = 0; tap < 3; ++tap) { const int jj = j + tap - 1; tv[r][tap] = cl && jj >= jlo && jj < jhi;
                if (tv[r][tap]) { const bf16* pp = p + (ptrdiff_t)(tap - 1) * INW; lt[r][2 * tap] = *(const v4u*)(pp + CPRE_OFF + ch0); lt[r][2 * tap + 1] = *(const v4u*)(pp + CVAL_OFF + ch0); }
                else { lt[r][2 * tap] = (v4u){0u, 0u, 0u, 0u}; lt[r][2 * tap + 1] = (v4u){0u, 0u, 0u, 0u}; } } }
#pragma unroll
        for (int r = 0; r < R; ++r) { const int s = s0 + r;
            float va[8], vb[8];
            unpack8(la[r], va); unpack8(lb[r], vb);
            if (cl) { float y[8];
#pragma unroll
                for (int k = 0; k < 8; ++k) y[k] = cbv[k];
#pragma unroll
                for (int tap = 0; tap < 3; ++tap) { float a[8], c[8]; unpack8(lt[r][2 * tap], a); unpack8(lt[r][2 * tap + 1], c);
#pragma unroll
                    for (int k = 0; k < 8; ++k) y[k] += cwv[tap][k] * (a[k] * c[k]); }
#pragma unroll
                for (int k = 0; k < 8; ++k) vb[k] = vb[k] * y[k]; }
            float sa = 0.f, sb = 0.f;
#pragma unroll
            for (int k = 0; k < 8; ++k) { sa += va[k] * va[k]; sb += vb[k] * vb[k]; }
            const float ra = 1.0f / sqrtf(wave_sum(sa, lane) * (1.0f / 512.0f) + NORM_EPS), rb = 1.0f / sqrtf(half_sum(sb, lane) * (1.0f / 256.0f) + NORM_EPS);
            v4u oa, ob;
            oa.x = pk2(va[0] * ra * gA[0], va[1] * ra * gA[1]); oa.y = pk2(va[2] * ra * gA[2], va[3] * ra * gA[3]); oa.z = pk2(va[4] * ra * gA[4], va[5] * ra * gA[5]); oa.w = pk2(va[6] * ra * gA[6], va[7] * ra * gA[7]);
            ob.x = pk2(vb[0] * rb * gB[0], vb[1] * rb * gB[1]); ob.y = pk2(vb[2] * rb * gB[2], vb[3] * rb * gB[3]); ob.z = pk2(vb[4] * rb * gB[4], vb[5] * rb * gB[5]); ob.w = pk2(vb[6] * rb * gB[6], vb[7] * rb * gB[7]);
            *(v4u*)(CAT + (size_t)s * DM + 8 * lane) = oa; *(v4u*)(CAT + (size_t)s * DM + 512 + 8 * lane) = ob; }
    }
}

__device__ __forceinline__ void moe_route(Frame& F, const float* mod) {
    const bf16* XB = (const bf16*)(F.ws + WS_XB); unsigned char* XT = F.ws + WS_XT8;
    int* tok_e = (int*)(F.ws + WS_MISC + MS_TOKE); float* tok_g = (float*)(F.ws + WS_MISC + MS_TOKG);
    const float* wr = inp(F, I_ROUTER); const float* br = inp(F, I_ROUTERB);
    LAS int* le = (LAS int*)F.lds;
    LAS int* lcnt = le + 256;
    LAS f32x4* wl = (LAS f32x4*)(F.lds + 2048);
    bool tabled = false;
    for (int ch = blockIdx.x; ch < NTOK / 128; ch += F.G) {
        const int bch = (ch * 128) / SEQ; const float* mrow = mod + (size_t)bch * 6144;
        f32x4 shv[2][2], scv[2][2];
#pragma unroll
        for (int h = 0; h < 2; ++h)
#pragma unroll
            for (int q = 0; q < 2; ++q) { shv[h][q] = *(const f32x4*)(mrow + 3072 + 512 * h + 8 * F.lane + 4 * q); scv[h][q] = *(const f32x4*)(mrow + 4096 + 512 * h + 8 * F.lane + 4 * q) + 1.0f; }
        const int tok0 = ch * 128 + F.wave * 16; const GAS v4u* xr0 = (const GAS v4u*)(XB + (size_t)(bch * TPB + (tok0 - bch * SEQ)) * DM) + F.lane;
        constexpr int RR = 4;
        v4u nw[RR][2];
#pragma unroll
        for (int r = 0; r < RR; ++r) { nw[r][0] = __builtin_nontemporal_load(xr0 + 128 * r); nw[r][1] = __builtin_nontemporal_load(xr0 + 128 * r + 64); }
        if (!tabled) {
            for (int idx = F.tid; idx < 2048; idx += NWAVES * 64) { const int ln = idx & 63, hf = (idx >> 6) & 1, kk = (idx >> 7) & 7, hh = idx >> 10; wl[idx] = *(const f32x4*)(wr + (size_t)(512 * hh + 8 * ln + kk) * 8 + 4 * hf); }
            __syncthreads(); tabled = true; }
#pragma unroll 1
        for (int i = 0; i < 16; i += RR) {
            float v[RR][2][8];
#pragma unroll
            for (int r = 0; r < RR; ++r) { unpack8(nw[r][0], v[r][0]); unpack8(nw[r][1], v[r][1]); }
            if (i + RR < 16) {
#pragma unroll
                for (int r = 0; r < RR; ++r) { nw[r][0] = __builtin_nontemporal_load(xr0 + 128 * (i + RR + r)); nw[r][1] = __builtin_nontemporal_load(xr0 + 128 * (i + RR + r) + 64); } }
            float ss[RR];
#pragma unroll
            for (int r = 0; r < RR; ++r) { ss[r] = 0.f;
#pragma unroll
                for (int h = 0; h < 2; ++h)
#pragma unroll
                    for (int q = 0; q < 8; ++q) ss[r] += v[r][h][q] * v[r][h][q]; }
#pragma unroll
            for (int r = 0; r < RR; ++r) ss[r] = wave_sum(ss[r], F.lane);
            float rstd[RR];
#pragma unroll
            for (int r = 0; r < RR; ++r) rstd[r] = 1.0f / sqrtf(ss[r] * (1.0f / DM) + NORM_EPS);
            typedef float rt_f32x2 __attribute__((ext_vector_type(2)));
            float lg[RR][8]; rt_f32x2 lgp[RR][4]; v2u ow[RR][2];
#pragma unroll
            for (int r = 0; r < RR; ++r)
#pragma unroll
                for (int e = 0; e < 4; ++e) lgp[r][e] = (rt_f32x2){0.f, 0.f};
#pragma unroll
            for (int h = 0; h < 2; ++h) {
                float y[RR][8];
#pragma unroll
                for (int r = 0; r < RR; ++r) {
#pragma unroll
                    for (int q = 0; q < 4; ++q) { y[r][q] = v[r][h][q] * rstd[r] * scv[h][0][q] + shv[h][0][q]; y[r][4 + q] = v[r][h][4 + q] * rstd[r] * scv[h][1][q] + shv[h][1][q]; }
                    ow[r][h].x = pk4_f8(y[r][0], y[r][1], y[r][2], y[r][3]); ow[r][h].y = pk4_f8(y[r][4], y[r][5], y[r][6], y[r][7]); }
#pragma unroll
                for (int q = 0; q < 8; ++q) { const f32x4 wa = wl[((h * 8 + q) * 2 + 0) * 64 + F.lane], wb = wl[((h * 8 + q) * 2 + 1) * 64 + F.lane];
#pragma unroll
                    for (int r = 0; r < RR; ++r) { const rt_f32x2 yk = {y[r][q], y[r][q]};
                        lgp[r][0] += yk * (rt_f32x2){wa.x, wa.y}; lgp[r][1] += yk * (rt_f32x2){wa.z, wa.w}; lgp[r][2] += yk * (rt_f32x2){wb.x, wb.y}; lgp[r][3] += yk * (rt_f32x2){wb.z, wb.w}; } } }
#pragma unroll
            for (int r = 0; r < RR; ++r)
#pragma unroll
                for (int e = 0; e < 4; ++e) { lg[r][2 * e] = lgp[r][e].x; lg[r][2 * e + 1] = lgp[r][e].y; }
            { const int ln = F.lane; float t4[RR][4], t2[RR][2], t1[RR];
#pragma unroll
              for (int e = 0; e < 4; ++e)
#pragma unroll
                  for (int r = 0; r < RR; ++r) { const auto sw = __builtin_amdgcn_permlane32_swap(__float_as_uint(lg[r][e]), __float_as_uint(lg[r][e + 4]), false, false); t4[r][e] = __uint_as_float(sw[0]) + __uint_as_float(sw[1]); }
#pragma unroll
              for (int e = 0; e < 2; ++e)
#pragma unroll
                  for (int r = 0; r < RR; ++r) { const auto sw = __builtin_amdgcn_permlane16_swap(__float_as_uint(t4[r][e]), __float_as_uint(t4[r][e + 2]), false, false); t2[r][e] = __uint_as_float(sw[0]) + __uint_as_float(sw[1]); }
#pragma unroll
              for (int r = 0; r < RR; ++r) { const float s0 = t2[r][0] + dpp_mov<0x128>(t2[r][0]), s1 = t2[r][1] + dpp_mov<0x128>(t2[r][1]);
                  float t = (ln & 8) ? s1 : s0; t += dpp_mov<0xB1>(t); t += dpp_mov<0x4E>(t); t += dpp_mov<0x141>(t); t1[r] = t; }
#pragma unroll
              for (int r = 0; r < RR; ++r)
#pragma unroll
                  for (int e = 0; e < 8; ++e) lg[r][e] = __int_as_float(__builtin_amdgcn_readlane(__float_as_int(t1[r]), 8 * e)) + br[e]; }
#pragma unroll
            for (int r = 0; r < RR; ++r) { const int tl = F.wave * 16 + i + r, tok = ch * 128 + tl;
                int e0 = 0; float v0 = lg[r][0];
#pragma unroll
                for (int e = 1; e < 8; ++e) if (lg[r][e] > v0) { v0 = lg[r][e]; e0 = e; }
                int e1 = -1; float v1 = -3.0e38f;
#pragma unroll
                for (int e = 0; e < 8; ++e) if (e != e0 && lg[r][e] > v1) { v1 = lg[r][e]; e1 = e; }
                const float p1 = __expf(v1 - v0), g0 = 1.0f / (1.0f + p1), g1 = p1 / (1.0f + p1);
#pragma unroll
                for (int h = 0; h < 2; ++h) *((GAS v2u*)(XT + (size_t)tok * DM + 512 * h + 8 * F.lane)) = ow[r][h];
                if (F.lane == 0) { tok_e[2 * tok] = e0; tok_e[2 * tok + 1] = e1; tok_g[2 * tok] = g0; tok_g[2 * tok + 1] = g1; le[2 * tl] = e0; le[2 * tl + 1] = e1; } }
        }
        __syncthreads();
        if (F.tid < 256) { const int e = le[F.tid];
#pragma unroll
            for (int ee = 0; ee < 8; ++ee) { const unsigned long long m = __ballot(e == ee); if (F.lane == 0) lcnt[F.wave * 8 + ee] = __popcll(m); } }
        __syncthreads();
        if (F.tid < 8) F.ctl[CW_CNT + ch * 8 + F.tid] = (unsigned)(lcnt[F.tid] + lcnt[8 + F.tid] + lcnt[16 + F.tid] + lcnt[24 + F.tid]);
        __syncthreads();
    }
}
__device__ __forceinline__ void moe_sort_scatter(Frame& F) {
    const int* tok_e = (const int*)(F.ws + WS_MISC + MS_TOKE); const float* tok_g = (const float*)(F.ws + WS_MISC + MS_TOKG);
    int* tok_s = (int*)(F.ws + WS_MISC + MS_TOKS); float* slot_g = (float*)(F.ws + WS_MISC + MS_SLOTG); int* meta = (int*)(F.ws + WS_MISC + MS_META); int* slot_t = (int*)(F.ws + WS_MISC + MS_SLOTT);
    LAS int* ltot = (LAS int*)F.lds; LAS int* lpre = ltot + 8; LAS int* lps = ltot + 16; LAS int* wcnt = ltot + 32; LAS int* lslot = ltot + 64; LAS int* lacc = ltot + 320;
    for (int ch = blockIdx.x; ch < NTOK / 128; ch += F.G) {
        int myexp = 0;
        if (F.tid < 256) {
            const v4u c0 = *(const GAS v4u*)(F.ctl + CW_CNT + F.tid * 8), c1 = *(const GAS v4u*)(F.ctl + CW_CNT + F.tid * 8 + 4);
            const unsigned cn[8] = {c0.x, c0.y, c0.z, c0.w, c1.x, c1.y, c1.z, c1.w};
            myexp = tok_e[2 * (ch * 128) + F.tid];
#pragma unroll
            for (int e = 0; e < 8; ++e) { unsigned v = cn[e] | ((F.tid < ch) ? (cn[e] << 16) : 0u);
#pragma unroll
                for (int o = 1; o < 64; o <<= 1) v += (unsigned)__builtin_amdgcn_ds_bpermute((F.lane ^ o) << 2, (int)v);
                if (F.lane == 0) lacc[F.wave * 8 + e] = (int)v; }
        }
        __syncthreads();
        if (F.tid < 8) { const unsigned v = (unsigned)lacc[F.tid] + (unsigned)lacc[8 + F.tid] + (unsigned)lacc[16 + F.tid] + (unsigned)lacc[24 + F.tid]; ltot[F.tid] = (int)(v & 0xffffu); lpre[F.tid] = (int)(v >> 16); }
        __syncthreads();
        if (F.tid == 0) { int p = 0;
#pragma unroll
            for (int e = 0; e < 8; ++e) { lps[e] = p; p += (ltot[e] + 255) & ~255; } lps[8] = p; }
        int myrank = 0;
        if (F.tid < 256) {
#pragma unroll
            for (int ee = 0; ee < 8; ++ee) { const unsigned long long m = __ballot(myexp == ee); if (myexp == ee) myrank = __popcll(m & ((1ull << F.lane) - 1ull)); if (F.lane == 0) wcnt[F.wave * 8 + ee] = __popcll(m); } }
        __syncthreads();
        if (F.tid < 256) { int base = lps[myexp] + lpre[myexp] + myrank;
            for (int w = 0; w < F.wave; ++w) base += wcnt[w * 8 + myexp];
            tok_s[2 * (ch * 128) + F.tid] = base; slot_g[base] = tok_g[2 * (ch * 128) + F.tid]; slot_t[base] = ch * 128 + (F.tid >> 1); }
        __syncthreads();
        if (ch < 8) {
            const int p0 = lps[ch] + ltot[ch], p1 = lps[ch + 1];
            for (int r = p0 + F.tid; r < p1; r += NWAVES * 64) { slot_g[r] = 0.f; slot_t[r] = 0; }
        }
        if (ch == 0 && F.tid < 8) meta[F.tid] = lps[F.tid + 1] >> 8;
        __syncthreads();
    }
}
__device__ __forceinline__ void moe_combine(Frame& F, const float* mod, int mode, int slot_lim, int gw, int NGW) { const bf16* Y = (const bf16*)(F.ws + WS_XN); const bf16* XB = (const bf16*)(F.ws + WS_XB); const int* tok_s = (const int*)(F.ws + WS_MISC + MS_TOKS);
    constexpr int R = 4;
    for (int t0 = gw * R; t0 < NTOK; t0 += NGW * R) {
        v4u wx[R][2], wa[R][2], wc[R][2]; bool ok[R]; int sl0[R], sl1[R]; bool any = false;
#pragma unroll
        for (int r = 0; r < R; ++r) { sl0[r] = tok_s[2 * (t0 + r)]; sl1[r] = tok_s[2 * (t0 + r) + 1]; ok[r] = ((sl0[r] < slot_lim && sl1[r] < slot_lim) ? 0 : 1) == mode; any = any || ok[r]; }
        if (!any) continue;
#pragma unroll
        for (int r = 0; r < R; ++r) { const int tok = t0 + r, b = tok / SEQ, s = b * TPB + (tok - b * SEQ), s0 = sl0[r], s1 = sl1[r];
            const GAS v4u* xr = (const GAS v4u*)(XB + (size_t)s * DM) + F.lane; const GAS v4u* y0 = (const GAS v4u*)(Y + (size_t)s0 * DM) + F.lane; const GAS v4u* y1 = (const GAS v4u*)(Y + (size_t)s1 * DM) + F.lane;
#pragma unroll
            for (int h = 0; h < 2; ++h) { wx[r][h] = __builtin_nontemporal_load(xr + 64 * h); wa[r][h] = __builtin_nontemporal_load(y0 + 64 * h); wc[r][h] = __builtin_nontemporal_load(y1 + 64 * h); } }
        f32x4 gv[2][2];
        { const float* g = mod + (size_t)(t0 / SEQ) * 6144 + 5120;
#pragma unroll
          for (int h = 0; h < 2; ++h) { gv[h][0] = *(const f32x4*)(g + 512 * h + 8 * F.lane); gv[h][1] = *(const f32x4*)(g + 512 * h + 8 * F.lane + 4); } }
#pragma unroll
        for (int r = 0; r < R; ++r) { const int tok = t0 + r; float* orow = F.out + (size_t)tok * DM;
#pragma unroll
            for (int h = 0; h < 2; ++h) { float x[8], a[8], c[8]; unpack8(wx[r][h], x); unpack8(wa[r][h], a); unpack8(wc[r][h], c);
                const int c0 = 512 * h + 8 * F.lane; const f32x4 g0 = gv[h][0], g1 = gv[h][1];
                f32x4 o0, o1;
#pragma unroll
                for (int i = 0; i < 4; ++i) { o0[i] = x[i] + g0[i] * (a[i] + c[i]); o1[i] = x[4 + i] + g1[i] * (a[4 + i] + c[4 + i]); }
                if (ok[r]) { __builtin_nontemporal_store(o0, (GAS f32x4*)(orow + c0)); __builtin_nontemporal_store(o1, (GAS f32x4*)(orow + c0 + 4)); } } }
    }
}

struct Args { const float* in[24]; float* out; unsigned char* ws; int ph_lo, ph_hi, li, pad; };
__global__ void __launch_bounds__(NWAVES * 64, 2) mk_fwd(Args args) {
    extern __shared__ __attribute__((aligned(16))) unsigned char lds[];
    Frame F;
    F.lds = (LAS unsigned char*)lds; F.MISC = (volatile LAS unsigned*)(F.lds + MISC_OFF);
    F.tid = threadIdx.x; F.lane = F.tid & 63; F.wave = __builtin_amdgcn_readfirstlane(F.tid >> 6);
    F.G = gridDim.x; { const int bx = blockIdx.x; F.vcu = (F.G % 8 == 0) ? (bx % 8) * (F.G / 8) + bx / 8 : bx; }
    F.out = args.out; F.ws = args.ws; F.ctl = (unsigned*)(args.ws + WS_CTL);
    for (int u = F.tid; u < (LDS_BYTES - LDSCTL_OFF) / 4; u += NWAVES * 64) ((LAS unsigned*)(F.lds + LDSCTL_OFF))[u] = 0u;
    __syncthreads();
    if (F.tid < 24) { const unsigned long long p = (unsigned long long)args.in[F.tid]; LAS unsigned* t = (LAS unsigned*)(F.lds + LDSCTL_OFF + 64) + 2 * F.tid; t[0] = (unsigned)p; t[1] = (unsigned)(p >> 32); }
    __syncthreads();
    XcdBarrier bar; bar.bar = F.ctl + CW_BAR; bar.x = 0; bar.st = nullptr;
    if (MK_N_LAUNCHES == 1) bar = xcd_barrier_post(F.ctl + CW_BAR, F.MISC + 8);
    const int lo = args.ph_lo, hi = args.ph_hi;
#ifndef PHMASK
#define PHMASK 0xFFFFFFFFu
#endif
#define PHON(k) (((PHMASK) >> (k)) & 1u)
#define IN(k) (PHON(k) && lo <= (k) && (k) < hi)
#define INL(x) ((((PHMASK) >> (1 + (x))) & 1u) && lo <= pb + (x) && pb + (x) < hi)
#define INR(k) (lo <= (k) && (k) < hi)
#ifdef PROF_MASK
    if (F.tid == 0) { F.MISC[16] = (unsigned)__builtin_amdgcn_s_memrealtime(); F.MISC[17] = 0u; }
#define STAMP(k) do { if (F.wave == 0 && __builtin_amdgcn_mbcnt_hi(~0u, __builtin_amdgcn_mbcnt_lo(~0u, 0u)) == 0u) { const unsigned now_ = (unsigned)__builtin_amdgcn_s_memrealtime(); if (((unsigned)(PROF_MASK) >> (k)) & 1u) F.MISC[17] = F.MISC[17] + (now_ - F.MISC[16]); F.MISC[16] = now_; } } while (0)
#else
#define STAMP(k) do { } while (0)
#endif
#define SEAM(k) do { if (INR(k) && INR((k) + 1)) xcd_barrier(bar); STAMP(k); } while (0)
    bf16* XB = (bf16*)(F.ws + WS_XB); bf16* XN = (bf16*)(F.ws + WS_XN); bf16* P = (bf16*)(F.ws + WS_P);
    const float* MOD = (const float*)(F.ws + WS_MOD);
#define TABMEM (F.lds + LDSCTL_OFF + 448)
#define PF() do { int ln_ = (int)__builtin_amdgcn_mbcnt_hi(~0u, __builtin_amdgcn_mbcnt_lo(~0u, 0u)); asm volatile("" : "+v"(ln_)); F.lane = ln_; F.tid = F.wave * 64 + ln_; } while (0)

    if (IN(0)) { PF(); p0_prologue(F); } SEAM(0);

#pragma unroll 1
    for (int l = 0; l < 2; ++l) {
        const int pb = 1 + 9 * l; const bool last = (l == 1);
        const float* mod = MOD + (size_t)l * 17 * 6144;
        const float* xlat = inp(F, I_X); const float* xctx = inp(F, I_CTX);
        if (INL(0)) { PF(); if (!last) norm_mod_rows(F, xlat, xctx, mod, 0, 1024, XN, true, XB); else norm_mod_rows_bf(F, XB, mod, 0, 1024, XN); } SEAM(pb + 0);
        if (INL(1)) { PF();
            pg8::Gemm g{XN, (const bf16*)(F.ws + WS_WIN) + (size_t)l * INW * 1024, MROWS, INW, 1024};
            const pg8::TabOrder T = last ? pg8::build_units(TABMEM, 1024, XN, g.Bt, F.G, (int)blockIdx.x, 128, 9, 0, 1, 0, 16, 3, 6, 2, nullptr, 0, F.tid)
                                         : pg8::build_units(TABMEM, 1024, XN, g.Bt, F.G, (int)blockIdx.x, NPAN, 9, 0, 0, 0, 0, 1, 0, 0, nullptr, 0, F.tid);
#ifdef SEPARATE_HN
            pg8::EpiRawBf16 E{P, INW};
            pg8::gemm_phase<pg8::EpiRawBf16, pg8::TabOrder, true, true>(F.lds, g, T, E, F.wave);
#else
            { const float* tg = (const float*)(F.ws + WS_MISC + MS_ROPE); LAS float* tl = (LAS float*)(F.lds + 131072);
              for (int i = F.tid; i < 2048; i += NWAVES * 64) tl[i] = tg[i];
              if (F.tid < 256) { const int w = F.tid >> 6, d = F.tid & 63; const float* gs = w == 0 ? inp(F, I_GQA) : (w == 1 ? inp(F, I_GKA) : (w == 2 ? inp(F, I_GQB) : inp(F, I_GKB))); ((LAS float*)(F.lds + LDSCTL_OFF + 2048))[F.tid] = gs[l * 64 + d]; } }
            pg8::EpiHeads E{P, (const LAS float*)(F.lds + LDSCTL_OFF + 2048), (const LAS float*)(F.lds + 131072)};
            pg8::gemm_phase<pg8::EpiHeads, pg8::TabOrder, true, true>(F.lds, g, T, E, F.wave);
#endif
            if (!last) tail_convert(F, NPAN * 9, 0, CV_S1, 0, 1300); else tail_convert(F, 128 * 9 + 16 * 3, CV_S4, CV_MOE_ITEMS);
        } SEAM(pb + 1);
#ifdef SEPARATE_HN
        if (INL(2)) { PF(); headnorm_rows(F, l, !last); } SEAM(pb + 2);
#endif
        #ifdef ATTN_NAIVE
        if (INL(3)) { PF(); attn_naive_phase(F, l, !last); } SEAM(pb + 3);
#else
        if (INL(3)) { PF(); attn_mfma_phase(F, l, !last, (char*)lds); } SEAM(pb + 3);
#endif
        if (INL(4)) { PF(); merge_rows(F, l, !last); } SEAM(pb + 4);
        if (INL(5)) { PF();
            pg8::Gemm g{XN, (const bf16*)(F.ws + WS_WOUT) + (size_t)l * 1024 * 1024, MROWS, 1024, 1024};
            const pg8::TabOrder T = pg8::build_units(TABMEM, 1024, XN, g.Bt, F.G, (int)blockIdx.x, last ? 128 : NPAN, 4, 0, last ? 1 : 0, 0, 0, 1, 0, 0, nullptr, 0, F.tid);
            pg8::EpiGateRes<8> E{XB, mod, 2048, 1.0f};
            pg8::gemm_phase<pg8::EpiGateRes<8>, pg8::TabOrder, true, true>(F.lds, g, T, E, F.wave);
            if (!last) tail_convert(F, NPAN * 4, CV_S1, CV_S2, 1300, 3 * CV_IT_F);
        } SEAM(pb + 5);
        if (!last) {
            if (IN(7)) { PF(); norm_mod_rows_bf<true>(F, XB, mod, 3072, 4096, XN); } SEAM(7);
            if (IN(8)) { PF();
                pg8::Gemm g{XN, (const bf16*)(F.ws + WS_F13), MROWS, 5632, 512};
                const pg8::TabOrder T = pg8::build_units(TABMEM, 512, XN, g.Bt, F.G, (int)blockIdx.x, NPAN, 22, 0, 0, 0, 0, 1, 0, 0, nullptr, 0, F.tid);
                pg8::EpiSwigluF8 E{(unsigned char*)P, DFF, 1.0f / 64.0f};
                pg8::gemm_phase<pg8::EpiSwigluF8, pg8::TabOrder, true, true, true>(F.lds, g, T, E, F.wave);
                tail_convert(F, NPAN * 22, CV_S2, CV_S3);
            } SEAM(8);
            if (IN(9)) { PF();
                pg8::Gemm g{P, (const bf16*)(F.ws + WS_F2), MROWS, 1024, DFF / 2};
                const pg8::TabOrder T = pg8::build_units(TABMEM, DFF / 2, P, g.Bt, F.G, (int)blockIdx.x, NPAN, 4, 0, 0, 0, 0, 1, 0, 0, nullptr, 0, F.tid);
                pg8::EpiGateRes<4> E{XB, mod, 5120, 1.0f / 64.0f};
                pg8::gemm_phase<pg8::EpiGateRes<4>, pg8::TabOrder, true, true, true>(F.lds, g, T, E, F.wave);
                tail_convert(F, NPAN * 4, CV_S3, CV_S4);
            } SEAM(9);
        }
    }
    {
        const float* mod = MOD + (size_t)17 * 6144;
        if (IN(16)) { PF(); moe_route(F, mod); } SEAM(16);
        if (IN(17)) { PF(); moe_sort_scatter(F); } SEAM(17);
        const int* meta = (const int*)(F.ws + WS_MISC + MS_META);
        if (IN(18)) { PF();
            const int TP = __builtin_amdgcn_readfirstlane(meta[7]);
            pg8::Gemm g{(const bf16*)(F.ws + WS_XT8), (const bf16*)(F.ws + WS_M13), 0, 5632, 512};
            const pg8::TabOrder T = pg8::build_units(TABMEM, 512, g.A, g.Bt, F.G, (int)blockIdx.x, TP, 22, 0, 0, 0, 0, 1, 0, 0, meta, (size_t)5632 * 1024, F.tid);
            { const int* slot_t = (const int*)(F.ws + WS_MISC + MS_SLOTT); LAS unsigned short* idt = (LAS unsigned short*)(F.lds + LDS_IDS_OFF);
              int pmv[16], idv[16];
#pragma unroll
              for (int q = 0; q < 16; ++q) { const int i = (F.tid >> 8) + 2 * q; pmv[q] = T.tab[8 * i + 6] ? (int)T.tab[8 * i + 4] : -1; }
#pragma unroll
              for (int q = 0; q < 16; ++q) idv[q] = pmv[q] >= 0 ? slot_t[pmv[q] * 256 + (F.tid & 255)] : 0;
#pragma unroll
              for (int q = 0; q < 16; ++q) idt[((F.tid >> 8) + 2 * q) * 256 + (F.tid & 255)] = (unsigned short)idv[q];
              __syncthreads(); }
            pg8::EpiSwigluF8 E{F.ws + WS_H8, DFF, 1.0f / 64.0f};
            pg8::gemm_phase<pg8::EpiSwigluF8, pg8::TabOrder, true, true, true, true>(F.lds, g, T, E, F.wave);
        } SEAM(18);
        if (IN(19)) { PF();
            const int TP = __builtin_amdgcn_readfirstlane(meta[7]), npa = TP < 256 ? TP : 256;
            pg8::Gemm g{(const bf16*)(F.ws + WS_H8), (const bf16*)(F.ws + WS_M2), 0, 1024, DFF / 2};
            const pg8::TabOrder T = pg8::build_units(TABMEM, DFF / 2, g.A, g.Bt, F.G, (int)blockIdx.x, npa, 4, 0, 0, 0, 0, 1, 0, 0, meta, (size_t)1024 * DFF, F.tid);
            pg8::EpiMoeOut E{XN, (const float*)(F.ws + WS_MISC + MS_SLOTG), 1.0f / 64.0f};
            pg8::gemm_phase<pg8::EpiMoeOut, pg8::TabOrder, true, true, true>(F.lds, g, T, E, F.wave);
        } SEAM(19);
        if (IN(20)) { PF();
            const int TP = __builtin_amdgcn_readfirstlane(meta[7]), npa = TP < 256 ? TP : 256, npb = TP - npa, n1 = npb * 4;
            if (n1 > 0 && n1 < F.G) {
                pg8::Gemm g{(const bf16*)(F.ws + WS_H8), (const bf16*)(F.ws + WS_M2), 0, 1024, DFF / 2};
                const pg8::TabOrder T = pg8::build_units(TABMEM, DFF / 2, g.A, g.Bt, F.G, (int)blockIdx.x, npb, 4, 0, 0, 256, 0, 1, 0, 0, meta, (size_t)1024 * DFF, F.tid);
                pg8::EpiMoeOut E{XN, (const float*)(F.ws + WS_MISC + MS_SLOTG), 1.0f / 64.0f};
                pg8::gemm_phase<pg8::EpiMoeOut, pg8::TabOrder, true, true, true>(F.lds, g, T, E, F.wave);
                if ((int)blockIdx.x >= n1) moe_combine(F, mod, 0, npa * 256, ((int)blockIdx.x - n1) * NWAVES + F.wave, (F.G - n1) * NWAVES);
            } else if (n1 == 0) moe_combine(F, mod, 0, npa * 256, F.vcu * NWAVES + F.wave, F.G * NWAVES);
            else {
                pg8::Gemm g{(const bf16*)(F.ws + WS_H8), (const bf16*)(F.ws + WS_M2), 0, 1024, DFF / 2};
                const pg8::TabOrder T = pg8::build_units(TABMEM, DFF / 2, g.A, g.Bt, F.G, (int)blockIdx.x, npb, 4, 0, 0, 256, 0, 1, 0, 0, meta, (size_t)1024 * DFF, F.tid);
                pg8::EpiMoeOut E{XN, (const float*)(F.ws + WS_MISC + MS_SLOTG), 1.0f / 64.0f};
                pg8::gemm_phase<pg8::EpiMoeOut, pg8::TabOrder, true, true, true>(F.lds, g, T, E, F.wave);
            }
        } SEAM(20);
        if (IN(22)) { PF();
            const int TP = __builtin_amdgcn_readfirstlane(meta[7]), npa = TP < 256 ? TP : 256, n1 = (TP - npa) * 4;
            if (n1 >= F.G) moe_combine(F, mod, 0, npa * 256, F.vcu * NWAVES + F.wave, F.G * NWAVES);
            moe_combine(F, mod, 1, npa * 256, F.vcu * NWAVES + F.wave, F.G * NWAVES);
        }
        STAMP(22);
    }
#ifdef PROF_MASK
    if (blockIdx.x == 0 && F.wave == 0 && __builtin_amdgcn_mbcnt_hi(~0u, __builtin_amdgcn_mbcnt_lo(~0u, 0u)) == 0u) { const unsigned long long t0_ = __builtin_amdgcn_s_memrealtime(); const unsigned long long w_ = 8ull * F.MISC[17]; while (__builtin_amdgcn_s_memrealtime() - t0_ < w_) __builtin_amdgcn_s_sleep(8); }
#endif
#undef IN
#undef SEAM
}

extern "C" void kernel_launch(void* const* d_in, const int* in_sizes, int n_in, void* d_out, int out_size, void* d_ws, size_t ws_size, hipStream_t stream) {
    static int grid = 0;
    if (grid == 0) {
        if (n_in != 24 || in_sizes[0] != BATCH * SEQ * DM || out_size != BATCH * SEQ * DM || ws_size < WS_END) { fprintf(stderr, "kernel_launch: unexpected shapes / workspace (n_in %d, ws %zu, need %zu); nothing launched\n", n_in, ws_size, (size_t)WS_END); grid = -1; return; }
        int dev = 0, cus = 0, per_cu = 0;
        if (hipGetDevice(&dev) != hipSuccess || hipDeviceGetAttribute(&cus, hipDeviceAttributeMultiprocessorCount, dev) != hipSuccess) { grid = -1; return; }
        if (hipFuncSetAttribute((const void*)mk_fwd, hipFuncAttributeMaxDynamicSharedMemorySize, LDS_BYTES) != hipSuccess) { fprintf(stderr, "kernel_launch: hipFuncSetAttribute failed\n"); grid = -1; return; }
        if (hipOccupancyMaxActiveBlocksPerMultiprocessor(&per_cu, (const void*)mk_fwd, NWAVES * 64, LDS_BYTES) != hipSuccess || per_cu < 1) fprintf(stderr, "kernel_launch: occupancy query reports %d\n", per_cu);
        (void)hipGetLastError();
        grid = cus;
    }
    if (grid < 0) return;
    if (hipMemsetAsync((char*)d_ws + WS_CTL, 0, CTL_ZERO_BYTES, stream) != hipSuccess) return;
    Args a{};
    for (int i = 0; i < 24; ++i) a.in[i] = (const float*)d_in[i];
    a.out = (float*)d_out; a.ws = (unsigned char*)d_ws; a.pad = 0;
    const int nl = MK_N_LAUNCHES == 1 ? 1 : NPH;
    for (int li = 0; li < nl; ++li) {
        a.ph_lo = nl == 1 ? 0 : li; a.ph_hi = nl == 1 ? NPH : li + 1; a.li = 0;
        hipLaunchKernelGGL(mk_fwd, dim3(grid), dim3(NWAVES * 64), LDS_BYTES, stream, a);
        const hipError_t le = hipPeekAtLastError();
        if (le != hipSuccess) { fprintf(stderr, "kernel_launch: launch %d failed: %s\n", li, hipGetErrorName(le)); break; }
    }
}
```
